# Optimizing an MI355X kernel written in HIP

```python
import math
import jax, jax.numpy as jnp
from jax import lax
import numpy as np

D_MODEL = 2048
BATCH = 4
SEQ = 2048
DEPTH = 2
DEC_BATCH = 128
DEC_SEQ = 1
PAST_LEN = 16384
PAGE_SIZE = 128

N_META = 16
CHUNK = 64
D_FF = 4 * D_MODEL
H_A = 4
W_A = D_MODEL // 2
DH_A = W_A // H_A
H_B = 8
W_B = D_MODEL // 2
DH_B = W_B // H_B
CONV_W = 4
DH_C = 64
W_C = D_MODEL // 2
H_C = W_C // DH_C
R_W = D_MODEL // 32
R_A = D_MODEL // 32
R_G = D_MODEL // 16
N_A = 4 * W_A + 2 * H_A
N_B = 4 * W_B + 2 * H_B
N_C = 3 * W_C + R_W + R_A + R_G
N_GATE = 3 * D_MODEL
N_IN = N_A + N_B + N_C + N_GATE
RMS_EPS = 1e-6
GN_EPS = 64e-5
L2_EPS = 1e-12

kernel_name = "hybrid_mlstm_gdn_rwkv7_step"


def _split(x, sizes):
    offs, o = [], 0
    for s in sizes[:-1]:
        o += s
        offs.append(o)
    return jnp.split(x, offs, axis=-1)


def _rms(x, w, eps=RMS_EPS):
    xf = x.astype(jnp.float32)
    y = xf * lax.rsqrt(jnp.mean(xf * xf, axis=-1, keepdims=True) + eps)
    return (y * w.astype(jnp.float32)).astype(x.dtype)


def _l2norm(x):
    return x * lax.rsqrt(jnp.sum(x * x, axis=-1, keepdims=True) + L2_EPS)


def _run_chunks(chunk_fn, state, xs, lead, chunk):
    ys = []
    if lead > 0:
        state, y = chunk_fn(state, tuple(x[:, :lead] for x in xs))
        ys.append(y)
    rest = xs[0].shape[1] - lead
    if rest > 0:
        n = rest // chunk
        blocks = tuple(jnp.swapaxes(x[:, lead:].reshape(x.shape[0], n, chunk, *x.shape[2:]), 0, 1) for x in xs)
        state, yb = lax.scan(chunk_fn, state, blocks)
        yb = jnp.swapaxes(yb, 0, 1)
        ys.append(yb.reshape(yb.shape[0], n * chunk, *yb.shape[3:]))
    return state, jnp.concatenate(ys, axis=1)


def _mlstm_chunk(state, xs):
    c, n, m = state
    q, k, v, logi, logf = xs
    L = q.shape[1]
    b = jnp.swapaxes(jnp.cumsum(logf, axis=1), 1, 2)
    li = jnp.swapaxes(logi, 1, 2)
    causal = jnp.tril(jnp.ones((L, L), dtype=bool))
    d_mat = jnp.where(causal, b[..., :, None] - b[..., None, :] + li[..., None, :], -jnp.inf)
    inter = b + m[..., None]
    m_row = jnp.maximum(inter, jnp.max(d_mat, axis=-1))
    w_intra = jnp.exp(d_mat - m_row[..., None])
    w_inter = jnp.exp(inter - m_row)
    s = jnp.einsum('blhd,bshd->bhls', q, k) * w_intra
    num = (jnp.einsum('bhls,bshd->blhd', s, v)
           + jnp.swapaxes(w_inter, 1, 2)[..., None] * jnp.einsum('blhk,bhkv->blhv', q, c))
    den = jnp.sum(s, axis=-1) + w_inter * jnp.einsum('blhk,bhk->bhl', q, n)
    den = jnp.maximum(jnp.abs(den), jnp.exp(-m_row))
    h = num / jnp.swapaxes(den, 1, 2)[..., None]
    b_last = b[..., -1]
    g = b_last[..., None] - b + li
    m_new = jnp.maximum(b_last + m, jnp.max(g, axis=-1))
    w_state = jnp.exp(g - m_new[..., None])
    decay = jnp.exp(b_last + m - m_new)
    c = decay[..., None, None] * c + jnp.einsum('bhs,bshk,bshv->bhkv', w_state, k, v)
    n = decay[..., None] * n + jnp.einsum('bhs,bshk->bhk', w_state, k)
    return (c, n, m_new), h


def _gdn_chunk(s, xs):
    q, k, v, log_alpha, beta = xs
    L = q.shape[1]
    q, k, v = (jnp.swapaxes(t, 1, 2) for t in (q, k, v))
    g = jnp.swapaxes(jnp.cumsum(log_alpha, axis=1), 1, 2)
    beta = jnp.swapaxes(beta, 1, 2)
    incl = jnp.tril(jnp.ones((L, L), dtype=bool))
    strict = jnp.tril(jnp.ones((L, L), dtype=bool), -1)
    decay = jnp.exp(jnp.where(incl, g[..., :, None] - g[..., None, :], -jnp.inf))
    a_mat = jnp.where(strict, beta[..., :, None] * jnp.einsum('bhld,bhsd->bhls', k, k) * decay, 0.0)
    eye = jnp.eye(L, dtype=q.dtype)
    rhs = jnp.concatenate([v * beta[..., None], k * (beta * jnp.exp(g))[..., None]], axis=-1)
    sol = lax.linalg.triangular_solve(a_mat + eye, rhs, left_side=True, lower=True, unit_diagonal=True)
    u, w = sol[..., :v.shape[-1]], sol[..., v.shape[-1]:]
    v_new = u - jnp.einsum('bhlk,bhkv->bhlv', w, s)
    attn = jnp.where(incl, jnp.einsum('bhld,bhsd->bhls', q, k) * decay, 0.0)
    o = (jnp.einsum('bhlk,bhkv->bhlv', q * jnp.exp(g)[..., None], s)
         + jnp.einsum('bhls,bhsv->bhlv', attn, v_new))
    g_last = g[..., -1]
    s = (jnp.exp(g_last)[..., None, None] * s
         + jnp.einsum('bhsk,bhsv->bhkv', k * jnp.exp(g_last[..., None] - g)[..., None], v_new))
    return s, jnp.swapaxes(o, 1, 2)


def _rwkv_step(s, xs):
    r, w, k, v, a_vec, b_vec = xs
    sa = jnp.einsum('bhvk,bhk->bhv', s, a_vec)
    s = s * w[:, :, None, :] + sa[..., None] * b_vec[:, :, None, :] + v[..., None] * k[:, :, None, :]
    return s, jnp.einsum('bhvk,bhk->bhv', s, r)


def _causal_conv(buf, u, w):
    T = u.shape[1]
    full = jnp.concatenate([buf, u], axis=1)
    y = sum(full[:, j:j + T] * w[j] for j in range(CONV_W))
    return y, full[:, T:]


def _mlstm_branch(pa, c0, n0, m0, b_i, b_f, norm_w, lead, chunk):
    B, T, _ = pa.shape
    q, k, v, o, ig, fg = _split(pa, (W_A, W_A, W_A, W_A, H_A, H_A))
    heads = lambda t: t.reshape(B, T, H_A, DH_A)
    logi = ig + b_i
    logf = jax.nn.log_sigmoid(fg + b_f)
    (c, n, m), h = _run_chunks(_mlstm_chunk, (c0, n0, m0),
                               (heads(q), heads(k) * DH_A ** -0.5, heads(v), logi, logf), lead, chunk)
    h = _rms(h, norm_w.reshape(H_A, DH_A))
    return jax.nn.sigmoid(o) * h.reshape(B, T, W_A), c, n, m


def _gdn_branch(pb, conv_buf, s0, conv_w, a_log, dt_bias, norm_w, lead, chunk):
    B, T, _ = pb.shape
    qkv, z, a, b = _split(pb, (3 * W_B, W_B, H_B, H_B))
    qkv, new_buf = _causal_conv(conv_buf, qkv, conv_w)
    q, k, v = [t.reshape(B, T, H_B, DH_B) for t in _split(jax.nn.silu(qkv), (W_B, W_B, W_B))]
    q = _l2norm(q) * DH_B ** -0.5
    k = _l2norm(k)
    log_alpha = -jnp.exp(a_log) * jax.nn.softplus(a + dt_bias)
    beta = jax.nn.sigmoid(b)
    s, o = _run_chunks(_gdn_chunk, s0, (q, k, v, log_alpha, beta), lead, chunk)
    o = _rms(o, norm_w) * jax.nn.silu(z.reshape(B, T, H_B, DH_B))
    return o.reshape(B, T, W_B), s, new_buf


def _rwkv_branch(pc, shift_buf, s0, mu, w0, w2, a0, a2, g2, k_k, k_a, r_k, ln_w, ln_b):
    B, T, _ = pc.shape
    prev = jnp.concatenate([shift_buf[:, None], pc[:, :-1]], axis=1)
    xm = pc + (prev - pc) * mu
    r, k, v, xw, xa, xg = _split(xm, (W_C, W_C, W_C, R_W, R_A, R_G))
    w_log = -jax.nn.softplus(-(w0 + jnp.tanh(xw) @ w2)) - 0.5
    decay = jnp.exp(-jnp.exp(w_log))
    a = jax.nn.sigmoid(a0 + xa @ a2)
    g = jax.nn.sigmoid(xg) @ g2
    heads = lambda t: t.reshape(B, T, H_C, DH_C)
    kk = _l2norm(heads(k * k_k))
    k = k * (1.0 + (a - 1.0) * k_a)
    r_h, k_h, v_h, a_h = heads(r), heads(k), heads(v), heads(a)
    tm = lambda t: jnp.swapaxes(t, 0, 1)
    s, y = lax.scan(_rwkv_step, s0, (tm(r_h), tm(heads(decay)), tm(k_h), tm(v_h), tm(-kk), tm(kk * a_h)))
    y = tm(y)
    mean = jnp.mean(y, axis=-1, keepdims=True)
    var = jnp.mean(jnp.square(y - mean), axis=-1, keepdims=True)
    y = (y - mean) * lax.rsqrt(var + GN_EPS) * ln_w.reshape(H_C, DH_C) + ln_b.reshape(H_C, DH_C)
    y = y + jnp.sum(r_h * k_h * r_k, axis=-1, keepdims=True) * v_h
    return y.reshape(B, T, W_C) * g, s, pc[:, -1]


def _hybrid_layer(x, st, lp, lead, chunk):
    f32 = lambda t: t.astype(jnp.float32)
    c0, n0, m0, gs0, gconv0, rs0, rshift0 = [f32(s) for s in st]
    B, T, _ = x.shape
    dt = x.dtype
    h = _rms(x, lp["norm_mix_w"])
    proj = f32(h @ lp["w_in"])
    pa, pb, pc, pg = _split(proj, (N_A, N_B, N_C, N_GATE))
    ya, c, n, m = _mlstm_branch(pa, c0, n0, m0, f32(lp["mlstm_b_i"]), f32(lp["mlstm_b_f"]),
                                f32(lp["mlstm_norm_w"]), lead, chunk)
    yb, gs, gconv = _gdn_branch(pb, gconv0, gs0, f32(lp["gdn_conv_w"]), f32(lp["gdn_a_log"]),
                                f32(lp["gdn_dt_bias"]), f32(lp["gdn_norm_w"]), lead, chunk)
    yc, rs, rshift = _rwkv_branch(pc, rshift0, rs0, f32(lp["rwkv_mu"]), f32(lp["rwkv_w0"]), f32(lp["rwkv_w2"]),
                                  f32(lp["rwkv_a0"]), f32(lp["rwkv_a2"]), f32(lp["rwkv_g2"]), f32(lp["rwkv_k_k"]),
                                  f32(lp["rwkv_k_a"]), f32(lp["rwkv_r_k"]), f32(lp["rwkv_ln_w"]), f32(lp["rwkv_ln_b"]))
    gates = jax.nn.sigmoid(pg).astype(dt).reshape(B, T, 3, D_MODEL)
    merged = (gates[:, :, 0] * (ya.astype(dt) @ lp["w_branch_a"])
              + gates[:, :, 1] * (yb.astype(dt) @ lp["w_branch_b"])
              + gates[:, :, 2] * (yc.astype(dt) @ lp["w_branch_c"]))
    x = x + merged @ lp["w_out"]
    u = jax.nn.relu(_rms(x, lp["norm_mlp_w"]) @ lp["w_up"])
    x = x + (u * u) @ lp["w_down"]
    return x, (c, n, m, gs, gconv, rs, rshift)


def _trunk(x, states, layers, final_norm_w, lead, chunk):
    new = [[] for _ in states]
    for l in range(DEPTH):
        lp = {name: p[l] for name, p in layers.items()}
        x, st = _hybrid_layer(x, [s[l] for s in states], lp, lead, chunk)
        for acc, s in zip(new, st):
            acc.append(s)
    return _rms(x, final_norm_w), [jnp.stack(acc) for acc in new]


def _zero_states(b):
    z = lambda *shape: jnp.zeros((DEPTH, b) + shape, jnp.float32)
    return [z(H_A, DH_A, DH_A), z(H_A, DH_A), z(H_A), z(H_B, DH_B, DH_B),
            z(CONV_W - 1, 3 * W_B), z(H_C, DH_C, DH_C), z(N_C)]


def setup_inputs(seed: int = 0) -> dict:
    key = jax.random.key(seed)
    keys = jax.random.split(key, 48)
    counter = iter(range(48))
    nxt = lambda: keys[next(counter)]
    nrm = lambda shape, scale=1.0: scale * jax.random.normal(nxt(), shape, jnp.float32)
    uni = lambda shape, lo, hi: jax.random.uniform(nxt(), shape, jnp.float32, lo, hi)
    gain = lambda shape: 1.0 + 0.02 * jax.random.normal(nxt(), shape, jnp.float32)
    L = DEPTH
    out = {
        "x_prompt": nrm((BATCH, SEQ, D_MODEL)),
        "x_sample": nrm((DEC_BATCH, DEC_SEQ, D_MODEL)),
        "state_mlstm_c": nrm((L, DEC_BATCH, H_A, DH_A, DH_A), 0.1),
        "state_mlstm_n": nrm((L, DEC_BATCH, H_A, DH_A)),
        "state_mlstm_m": nrm((L, DEC_BATCH, H_A), 0.5),
        "state_gdn_s": nrm((L, DEC_BATCH, H_B, DH_B, DH_B), 0.1),
        "state_gdn_conv": nrm((L, DEC_BATCH, CONV_W - 1, 3 * W_B)),
        "state_rwkv_s": nrm((L, DEC_BATCH, H_C, DH_C, DH_C), 0.1),
        "state_rwkv_shift": nrm((L, DEC_BATCH, N_C)),
        "meta_tokens": nrm((N_META, D_MODEL)),
        "norm_mix_w": gain((L, D_MODEL)),
        "w_in": nrm((L, D_MODEL, N_IN), D_MODEL ** -0.5),
        "mlstm_b_i": nrm((L, H_A), 0.1),
        "mlstm_b_f": 3.0 + nrm((L, H_A), 0.5),
        "mlstm_norm_w": gain((L, W_A)),
        "gdn_conv_w": nrm((L, CONV_W, 3 * W_B), CONV_W ** -0.5),
        "gdn_a_log": jnp.log(uni((L, H_B), 1.0, 16.0)),
        "gdn_dt_bias": jnp.log(jnp.expm1(jnp.exp(uni((L, H_B), math.log(1e-3), math.log(1e-1))))),
        "gdn_norm_w": gain((L, DH_B)),
        "rwkv_mu": uni((L, N_C), 0.0, 1.0),
        "rwkv_w0": uni((L, W_C), -6.0, 1.0),
        "rwkv_w2": nrm((L, R_W, W_C), 0.1 * R_W ** -0.5),
        "rwkv_a0": nrm((L, W_C), 0.1),
        "rwkv_a2": nrm((L, R_A, W_C), 0.5 * R_A ** -0.5),
        "rwkv_g2": nrm((L, R_G, W_C), R_G ** -0.5),
        "rwkv_k_k": 0.85 + nrm((L, W_C), 0.05),
        "rwkv_k_a": uni((L, W_C), 0.5, 1.0),
        "rwkv_r_k": nrm((L, H_C, DH_C), 0.1),
        "rwkv_ln_w": gain((L, W_C)),
        "rwkv_ln_b": nrm((L, W_C), 0.01),
        "w_branch_a": nrm((L, W_A, D_MODEL), W_A ** -0.5),
        "w_branch_b": nrm((L, W_B, D_MODEL), W_B ** -0.5),
        "w_branch_c": nrm((L, W_C, D_MODEL), W_C ** -0.5),
        "w_out": nrm((L, D_MODEL, D_MODEL), D_MODEL ** -0.5),
        "norm_mlp_w": gain((L, D_MODEL)),
        "w_up": nrm((L, D_MODEL, D_FF), D_MODEL ** -0.5),
        "w_down": nrm((L, D_FF, D_MODEL), D_FF ** -0.5),
        "final_norm_w": gain((D_MODEL,)),
    }
    return out


def reference(x_prompt, x_sample, state_mlstm_c, state_mlstm_n, state_mlstm_m, state_gdn_s, state_gdn_conv,
              state_rwkv_s, state_rwkv_shift, meta_tokens, norm_mix_w, w_in, mlstm_b_i, mlstm_b_f, mlstm_norm_w,
              gdn_conv_w, gdn_a_log, gdn_dt_bias, gdn_norm_w, rwkv_mu, rwkv_w0, rwkv_w2, rwkv_a0, rwkv_a2,
              rwkv_g2, rwkv_k_k, rwkv_k_a, rwkv_r_k, rwkv_ln_w, rwkv_ln_b, w_branch_a, w_branch_b, w_branch_c,
              w_out, norm_mlp_w, w_up, w_down, final_norm_w):
    layers = {
        "norm_mix_w": norm_mix_w, "w_in": w_in, "mlstm_b_i": mlstm_b_i, "mlstm_b_f": mlstm_b_f,
        "mlstm_norm_w": mlstm_norm_w, "gdn_conv_w": gdn_conv_w, "gdn_a_log": gdn_a_log,
        "gdn_dt_bias": gdn_dt_bias, "gdn_norm_w": gdn_norm_w, "rwkv_mu": rwkv_mu, "rwkv_w0": rwkv_w0,
        "rwkv_w2": rwkv_w2, "rwkv_a0": rwkv_a0, "rwkv_a2": rwkv_a2, "rwkv_g2": rwkv_g2,
        "rwkv_k_k": rwkv_k_k, "rwkv_k_a": rwkv_k_a, "rwkv_r_k": rwkv_r_k, "rwkv_ln_w": rwkv_ln_w,
        "rwkv_ln_b": rwkv_ln_b, "w_branch_a": w_branch_a, "w_branch_b": w_branch_b,
        "w_branch_c": w_branch_c, "w_out": w_out, "norm_mlp_w": norm_mlp_w, "w_up": w_up, "w_down": w_down,
    }
    b = x_prompt.shape[0]
    meta = jnp.broadcast_to(meta_tokens.astype(x_prompt.dtype)[None], (b, N_META, D_MODEL))
    xp = jnp.concatenate([meta, x_prompt], axis=1)
    yp, sp = _trunk(xp, _zero_states(b), layers, final_norm_w, N_META, CHUNK)
    y_prompt = yp[:, N_META:]
    y_sample, ss = _trunk(x_sample, [state_mlstm_c, state_mlstm_n, state_mlstm_m, state_gdn_s, state_gdn_conv,
                                     state_rwkv_s, state_rwkv_shift],
                          layers, final_norm_w, x_sample.shape[1], CHUNK)
    p_c, p_n, p_m, p_gs, p_gconv, p_rs, p_rshift = sp
    s_c, s_n, s_m, s_gs, s_gconv, s_rs, s_rshift = ss
    return (y_prompt, y_sample, p_c, p_n, p_m, p_gs, p_gconv, p_rs, p_rshift,
            s_c, s_n, s_m, s_gs, s_gconv, s_rs, s_rshift)
```

```cpp
#include <hip/hip_runtime.h>
#include <cstdio>
#include <cstdint>

#ifndef MK_MULTI
#define MK_MULTI 0
#endif

#ifndef REP_PREP
#define REP_PREP 1
#endif
#ifndef REP_MISC
#define REP_MISC 1
#endif
#ifndef REP_SEQ
#define REP_SEQ 1
#endif
#ifndef REP_G1
#define REP_G1 1
#endif
#ifndef REP_G4
#define REP_G4 1
#endif
#define LAS __attribute__((address_space(3)))
#define GAS __attribute__((address_space(1)))
typedef unsigned short bf16_t;
typedef short bf16x8 __attribute__((ext_vector_type(8)));
typedef float f32x4 __attribute__((ext_vector_type(4)));
typedef float f32x2 __attribute__((ext_vector_type(2)));
typedef unsigned u32x4 __attribute__((ext_vector_type(4)));
typedef unsigned u32x2 __attribute__((ext_vector_type(2)));

constexpr int D = 2048, BATCH = 4, SEQ = 2048, NMETA = 16, TP = SEQ + NMETA, NB = 128;
constexpr int MPROMPT = BATCH * TP;
constexpr int MREAL = MPROMPT + NB;
constexpr int MP = 8448;
constexpr int NSEQ = BATCH + NB;
constexpr int HA = 4, DHA = 256, HB = 8, DHB = 128, HC = 16, DHC = 64;
constexpr int NCC = 3328, NIN = 17688, NPROJ = 17664, DFF = 8192;
constexpr int PA_Q = 0, PA_K = 1024, PA_V = 2048, PA_O = 3072, PB_QKV = 4096, PB_Z = 7168, PC0 = 8192, PG0 = 11520;
constexpr int NSG = 24, SGLD = 32;
constexpr int YLD = 3072;

constexpr size_t O_YP = 0;
constexpr size_t O_YS = O_YP + (size_t)BATCH * SEQ * D;
constexpr size_t O_PC = O_YS + (size_t)NB * D;
constexpr size_t O_PN = O_PC + (size_t)2 * BATCH * HA * DHA * DHA;
constexpr size_t O_PM = O_PN + (size_t)2 * BATCH * HA * DHA;
constexpr size_t O_PGS = O_PM + (size_t)2 * BATCH * HA;
constexpr size_t O_PGC = O_PGS + (size_t)2 * BATCH * HB * DHB * DHB;
constexpr size_t O_PRS = O_PGC + (size_t)2 * BATCH * 3 * 3072;
constexpr size_t O_PRSH = O_PRS + (size_t)2 * BATCH * HC * DHC * DHC;
constexpr size_t O_SC = O_PRSH + (size_t)2 * BATCH * NCC;
constexpr size_t O_SN = O_SC + (size_t)2 * NB * HA * DHA * DHA;
constexpr size_t O_SM = O_SN + (size_t)2 * NB * HA * DHA;
constexpr size_t O_SGS = O_SM + (size_t)2 * NB * HA;
constexpr size_t O_SGC = O_SGS + (size_t)2 * NB * HB * DHB * DHB;
constexpr size_t O_SRS = O_SGC + (size_t)2 * NB * 3 * 3072;
constexpr size_t O_SRSH = O_SRS + (size_t)2 * NB * HC * DHC * DHC;
constexpr size_t O_END = O_SRSH + (size_t)2 * NB * NCC;
static_assert(O_END == 141732896ull, "output size");

constexpr size_t AL(size_t x) { return (x + 255) & ~(size_t)255; }
constexpr size_t WS_CTL = 0, CTL_BYTES = 1u << 20;
constexpr size_t WS_WIN = CTL_BYTES;
constexpr size_t WS_WSG = AL(WS_WIN + (size_t)2 * NPROJ * D * 2);
constexpr size_t WS_WBR = AL(WS_WSG + (size_t)2 * NSG * D * 4);
constexpr size_t WS_WOUT = AL(WS_WBR + (size_t)2 * 3 * D * 1024 * 2);
constexpr size_t WS_WUP = AL(WS_WOUT + (size_t)2 * D * D * 2);
constexpr size_t WS_WDN = AL(WS_WUP + (size_t)2 * DFF * D * 2);
constexpr size_t WS_X = AL(WS_WDN + (size_t)2 * D * DFF * 2);
constexpr size_t WS_HN = AL(WS_X + (size_t)MP * D * 4);
constexpr size_t WS_SG = AL(WS_HN + (size_t)MP * D * 2);
constexpr size_t WS_YBR = AL(WS_SG + (size_t)MP * SGLD * 4);
constexpr size_t WS_MRG = AL(WS_YBR + (size_t)MP * YLD * 2);
constexpr size_t WS_PROJ = AL(WS_MRG + (size_t)MP * D * 2);
constexpr size_t WS_MRGF = AL(WS_PROJ + (size_t)MP * NPROJ * 2);
constexpr int NCH = 33;
constexpr int NU_ML = BATCH * HA * NCH, NU_GD = BATCH * HB * NCH, NU_RW = BATCH * HC * NCH;
constexpr size_t WS_ML_KTW = WS_MRGF;
constexpr size_t WS_ML_VT = AL(WS_ML_KTW + (size_t)NU_ML * 256 * 64 * 2);
constexpr size_t WS_ML_NP = AL(WS_ML_VT + (size_t)NU_ML * 256 * 64 * 2);
constexpr size_t WS_ML_SC = AL(WS_ML_NP + (size_t)NU_ML * 64 * 256 * 4);
constexpr size_t WS_HA = AL(WS_ML_SC + (size_t)NU_ML * 256 * 4);
constexpr size_t WS_GD_W = AL(WS_HA + (size_t)MPROMPT * 1024 * 4);
constexpr size_t WS_GD_UT = AL(WS_GD_W + (size_t)NU_GD * 64 * 128 * 2);
constexpr size_t WS_GD_AT = AL(WS_GD_UT + (size_t)NU_GD * 128 * 64 * 2);
constexpr size_t WS_GD_Q = AL(WS_GD_AT + (size_t)NU_GD * 64 * 64 * 2);
constexpr size_t WS_GD_KD = AL(WS_GD_Q + (size_t)NU_GD * 64 * 128 * 2);
constexpr size_t WS_GD_SC = AL(WS_GD_KD + (size_t)NU_GD * 128 * 64 * 2);
constexpr size_t WS_RW = AL(WS_GD_SC + (size_t)NU_GD * 128 * 4);
enum { RW_TA = 0  , RW_PVT  , RW_RH  , RW_YV  , RW_ARB  , RW_BHT  , RW_KVT  , RW_V  , RW_G  , RW_N };
constexpr size_t WS_RW_SC = AL(WS_RW + (size_t)NU_RW * RW_N * 4096 * 2);
constexpr size_t WS_MIX_END = AL(WS_RW_SC + (size_t)NU_RW * 128 * 4);
constexpr size_t WS_SLOTS = WS_MRGF;
constexpr int FLAG_W0 = 16384;
static_assert((size_t)(FLAG_W0 + 6 * 256 * 64) * 4 <= CTL_BYTES && WS_SLOTS + (size_t)256 * 65536 * 4 <= WS_MIX_END, "stream-K scratch");
constexpr size_t WS_END = WS_MIX_END > AL(WS_MRGF + (size_t)MP * D * 4) ? WS_MIX_END : AL(WS_MRGF + (size_t)MP * D * 4);
static_assert((size_t)MP * DFF * 2 <= (size_t)MP * NPROJ * 2, "U overlays PROJ");

__device__ __forceinline__ float bf2f(bf16_t b) { return __uint_as_float(((unsigned)b) << 16); }
typedef __bf16 bf16x2_t __attribute__((ext_vector_type(2)));
__device__ __forceinline__ unsigned pk2(float lo, float hi) { const f32x2 v = {lo, hi}; return __builtin_bit_cast(unsigned, __builtin_convertvector(v, bf16x2_t)); }
__device__ __forceinline__ unsigned f2bf(float f) { return pk2(f, 0.f) & 0xffffu; }
__device__ __forceinline__ float sigmoidf_(float x) { return __builtin_amdgcn_rcpf(1.f + __expf(-x)); }
__device__ __forceinline__ float softplusf_(float x) { const float e = __expf(x); return x > 15.f ? x : (e < 1e-3f ? e * (1.f - 0.5f * e) : __logf(1.f + e)); }
__device__ __forceinline__ float siluf_(float x) { return x * __builtin_amdgcn_rcpf(1.f + __expf(-x)); }
__device__ __forceinline__ float fsigmoid(float x) { return __builtin_amdgcn_rcpf(1.f + __expf(-x)); }
__device__ __forceinline__ float fsoftplus(float x) { return x > 15.f ? x : __logf(1.f + __expf(x)); }
__device__ __forceinline__ float ftanh(float x) { return 1.f - 2.f * __builtin_amdgcn_rcpf(1.f + __expf(2.f * x)); }
__device__ __forceinline__ int hw_lane() { int l; asm volatile("v_mbcnt_lo_u32_b32 %0, -1, 0\n\tv_mbcnt_hi_u32_b32 %0, -1, %0" : "=v"(l)); return l; }
template <int CTRL, int ROWMASK>
__device__ __forceinline__ float dpp_mov(float old, float src) {
    return __builtin_bit_cast(float, __builtin_amdgcn_update_dpp(__builtin_bit_cast(int, old), __builtin_bit_cast(int, src), CTRL, ROWMASK, 0xf, false));
}
__device__ __forceinline__ float lane_bcast(float v, int l) { return __builtin_bit_cast(float, __builtin_amdgcn_readlane(__builtin_bit_cast(int, v), l)); }
__device__ __forceinline__ float wave_scan_sum(float v) {
    v += dpp_mov<0x111, 0xf>(0.f, v); v += dpp_mov<0x112, 0xf>(0.f, v); v += dpp_mov<0x114, 0xf>(0.f, v); v += dpp_mov<0x118, 0xf>(0.f, v);
    v += dpp_mov<0x142, 0xa>(0.f, v); v += dpp_mov<0x143, 0xc>(0.f, v);
    return v;
}
__device__ __forceinline__ float wave_sum(float v) { return lane_bcast(wave_scan_sum(v), 63); }
__device__ __forceinline__ float row16_sum(float v) {
    v += dpp_mov<0x121, 0xf>(0.f, v); v += dpp_mov<0x122, 0xf>(0.f, v); v += dpp_mov<0x124, 0xf>(0.f, v); v += dpp_mov<0x128, 0xf>(0.f, v);
    return v;
}
__device__ __forceinline__ void lds_barrier() { asm volatile("s_waitcnt lgkmcnt(0)" ::: "memory"); __builtin_amdgcn_s_barrier(); asm volatile("" ::: "memory"); }
__device__ __forceinline__ float block_sum(float v, LAS float* sc, const int wave) {
    v = wave_sum(v);
    if (hw_lane() == 0) sc[wave] = v;
    lds_barrier();
    float r = 0.f;
#pragma unroll
    for (int i = 0; i < 8; ++i) r += sc[i];
    lds_barrier();
    return r;
}

#define XB_TMO      128
#define XB_XCNT(j)  (256  + 64 * (j))
#define XB_XSUB(j)  (1280 + 64 * (j))
#define XB_XGEN(j)  (2304 + 64 * (j))
#define XB_TOP      3328
#define XB_TOPGEN   3392
#define XCD_BAR_WORDS 3456
#define XB_SPIN_CAP (1u << 22)

__device__ __forceinline__ unsigned xb_ld(unsigned* p)              { return __hip_atomic_load(p, __ATOMIC_RELAXED, __HIP_MEMORY_SCOPE_AGENT); }
__device__ __forceinline__ unsigned xb_add(unsigned* p, unsigned v) { return __hip_atomic_fetch_add(p, v, __ATOMIC_RELAXED, __HIP_MEMORY_SCOPE_AGENT); }
__device__ __forceinline__ unsigned xb_xcc_id() { return (unsigned)__builtin_amdgcn_s_getreg((3 << 11) | 20) & 0xFu; }
#define XB_SPIN(cond, bar) do { unsigned _sp = 0; while (cond) { __builtin_amdgcn_s_sleep(1); \
    if ((++_sp & 255u) == 0u) { if (xb_ld(&(bar)[XB_TMO])) break; if (_sp > XB_SPIN_CAP) { atomicAdd(&(bar)[XB_TMO], 1u); break; } } } } while (0)

struct XcdBarrier { unsigned* bar; unsigned x; volatile LAS unsigned* st; };

__device__ __forceinline__ XcdBarrier xcd_barrier_post(unsigned* bar, volatile LAS unsigned* st) {
    XcdBarrier b; b.bar = bar; b.x = xb_xcc_id(); b.st = st;
    if (threadIdx.x == 0) (void)xb_add(&bar[XB_XCNT(b.x)], 1u);
    return b;
}
__device__ __forceinline__ void xcd_barrier_complete(unsigned* bar, unsigned x, unsigned& nloc, unsigned& nx) {
    const unsigned G = gridDim.x * gridDim.y * gridDim.z;
    unsigned sum, cnt, mine, sp = 0u;
    for (;;) {
        sum = 0u; cnt = 0u; mine = 0u;
#pragma unroll
        for (unsigned j = 0; j < 16; ++j) { const unsigned c = xb_ld(&bar[XB_XCNT(j)]); sum += c; cnt += (c > 0u) ? 1u : 0u; mine = (j == x) ? c : mine; }
        if (sum == G) break;
        __builtin_amdgcn_s_sleep(1);
        if ((++sp & 255u) == 0u) { if (xb_ld(&bar[XB_TMO])) break; if (sp > XB_SPIN_CAP) { atomicAdd(&bar[XB_TMO], 1u); break; } }
    }
    nloc = mine > 0u ? mine : 1u; nx = cnt > 0u ? cnt : 1u;
}
__device__ __forceinline__ void xcd_barrier(const XcdBarrier& b, const int wave) {
    asm volatile("s_waitcnt vmcnt(0)" ::: "memory");
    __syncthreads();
    if (wave == 0 && hw_lane() == 0) {
        unsigned* bar = b.bar;
        __builtin_amdgcn_s_waitcnt(0);
        unsigned nloc = b.st[0], nx = b.st[1];
        if (nloc == 0u) { xcd_barrier_complete(bar, b.x, nloc, nx); b.st[0] = nloc; b.st[1] = nx; }
        const unsigned old = xb_add(&bar[XB_XSUB(b.x)], 1u);
        const unsigned gen = old / nloc;
        if (old + 1u == (gen + 1u) * nloc) {
            __builtin_amdgcn_fence(__ATOMIC_RELEASE, "agent");
            asm volatile("s_waitcnt vmcnt(0)" ::: "memory");
            const unsigned og = xb_add(&bar[XB_TOP], 1u);
            const unsigned tg = og / nx;
            if (og + 1u == (tg + 1u) * nx) xb_add(&bar[XB_TOPGEN], 1u);
            else XB_SPIN(xb_ld(&bar[XB_TOPGEN]) == tg, bar);
            __builtin_amdgcn_fence(__ATOMIC_ACQUIRE, "agent");
            xb_add(&bar[XB_XGEN(b.x)], 1u);
            asm volatile("s_waitcnt vmcnt(0)" ::: "memory");
        } else {
            XB_SPIN(xb_ld(&bar[XB_XGEN(b.x)]) == gen, bar);
            __builtin_amdgcn_fence(__ATOMIC_ACQUIRE, "agent");
            asm volatile("s_waitcnt vmcnt(0)" ::: "memory");
        }
    }
    __syncthreads();
}

__device__ __forceinline__ void mini_barrier(unsigned* ctr, unsigned n, const int wave) {
    asm volatile("s_waitcnt vmcnt(0)" ::: "memory");
    __syncthreads();
    if (wave == 0 && hw_lane() == 0) {
        __builtin_amdgcn_fence(__ATOMIC_RELEASE, "agent");
        asm volatile("s_waitcnt vmcnt(0)" ::: "memory");
        (void)xb_add(ctr, 1u);
        unsigned sp = 0u;
        while (xb_ld(ctr) < n) { __builtin_amdgcn_s_sleep(1); if (++sp > XB_SPIN_CAP) break; }
        __builtin_amdgcn_fence(__ATOMIC_ACQUIRE, "agent");
        asm volatile("s_waitcnt vmcnt(0)" ::: "memory");
    }
    __syncthreads();
}

__device__ __forceinline__ void wg_signal(unsigned* ctr, const int wave) {
    asm volatile("s_waitcnt vmcnt(0)" ::: "memory");
    __syncthreads();
    if (wave == 0 && hw_lane() == 0) { __builtin_amdgcn_fence(__ATOMIC_RELEASE, "agent"); asm volatile("s_waitcnt vmcnt(0)" ::: "memory"); (void)xb_add(ctr, 1u); }
}
__device__ __forceinline__ void wg_wait(unsigned* ctr, unsigned n, const int wave) {
    if (wave == 0 && hw_lane() == 0) { unsigned sp = 0u;
        while (xb_ld(ctr) < n) { __builtin_amdgcn_s_sleep(1); if (++sp > XB_SPIN_CAP) break; }
        __builtin_amdgcn_fence(__ATOMIC_ACQUIRE, "agent");
        asm volatile("s_waitcnt vmcnt(0)" ::: "memory"); }
    __syncthreads();
}

__device__ __forceinline__ const float* x0_row(const float* meta, const float* xp, const float* xs, int row) {
    const int b = row / TP, t = row - b * TP;
    const float* p = t < NMETA ? meta + (size_t)t * D : xp + ((size_t)b * SEQ + (t - NMETA)) * D;
    if (row >= MPROMPT) p = row < MREAL ? xs + (size_t)(row - MPROMPT) * D : meta;
    return p;
}
namespace pg8 {
constexpr int BM = 256, BK = 64, HALF = 128, HTB = HALF * BK * 2, STAGE_BYTES = 8 * HTB, NXCD = 8, WGM = 8;
__host__ __device__ __forceinline__ int lds_byte(int r, int c) { const int st = (r >> 4) * 2 + (c >> 5), rr = r & 15, cc = c & 31, ob = rr * 64 + cc * 2; return st * 1024 + (ob ^ (((ob >> 9) & 1) << 5)); }
__host__ __device__ __forceinline__ void stage_rc(int b, int& R, int& C) { const int st = b / 1024, sb = b % 1024, swz = sb ^ (((sb >> 9) & 1) << 5); R = (st >> 1) * 16 + swz / 64; C = (st & 1) * 32 + (swz % 64) / 2; }
__host__ __device__ __forceinline__ int perm32(int rho) { const int n = rho >> 4, i = rho & 15; return 8 * (i >> 2) + 4 * n + (i & 3); }

struct Unit { int pm, pn, z, kb, kn, role; };
template <int LDA_, int LDB_, int K_, long ZSA_ = 0, long ZSB_ = 0> struct Gemm { static constexpr int lda = LDA_, ldb = LDB_, K = K_; static constexpr size_t zsA = (size_t)ZSA_, zsB = (size_t)ZSB_; const bf16_t* A; const bf16_t* Bt; };

template <int M_, int N_, int NZ_> struct TileOrder {
    static constexpr bool STREAM = false;
    static constexpr int nM = M_ / BM, nN = N_ / BM, nz = NZ_, nwg = nM * nN;
    int G, c;
    __device__ void init(int G_, int c_) { G = G_; c = c_; }
    __device__ __forceinline__ bool next(int i, Unit& u) const {
        u.kb = 0; u.kn = 0; u.role = 0;
        const int ti = i / nz; u.z = i - ti * nz;
        const long L = (long)ti * G + c; if (L >= nwg) return false;
        int wgid = (int)L; { const int q = nwg / NXCD, r = nwg % NXCD, xcd = wgid % NXCD, off = wgid / NXCD; wgid = (xcd < r ? xcd * (q + 1) : r * (q + 1) + (xcd - r) * q) + off; }
        const int nig = WGM * nN, gid = wgid / nig, fm = gid * WGM, gsz = (nM - fm) < WGM ? (nM - fm) : WGM;
        u.pm = fm + ((wgid % nig) % gsz); u.pn = (wgid % nig) / gsz; return true;
    }
};

template <int M_, int N_, int NT_> struct StreamOrder {
    static constexpr bool STREAM = true;
    static constexpr int nN = N_ / BM, nU = (M_ / BM) * nN, UQ = NT_ / 4, Q = nU * UQ;
    int G, c, start, share;
    __device__ void init(int G_, int c_) { G = G_; c = c_; const int base = Q / G_, rem = Q % G_; share = base + (c_ < rem ? 1 : 0); start = c_ * base + (c_ < rem ? c_ : rem); }
    __device__ __forceinline__ bool next(int i, Unit& u) const {
        int p = start; const int e = start + share;
        for (int idx = 0; p < e; ++idx) { const int uu = p / UQ, off = p - uu * UQ; const int len = (UQ - off) < (e - p) ? (UQ - off) : (e - p);
            if (idx == i) { u.pm = uu / nN; u.pn = uu - u.pm * nN; u.z = 0; u.kb = 4 * off; u.kn = 4 * len; u.role = off > 0 ? 1 : (len < UQ ? 2 : 0); return true; }
            p += len; }
        return false;
    }
};
template <int M_, int N_, int NZ_> struct FlatOrder {
    static constexpr bool STREAM = false;
    static constexpr int nM = M_ / BM, nN = N_ / BM, nwg = nM * nN;
    int G, c;
    __device__ void init(int G_, int c_) { G = G_; c = c_; }
    __device__ __forceinline__ bool next(int i, Unit& u) const {
        u.kb = 0; u.kn = 0; u.role = 0;
        const int L = i * G + c; if (L >= nwg * NZ_) return false;
        u.z = L / nwg; int wgid = L - u.z * nwg;
        { const int q = nwg / NXCD, r = nwg % NXCD, xcd = wgid % NXCD, off = wgid / NXCD; wgid = (xcd < r ? xcd * (q + 1) : r * (q + 1) + (xcd - r) * q) + off; }
        const int nig = WGM * nN, gid = wgid / nig, fm = gid * WGM, gsz = (nM - fm) < WGM ? (nM - fm) : WGM;
        u.pm = fm + ((wgid % nig) % gsz); u.pn = (wgid % nig) / gsz; return true;
    }
};
template <int PM_, int N_, int NZ_> struct TailOrder {
    static constexpr bool STREAM = false;
    static constexpr int nN = N_ / BM;
    int G, c;
    __device__ void init(int G_, int c_) { G = G_; c = c_; }
    __device__ __forceinline__ bool next(int i, Unit& u) const { const int L = i * G + c; if (L >= nN * NZ_) return false; u.pm = PM_; u.pn = L % nN; u.z = L / nN; u.kb = 0; u.kn = 0; u.role = 0; return true; }
};
template <int PM_, int N_, int NP_, int KP_> struct SplitOrder {
    static constexpr bool STREAM = true;
    static constexpr int nN = N_ / BM, nprod = nN * NP_;
    int G, c;
    __device__ void init(int G_, int c_) { G = G_; c = c_; }
    __device__ __forceinline__ bool next(int i, Unit& u) const { if (i > 0 || c >= nprod) return false; u.pm = PM_; u.pn = c % nN; u.z = 0; u.kb = KP_ * (c / nN); u.kn = KP_; u.role = 1; return true; }
};
struct StreamX { float* slots; unsigned* flags; unsigned* tmo; };

__device__ __forceinline__ unsigned cvt_pk_bf16(float lo, float hi) { unsigned r; asm volatile("v_cvt_pk_bf16_f32 %0, %1, %2" : "=v"(r) : "v"(lo), "v"(hi)); return r; }

template <int ACT> struct EpiBf16 {
    static constexpr bool PERM = true;
    bf16_t* O; int ldc;
    __device__ __forceinline__ void operator()(const f32x4 (&acc)[2][2][4][2], const Unit& u, int wr, int wc, int fr, int fq) const {
        const int row0 = u.pm * BM + wr * 64 + fr; const int col0 = u.pn * BM + wc * 32 + 8 * fq;
#pragma unroll
        for (int ai = 0; ai < 2; ++ai)
#pragma unroll
            for (int m = 0; m < 4; ++m) { bf16_t* rowp = O + (size_t)(row0 + ai * HALF + m * 16) * ldc + col0;
#pragma unroll
                for (int bj = 0; bj < 2; ++bj) { f32x4 v0 = acc[ai][bj][m][0], v1 = acc[ai][bj][m][1];
                    if (ACT == 1) {
#pragma unroll
                        for (int j = 0; j < 4; ++j) { const float a = fmaxf(v0[j], 0.f), b = fmaxf(v1[j], 0.f); v0[j] = a * a; v1[j] = b * b; } }
                    u32x4 w; w.x = cvt_pk_bf16(v0[0], v0[1]); w.y = cvt_pk_bf16(v0[2], v0[3]); w.z = cvt_pk_bf16(v1[0], v1[1]); w.w = cvt_pk_bf16(v1[2], v1[3]);
                    *(u32x4*)(rowp + bj * HALF) = w; } }
    }
};
struct EpiGateBf16 {
    static constexpr bool PERM = true;
    const bf16_t* PG; int ldg; bf16_t* O; int ldc; size_t zstride;
    __device__ __forceinline__ void operator()(const f32x4 (&acc)[2][2][4][2], const Unit& u, int wr, int wc, int fr, int fq) const {
        const int row0 = u.pm * BM + wr * 64 + fr; const int col0 = u.pn * BM + wc * 32 + 8 * fq;
        bf16_t* Oz = O + (size_t)u.z * zstride;
#pragma unroll
        for (int ai = 0; ai < 2; ++ai)
#pragma unroll
            for (int m2 = 0; m2 < 2; ++m2) { u32x4 g[2][2];
#pragma unroll
                for (int mm = 0; mm < 2; ++mm)
#pragma unroll
                    for (int bj = 0; bj < 2; ++bj) g[mm][bj] = *(const u32x4*)(PG + (size_t)(row0 + ai * HALF + (2 * m2 + mm) * 16) * ldg + (size_t)u.z * 2048 + col0 + bj * HALF);
#pragma unroll
                for (int mm = 0; mm < 2; ++mm)
#pragma unroll
                    for (int bj = 0; bj < 2; ++bj) { const int m = 2 * m2 + mm; const u32x4 gg = g[mm][bj];
                        f32x4 v0 = acc[ai][bj][m][0], v1 = acc[ai][bj][m][1];
                        v0[0] *= fsigmoid(__uint_as_float(gg.x << 16)); v0[1] *= fsigmoid(__uint_as_float(gg.x & 0xffff0000u));
                        v0[2] *= fsigmoid(__uint_as_float(gg.y << 16)); v0[3] *= fsigmoid(__uint_as_float(gg.y & 0xffff0000u));
                        v1[0] *= fsigmoid(__uint_as_float(gg.z << 16)); v1[1] *= fsigmoid(__uint_as_float(gg.z & 0xffff0000u));
                        v1[2] *= fsigmoid(__uint_as_float(gg.w << 16)); v1[3] *= fsigmoid(__uint_as_float(gg.w & 0xffff0000u));
                        u32x4 w; w.x = cvt_pk_bf16(v0[0], v0[1]); w.y = cvt_pk_bf16(v0[2], v0[3]); w.z = cvt_pk_bf16(v1[0], v1[1]); w.w = cvt_pk_bf16(v1[2], v1[3]);
                        *(u32x4*)(Oz + (size_t)(row0 + ai * HALF + m * 16) * ldc + col0 + bj * HALF) = w; } }
    }
};
struct EpiGateAcc {
    static constexpr bool PERM = true;
    const bf16_t* PG; int ldg; bf16_t* O; int ldc;
    __device__ __forceinline__ void operator()(const f32x4 (&acc)[2][2][4][2], const Unit& u, int wr, int wc, int fr, int fq) const {
        const int row0 = u.pm * BM + wr * 64 + fr; const int col0 = u.pn * BM + wc * 32 + 8 * fq;
        const bool first = u.z == 0;
#pragma unroll
        for (int ai = 0; ai < 2; ++ai)
#pragma unroll
            for (int m2 = 0; m2 < 2; ++m2) { u32x4 g[2][2], p[2][2];
#pragma unroll
                for (int mm = 0; mm < 2; ++mm)
#pragma unroll
                    for (int bj = 0; bj < 2; ++bj) { const size_t row = (size_t)(row0 + ai * HALF + (2 * m2 + mm) * 16);
                        g[mm][bj] = *(const u32x4*)(PG + row * ldg + (size_t)u.z * 2048 + col0 + bj * HALF);
                        p[mm][bj] = (u32x4){0u, 0u, 0u, 0u};
                        if (!first) p[mm][bj] = *(const u32x4*)(O + row * ldc + col0 + bj * HALF); }
#pragma unroll
                for (int mm = 0; mm < 2; ++mm)
#pragma unroll
                    for (int bj = 0; bj < 2; ++bj) { const int m = 2 * m2 + mm; const u32x4 gg = g[mm][bj], pp = p[mm][bj];
                        f32x4 v0 = acc[ai][bj][m][0], v1 = acc[ai][bj][m][1];
                        v0[0] = v0[0] * fsigmoid(__uint_as_float(gg.x << 16)) + __uint_as_float(pp.x << 16); v0[1] = v0[1] * fsigmoid(__uint_as_float(gg.x & 0xffff0000u)) + __uint_as_float(pp.x & 0xffff0000u);
                        v0[2] = v0[2] * fsigmoid(__uint_as_float(gg.y << 16)) + __uint_as_float(pp.y << 16); v0[3] = v0[3] * fsigmoid(__uint_as_float(gg.y & 0xffff0000u)) + __uint_as_float(pp.y & 0xffff0000u);
                        v1[0] = v1[0] * fsigmoid(__uint_as_float(gg.z << 16)) + __uint_as_float(pp.z << 16); v1[1] = v1[1] * fsigmoid(__uint_as_float(gg.z & 0xffff0000u)) + __uint_as_float(pp.z & 0xffff0000u);
                        v1[2] = v1[2] * fsigmoid(__uint_as_float(gg.w << 16)) + __uint_as_float(pp.w << 16); v1[3] = v1[3] * fsigmoid(__uint_as_float(gg.w & 0xffff0000u)) + __uint_as_float(pp.w & 0xffff0000u);
                        u32x4 w; w.x = cvt_pk_bf16(v0[0], v0[1]); w.y = cvt_pk_bf16(v0[2], v0[3]); w.z = cvt_pk_bf16(v1[0], v1[1]); w.w = cvt_pk_bf16(v1[2], v1[3]);
                        *(u32x4*)(O + (size_t)(row0 + ai * HALF + m * 16) * ldc + col0 + bj * HALF) = w; }
                asm volatile("" ::: "memory"); }
    }
};
struct EpiGate {
    static constexpr bool PERM = true;
    const bf16_t* PG; int ldg;
    float* F; bf16_t* O; int ldc;
    __device__ __forceinline__ void operator()(const f32x4 (&acc)[2][2][4][2], const Unit& u, int wr, int wc, int fr, int fq) const {
        const int row0 = u.pm * BM + wr * 64 + fr; const int col0 = u.pn * BM + wc * 32 + 8 * fq;
#pragma unroll
        for (int ai = 0; ai < 2; ++ai)
#pragma unroll
            for (int m = 0; m < 4; ++m) { const size_t row = (size_t)(row0 + ai * HALF + m * 16);
                u32x4 g[2]; f32x4 f0[2], f1[2];
#pragma unroll
                for (int bj = 0; bj < 2; ++bj) { const int col = col0 + bj * HALF; g[bj] = *(const u32x4*)(PG + row * ldg + (size_t)u.z * 2048 + col);
                    f0[bj] = (f32x4){0.f, 0.f, 0.f, 0.f}; f1[bj] = f0[bj];
                    if (u.z > 0) { const float* fp = F + row * ldc + col; f0[bj] = *(const f32x4*)fp; f1[bj] = *(const f32x4*)(fp + 4); } }
#pragma unroll
                for (int bj = 0; bj < 2; ++bj) { const int col = col0 + bj * HALF;
                    f32x4 v0 = acc[ai][bj][m][0], v1 = acc[ai][bj][m][1];
                    v0[0] *= fsigmoid(__uint_as_float(g[bj].x << 16)); v0[1] *= fsigmoid(__uint_as_float(g[bj].x & 0xffff0000u));
                    v0[2] *= fsigmoid(__uint_as_float(g[bj].y << 16)); v0[3] *= fsigmoid(__uint_as_float(g[bj].y & 0xffff0000u));
                    v1[0] *= fsigmoid(__uint_as_float(g[bj].z << 16)); v1[1] *= fsigmoid(__uint_as_float(g[bj].z & 0xffff0000u));
                    v1[2] *= fsigmoid(__uint_as_float(g[bj].w << 16)); v1[3] *= fsigmoid(__uint_as_float(g[bj].w & 0xffff0000u));
                    v0 += f0[bj]; v1 += f1[bj];
                    float* fp = F + row * ldc + col;
                    if (u.z < 2) { *(f32x4*)fp = v0; *(f32x4*)(fp + 4) = v1; }
                    else { u32x4 w; w.x = cvt_pk_bf16(v0[0], v0[1]); w.y = cvt_pk_bf16(v0[2], v0[3]); w.z = cvt_pk_bf16(v1[0], v1[1]); w.w = cvt_pk_bf16(v1[2], v1[3]);
                           *(u32x4*)(O + row * ldc + col) = w; } } }
    }
};
struct EpiResid {
    static constexpr bool PERM = false;
    const float* Xin; float* Xout; int ldc;
    __device__ __forceinline__ void operator()(const f32x4 (&acc)[2][2][4][2], const Unit& u, int wr, int wc, int fr, int fq) const {
        const int row0 = u.pm * BM + wr * 64 + fr, col0 = u.pn * BM + wc * 32 + 4 * fq;
#pragma unroll
        for (int ai = 0; ai < 2; ++ai)
#pragma unroll
            for (int m = 0; m < 4; ++m) { f32x4 t[2][2]; const size_t ro = (size_t)(row0 + ai * HALF + m * 16) * ldc + col0;
#pragma unroll
                for (int bj = 0; bj < 2; ++bj)
#pragma unroll
                    for (int n = 0; n < 2; ++n) t[bj][n] = *(const f32x4*)(Xin + ro + bj * HALF + n * 16);
#pragma unroll
                for (int bj = 0; bj < 2; ++bj)
#pragma unroll
                    for (int n = 0; n < 2; ++n) *(f32x4*)(Xout + ro + bj * HALF + n * 16) = t[bj][n] + acc[ai][bj][m][n];
                asm volatile("" ::: "memory"); }
    }
};

struct EpiResidSrc {
    static constexpr bool PERM = false;
    const float* meta; const float* xp; const float* xs; float* Xout; int ldc;
    __device__ __forceinline__ void operator()(const f32x4 (&acc)[2][2][4][2], const Unit& u, int wr, int wc, int fr, int fq) const {
        const int row0 = u.pm * BM + wr * 64 + fr, col0 = u.pn * BM + wc * 32 + 4 * fq;
#pragma unroll
        for (int ai = 0; ai < 2; ++ai)
#pragma unroll
            for (int m = 0; m < 4; ++m) { f32x4 t[2][2]; const int row = row0 + ai * HALF + m * 16; const size_t ro = (size_t)row * ldc + col0;
                const float* src = x0_row(meta, xp, xs, row) + col0;
#pragma unroll
                for (int bj = 0; bj < 2; ++bj)
#pragma unroll
                    for (int n = 0; n < 2; ++n) t[bj][n] = *(const f32x4*)(src + bj * HALF + n * 16);
#pragma unroll
                for (int bj = 0; bj < 2; ++bj)
#pragma unroll
                    for (int n = 0; n < 2; ++n) *(f32x4*)(Xout + ro + bj * HALF + n * 16) = t[bj][n] + acc[ai][bj][m][n];
                asm volatile("" ::: "memory"); }
    }
};

template <int MODE>
__device__ __forceinline__ void split_reduce(const int wid, float* X, bf16_t* U, int ldc, const StreamX sx, int pm, int pn, int nN, int NP) {
    const int lane = hw_lane(), tid = wid * 64 + lane, wr = wid >> 2, wc = wid & 3, fr = lane & 15, fq = lane >> 4;
    if (wid == 0) {
#pragma unroll 1
        for (int j = 0; j < NP; ++j) { unsigned sp = 0;
            while ((unsigned)__builtin_amdgcn_readfirstlane(__hip_atomic_load(sx.flags + 64 * (pn + nN * j), __ATOMIC_RELAXED, __HIP_MEMORY_SCOPE_AGENT)) != 1u) {
                __builtin_amdgcn_s_sleep(1);
                if ((++sp & 255u) == 0u) { if (__builtin_amdgcn_readfirstlane(__hip_atomic_load(sx.tmo, __ATOMIC_RELAXED, __HIP_MEMORY_SCOPE_AGENT))) break; if (sp > (1u << 20)) { if (lane == 0) __hip_atomic_store(sx.tmo, 1u, __ATOMIC_RELAXED, __HIP_MEMORY_SCOPE_AGENT); break; } } } }
        __builtin_amdgcn_fence(__ATOMIC_ACQUIRE, "agent"); asm volatile("s_waitcnt vmcnt(0)" ::: "memory"); }
    __syncthreads();
    const float* s0 = sx.slots + (size_t)pn * 65536 + tid * 32; const size_t jstride = (size_t)nN * 65536;
#pragma unroll 2
    for (int am = 0; am < 16; ++am) {
        const int a = am >> 3, b = (am >> 2) & 1, m = am & 3;
        f32x4 v0 = (f32x4){0.f, 0.f, 0.f, 0.f}, v1 = v0;
        const float* p = s0 + (am >> 2) * 16384 + (am & 3) * 8;
#pragma unroll 4
        for (int j = 0; j < NP; ++j) { v0 += *(const f32x4*)(p + j * jstride); v1 += *(const f32x4*)(p + j * jstride + 4); }
        const size_t row = (size_t)(pm * BM + a * HALF + wr * 64 + m * 16 + fr);
        if (MODE == 0) { float* xp = X + row * ldc + pn * BM + b * HALF + wc * 32 + 4 * fq;
            *(f32x4*)xp = *(const f32x4*)xp + v0; *(f32x4*)(xp + 16) = *(const f32x4*)(xp + 16) + v1; }
        else {
#pragma unroll
            for (int e = 0; e < 4; ++e) { const float x0 = fmaxf(v0[e], 0.f), x1 = fmaxf(v1[e], 0.f); v0[e] = x0 * x0; v1[e] = x1 * x1; }
            u32x4 w; w.x = cvt_pk_bf16(v0[0], v0[1]); w.y = cvt_pk_bf16(v0[2], v0[3]); w.z = cvt_pk_bf16(v1[0], v1[1]); w.w = cvt_pk_bf16(v1[2], v1[3]);
            *(u32x4*)(U + row * ldc + pn * BM + b * HALF + wc * 32 + 8 * fq) = w; }
    }
    __syncthreads();
}

template <class Epi, class Sched, class GemmT>
__device__ __forceinline__ void gemm_phase(LAS unsigned char* lds, const int wid, const GemmT g, const Sched& S, const Epi& E, const StreamX sx = StreamX{nullptr, nullptr, nullptr}) {
    const int lane = hw_lane(), tid = wid * 64 + lane, wr = wid >> 2, wc = wid & 3, fr = lane & 15, fq = lane >> 4;
    constexpr int K = GemmT::K, nt = K / BK;
    unsigned voffA[2], voffB[2];
#pragma unroll
    for (int i = 0; i < 2; ++i) { int R, C; stage_rc(tid * 16 + i * 8192, R, C); const int Rb = Epi::PERM ? ((R & ~31) + perm32(R & 31)) : R;
        voffA[i] = (unsigned)(R * GemmT::lda + C) * 2u; voffB[i] = (unsigned)(Rb * GemmT::ldb + C) * 2u; }
    constexpr size_t kstep = (size_t)(BK * 2);
    constexpr size_t hstepA = (size_t)HALF * GemmT::lda * 2, hstepB = (size_t)HALF * GemmT::ldb * 2;
    constexpr size_t tstepA = 2 * hstepA, tstepB = 2 * hstepB;
    const unsigned ldsw = (unsigned)wid * 1024u;
    const int aoff = lds_byte(wr * 64 + fr, fq * 8), boff = lds_byte(wc * 32 + fr, fq * 8);
#define PG8_SA(b, h) (((b) * 2 + (h)) * HTB)
#define PG8_SB(b, h) ((4 + (b) * 2 + (h)) * HTB)
#define PG8_STAGE(bufoff, gbase, voff) do { _Pragma("unroll") for (int _i = 0; _i < 2; ++_i) \
        __builtin_amdgcn_global_load_lds((const unsigned*)((const char*)(gbase) + (voff)[_i]), (LAS unsigned*)(lds + (bufoff) + ldsw + _i * 8192), 16, 0, 0); } while (0)
#define PG8_LDA(dst, b, h) do { _Pragma("unroll") for (int m = 0; m < 4; ++m) _Pragma("unroll") for (int k = 0; k < 2; ++k) dst[m][k] = *(const LAS bf16x8*)(lds + PG8_SA(b, h) + aoff + m * 2048 + k * 1024); } while (0)
#define PG8_LDB(dst, b, h) do { _Pragma("unroll") for (int n = 0; n < 2; ++n) _Pragma("unroll") for (int k = 0; k < 2; ++k) dst[n][k] = *(const LAS bf16x8*)(lds + PG8_SB(b, h) + boff + n * 2048 + k * 1024); } while (0)
#define PG8_MMA(ai, bj, At, Bt) do { __builtin_amdgcn_s_setprio(1); _Pragma("unroll") for (int m = 0; m < 4; ++m) _Pragma("unroll") for (int n = 0; n < 2; ++n) _Pragma("unroll") for (int k = 0; k < 2; ++k) \
        acc[ai][bj][m][n] = __builtin_amdgcn_mfma_f32_16x16x32_bf16(Bt[n][k], At[m][k], acc[ai][bj][m][n], 0, 0, 0); __builtin_amdgcn_s_setprio(0); } while (0)
#define PG8_WAIT_V(n) asm volatile("s_waitcnt vmcnt(" #n ")" ::: "memory")
#define PG8_WAIT_L(n) asm volatile("s_waitcnt lgkmcnt(" #n ")" ::: "memory")
#define PG8_BAR __builtin_amdgcn_s_barrier()
#define PG8_SCHED __builtin_amdgcn_sched_barrier(0)
    Unit cur, nxt; int ui = 0;
    if (!S.next(0, cur)) return;
    f32x4 acc[2][2][4][2];
#pragma unroll
    for (int a = 0; a < 2; ++a)
#pragma unroll
        for (int b = 0; b < 2; ++b)
#pragma unroll
            for (int m = 0; m < 4; ++m)
#pragma unroll
                for (int n = 0; n < 2; ++n) acc[a][b][m][n] = (f32x4){0.f, 0.f, 0.f, 0.f};
    bf16x8 At[4][2], B0[2][2], B1[2][2];
    const char* cA = (const char*)g.A + (size_t)cur.pm * tstepA + (size_t)cur.z * GemmT::zsA + (size_t)cur.kb * kstep; const char* cB = (const char*)g.Bt + (size_t)cur.pn * tstepB + (size_t)cur.z * GemmT::zsB + (size_t)cur.kb * kstep;
    PG8_STAGE(PG8_SB(0, 0), cB, voffB); PG8_STAGE(PG8_SB(0, 1), cB + hstepB, voffB); PG8_STAGE(PG8_SA(0, 0), cA, voffA); PG8_STAGE(PG8_SA(0, 1), cA + hstepA, voffA);
    if (wr == 1) PG8_BAR;
    PG8_WAIT_V(2); PG8_BAR;
    PG8_STAGE(PG8_SB(1, 0), cB + kstep, voffB); PG8_STAGE(PG8_SA(1, 0), cA + kstep, voffA); PG8_STAGE(PG8_SB(1, 1), cB + hstepB + kstep, voffB);
    PG8_WAIT_V(6); PG8_BAR;
    for (;;) {
        const bool has_next = S.next(ui + 1, nxt);
        const char* nA = has_next ? (const char*)g.A + (size_t)nxt.pm * tstepA + (size_t)nxt.z * GemmT::zsA + (size_t)nxt.kb * kstep : cA;
        const char* nB = has_next ? (const char*)g.Bt + (size_t)nxt.pn * tstepB + (size_t)nxt.z * GemmT::zsB + (size_t)nxt.kb * kstep : cB;
        const int ntu = Sched::STREAM ? cur.kn : nt;
        for (int t = 0; t < ntu; t += 2) {
            const bool last = (t == ntu - 2);
            const char* a1 = cA + (size_t)(t + 1) * kstep;
            const char* a2 = last ? nA : cA + (size_t)(t + 2) * kstep; const char* b2 = last ? nB : cB + (size_t)(t + 2) * kstep;
            const char* a3 = a2 + kstep; const char* b3 = b2 + kstep;
            PG8_LDB(B0, 0, 0); PG8_LDB(B1, 0, 1); PG8_SCHED; PG8_LDA(At, 0, 0); PG8_STAGE(PG8_SA(1, 1), a1 + hstepA, voffA);
            PG8_WAIT_V(8); PG8_WAIT_L(0); PG8_BAR; PG8_MMA(0, 0, At, B0); PG8_MMA(0, 1, At, B1); PG8_BAR; PG8_SCHED;
            PG8_LDA(At, 0, 1); PG8_STAGE(PG8_SB(0, 0), b2, voffB); PG8_STAGE(PG8_SB(0, 1), b2 + hstepB, voffB); PG8_STAGE(PG8_SA(0, 0), a2, voffA);
            PG8_WAIT_V(8); PG8_WAIT_L(0); PG8_BAR; PG8_MMA(1, 0, At, B0); PG8_MMA(1, 1, At, B1); PG8_BAR; PG8_SCHED;
            PG8_LDB(B0, 1, 0); PG8_LDB(B1, 1, 1); PG8_SCHED; PG8_LDA(At, 1, 0); PG8_STAGE(PG8_SA(0, 1), a2 + hstepA, voffA);
            PG8_WAIT_V(8); PG8_WAIT_L(0); PG8_BAR; PG8_MMA(0, 0, At, B0); PG8_MMA(0, 1, At, B1); PG8_BAR; PG8_SCHED;
            PG8_LDA(At, 1, 1); PG8_STAGE(PG8_SB(1, 0), b3, voffB); PG8_STAGE(PG8_SB(1, 1), b3 + hstepB, voffB); PG8_STAGE(PG8_SA(1, 0), a3, voffA);
            PG8_WAIT_V(8); PG8_WAIT_L(0); PG8_BAR; PG8_MMA(1, 0, At, B0); PG8_MMA(1, 1, At, B1); PG8_BAR; PG8_SCHED;
        }
        if (wr == 0) PG8_BAR;
        const int lane_e = hw_lane(), tid_e = wid * 64 + lane_e, fr_e = lane_e & 15, fq_e = lane_e >> 4;
        if (Sched::STREAM && cur.role == 1) {
            const __amdgpu_buffer_rsrc_t rs = __builtin_amdgcn_make_buffer_rsrc(sx.slots, 0, 256 * 65536 * 4, 0x00020000);
            const unsigned sbase = (unsigned)S.c * 262144u + (unsigned)tid_e * 128u;
#pragma unroll
            for (int a = 0; a < 2; ++a)
#pragma unroll
                for (int b = 0; b < 2; ++b)
#pragma unroll
                    for (int m = 0; m < 4; ++m)
#pragma unroll
                        for (int n = 0; n < 2; ++n) { constexpr int dummy = 0; const int k = ((a * 2 + b) * 4 + m) * 2 + n;
                            __builtin_amdgcn_raw_buffer_store_b128(__builtin_bit_cast(u32x4, acc[a][b][m][n]), rs, sbase + (unsigned)((k >> 3) * 65536), (k & 7) * 16 + dummy, 16); }
            asm volatile("s_waitcnt vmcnt(0)" ::: "memory"); PG8_BAR; asm volatile("" ::: "memory");
            if (tid_e == 0) __hip_atomic_store(sx.flags + 64 * S.c, 1u, __ATOMIC_RELAXED, __HIP_MEMORY_SCOPE_AGENT);
        } else {
            E(acc, cur, wr, wc, fr_e, fq_e);
        }
        if (!has_next) break;
        if (Sched::STREAM && nxt.role == 2) {
            if (wid == 0) { unsigned sp = 0;
                while ((unsigned)__builtin_amdgcn_readfirstlane(__hip_atomic_load(sx.flags + 64 * (S.c + 1), __ATOMIC_RELAXED, __HIP_MEMORY_SCOPE_AGENT)) != 1u) {
                    __builtin_amdgcn_s_sleep(1);
                    if ((++sp & 255u) == 0u) { if (__builtin_amdgcn_readfirstlane(__hip_atomic_load(sx.tmo, __ATOMIC_RELAXED, __HIP_MEMORY_SCOPE_AGENT))) break; if (sp > (1u << 20)) { if (lane == 0) __hip_atomic_store(sx.tmo, 1u, __ATOMIC_RELAXED, __HIP_MEMORY_SCOPE_AGENT); break; } } }
                __builtin_amdgcn_fence(__ATOMIC_ACQUIRE, "agent"); asm volatile("s_waitcnt vmcnt(0)" ::: "memory"); }
            asm volatile("" ::: "memory"); PG8_BAR; asm volatile("" ::: "memory");
            const float* ps = sx.slots + (size_t)(S.c + 1) * 65536 + tid * 32;
#pragma unroll
            for (int a = 0; a < 2; ++a)
#pragma unroll
                for (int b = 0; b < 2; ++b)
#pragma unroll
                    for (int m = 0; m < 4; ++m)
#pragma unroll
                        for (int n = 0; n < 2; ++n) { const int k = ((a * 2 + b) * 4 + m) * 2 + n; acc[a][b][m][n] = *(const f32x4*)(ps + (k >> 3) * 16384 + (k & 7) * 4); }
        } else {
#pragma unroll
        for (int a = 0; a < 2; ++a)
#pragma unroll
            for (int b = 0; b < 2; ++b)
#pragma unroll
                for (int m = 0; m < 4; ++m)
#pragma unroll
                    for (int n = 0; n < 2; ++n) acc[a][b][m][n] = (f32x4){0.f, 0.f, 0.f, 0.f};
        }
        cur = nxt; cA = nA; cB = nB; ++ui;
        if (wr == 1) PG8_BAR;
    }
    PG8_WAIT_V(0);
    PG8_BAR;
#undef PG8_SA
#undef PG8_SB
#undef PG8_STAGE
#undef PG8_LDA
#undef PG8_LDB
#undef PG8_MMA
#undef PG8_WAIT_V
#undef PG8_WAIT_L
#undef PG8_BAR
#undef PG8_SCHED
}
}

constexpr int NWAVES = 8, NTHR = 512;
constexpr int LDS_BYTES = 147456;
constexpr int LDS_MISC = 131072;
constexpr int NPHASE = 22;

struct Params {
    const float* in[38];
    float* out;
    unsigned char* ws;
    int ph_lo, ph_hi;
};
struct Ctx {
    float* out; unsigned char* ws;
    LAS unsigned char* lds;
    int tid, lane, wave, G, bid;
};
__device__ __forceinline__ const float* inp(const Ctx& c, int i);
enum { I_XP = 0, I_XS, I_SC, I_SN, I_SM, I_SGS, I_SGC, I_SRS, I_SRSH, I_META, I_NMIX, I_WIN, I_BI, I_BF, I_MNW, I_CONVW, I_ALOG, I_DTB, I_GNW, I_MU, I_W0, I_W2, I_A0, I_A2, I_G2,
       I_KK, I_KA, I_RK, I_LNW, I_LNB, I_WBA, I_WBB, I_WBC, I_WOUT, I_NMLP, I_WUP, I_WDN, I_FNW };

__device__ __forceinline__ const float* inp(const Ctx& c, int i) {
    const LAS unsigned* t = (const LAS unsigned*)(c.lds + LDS_MISC + 64) + 2 * i;
    const unsigned lo = __builtin_amdgcn_readfirstlane(t[0]), hi = __builtin_amdgcn_readfirstlane(t[1]);
    typedef const float __attribute__((address_space(1)))* gptr_t;
    return (const float*)(gptr_t)(((unsigned long long)hi << 32) | lo);
}
__device__ __forceinline__ void transpose_item(const float* W, int K, int Nsrc, int src_col, bf16_t* WT, int dst_row, int k0, LAS float* scr, int lane) {
    float v[32];
    const float* src = W + (size_t)(k0 + (lane >> 5)) * Nsrc + src_col + (lane & 31);
#pragma unroll
    for (int i = 0; i < 32; ++i) v[i] = src[(size_t)(2 * i) * Nsrc];
#pragma unroll
    for (int i = 0; i < 32; ++i) scr[(2 * i + (lane >> 5)) * 33 + (lane & 31)] = v[i];
    asm volatile("s_waitcnt lgkmcnt(0)" ::: "memory");
    const int c = lane & 7;
#pragma unroll
    for (int j = 0; j < 4; ++j) { const int n = (lane >> 3) + 8 * j; const LAS float* s = scr + (8 * c) * 33 + n;
        u32x4 o; o.x = pk2(s[0 * 33], s[1 * 33]); o.y = pk2(s[2 * 33], s[3 * 33]); o.z = pk2(s[4 * 33], s[5 * 33]); o.w = pk2(s[6 * 33], s[7 * 33]);
        *(u32x4*)(WT + (size_t)(dst_row + n) * K + k0 + 8 * c) = o; }
    asm volatile("s_waitcnt lgkmcnt(0)" ::: "memory");
}
__device__ __forceinline__ int win_src_col(int n) {
    return n < 4096 ? n : (n < 8192 ? n + 8 : (n < 11520 ? n + 24 : n + 24));
}
constexpr int CI_IN = 32 * (NPROJ / 32), CI_BR = 16 * 64, CI_O = 32 * 64, CI_U = 32 * 256, CI_D = 128 * 64;
constexpr int CO_BR = CI_IN, CO_O = CO_BR + 3 * CI_BR, CO_U = CO_O + CI_O, CO_D = CO_U + CI_U, C_PER_L = CO_D + CI_D;
#ifndef TAILCONV
#define TAILCONV 1
#endif
#if TAILCONV
constexpr int PREP_L0_END = CO_O, PREP_L1_BEG = CO_BR, PREP_L1_END = CO_O;
#else
constexpr int PREP_L0_END = C_PER_L, PREP_L1_BEG = 0, PREP_L1_END = C_PER_L;
#endif
__device__ __forceinline__ void convert_items(const Ctx& c0, const int l, const int r0, const int r1, const int b0) {
    if (c0.bid < b0) return;
    Ctx c = c0; c.lane = hw_lane();
    LAS float* scr = (LAS float*)(c.lds + c.wave * 16384);
    const int gw = (c.bid - b0) * NWAVES + c.wave, NGW = (c.G - b0) * NWAVES;
#pragma unroll 1
    for (int it = r0 + gw; it < r1; it += NGW) {
        int r = it;
        const float* W; bf16_t* WT; int K, Nsrc, scol, drow, k0;
        if (r < CI_IN) { const int nblk = NPROJ / 32, kb = r / nblk, nb = r % nblk;
            W = inp(c, I_WIN) + (size_t)l * D * NIN; K = D; Nsrc = NIN; scol = win_src_col(32 * nb); WT = (bf16_t*)(c.ws + WS_WIN) + (size_t)l * NPROJ * D; drow = 32 * nb; k0 = 64 * kb; }
        else if ((r -= CI_IN) < 3 * CI_BR) { const int br = r / CI_BR, rr = r % CI_BR, kb = rr / 64, nb = rr % 64;
            W = (br == 0 ? inp(c, I_WBA) : br == 1 ? inp(c, I_WBB) : inp(c, I_WBC)) + (size_t)l * 1024 * D; K = 1024; Nsrc = D; scol = 32 * nb; WT = (bf16_t*)(c.ws + WS_WBR) + ((size_t)l * 3 + br) * D * 1024; drow = 32 * nb; k0 = 64 * kb; }
        else if ((r -= 3 * CI_BR) < CI_O) { const int kb = r / 64, nb = r % 64;
            W = inp(c, I_WOUT) + (size_t)l * D * D; K = D; Nsrc = D; scol = 32 * nb; WT = (bf16_t*)(c.ws + WS_WOUT) + (size_t)l * D * D; drow = 32 * nb; k0 = 64 * kb; }
        else if ((r -= CI_O) < CI_U) { const int kb = r / 256, nb = r % 256;
            W = inp(c, I_WUP) + (size_t)l * D * DFF; K = D; Nsrc = DFF; scol = 32 * nb; WT = (bf16_t*)(c.ws + WS_WUP) + (size_t)l * DFF * D; drow = 32 * nb; k0 = 64 * kb; }
        else { r -= CI_U; const int kb = r / 64, nb = r % 64;
            W = inp(c, I_WDN) + (size_t)l * DFF * D; K = DFF; Nsrc = D; scol = 32 * nb; WT = (bf16_t*)(c.ws + WS_WDN) + (size_t)l * D * DFF; drow = 32 * nb; k0 = 64 * kb; }
        int ln = c.lane; asm volatile("" : "+v"(ln));
        transpose_item(W, K, Nsrc, scol, WT, drow, k0, scr, ln);
    }
}
__device__ __forceinline__ void phase_prep(const Ctx& c0) {
    Ctx c = c0; c.lane = hw_lane(); c.tid = c.wave * 64 + c.lane;
    const int gw = c.bid * NWAVES + c.wave, NGW = c.G * NWAVES;
    convert_items(c0, 0, 0, PREP_L0_END, 0);
    convert_items(c0, 1, PREP_L1_BEG, PREP_L1_END, 0);
    float* wsg = (float*)(c.ws + WS_WSG);
    for (int i = c.bid * NTHR + c.tid; i < 2 * NSG * D; i += c.G * NTHR) {
        const int l = i / (NSG * D), r = i % (NSG * D), j = r / D, k = r % D;
        const int col = j < 8 ? 4096 + j : 8200 + (j - 8);
        wsg[i] = inp(c, I_WIN)[((size_t)l * D + k) * NIN + col];
    }
}

template <bool GATES>
__device__ __forceinline__ void phase_norm(const Ctx& c0, const float* w, const float* wsg) {
    Ctx c = c0; c.lane = hw_lane(); c.tid = c.wave * 64 + c.lane;
    const int gw = c.bid * NWAVES + c.wave, NGW = c.G * NWAVES;
    const float* X = (const float*)(c.ws + WS_X); bf16_t* HN = (bf16_t*)(c.ws + WS_HN); float* SG = (float*)(c.ws + WS_SG);
    f32x4 wv[8];
#pragma unroll
    for (int j = 0; j < 8; ++j) wv[j] = ((const f32x4*)w)[c.lane + 64 * j];
    for (int row = gw; row < MP; row += 2 * NGW) {
        const int row1 = row + NGW; const bool two = row1 < MP;
        const f32x4* xr0 = (const f32x4*)(X + (size_t)row * D) + c.lane; const f32x4* xr1 = (const f32x4*)(X + (size_t)(two ? row1 : row) * D) + c.lane;
        f32x4 v0[8], v1[8]; float s0 = 0.f, s1 = 0.f;
#pragma unroll
        for (int j = 0; j < 8; ++j) { v0[j] = xr0[64 * j]; v1[j] = xr1[64 * j]; }
#pragma unroll
        for (int j = 0; j < 8; ++j) { s0 += (v0[j].x * v0[j].x + v0[j].y * v0[j].y) + (v0[j].z * v0[j].z + v0[j].w * v0[j].w); s1 += (v1[j].x * v1[j].x + v1[j].y * v1[j].y) + (v1[j].z * v1[j].z + v1[j].w * v1[j].w); }
        const float r0 = rsqrtf(wave_sum(s0) * (1.f / D) + 1e-6f), r1 = rsqrtf(wave_sum(s1) * (1.f / D) + 1e-6f);
        u32x2* o0 = (u32x2*)(HN + (size_t)row * D) + c.lane; u32x2* o1 = (u32x2*)(HN + (size_t)(two ? row1 : row) * D) + c.lane;
#pragma unroll
        for (int j = 0; j < 8; ++j) { v0[j] = v0[j] * r0 * wv[j]; v1[j] = v1[j] * r1 * wv[j];
            u32x2 o; o.x = pk2(v0[j].x, v0[j].y); o.y = pk2(v0[j].z, v0[j].w); o0[64 * j] = o;
            if (two) { o.x = pk2(v1[j].x, v1[j].y); o.y = pk2(v1[j].z, v1[j].w); o1[64 * j] = o; } }
        if (GATES) {
#pragma unroll 1
            for (int g0 = 0; g0 < NSG; g0 += 2) {
                f32x4 q[2][8];
#pragma unroll
                for (int gg = 0; gg < 2; ++gg)
#pragma unroll
                    for (int j = 0; j < 8; ++j) q[gg][j] = ((const f32x4*)(wsg + (size_t)(g0 + gg) * D))[c.lane + 64 * j];
#pragma unroll
                for (int gg = 0; gg < 2; ++gg) { float a0 = 0.f, a1 = 0.f;
#pragma unroll
                    for (int j = 0; j < 8; ++j) { a0 += (v0[j].x * q[gg][j].x + v0[j].y * q[gg][j].y) + (v0[j].z * q[gg][j].z + v0[j].w * q[gg][j].w);
                                                  a1 += (v1[j].x * q[gg][j].x + v1[j].y * q[gg][j].y) + (v1[j].z * q[gg][j].z + v1[j].w * q[gg][j].w); }
                    a0 = wave_sum(a0); a1 = wave_sum(a1);
                    if (c.lane == 0) { SG[(size_t)row * SGLD + g0 + gg] = a0; if (two) SG[(size_t)row1 * SGLD + g0 + gg] = a1; } }
            }
        }
    }
}
constexpr int NR1 = 5;
template <int NV>
__device__ __forceinline__ void norm_gate_group(const f32x4 (&v)[NR1][8], const LAS f32x4* gb, float* SG, const int (&rows)[NR1], int g0, int lane) {
#pragma unroll 1
    for (int g = 0; g < 4; ++g) {
        float a[NR1];
#pragma unroll
        for (int r = 0; r < NR1; ++r) a[r] = 0.f;
#pragma unroll
        for (int j = 0; j < 8; ++j) { const f32x4 q = gb[g * 512 + lane + 64 * j];
#pragma unroll
            for (int r = 0; r < NV; ++r) a[r] += (v[r][j].x * q.x + v[r][j].y * q.y) + (v[r][j].z * q.z + v[r][j].w * q.w); }
#pragma unroll
        for (int r = 0; r < NV; ++r) { const float t = wave_sum(a[r]); if (lane == 0) SG[(size_t)rows[r] * SGLD + g0 + g] = t; }
    }
}
template <bool FIRST>
__device__ __forceinline__ void phase_norm_gates(const Ctx& c0, const float* w, const float* wsg) {
    Ctx c = c0; c.lane = hw_lane(); c.tid = c.wave * 64 + c.lane;
    const int gw = c.bid * NWAVES + c.wave, NGW = c.G * NWAVES;
    const float* X = (const float*)(c.ws + WS_X); bf16_t* HN = (bf16_t*)(c.ws + WS_HN); float* SG = (float*)(c.ws + WS_SG);
    LAS f32x4* GB = (LAS f32x4*)c.lds;
    const f32x4* wsg4 = (const f32x4*)wsg;
    const float* xmeta = FIRST ? inp(c, I_META) : nullptr; const float* xprm = FIRST ? inp(c, I_XP) : nullptr; const float* xsmp = FIRST ? inp(c, I_XS) : nullptr;
#pragma unroll 1
    for (int base = 0; base < MP; base += NR1 * NGW) {
        int rows[NR1]; f32x4 v[NR1][8]; f32x4 st[4];
        int nv = 0;
#pragma unroll
        for (int r = 0; r < NR1; ++r) { const int row = base + r * NGW + gw; nv += row < MP ? 1 : 0; rows[r] = row < MP ? row : MP - 1; }
        nv = __builtin_amdgcn_readfirstlane(nv);
#pragma unroll
        for (int r = 0; r < NR1; ++r) { const f32x4* xr = (const f32x4*)(FIRST ? x0_row(xmeta, xprm, xsmp, rows[r]) : X + (size_t)rows[r] * D) + c.lane;
#pragma unroll
            for (int j = 0; j < 8; ++j) v[r][j] = xr[64 * j]; }
#pragma unroll
        for (int k = 0; k < 4; ++k) st[k] = wsg4[c.tid + 512 * k];
        float rs[NR1];
#pragma unroll
        for (int r = 0; r < NR1; ++r) { float s = 0.f;
#pragma unroll
            for (int j = 0; j < 8; ++j) s += (v[r][j].x * v[r][j].x + v[r][j].y * v[r][j].y) + (v[r][j].z * v[r][j].z + v[r][j].w * v[r][j].w);
            rs[r] = rsqrtf(wave_sum(s) * (1.f / D) + 1e-6f); }
#pragma unroll
        for (int j = 0; j < 8; ++j) { const f32x4 wj = ((const f32x4*)w)[c.lane + 64 * j];
#pragma unroll
            for (int r = 0; r < NR1; ++r) { v[r][j] = v[r][j] * rs[r] * wj;
                if (r < nv) { u32x2 p; p.x = pk2(v[r][j].x, v[r][j].y); p.y = pk2(v[r][j].z, v[r][j].w); ((u32x2*)(HN + (size_t)rows[r] * D) + c.lane)[64 * j] = p; } } }
#pragma unroll
        for (int k = 0; k < 4; ++k) GB[c.tid + 512 * k] = st[k];
        lds_barrier();
#pragma unroll 1
        for (int ch = 0; ch < NSG / 4; ++ch) {
            if (ch + 1 < NSG / 4) {
#pragma unroll
                for (int k = 0; k < 4; ++k) st[k] = wsg4[(ch + 1) * 2048 + c.tid + 512 * k]; }
            const LAS f32x4* gb = GB + (ch & 1) * 2048;
            if (NR1 >= 5 && nv == 5) norm_gate_group<(NR1 >= 5 ? 5 : 1)>(v, gb, SG, rows, 4 * ch, c.lane);
            else if (NR1 >= 4 && nv == 4) norm_gate_group<(NR1 >= 4 ? 4 : 1)>(v, gb, SG, rows, 4 * ch, c.lane);
            else if (nv == 3) norm_gate_group<3>(v, gb, SG, rows, 4 * ch, c.lane);
            else if (nv == 2) norm_gate_group<2>(v, gb, SG, rows, 4 * ch, c.lane);
            else if (nv == 1) norm_gate_group<1>(v, gb, SG, rows, 4 * ch, c.lane);
            if (ch + 1 < NSG / 4) {
#pragma unroll
                for (int k = 0; k < 4; ++k) GB[((ch + 1) & 1) * 2048 + c.tid + 512 * k] = st[k]; }
            lds_barrier();
        }
    }
}
__device__ __forceinline__ void final_rows(const Ctx& c0, const int r0, const int r1, const int gw, const int NGW) {
    Ctx c = c0; c.lane = hw_lane(); c.tid = c.wave * 64 + c.lane;
    const float* X = (const float*)(c.ws + WS_X); const float* w = inp(c, I_FNW);
    f32x4 wv[8];
#pragma unroll
    for (int j = 0; j < 8; ++j) wv[j] = ((const f32x4*)w)[c.lane + 64 * j];
    for (int row = r0 + gw; row < r1; row += NGW) {
        float* dst;
        if (row < MPROMPT) { const int b = row / TP, t = row % TP; if (t < NMETA) continue; dst = c.out + O_YP + ((size_t)b * SEQ + (t - NMETA)) * D; }
        else dst = c.out + O_YS + (size_t)(row - MPROMPT) * D;
        const f32x4* xr = (const f32x4*)(X + (size_t)row * D) + c.lane;
        f32x4 v[8]; float s = 0.f;
#pragma unroll
        for (int j = 0; j < 8; ++j) { v[j] = xr[64 * j]; s += (v[j].x * v[j].x + v[j].y * v[j].y) + (v[j].z * v[j].z + v[j].w * v[j].w); }
        const float rstd = rsqrtf(wave_sum(s) * (1.f / D) + 1e-6f);
#pragma unroll
        for (int j = 0; j < 8; ++j) ((f32x4*)dst)[c.lane + 64 * j] = v[j] * rstd * wv[j];
    }
}
#ifndef FIN_IN_TAIL
#define FIN_IN_TAIL 1
#endif
__device__ __forceinline__ void phase_final(const Ctx& c0) {
    const bool tail_did = FIN_IN_TAIL && c0.G == 256;
    final_rows(c0, tail_did ? 8192 : 0, MREAL, c0.bid * NWAVES + c0.wave, c0.G * NWAVES);
}

__device__ __forceinline__ void mlstm_unit(const Ctx& c0, int l, int seq, int h) {
    Ctx c = c0; c.lane = hw_lane(); c.tid = c.wave * 64 + c.lane;
    const int tid = c.tid, v = tid & 255, kh = c.wave >> 2;
    const bool prompt = seq < BATCH; const int T = prompt ? TP : 1; const int row0 = prompt ? seq * TP : MPROMPT + (seq - BATCH);
    const bf16_t* PROJ = (const bf16_t*)(c.ws + WS_PROJ); const float* SG = (const float*)(c.ws + WS_SG); bf16_t* YBR = (bf16_t*)(c.ws + WS_YBR);
    LAS float* sm = (LAS float*)c.lds; LAS float* qs = sm, *ks = sm + 256, *vs = sm + 512, *red = sm + 768, *misc = sm + 1280, *sc = sm + 1296;
    float C[128]; float nreg = 0.f, m = 0.f;
    float *oc, *on, *om;
    if (prompt) { oc = c.out + O_PC + (((size_t)l * BATCH + seq) * HA + h) * DHA * DHA; on = c.out + O_PN + (((size_t)l * BATCH + seq) * HA + h) * DHA; om = c.out + O_PM + ((size_t)l * BATCH + seq) * HA + h;
#pragma unroll
        for (int j = 0; j < 128; ++j) C[j] = 0.f;
    } else { const int s = seq - BATCH; const size_t u = ((size_t)l * NB + s) * HA + h;
        oc = c.out + O_SC + u * DHA * DHA; on = c.out + O_SN + u * DHA; om = c.out + O_SM + u;
        const float* ci = inp(c, I_SC) + u * DHA * DHA;
        { const float* cp = ci + ((size_t)(kh * 128) * 256 + v);
#pragma unroll
          for (int jj = 0; jj < 32; ++jj) { asm volatile("" : "+v"(cp)); C[4 * jj] = cp[0]; C[4 * jj + 1] = cp[256]; C[4 * jj + 2] = cp[512]; C[4 * jj + 3] = cp[768]; cp += 1024; } }
        if (tid < 256) nreg = inp(c, I_SN)[u * DHA + tid];
        m = inp(c, I_SM)[u];
    }
    const float bi = inp(c, I_BI)[l * HA + h], bfv = inp(c, I_BF)[l * HA + h];
    const float nw = tid < 256 ? inp(c, I_MNW)[l * 1024 + h * 256 + tid] : 0.f;
    for (int t = 0; t < T; ++t) {
        const size_t row = (size_t)(row0 + t); const bf16_t* prow = PROJ + row * NPROJ;
        if (tid < 256) { qs[tid] = bf2f(prow[PA_Q + h * 256 + tid]); ks[tid] = bf2f(prow[PA_K + h * 256 + tid]) * 0.0625f; vs[tid] = bf2f(prow[PA_V + h * 256 + tid]); }
        if (tid == 0) { misc[0] = SG[row * SGLD + h] + bi; misc[1] = -softplusf_(-(SG[row * SGLD + 4 + h] + bfv)); }
        lds_barrier();
        const float gi = misc[0], gf = misc[1];
        const float mn = fmaxf(gf + m, gi), fw = __expf(gf + m - mn), iw = __expf(gi - mn); m = mn;
        const float vv = vs[v] * iw; float acc = 0.f;
#pragma unroll
        for (int jj = 0; jj < 16; ++jj) {
            const f32x4 k0 = *(const LAS f32x4*)(ks + kh * 128 + jj * 8), k1 = *(const LAS f32x4*)(ks + kh * 128 + jj * 8 + 4);
            const f32x4 q0 = *(const LAS f32x4*)(qs + kh * 128 + jj * 8), q1 = *(const LAS f32x4*)(qs + kh * 128 + jj * 8 + 4);
#pragma unroll
            for (int e = 0; e < 4; ++e) { C[jj * 8 + e] = fw * C[jj * 8 + e] + k0[e] * vv; acc += q0[e] * C[jj * 8 + e];
                                          C[jj * 8 + 4 + e] = fw * C[jj * 8 + 4 + e] + k1[e] * vv; acc += q1[e] * C[jj * 8 + 4 + e]; }
            asm volatile("" ::: "memory");
        }
        red[tid] = acc;
        float dpart = 0.f;
        if (tid < 256) { nreg = fw * nreg + iw * ks[tid]; dpart = qs[tid] * nreg; }
        const float den = block_sum(dpart, sc, c.wave);
        float hh = 0.f;
        if (tid < 256) hh = (red[tid] + red[256 + tid]) / fmaxf(fabsf(den), __expf(-m));
        const float ss = block_sum(hh * hh, sc, c.wave);
        if (tid < 256) { const float y = hh * rsqrtf(ss * (1.f / 256.f) + 1e-6f) * nw; const float o = bf2f(prow[PA_O + h * 256 + tid]);
            YBR[row * YLD + h * 256 + tid] = (bf16_t)f2bf(sigmoidf_(o) * y); }
        lds_barrier();
    }
    { float* op = oc + ((size_t)(kh * 128) * 256 + v);
#pragma unroll
      for (int jj = 0; jj < 32; ++jj) { asm volatile("" : "+v"(op)); op[0] = C[4 * jj]; op[256] = C[4 * jj + 1]; op[512] = C[4 * jj + 2]; op[768] = C[4 * jj + 3]; op += 1024; } }
    if (tid < 256) on[tid] = nreg;
    if (tid == 0) *om = m;
    lds_barrier();
}

__device__ __forceinline__ void mlstm_unit_s(const Ctx& c0, int l, int s, int h) {
    Ctx c = c0; c.lane = hw_lane(); c.tid = c.wave * 64 + c.lane;
    const int tid = c.tid, vq = c.lane, kg = c.wave;
    const size_t row = (size_t)(MPROMPT + s);
    const bf16_t* PROJ = (const bf16_t*)(c.ws + WS_PROJ); const float* SG = (const float*)(c.ws + WS_SG); bf16_t* YBR = (bf16_t*)(c.ws + WS_YBR);
    LAS float* sm = (LAS float*)c.lds; LAS float* qs = sm, *ks = sm + 256, *vs = sm + 512, *red = sm + 768  , *misc = sm + 2816, *sc = sm + 2832;
    const size_t u = ((size_t)l * NB + s) * HA + h;
    const f32x4* ci = (const f32x4*)(inp(c, I_SC) + u * DHA * DHA) + (size_t)(kg * 32) * 64 + vq;
    f32x4* oc = (f32x4*)(c.out + O_SC + u * DHA * DHA) + (size_t)(kg * 32) * 64 + vq;
    f32x4 C[32];
#pragma unroll
    for (int j = 0; j < 32; ++j) C[j] = ci[j * 64];
    float nreg = 0.f;
    if (tid < 256) nreg = inp(c, I_SN)[u * DHA + tid];
    float m = inp(c, I_SM)[u];
    const float bi = inp(c, I_BI)[l * HA + h], bfv = inp(c, I_BF)[l * HA + h];
    const float nw = tid < 256 ? inp(c, I_MNW)[l * 1024 + h * 256 + tid] : 0.f;
    const bf16_t* prow = PROJ + row * NPROJ;
    if (tid < 256) { qs[tid] = bf2f(prow[PA_Q + h * 256 + tid]); ks[tid] = bf2f(prow[PA_K + h * 256 + tid]) * 0.0625f; vs[tid] = bf2f(prow[PA_V + h * 256 + tid]); }
    if (tid == 0) { misc[0] = SG[row * SGLD + h] + bi; misc[1] = -softplusf_(-(SG[row * SGLD + 4 + h] + bfv)); }
    lds_barrier();
    const float gi = misc[0], gf = misc[1];
    const float mn = fmaxf(gf + m, gi), fw = __expf(gf + m - mn), iw = __expf(gi - mn); m = mn;
    const f32x4 vv = *(const LAS f32x4*)(vs + 4 * vq) * iw;
    f32x4 acc = (f32x4){0.f, 0.f, 0.f, 0.f};
#pragma unroll
    for (int jj = 0; jj < 8; ++jj) {
        const f32x4 k4 = *(const LAS f32x4*)(ks + kg * 32 + jj * 4), q4 = *(const LAS f32x4*)(qs + kg * 32 + jj * 4);
#pragma unroll
        for (int e = 0; e < 4; ++e) { C[jj * 4 + e] = C[jj * 4 + e] * fw + vv * k4[e]; acc += C[jj * 4 + e] * q4[e]; }
    }
#pragma unroll
    for (int j = 0; j < 32; ++j) oc[j * 64] = C[j];
    *(LAS f32x4*)(red + kg * 256 + 4 * vq) = acc;
    float dpart = 0.f;
    if (tid < 256) { nreg = fw * nreg + iw * ks[tid]; dpart = qs[tid] * nreg; }
    const float den = block_sum(dpart, sc, c.wave);
    float hh = 0.f;
    if (tid < 256) { float num = 0.f;
#pragma unroll
        for (int g = 0; g < 8; ++g) num += red[g * 256 + tid];
        hh = num / fmaxf(fabsf(den), __expf(-m)); }
    const float ss = block_sum(hh * hh, sc, c.wave);
    if (tid < 256) { const float y = hh * rsqrtf(ss * (1.f / 256.f) + 1e-6f) * nw; const float o = bf2f(prow[PA_O + h * 256 + tid]);
        YBR[row * YLD + h * 256 + tid] = (bf16_t)f2bf(sigmoidf_(o) * y);
        (c.out + O_SN + u * DHA)[tid] = nreg; }
    if (tid == 0) (c.out + O_SM)[u] = m;
    lds_barrier();
}

__device__ __forceinline__ void gdn_unit(const Ctx& c0, int l, int seq, int h) {
    Ctx c = c0; c.lane = hw_lane(); c.tid = c.wave * 64 + c.lane;
    const int tid = c.tid, v = tid & 127, kq = tid >> 7;
    const bool prompt = seq < BATCH; const int T = prompt ? TP : 1; const int row0 = prompt ? seq * TP : MPROMPT + (seq - BATCH);
    const bf16_t* PROJ = (const bf16_t*)(c.ws + WS_PROJ); const float* SG = (const float*)(c.ws + WS_SG); bf16_t* YBR = (bf16_t*)(c.ws + WS_YBR);
    LAS float* sm = (LAS float*)c.lds; LAS float* ring = sm  , *qk = sm + 1536  , *red = sm + 1920  , *part = sm + 2432  , *sc = sm + 2448;
    float S[32];
    float *os, *ocv; const float* cin = nullptr;
    const int cg = tid < 384 ? (tid >> 7) * 1024 + h * 128 + (tid & 127) : 0;
    if (prompt) { os = c.out + O_PGS + (((size_t)l * BATCH + seq) * HB + h) * DHB * DHB; ocv = c.out + O_PGC + ((size_t)l * BATCH + seq) * 3 * 3072;
#pragma unroll
        for (int j = 0; j < 32; ++j) S[j] = 0.f;
    } else { const int s = seq - BATCH; const size_t u = ((size_t)l * NB + s) * HB + h;
        os = c.out + O_SGS + u * DHB * DHB; ocv = c.out + O_SGC + ((size_t)l * NB + s) * 3 * 3072;
        const float* si = inp(c, I_SGS) + u * DHB * DHB;
#pragma unroll
        for (int j = 0; j < 32; ++j) S[j] = si[(size_t)(kq * 32 + j) * 128 + v];
        cin = inp(c, I_SGC) + ((size_t)l * NB + s) * 3 * 3072;
    }
    float cw0 = 0.f, cw1 = 0.f, cw2 = 0.f, cw3 = 0.f;
    if (tid < 384) { const float* cw = inp(c, I_CONVW) + (size_t)l * 4 * 3072; cw0 = cw[cg]; cw1 = cw[3072 + cg]; cw2 = cw[2 * 3072 + cg]; cw3 = cw[3 * 3072 + cg];
        ring[3 * 384 + tid] = cin ? cin[2 * 3072 + cg] : 0.f; ring[2 * 384 + tid] = cin ? cin[3072 + cg] : 0.f; ring[1 * 384 + tid] = cin ? cin[cg] : 0.f; ring[tid] = 0.f; }
    const float alog = inp(c, I_ALOG)[l * HB + h], dtb = inp(c, I_DTB)[l * HB + h];
    const float gnw = tid < 128 ? inp(c, I_GNW)[l * DHB + tid] : 0.f;
    lds_barrier();
    for (int t = 0; t < T; ++t) {
        const size_t row = (size_t)(row0 + t); const bf16_t* prow = PROJ + row * NPROJ;
        float y = 0.f;
        if (tid < 384) { const float u = bf2f(prow[PB_QKV + cg]); ring[(t & 3) * 384 + tid] = u;
            y = cw3 * u + cw2 * ring[((t - 1) & 3) * 384 + tid] + cw1 * ring[((t - 2) & 3) * 384 + tid] + cw0 * ring[((t - 3) & 3) * 384 + tid];
            y = siluf_(y); qk[tid] = y; }
        { const float s2 = wave_sum(y * y); if (c.lane == 0) part[c.wave] = s2; }
        lds_barrier();
        const float qn = rsqrtf(part[0] + part[1] + 1e-12f) * 0.08838834764831845f, kn = rsqrtf(part[2] + part[3] + 1e-12f);
        const float ga = SG[row * SGLD + 8 + h], gb = SG[row * SGLD + 16 + h];
        const float alpha = __expf(-__expf(alog) * softplusf_(ga + dtb)), beta = sigmoidf_(gb);
        float p = 0.f;
#pragma unroll
        for (int j = 0; j < 32; ++j) p += qk[128 + kq * 32 + j] * S[j];
        red[tid] = p * kn;
        lds_barrier();
        const float kS = red[v] + red[128 + v] + red[256 + v] + red[384 + v];
        const float vn = beta * (qk[256 + v] - alpha * kS);
        float o = 0.f;
#pragma unroll
        for (int j = 0; j < 32; ++j) { S[j] = alpha * S[j] + (qk[128 + kq * 32 + j] * kn) * vn; o += qk[kq * 32 + j] * S[j]; }
        lds_barrier();
        red[tid] = o * qn;
        lds_barrier();
        float oo = 0.f;
        if (tid < 128) oo = red[tid] + red[128 + tid] + red[256 + tid] + red[384 + tid];
        const float ss = block_sum(oo * oo, sc, c.wave);
        if (tid < 128) { const float z = bf2f(prow[PB_Z + h * 128 + tid]);
            YBR[row * YLD + 1024 + h * 128 + tid] = (bf16_t)f2bf(oo * rsqrtf(ss * (1.f / 128.f) + 1e-6f) * gnw * siluf_(z)); }
        lds_barrier();
    }
#pragma unroll
    for (int j = 0; j < 32; ++j) os[(size_t)(kq * 32 + j) * 128 + v] = S[j];
    if (tid < 384) {
#pragma unroll
        for (int j = 0; j < 3; ++j) ocv[j * 3072 + cg] = ring[((T - 3 + j) & 3) * 384 + tid];
    }
    lds_barrier();
}

__device__ __forceinline__ void gdn_unit_s(const Ctx& c0, int l, int s, int h) {
    Ctx c = c0; c.lane = hw_lane(); c.tid = c.wave * 64 + c.lane;
    const int tid = c.tid, vq = tid & 31, kg = tid >> 5;
    const size_t row = (size_t)(MPROMPT + s);
    const bf16_t* PROJ = (const bf16_t*)(c.ws + WS_PROJ); const float* SG = (const float*)(c.ws + WS_SG); bf16_t* YBR = (bf16_t*)(c.ws + WS_YBR);
    LAS float* sm = (LAS float*)c.lds; LAS float* qk = sm  , *red = sm + 384  , *red2 = sm + 2432  , *part = sm + 4480  , *sc = sm + 4496;
    const size_t u = ((size_t)l * NB + s) * HB + h;
    const f32x4* si = (const f32x4*)(inp(c, I_SGS) + u * DHB * DHB) + (size_t)(kg * 8) * 32 + vq;
    f32x4* os = (f32x4*)(c.out + O_SGS + u * DHB * DHB) + (size_t)(kg * 8) * 32 + vq;
    f32x4 S[8];
#pragma unroll
    for (int j = 0; j < 8; ++j) S[j] = si[j * 32];
    const bf16_t* prow = PROJ + row * NPROJ;
    float y = 0.f;
    if (tid < 384) { const int cg = (tid >> 7) * 1024 + h * 128 + (tid & 127);
        const float* cw = inp(c, I_CONVW) + (size_t)l * 4 * 3072; const float* cin = inp(c, I_SGC) + ((size_t)l * NB + s) * 3 * 3072; float* ocv = c.out + O_SGC + ((size_t)l * NB + s) * 3 * 3072;
        const float cw0 = cw[cg], cw1 = cw[3072 + cg], cw2 = cw[2 * 3072 + cg], cw3 = cw[3 * 3072 + cg];
        const float p0 = cin[cg], p1 = cin[3072 + cg], p2 = cin[2 * 3072 + cg]; const float uu = bf2f(prow[PB_QKV + cg]);
        y = siluf_(cw3 * uu + cw2 * p2 + cw1 * p1 + cw0 * p0); qk[tid] = y;
        ocv[cg] = p1; ocv[3072 + cg] = p2; ocv[2 * 3072 + cg] = uu; }
    { const float s2 = wave_sum(y * y); if (c.lane == 0) part[c.wave] = s2; }
    const float alog = inp(c, I_ALOG)[l * HB + h], dtb = inp(c, I_DTB)[l * HB + h];
    const float ga = SG[row * SGLD + 8 + h], gb = SG[row * SGLD + 16 + h];
    const float gnw = tid < 128 ? inp(c, I_GNW)[l * DHB + tid] : 0.f;
    const float z = tid < 128 ? bf2f(prow[PB_Z + h * 128 + tid]) : 0.f;
    lds_barrier();
    const float qn = rsqrtf(part[0] + part[1] + 1e-12f) * 0.08838834764831845f, kn = rsqrtf(part[2] + part[3] + 1e-12f);
    const float alpha = __expf(-__expf(alog) * softplusf_(ga + dtb)), beta = sigmoidf_(gb);
    const f32x4 ka = *(const LAS f32x4*)(qk + 128 + kg * 8), kb = *(const LAS f32x4*)(qk + 128 + kg * 8 + 4);
    const f32x4 qa = *(const LAS f32x4*)(qk + kg * 8), qb = *(const LAS f32x4*)(qk + kg * 8 + 4);
    { f32x4 p = S[0] * ka[0];
#pragma unroll
      for (int j = 1; j < 8; ++j) p += S[j] * (j < 4 ? ka[j] : kb[j - 4]);
      *(LAS f32x4*)(red + kg * 128 + 4 * vq) = p; }
    lds_barrier();
    f32x4 kS = *(const LAS f32x4*)(red + 4 * vq);
#pragma unroll
    for (int g = 1; g < 16; ++g) kS += *(const LAS f32x4*)(red + g * 128 + 4 * vq);
    const f32x4 vn = (*(const LAS f32x4*)(qk + 256 + 4 * vq) - kS * (alpha * kn)) * beta;
    { f32x4 o = (f32x4){0.f, 0.f, 0.f, 0.f};
#pragma unroll
      for (int j = 0; j < 8; ++j) { const float kj = (j < 4 ? ka[j] : kb[j - 4]) * kn, qj = j < 4 ? qa[j] : qb[j - 4]; S[j] = S[j] * alpha + vn * kj; o += S[j] * qj; }
#pragma unroll
      for (int j = 0; j < 8; ++j) os[j * 32] = S[j];
      *(LAS f32x4*)(red2 + kg * 128 + 4 * vq) = o; }
    lds_barrier();
    float oo = 0.f;
    if (tid < 128) {
#pragma unroll
        for (int g = 0; g < 16; ++g) oo += red2[g * 128 + tid];
        oo *= qn; }
    const float ss = block_sum(oo * oo, sc, c.wave);
    if (tid < 128) YBR[row * YLD + 1024 + h * 128 + tid] = (bf16_t)f2bf(oo * rsqrtf(ss * (1.f / 128.f) + 1e-6f) * gnw * siluf_(z));
    lds_barrier();
}

__device__ __forceinline__ void gdn_unit_s2(const Ctx& c0, int l, int s, int h0) {
    Ctx c = c0; c.lane = hw_lane(); c.tid = c.wave * 64 + c.lane;
    const int tid = c.tid, vq = tid & 31, kg = tid >> 5;
    const size_t row = (size_t)(MPROMPT + s);
    const bf16_t* PROJ = (const bf16_t*)(c.ws + WS_PROJ); const float* SG = (const float*)(c.ws + WS_SG); bf16_t* YBR = (bf16_t*)(c.ws + WS_YBR);
    LAS float* sm = (LAS float*)c.lds; LAS float* qk = sm  , *red = sm + 768  , *red2 = sm + 4864  , *part = sm + 8960  , *sc = sm + 8976  ;
    const size_t u = ((size_t)l * NB + s) * HB + h0;
    const f32x4* si = (const f32x4*)(inp(c, I_SGS) + u * DHB * DHB) + (size_t)(kg * 8) * 32 + vq;
    f32x4* os = (f32x4*)(c.out + O_SGS + u * DHB * DHB) + (size_t)(kg * 8) * 32 + vq;
    f32x4 S[2][8];
#pragma unroll
    for (int q = 0; q < 2; ++q)
#pragma unroll
        for (int j = 0; j < 8; ++j) S[q][j] = si[q * 4096 + j * 32];
    const bf16_t* prow = PROJ + row * NPROJ;
    float y[2] = {0.f, 0.f};
    if (tid < 384) { const float* cw = inp(c, I_CONVW) + (size_t)l * 4 * 3072; const float* cin = inp(c, I_SGC) + ((size_t)l * NB + s) * 3 * 3072; float* ocv = c.out + O_SGC + ((size_t)l * NB + s) * 3 * 3072;
        float cwv[2][4], pv[2][3], uu[2];
#pragma unroll
        for (int q = 0; q < 2; ++q) { const int cg = (tid >> 7) * 1024 + (h0 + q) * 128 + (tid & 127);
            cwv[q][0] = cw[cg]; cwv[q][1] = cw[3072 + cg]; cwv[q][2] = cw[2 * 3072 + cg]; cwv[q][3] = cw[3 * 3072 + cg];
            pv[q][0] = cin[cg]; pv[q][1] = cin[3072 + cg]; pv[q][2] = cin[2 * 3072 + cg]; uu[q] = bf2f(prow[PB_QKV + cg]); }
#pragma unroll
        for (int q = 0; q < 2; ++q) { const int cg = (tid >> 7) * 1024 + (h0 + q) * 128 + (tid & 127);
            y[q] = siluf_(cwv[q][3] * uu[q] + cwv[q][2] * pv[q][2] + cwv[q][1] * pv[q][1] + cwv[q][0] * pv[q][0]); qk[q * 384 + tid] = y[q];
            ocv[cg] = pv[q][1]; ocv[3072 + cg] = pv[q][2]; ocv[2 * 3072 + cg] = uu[q]; } }
#pragma unroll
    for (int q = 0; q < 2; ++q) { const float s2 = wave_sum(y[q] * y[q]); if (c.lane == 0) part[q * 8 + c.wave] = s2; }
    float alog[2], dtb[2], ga[2], gb[2], z[2];
#pragma unroll
    for (int q = 0; q < 2; ++q) { alog[q] = inp(c, I_ALOG)[l * HB + h0 + q]; dtb[q] = inp(c, I_DTB)[l * HB + h0 + q]; ga[q] = SG[row * SGLD + 8 + h0 + q]; gb[q] = SG[row * SGLD + 16 + h0 + q];
        z[q] = tid < 128 ? bf2f(prow[PB_Z + (h0 + q) * 128 + tid]) : 0.f; }
    const float gnw = tid < 128 ? inp(c, I_GNW)[l * DHB + tid] : 0.f;
    lds_barrier();
    float qn[2], kn[2], alpha[2], beta[2];
#pragma unroll
    for (int q = 0; q < 2; ++q) { qn[q] = rsqrtf(part[q * 8] + part[q * 8 + 1] + 1e-12f) * 0.08838834764831845f; kn[q] = rsqrtf(part[q * 8 + 2] + part[q * 8 + 3] + 1e-12f);
        alpha[q] = __expf(-__expf(alog[q]) * softplusf_(ga[q] + dtb[q])); beta[q] = sigmoidf_(gb[q]);
        const LAS float* qq = qk + q * 384;
        const f32x4 ka = *(const LAS f32x4*)(qq + 128 + kg * 8), kb = *(const LAS f32x4*)(qq + 128 + kg * 8 + 4);
        f32x4 p = S[q][0] * ka[0];
#pragma unroll
        for (int j = 1; j < 8; ++j) p += S[q][j] * (j < 4 ? ka[j] : kb[j - 4]);
        *(LAS f32x4*)(red + q * 2048 + kg * 128 + 4 * vq) = p; }
    lds_barrier();
#pragma unroll
    for (int q = 0; q < 2; ++q) { const LAS float* qq = qk + q * 384; const LAS float* rq = red + q * 2048;
        const f32x4 ka = *(const LAS f32x4*)(qq + 128 + kg * 8), kb = *(const LAS f32x4*)(qq + 128 + kg * 8 + 4);
        const f32x4 qa = *(const LAS f32x4*)(qq + kg * 8), qb = *(const LAS f32x4*)(qq + kg * 8 + 4);
        f32x4 kS = *(const LAS f32x4*)(rq + 4 * vq);
#pragma unroll
        for (int g = 1; g < 16; ++g) kS += *(const LAS f32x4*)(rq + g * 128 + 4 * vq);
        const f32x4 vn = (*(const LAS f32x4*)(qq + 256 + 4 * vq) - kS * (alpha[q] * kn[q])) * beta[q];
        f32x4 o = (f32x4){0.f, 0.f, 0.f, 0.f};
#pragma unroll
        for (int j = 0; j < 8; ++j) { const float kj = (j < 4 ? ka[j] : kb[j - 4]) * kn[q], qj = j < 4 ? qa[j] : qb[j - 4]; S[q][j] = S[q][j] * alpha[q] + vn * kj; o += S[q][j] * qj; }
#pragma unroll
        for (int j = 0; j < 8; ++j) os[q * 4096 + j * 32] = S[q][j];
        *(LAS f32x4*)(red2 + q * 2048 + kg * 128 + 4 * vq) = o; }
    lds_barrier();
    float oo[2] = {0.f, 0.f};
    if (tid < 128) {
#pragma unroll
        for (int q = 0; q < 2; ++q) {
#pragma unroll
            for (int g = 0; g < 16; ++g) oo[q] += red2[q * 2048 + g * 128 + tid];
            oo[q] *= qn[q]; } }
#pragma unroll
    for (int q = 0; q < 2; ++q) { const float t = wave_sum(oo[q] * oo[q]); if (c.lane == 0) sc[q * 8 + c.wave] = t; }
    lds_barrier();
    if (tid < 128) {
#pragma unroll
        for (int q = 0; q < 2; ++q) { float ss = 0.f;
#pragma unroll
            for (int i = 0; i < 8; ++i) ss += sc[q * 8 + i];
            YBR[row * YLD + 1024 + (h0 + q) * 128 + tid] = (bf16_t)f2bf(oo[q] * rsqrtf(ss * (1.f / 128.f) + 1e-6f) * gnw * siluf_(z[q])); } }
    lds_barrier();
}

__device__ __forceinline__ void rwkv_unit(const Ctx& c0, int l, int seq, int h, int& cached_h) {
    Ctx c = c0; c.lane = hw_lane(); c.tid = c.wave * 64 + c.lane;
    const int tid = c.tid, k = tid & 63, vq = tid >> 6;
    const bool prompt = seq < BATCH; const int T = prompt ? TP : 1; const int row0 = prompt ? seq * TP : MPROMPT + (seq - BATCH);
    const bf16_t* PROJ = (const bf16_t*)(c.ws + WS_PROJ); bf16_t* YBR = (bf16_t*)(c.ws + WS_YBR);
    LAS float* sm = (LAS float*)c.lds;
    LAS float* w2s = sm, *a2s = sm + 4096, *g2s = sm + 8192  , *xs = sm + 16384  , *partl = sm + 16896  ;
    LAS float* dec = sm + 17408, *k2s = dec + 64, *avs = dec + 128, *bvs = dec + 192, *rrs = dec + 256, *vvs = dec + 320, *ggs = dec + 384, *ys = dec + 448, *misc = dec + 512;
    float S[8];
    float *os, *osh; const float* shin = nullptr;
    if (prompt) { os = c.out + O_PRS + (((size_t)l * BATCH + seq) * HC + h) * DHC * DHC; osh = c.out + O_PRSH + ((size_t)l * BATCH + seq) * NCC;
#pragma unroll
        for (int j = 0; j < 8; ++j) S[j] = 0.f;
    } else { const int s = seq - BATCH; const size_t u = ((size_t)l * NB + s) * HC + h;
        os = c.out + O_SRS + u * DHC * DHC; osh = c.out + O_SRSH + ((size_t)l * NB + s) * NCC;
        const float* si = inp(c, I_SRS) + u * DHC * DHC;
#pragma unroll
        for (int j = 0; j < 8; ++j) S[j] = si[(size_t)(vq * 8 + j) * 64 + k];
        shin = inp(c, I_SRSH) + ((size_t)l * NB + s) * NCC;
    }
    if (cached_h != h) { cached_h = h; const float* w2p = inp(c, I_W2) + (size_t)l * 64 * 1024 + h * 64; const float* a2p = inp(c, I_A2) + (size_t)l * 64 * 1024 + h * 64; const float* g2p = inp(c, I_G2) + (size_t)l * 128 * 1024 + h * 64;
      float lw2[8], la2[8], lg2[16];
#pragma unroll
      for (int k = 0; k < 8; ++k) { const int i = tid + k * NTHR; lw2[k] = w2p[(i >> 6) * 1024 + (i & 63)]; la2[k] = a2p[(i >> 6) * 1024 + (i & 63)]; }
#pragma unroll
      for (int k = 0; k < 16; ++k) { const int i = tid + k * NTHR; lg2[k] = g2p[(i >> 6) * 1024 + (i & 63)]; }
#pragma unroll
      for (int k = 0; k < 8; ++k) { const int i = tid + k * NTHR; w2s[i] = lw2[k]; a2s[i] = la2[k]; }
#pragma unroll
      for (int k = 0; k < 16; ++k) { const int i = tid + k * NTHR; g2s[i] = lg2[k]; } }
    int cidx = 0;
    if (tid < 64) cidx = h * 64 + tid; else if (tid < 128) cidx = 1024 + h * 64 + (tid - 64); else if (tid < 192) cidx = 2048 + h * 64 + (tid - 128); else if (tid < 448) cidx = 3072 + (tid - 192);
    float prev = 0.f, mu = 0.f;
    if (tid < 448) { prev = shin ? shin[cidx] : 0.f; mu = inp(c, I_MU)[(size_t)l * NCC + cidx]; }
    const int C = h * 64 + (tid & 63);
    float w0 = 0.f, a0 = 0.f, kkw = 0.f, kaw = 0.f, rkw = 0.f, lnw = 0.f, lnb = 0.f;
    if (tid < 64) { w0 = inp(c, I_W0)[l * 1024 + C]; a0 = inp(c, I_A0)[l * 1024 + C]; kkw = inp(c, I_KK)[l * 1024 + C]; kaw = inp(c, I_KA)[l * 1024 + C]; rkw = inp(c, I_RK)[l * 1024 + C];
        lnw = inp(c, I_LNW)[l * 1024 + C]; lnb = inp(c, I_LNB)[l * 1024 + C]; }
    lds_barrier();
    for (int t = 0; t < T; ++t) {
        const size_t row = (size_t)(row0 + t); const bf16_t* prow = PROJ + row * NPROJ;
        if (tid < 448) { const float cur = bf2f(prow[PC0 + cidx]); float xm = cur + (prev - cur) * mu; prev = cur;
            if (tid >= 192 && tid < 256) xm = ftanh(xm); else if (tid >= 320) xm = sigmoidf_(xm);
            xs[tid] = xm; }
        lds_barrier();
        { const int cc = tid & 63, pt = tid >> 6; float a = 0.f;
            if (pt < 2) { for (int j = 0; j < 32; ++j) a += xs[192 + pt * 32 + j] * w2s[(pt * 32 + j) * 64 + cc]; }
            else if (pt < 4) { for (int j = 0; j < 32; ++j) a += xs[256 + (pt - 2) * 32 + j] * a2s[((pt - 2) * 32 + j) * 64 + cc]; }
            else { for (int j = 0; j < 32; ++j) a += xs[320 + (pt - 4) * 32 + j] * g2s[((pt - 4) * 32 + j) * 64 + cc]; }
            partl[pt * 64 + cc] = a; }
        lds_barrier();
        if (tid < 64) {
            const float wl = w0 + partl[tid] + partl[64 + tid]; const float wlog = -softplusf_(-wl) - 0.5f; const float dc = __expf(-__expf(wlog));
            const float aa = sigmoidf_(a0 + partl[128 + tid] + partl[192 + tid]);
            const float gg = (partl[256 + tid] + partl[320 + tid]) + (partl[384 + tid] + partl[448 + tid]);
            const float kraw = xs[64 + tid], kkv = kraw * kkw; const float nrm = wave_sum(kkv * kkv); const float kk = kkv * rsqrtf(nrm + 1e-12f);
            const float k2 = kraw * (1.f + (aa - 1.f) * kaw);
            dec[tid] = dc; k2s[tid] = k2; avs[tid] = -kk; bvs[tid] = kk * aa; rrs[tid] = xs[tid]; vvs[tid] = xs[128 + tid]; ggs[tid] = gg;
            const float bs = wave_sum(xs[tid] * k2 * rkw); if (tid == 0) misc[0] = bs;
        }
        lds_barrier();
        { const float av = avs[k], bv = bvs[k], dk = dec[k], kk2 = k2s[k], rr = rrs[k];
#pragma unroll
            for (int j = 0; j < 8; ++j) { const int vi = vq * 8 + j; const float sa = wave_sum(S[j] * av); S[j] = S[j] * dk + sa * bv + vvs[vi] * kk2; const float yy = wave_sum(S[j] * rr); if (k == 0) ys[vi] = yy; } }
        lds_barrier();
        if (tid < 64) { const float y = ys[tid]; const float mean = wave_sum(y) * (1.f / 64.f); const float d = y - mean; const float var = wave_sum(d * d) * (1.f / 64.f);
            const float yn = d * rsqrtf(var + 64e-5f) * lnw + lnb; const float o = (yn + misc[0] * vvs[tid]) * ggs[tid];
            YBR[row * YLD + 2048 + h * 64 + tid] = (bf16_t)f2bf(o); }
        lds_barrier();
    }
#pragma unroll
    for (int j = 0; j < 8; ++j) os[(size_t)(vq * 8 + j) * 64 + k] = S[j];
    if (tid < 192 || (h == 0 && tid < 448)) osh[cidx] = prev;
    lds_barrier();
}


__device__ __forceinline__ void rwkv_unit4(const Ctx& c0, int l, int s0, int h, int& cached_h) {
    Ctx c = c0; c.lane = hw_lane(); c.tid = c.wave * 64 + c.lane;
    const int tid = c.tid, k = tid & 63, vq = tid >> 6;
    const bf16_t* PROJ = (const bf16_t*)(c.ws + WS_PROJ); bf16_t* YBR = (bf16_t*)(c.ws + WS_YBR);
    LAS float* sm = (LAS float*)c.lds;
    LAS float* W = sm  , *xs = sm + 16384  , *partl = sm + 18176  , *vec = sm + 20224  , *misc = sm + 22272  ;
    const size_t u0 = ((size_t)l * NB + s0) * HC + h;
    float S[4][8];
    { const float* si = inp(c, I_SRS) + u0 * DHC * DHC;
#pragma unroll
      for (int q = 0; q < 4; ++q)
#pragma unroll
        for (int j = 0; j < 8; ++j) S[q][j] = si[(size_t)q * HC * DHC * DHC + (size_t)(vq * 8 + j) * 64 + k]; }
    if (cached_h != h) { cached_h = h; const float* w2p = inp(c, I_W2) + (size_t)l * 64 * 1024 + h * 64; const float* a2p = inp(c, I_A2) + (size_t)l * 64 * 1024 + h * 64; const float* g2p = inp(c, I_G2) + (size_t)l * 128 * 1024 + h * 64;
      float lw2[8], la2[8], lg2[16];
#pragma unroll
      for (int kk = 0; kk < 8; ++kk) { const int i = tid + kk * NTHR; lw2[kk] = w2p[(i >> 6) * 1024 + (i & 63)]; la2[kk] = a2p[(i >> 6) * 1024 + (i & 63)]; }
#pragma unroll
      for (int kk = 0; kk < 16; ++kk) { const int i = tid + kk * NTHR; lg2[kk] = g2p[(i >> 6) * 1024 + (i & 63)]; }
#pragma unroll
      for (int kk = 0; kk < 8; ++kk) { const int i = tid + kk * NTHR; W[i] = lw2[kk]; W[4096 + i] = la2[kk]; }
#pragma unroll
      for (int kk = 0; kk < 16; ++kk) { const int i = tid + kk * NTHR; W[8192 + i] = lg2[kk]; } }
    int cidx = 0;
    if (tid < 64) cidx = h * 64 + tid; else if (tid < 128) cidx = 1024 + h * 64 + (tid - 64); else if (tid < 192) cidx = 2048 + h * 64 + (tid - 128); else if (tid < 448) cidx = 3072 + (tid - 192);
    const int C = h * 64 + k;
    float w0 = 0.f, a0 = 0.f, kkw = 0.f, kaw = 0.f, rkw = 0.f, lnw = 0.f, lnb = 0.f;
    if (tid < 256) { w0 = inp(c, I_W0)[l * 1024 + C]; a0 = inp(c, I_A0)[l * 1024 + C]; kkw = inp(c, I_KK)[l * 1024 + C]; kaw = inp(c, I_KA)[l * 1024 + C]; rkw = inp(c, I_RK)[l * 1024 + C];
        lnw = inp(c, I_LNW)[l * 1024 + C]; lnb = inp(c, I_LNB)[l * 1024 + C]; }
    if (tid < 448) { const float mu = inp(c, I_MU)[(size_t)l * NCC + cidx]; const float* shin = inp(c, I_SRSH) + ((size_t)l * NB + s0) * NCC + cidx; float* osh = c.out + O_SRSH + ((size_t)l * NB + s0) * NCC + cidx;
        float prev[4], cur[4];
#pragma unroll
        for (int q = 0; q < 4; ++q) { prev[q] = shin[(size_t)q * NCC]; cur[q] = bf2f(PROJ[(size_t)(MPROMPT + s0 + q) * NPROJ + PC0 + cidx]); }
#pragma unroll
        for (int q = 0; q < 4; ++q) { float xm = cur[q] + (prev[q] - cur[q]) * mu;
            if (tid >= 192 && tid < 256) xm = ftanh(xm); else if (tid >= 320) xm = sigmoidf_(xm);
            xs[q * 448 + tid] = xm;
            if (tid < 192 || h == 0) osh[(size_t)q * NCC] = cur[q]; } }
    lds_barrier();
    { const int pt = vq; float a[4] = {0.f, 0.f, 0.f, 0.f};
        const LAS float* wp = W + (pt * 32) * 64 + k; const LAS float* xp = xs + 192 + pt * 32;
#pragma unroll 8
        for (int j = 0; j < 32; ++j) { const float wv = wp[j * 64];
#pragma unroll
            for (int q = 0; q < 4; ++q) a[q] += xp[q * 448 + j] * wv; }
#pragma unroll
        for (int q = 0; q < 4; ++q) partl[q * 512 + pt * 64 + k] = a[q]; }
    lds_barrier();
    if (tid < 256) { const int q = vq; const LAS float* pl = partl + q * 512; const LAS float* x = xs + q * 448; LAS float* vv = vec + q * 512;
        const float wl = w0 + pl[k] + pl[64 + k]; const float wlog = -softplusf_(-wl) - 0.5f; const float dc = __expf(-__expf(wlog));
        const float aa = sigmoidf_(a0 + pl[128 + k] + pl[192 + k]);
        const float gg = (pl[256 + k] + pl[320 + k]) + (pl[384 + k] + pl[448 + k]);
        const float kraw = x[64 + k], kkv = kraw * kkw; const float nrm = wave_sum(kkv * kkv); const float kk = kkv * rsqrtf(nrm + 1e-12f);
        const float k2 = kraw * (1.f + (aa - 1.f) * kaw);
        vv[k] = dc; vv[64 + k] = k2; vv[128 + k] = -kk; vv[192 + k] = kk * aa; vv[256 + k] = x[k]; vv[320 + k] = x[128 + k]; vv[384 + k] = gg;
        const float bs = wave_sum(x[k] * k2 * rkw); if (k == 0) misc[q] = bs; }
    lds_barrier();
#pragma unroll
    for (int q = 0; q < 4; ++q) { const LAS float* vv = vec + q * 512; const float dk = vv[k], kk2 = vv[64 + k], av = vv[128 + k], bv = vv[192 + k], rr = vv[256 + k];
#pragma unroll
        for (int j = 0; j < 8; ++j) { const int vi = vq * 8 + j; const float sa = wave_sum(S[q][j] * av); S[q][j] = S[q][j] * dk + sa * bv + vv[320 + vi] * kk2; const float yy = wave_sum(S[q][j] * rr); if (k == 0) vec[q * 512 + 448 + vi] = yy; } }
    lds_barrier();
    if (tid < 256) { const int q = vq; const LAS float* vv = vec + q * 512; const float y = vv[448 + k]; const float mean = wave_sum(y) * (1.f / 64.f); const float d = y - mean; const float var = wave_sum(d * d) * (1.f / 64.f);
        const float yn = d * rsqrtf(var + 64e-5f) * lnw + lnb; const float o = (yn + misc[q] * vv[320 + k]) * vv[384 + k];
        YBR[(size_t)(MPROMPT + s0 + q) * YLD + 2048 + h * 64 + k] = (bf16_t)f2bf(o); }
    { float* os = c.out + O_SRS + u0 * DHC * DHC;
#pragma unroll
      for (int q = 0; q < 4; ++q)
#pragma unroll
        for (int j = 0; j < 8; ++j) os[(size_t)q * HC * DHC * DHC + (size_t)(vq * 8 + j) * 64 + k] = S[q][j]; }
    lds_barrier();
}

__device__ __forceinline__ f32x4 mfma16(bf16x8 a, bf16x8 b, f32x4 c) { return __builtin_amdgcn_mfma_f32_16x16x32_bf16(a, b, c, 0, 0, 0); }
__device__ __forceinline__ bf16x8 ldfrag(const LAS bf16_t* X, int ld, int r0, int k0, int lane) { return *(const LAS bf16x8*)(X + (r0 + (lane & 15)) * ld + k0 + ((lane >> 4) << 3)); }
template <int MT, int NT, int KS>
__device__ __forceinline__ void mma_lds(f32x4 (&acc)[MT][NT], const LAS bf16_t* A, int lda, int m0, const LAS bf16_t* Bt, int ldb, int n0, int lane) {
#pragma unroll
    for (int ks = 0; ks < KS; ++ks) {
        bf16x8 a[MT], b[NT];
#pragma unroll
        for (int i = 0; i < MT; ++i) a[i] = ldfrag(A, lda, m0 + 16 * i, 32 * ks, lane);
#pragma unroll
        for (int j = 0; j < NT; ++j) b[j] = ldfrag(Bt, ldb, n0 + 16 * j, 32 * ks, lane);
#pragma unroll
        for (int i = 0; i < MT; ++i)
#pragma unroll
            for (int j = 0; j < NT; ++j) acc[i][j] = mfma16(a[i], b[j], acc[i][j]);
    }
}
__device__ __forceinline__ float wave_incl_sum(float x, int lane) { (void)lane; return wave_scan_sum(x); }
__device__ __forceinline__ float wave_incl_max(float x, int lane) { (void)lane; const float NI = -__builtin_huge_valf();
    x = fmaxf(x, dpp_mov<0x111, 0xf>(NI, x)); x = fmaxf(x, dpp_mov<0x112, 0xf>(NI, x)); x = fmaxf(x, dpp_mov<0x114, 0xf>(NI, x)); x = fmaxf(x, dpp_mov<0x118, 0xf>(NI, x));
    x = fmaxf(x, dpp_mov<0x142, 0xa>(NI, x)); x = fmaxf(x, dpp_mov<0x143, 0xc>(NI, x));
    return x;
}
__device__ __forceinline__ void chunk_range(int c, int& t0, int& Lv) { if (c == 0) { t0 = 0; Lv = NMETA; } else { t0 = NMETA + 64 * (c - 1); Lv = 64; } }

__device__ __forceinline__ void mlstm_prep_unit(const Ctx& c, int l, int u) {
    int w = c.wave; asm volatile("" : "+s"(w)); const int lane = hw_lane(), tid = w * 64 + lane;
    const int cch = u % NCH, bh = u / NCH, h = bh % HA, b = bh / HA;
    int t0, Lv; chunk_range(cch, t0, Lv);
    const size_t row0 = (size_t)b * TP + t0;
    const bf16_t* PROJ = (const bf16_t*)(c.ws + WS_PROJ); const float* SG = (const float*)(c.ws + WS_SG);
    LAS bf16_t* Qs = (LAS bf16_t*)c.lds; LAS bf16_t* Ks = Qs + 64 * 264; LAS bf16_t* VTs = Ks + 64 * 264; LAS bf16_t* Ss = VTs + 256 * 72;
    LAS float* ga = (LAS float*)(Ss + 64 * 72); LAS float* gcm = ga + 64, *gb = ga + 128, *gwk = ga + 192, *dpart = ga + 256  ;
    bf16_t* gKTw = (bf16_t*)(c.ws + WS_ML_KTW) + (size_t)u * 256 * 64; bf16_t* gVT = (bf16_t*)(c.ws + WS_ML_VT) + (size_t)u * 256 * 64;
    float* gNP = (float*)(c.ws + WS_ML_NP) + (size_t)u * 64 * 256; float* gSC = (float*)(c.ws + WS_ML_SC) + (size_t)u * 256;
    if (w == 0) {
        float li = -1e30f, lf = 0.f;
        if (lane < Lv) { li = SG[(row0 + lane) * SGLD + h] + inp(c, I_BI)[l * HA + h]; lf = -softplusf_(-(SG[(row0 + lane) * SGLD + 4 + h] + inp(c, I_BF)[l * HA + h])); }
        const float bb = wave_incl_sum(lf, lane); const float a = li - bb; const float cm = wave_incl_max(a, lane);
        const float cml = lane_bcast(cm, 63);
        ga[lane] = a; gcm[lane] = cm; gb[lane] = bb; gwk[lane] = __expf(a - cml);
        gSC[lane] = bb; gSC[64 + lane] = cm;
    }
    { u32x4 q4[4], k4[4], v4[4];
#pragma unroll
      for (int k = 0; k < 4; ++k) { const int i = tid + k * NTHR; const int r = i >> 5, c8 = i & 31, rv = i & 63, cv = i >> 6;
          q4[k] = (u32x4){0u, 0u, 0u, 0u}; k4[k] = q4[k]; v4[k] = q4[k];
          if (r < Lv) { const bf16_t* pr = PROJ + (row0 + r) * NPROJ + h * 256 + c8 * 8; q4[k] = *(const u32x4*)(pr + PA_Q); k4[k] = *(const u32x4*)(pr + PA_K); }
          if (rv < Lv) v4[k] = *(const u32x4*)(PROJ + (row0 + rv) * NPROJ + PA_V + h * 256 + cv * 8); }
#pragma unroll
      for (int k = 0; k < 4; ++k) { const int i = tid + k * NTHR; const int r = i >> 5, c8 = i & 31, rv = i & 63, cv = i >> 6;
          *(LAS u32x4*)(Qs + r * 264 + c8 * 8) = q4[k]; *(LAS u32x4*)(Ks + r * 264 + c8 * 8) = k4[k];
          LAS bf16_t* d = VTs + (cv * 8) * 72 + rv; const u32x4 v = v4[k];
          d[0] = (bf16_t)(v.x & 0xffffu); d[72] = (bf16_t)(v.x >> 16); d[144] = (bf16_t)(v.y & 0xffffu); d[216] = (bf16_t)(v.y >> 16);
          d[288] = (bf16_t)(v.z & 0xffffu); d[360] = (bf16_t)(v.z >> 16); d[432] = (bf16_t)(v.w & 0xffffu); d[504] = (bf16_t)(v.w >> 16); } }
    lds_barrier();
    { const int mt = w & 3, nh = w >> 2;
      f32x4 acc[1][2]; acc[0][0] = (f32x4){0.f, 0.f, 0.f, 0.f}; acc[0][1] = acc[0][0];
      mma_lds<1, 2, 8>(acc, Qs, 264, 16 * mt, Ks, 264, 32 * nh, lane);
      float rs[4] = {0.f, 0.f, 0.f, 0.f};
#pragma unroll
      for (int j = 0; j < 2; ++j) { const int sidx = 32 * nh + 16 * j + (lane & 15); const float as = ga[sidx];
#pragma unroll
          for (int r = 0; r < 4; ++r) { const int lidx = 16 * mt + 4 * (lane >> 4) + r;
              const float val = sidx <= lidx ? acc[0][j][r] * 0.0625f * __expf(as - gcm[lidx]) : 0.f;
              rs[r] += val; Ss[lidx * 72 + sidx] = (bf16_t)f2bf(val); } }
#pragma unroll
      for (int r = 0; r < 4; ++r) { const float x = row16_sum(rs[r]);
          if ((lane & 15) == 0) dpart[nh * 64 + 16 * mt + 4 * (lane >> 4) + r] = x; }
    }
    for (int i = tid; i < 256 * 8; i += NTHR) { const int r = i >> 3, c8 = i & 7; *(u32x4*)(gVT + r * 64 + c8 * 8) = *(const LAS u32x4*)(VTs + r * 72 + c8 * 8); }
    for (int i = tid; i < 256 * 8; i += NTHR) { const int k = i & 255, c8 = i >> 8; u32x4 o; float x[8];
#pragma unroll
        for (int e = 0; e < 8; ++e) x[e] = bf2f(Ks[(c8 * 8 + e) * 264 + k]) * 0.0625f * gwk[c8 * 8 + e];
        o.x = pk2(x[0], x[1]); o.y = pk2(x[2], x[3]); o.z = pk2(x[4], x[5]); o.w = pk2(x[6], x[7]);
        *(u32x4*)(gKTw + k * 64 + c8 * 8) = o; }
    lds_barrier();
    if (tid < 64) gSC[128 + tid] = dpart[tid] + dpart[64 + tid];
    { f32x4 acc[2][4];
#pragma unroll
      for (int i = 0; i < 2; ++i)
#pragma unroll
          for (int j = 0; j < 4; ++j) acc[i][j] = (f32x4){0.f, 0.f, 0.f, 0.f};
      mma_lds<2, 4, 2>(acc, VTs, 72, 32 * w, Ss, 72, 0, lane);
#pragma unroll
      for (int i = 0; i < 2; ++i)
#pragma unroll
          for (int j = 0; j < 4; ++j) { const int v0 = 32 * w + 16 * i + 4 * (lane >> 4), lidx = 16 * j + (lane & 15); *(f32x4*)(gNP + lidx * 256 + v0) = acc[i][j]; }
    }
    lds_barrier();
}

__device__ __forceinline__ void mlstm_seq_unit(const Ctx& c, int l, int b, int h, int vs) {
    int w = c.wave; asm volatile("" : "+s"(w)); const int lane = hw_lane(), tid = w * 64 + lane;
    const bf16_t* PROJ = (const bf16_t*)(c.ws + WS_PROJ);
    LAS bf16_t* Qs = (LAS bf16_t*)c.lds; LAS bf16_t* KTw = Qs + 64 * 264; LAS bf16_t* VTs = KTw + 256 * 72; LAS bf16_t* CTs = VTs + 80 * 72;
    LAS float* sb = (LAS float*)(CTs + 80 * 264); LAS float* scm = sb + 64, *sdp = sb + 128, *sqn = sb + 192;
    float* HAo = (float*)(c.ws + WS_HA);
    for (int i = tid; i < 80 * 264; i += NTHR) CTs[i] = 0;
    for (int i = tid; i < 16 * 72; i += NTHR) VTs[64 * 72 + i] = (i < 72) ? (bf16_t)0x3f80 : (bf16_t)0;
    f32x4 Cst[2][5];
#pragma unroll
    for (int i = 0; i < 2; ++i)
#pragma unroll
        for (int j = 0; j < 5; ++j) Cst[i][j] = (f32x4){0.f, 0.f, 0.f, 0.f};
    float m = 0.f;
    const int lt = w & 3, vh = w >> 2;
    u32x4 pq[2][4], pk[2][4], pv[2]; float psc[2] = {0.f, 0.f}; f32x4 pn[2][2];
#define ML_ISSUE(cc, S_) do { int t0_, Lv_; chunk_range((cc), t0_, Lv_); const size_t row0_ = (size_t)b * TP + t0_; const int u_ = (b * HA + h) * NCH + (cc); \
        const bf16_t* gK_ = (const bf16_t*)(c.ws + WS_ML_KTW) + (size_t)u_ * 256 * 64; const bf16_t* gV_ = (const bf16_t*)(c.ws + WS_ML_VT) + (size_t)u_ * 256 * 64 + (size_t)vs * 64 * 64; \
        const float* gN_ = (const float*)(c.ws + WS_ML_NP) + (size_t)u_ * 64 * 256; const float* gS_ = (const float*)(c.ws + WS_ML_SC) + (size_t)u_ * 256; \
        _Pragma("unroll") for (int k_ = 0; k_ < 4; ++k_) { const int i_ = tid + k_ * NTHR; const int r_ = i_ >> 5, c8_ = i_ & 31; pq[S_][k_] = (u32x4){0u, 0u, 0u, 0u}; \
            if (r_ < Lv_) pq[S_][k_] = *(const u32x4*)(PROJ + (row0_ + r_) * NPROJ + PA_Q + h * 256 + c8_ * 8); pk[S_][k_] = *(const u32x4*)(gK_ + (i_ >> 3) * 64 + (i_ & 7) * 8); } \
        pv[S_] = *(const u32x4*)(gV_ + (tid >> 3) * 64 + (tid & 7) * 8); psc[S_] = tid < 192 ? gS_[tid] : 0.f; \
        _Pragma("unroll") for (int j_ = 0; j_ < 2; ++j_) pn[S_][j_] = *(const f32x4*)(gN_ + (16 * lt + (lane & 15)) * 256 + vs * 64 + 16 * (vh + 2 * j_) + 4 * (lane >> 4)); } while (0)
#define ML_CHUNK(cch, S) do { \
        int t0, Lv; chunk_range((cch), t0, Lv); \
        const size_t row0 = (size_t)b * TP + t0; \
        _Pragma("unroll") \
        for (int k = 0; k < 4; ++k) { const int i = tid + k * NTHR; *(LAS u32x4*)(Qs + (i >> 5) * 264 + (i & 31) * 8) = pq[S][k]; *(LAS u32x4*)(KTw + (i >> 3) * 72 + (i & 7) * 8) = pk[S][k]; } \
        *(LAS u32x4*)(VTs + (tid >> 3) * 72 + (tid & 7) * 8) = pv[S]; \
        if (tid < 192) sb[tid] = psc[S]; \
        const f32x4 np0 = pn[S][0], np1 = pn[S][1]; \
        if ((cch) + 2 < NCH) ML_ISSUE((cch) + 2, S); \
        lds_barrier(); \
        f32x4 ia[3]; ia[0] = (f32x4){0.f, 0.f, 0.f, 0.f}; ia[1] = ia[0]; ia[2] = ia[0]; \
        _Pragma("unroll") \
        for (int ks = 0; ks < 8; ++ks) { const bf16x8 qf = ldfrag(Qs, 264, 16 * lt, 32 * ks, lane); \
            ia[0] = mfma16(ldfrag(CTs, 264, 16 * vh, 32 * ks, lane), qf, ia[0]); \
            ia[1] = mfma16(ldfrag(CTs, 264, 16 * (vh + 2), 32 * ks, lane), qf, ia[1]); \
            if (vh == 0) ia[2] = mfma16(ldfrag(CTs, 264, 64, 32 * ks, lane), qf, ia[2]); } \
        if (vh == 0 && lane < 16) sqn[16 * lt + lane] = ia[2][0]; \
        lds_barrier(); \
        { const int lidx = 16 * lt + (lane & 15); \
          const float cm = scm[lidx], bl = sb[lidx]; const float M = fmaxf(m, cm), rho = __expf(cm - M), sig = __expf(m - M); \
          float den = rho * sdp[lidx] + sig * sqn[lidx]; den = fmaxf(fabsf(den), __expf(-(bl + M))); const float dinv = __builtin_amdgcn_rcpf(den); \
          if (lidx < Lv) { \
        _Pragma("unroll") \
              for (int j = 0; j < 2; ++j) { const int v0 = 16 * (vh + 2 * j) + 4 * (lane >> 4); \
                  const f32x4 np = j == 0 ? np0 : np1; \
                  *(f32x4*)(HAo + (row0 + lidx) * 1024 + h * 256 + vs * 64 + v0) = (np * rho + ia[j] * sig) * dinv; } } } \
        { const float cml = scm[63], Ml = fmaxf(m, cml), dec = __expf(m - Ml), rl = __expf(cml - Ml); \
          _Pragma("unroll") for (int i = 0; i < 2; ++i) { f32x4 d2[1][5]; \
              _Pragma("unroll") for (int j = 0; j < 5; ++j) d2[0][j] = (f32x4){0.f, 0.f, 0.f, 0.f}; \
              mma_lds<1, 5, 2>(d2, KTw, 72, 32 * w + 16 * i, VTs, 72, 0, lane); \
              _Pragma("unroll") for (int j = 0; j < 5; ++j) { Cst[i][j] = Cst[i][j] * dec + d2[0][j] * rl; \
                  u32x2 o; o.x = pk2(Cst[i][j][0], Cst[i][j][1]); o.y = pk2(Cst[i][j][2], Cst[i][j][3]); \
                  *(LAS u32x2*)(CTs + (16 * j + (lane & 15)) * 264 + 32 * w + 16 * i + 4 * (lane >> 4)) = o; } } \
          m = sb[63] + Ml; } \
        lds_barrier(); \
    } while (0)
    ML_ISSUE(0, 0); ML_ISSUE(1, 1);
    lds_barrier();
    for (int cch = 0; cch + 1 < NCH; cch += 2) { ML_CHUNK(cch, 0); ML_CHUNK(cch + 1, 1); }
    ML_CHUNK(NCH - 1, 0);
#undef ML_CHUNK
#undef ML_ISSUE
    float* oc = c.out + O_PC + (((size_t)l * BATCH + b) * HA + h) * DHA * DHA; float* on = c.out + O_PN + (((size_t)l * BATCH + b) * HA + h) * DHA;
#pragma unroll
    for (int i = 0; i < 2; ++i) { const int k0 = 32 * w + 16 * i + 4 * (lane >> 4);
#pragma unroll
        for (int j = 0; j < 4; ++j)
#pragma unroll
            for (int r = 0; r < 4; ++r) oc[(size_t)(k0 + r) * 256 + vs * 64 + 16 * j + (lane & 15)] = Cst[i][j][r];
        if (vs == 0 && (lane & 15) == 0) {
#pragma unroll
            for (int r = 0; r < 4; ++r) on[k0 + r] = Cst[i][4][r]; } }
    if (vs == 0 && tid == 0) c.out[O_PM + ((size_t)l * BATCH + b) * HA + h] = m;
    lds_barrier();
}

__device__ __forceinline__ f32x4 mfma4f(float a, float b, f32x4 c) { return __builtin_amdgcn_mfma_f32_16x16x4f32(a, b, c, 0, 0, 0); }
__device__ __forceinline__ void tri_inv64(const LAS float* Am, LAS float* Tm, LAS float* Xt, int tid, int w, LAS bf16_t* Tb) {
    for (int i = tid; i < 64 * 65; i += NTHR) Tm[i] = 0.f;
    for (int i = tid; i < 64 * 36; i += NTHR) ((LAS unsigned*)Tb)[i] = 0u;
    lds_barrier();
    if (tid < 64) { const int base = (tid >> 3) * 8, cc = tid & 7; float x[8];
#pragma unroll
        for (int r = 0; r < 8; ++r) { float a = 0.f;
#pragma unroll
            for (int j = 0; j < r; ++j) a += Am[(base + r) * 65 + base + j] * x[j];
            x[r] = (r == cc) ? 1.f : (r < cc ? 0.f : -a); }
#pragma unroll
        for (int r = 0; r < 8; ++r) { Tm[(base + r) * 65 + base + cc] = x[r]; Tb[(base + r) * 72 + base + cc] = (bf16_t)f2bf(x[r]); } }
    lds_barrier();
    const int lane = tid & 63, li = lane & 15, lk = lane >> 4;
    if (w < 2) {
        const int bi = 32 * w + (li < 8 ? 0 : 16), l7 = li & 7; LAS float* X = Xt + w * 512;
        f32x4 x = {0.f, 0.f, 0.f, 0.f};
#pragma unroll
        for (int ks = 0; ks < 2; ++ks) x = mfma4f(Am[(bi + 8 + l7) * 65 + bi + 4 * ks + lk], Tm[(bi + 4 * ks + lk) * 65 + bi + l7], x);
#pragma unroll
        for (int r = 0; r < 4; ++r) X[(4 * lk + r) * 16 + li] = x[r];
        asm volatile("s_waitcnt lgkmcnt(0)" ::: "memory");
        f32x4 y = {0.f, 0.f, 0.f, 0.f};
#pragma unroll
        for (int ks = 0; ks < 2; ++ks) y = mfma4f(Tm[(bi + 8 + l7) * 65 + bi + 8 + 4 * ks + lk], X[(4 * ks + lk + (li < 8 ? 0 : 8)) * 16 + li], y);
        if ((lk < 2) == (li < 8)) {
#pragma unroll
            for (int r = 0; r < 4; ++r) { const int rr = bi + 8 + ((4 * lk + r) & 7); Tm[rr * 65 + bi + l7] = -y[r]; Tb[rr * 72 + bi + l7] = (bf16_t)f2bf(-y[r]); } } }
    lds_barrier();
    if (w < 2) { const int lb = 32 * w, hb = lb + 16; LAS float* X = Xt + w * 512;
        f32x4 x = {0.f, 0.f, 0.f, 0.f};
#pragma unroll
        for (int ks = 0; ks < 4; ++ks) x = mfma4f(Am[(hb + li) * 65 + lb + 4 * ks + lk], Tm[(lb + 4 * ks + lk) * 65 + lb + li], x);
#pragma unroll
        for (int r = 0; r < 4; ++r) X[(4 * lk + r) * 16 + li] = x[r];
        asm volatile("s_waitcnt lgkmcnt(0)" ::: "memory");
        f32x4 y = {0.f, 0.f, 0.f, 0.f};
#pragma unroll
        for (int ks = 0; ks < 4; ++ks) y = mfma4f(Tm[(hb + li) * 65 + hb + 4 * ks + lk], X[(4 * ks + lk) * 16 + li], y);
#pragma unroll
        for (int r = 0; r < 4; ++r) { Tm[(hb + 4 * lk + r) * 65 + lb + li] = -y[r]; Tb[(hb + 4 * lk + r) * 72 + lb + li] = (bf16_t)f2bf(-y[r]); } }
    lds_barrier();
    if (w < 2) { LAS float* X = Xt + w * 512;
        f32x4 x0 = {0.f, 0.f, 0.f, 0.f}, x1 = x0;
#pragma unroll
        for (int ks = 0; ks < 8; ++ks) { const float bb = Tm[(4 * ks + lk) * 65 + 16 * w + li];
            x0 = mfma4f(Am[(32 + li) * 65 + 4 * ks + lk], bb, x0); x1 = mfma4f(Am[(48 + li) * 65 + 4 * ks + lk], bb, x1); }
#pragma unroll
        for (int r = 0; r < 4; ++r) { X[(4 * lk + r) * 16 + li] = x0[r]; X[(16 + 4 * lk + r) * 16 + li] = x1[r]; }
        asm volatile("s_waitcnt lgkmcnt(0)" ::: "memory");
        f32x4 y0 = {0.f, 0.f, 0.f, 0.f}, y1 = y0;
#pragma unroll
        for (int ks = 0; ks < 8; ++ks) { const float bb = X[(4 * ks + lk) * 16 + li];
            y0 = mfma4f(Tm[(32 + li) * 65 + 32 + 4 * ks + lk], bb, y0); y1 = mfma4f(Tm[(48 + li) * 65 + 32 + 4 * ks + lk], bb, y1); }
#pragma unroll
        for (int r = 0; r < 4; ++r) { Tb[(32 + 4 * lk + r) * 72 + 16 * w + li] = (bf16_t)f2bf(-y0[r]); Tb[(48 + 4 * lk + r) * 72 + 16 * w + li] = (bf16_t)f2bf(-y1[r]); } }
    lds_barrier();
}

__device__ __forceinline__ void gdn_prep_unit(const Ctx& c, int l, int u) {
    int w = c.wave; asm volatile("" : "+s"(w)); const int lane = hw_lane(), tid = w * 64 + lane;
    const int cch = u % NCH, bh = u / NCH, h = bh % HB, b = bh / HB;
    int t0, Lv; chunk_range(cch, t0, Lv);
    const size_t row0 = (size_t)b * TP + t0;
    const bf16_t* PROJ = (const bf16_t*)(c.ws + WS_PROJ); const float* SG = (const float*)(c.ws + WS_SG);
    LAS bf16_t* Qs = (LAS bf16_t*)c.lds; LAS bf16_t* Ks = Qs + 64 * 136; LAS bf16_t* RAW = Ks + 64 * 136; LAS bf16_t* RT = RAW; LAS bf16_t* Tb = RT + 256 * 72;
    LAS float* Am = (LAS float*)(c.lds + 86272); LAS float* Tm = Am + 64 * 65; LAS float* Xt = Tm + 64 * 65; LAS float* psq = Xt + 32 * 33; LAS float* sg = psq + 1024; LAS float* sbe = sg + 64;
    bf16_t* gW = (bf16_t*)(c.ws + WS_GD_W) + (size_t)u * 64 * 128; bf16_t* gUT = (bf16_t*)(c.ws + WS_GD_UT) + (size_t)u * 128 * 64; bf16_t* gAT = (bf16_t*)(c.ws + WS_GD_AT) + (size_t)u * 64 * 64;
    bf16_t* gQ = (bf16_t*)(c.ws + WS_GD_Q) + (size_t)u * 64 * 128; bf16_t* gKD = (bf16_t*)(c.ws + WS_GD_KD) + (size_t)u * 128 * 64; float* gSC = (float*)(c.ws + WS_GD_SC) + (size_t)u * 128;
    if (w == 0) { float ga = 0.f, be = 0.f;
        if (lane < Lv) { const float a = SG[(row0 + lane) * SGLD + 8 + h], bb = SG[(row0 + lane) * SGLD + 16 + h];
            ga = -__expf(inp(c, I_ALOG)[l * HB + h]) * softplusf_(a + inp(c, I_DTB)[l * HB + h]); be = sigmoidf_(bb); }
        const float g = wave_incl_sum(ga, lane); sg[lane] = g; sbe[lane] = be; gSC[lane] = __expf(g); if (lane == 63) gSC[64] = __expf(g); }
    { u32x4 rv[7]; float cwv[3];
#pragma unroll
      for (int k = 0; k < 3; ++k) { const int i = tid + k * NTHR; const int j = i / 384, ch = i % 384; cwv[k] = inp(c, I_CONVW)[(size_t)l * 4 * 3072 + j * 3072 + (ch >> 7) * 1024 + h * 128 + (ch & 127)]; }
#pragma unroll
      for (int k = 0; k < 7; ++k) { const int i = tid + k * NTHR; rv[k] = (u32x4){0u, 0u, 0u, 0u};
          if (i < 67 * 48) { const int rr = i / 48, c8 = i % 48, part = c8 >> 4, d8 = c8 & 15; const int tt = t0 - 3 + rr;
              if (tt >= 0 && rr - 3 < Lv) rv[k] = *(const u32x4*)(PROJ + ((size_t)b * TP + tt) * NPROJ + PB_QKV + part * 1024 + h * 128 + d8 * 8); } }
#pragma unroll
      for (int k = 0; k < 7; ++k) { const int i = tid + k * NTHR; if (i < 67 * 48) { const int rr = i / 48, c8 = i % 48; *(LAS u32x4*)(RAW + rr * 384 + c8 * 8) = rv[k]; } }
#pragma unroll
      for (int k = 0; k < 3; ++k) ((LAS float*)(c.lds + 102912))[tid + k * NTHR] = cwv[k]; }
    lds_barrier();
    const int s = lane, p = w;
    float yq[16], yk[16], yv[16];
    { const LAS float* cw = (const LAS float*)(c.lds + 102912); float sq = 0.f, sk = 0.f;
#pragma unroll
      for (int part = 0; part < 3; ++part) {
#pragma unroll
          for (int e4 = 0; e4 < 4; ++e4) { f32x4 a = (f32x4){0.f, 0.f, 0.f, 0.f};
#pragma unroll
              for (int j = 0; j < 4; ++j) { const f32x4 wv = *(const LAS f32x4*)(cw + j * 384 + part * 128 + p * 16 + e4 * 4);
                  const u32x2 rv = *(const LAS u32x2*)(RAW + (s + j) * 384 + part * 128 + p * 16 + e4 * 4);
                  a[0] += wv[0] * __uint_as_float(rv.x << 16); a[1] += wv[1] * __uint_as_float(rv.x & 0xffff0000u); a[2] += wv[2] * __uint_as_float(rv.y << 16); a[3] += wv[3] * __uint_as_float(rv.y & 0xffff0000u); }
#pragma unroll
              for (int e = 0; e < 4; ++e) { const float y = s < Lv ? siluf_(a[e]) : 0.f;
                  if (part == 0) { yq[e4 * 4 + e] = y; sq += y * y; } else if (part == 1) { yk[e4 * 4 + e] = y; sk += y * y; } else yv[e4 * 4 + e] = y; } } }
      psq[p * 64 + s] = sq; psq[512 + p * 64 + s] = sk; }
    lds_barrier();
    { float sq = 0.f, sk = 0.f;
#pragma unroll
      for (int i = 0; i < 8; ++i) { sq += psq[i * 64 + s]; sk += psq[512 + i * 64 + s]; }
      const float qn = rsqrtf(sq + 1e-12f) * 0.08838834764831845f, kn = rsqrtf(sk + 1e-12f);
      const float g = sg[s], be = sbe[s], gL = sg[63]; const float kb = kn * be * __expf(g), kd = kn * __expf(gL - g);
      u32x4 o0, o1;
      o0.x = pk2(yq[0] * qn, yq[1] * qn); o0.y = pk2(yq[2] * qn, yq[3] * qn); o0.z = pk2(yq[4] * qn, yq[5] * qn); o0.w = pk2(yq[6] * qn, yq[7] * qn);
      o1.x = pk2(yq[8] * qn, yq[9] * qn); o1.y = pk2(yq[10] * qn, yq[11] * qn); o1.z = pk2(yq[12] * qn, yq[13] * qn); o1.w = pk2(yq[14] * qn, yq[15] * qn);
      *(LAS u32x4*)(Qs + s * 136 + p * 16) = o0; *(LAS u32x4*)(Qs + s * 136 + p * 16 + 8) = o1; *(u32x4*)(gQ + s * 128 + p * 16) = o0; *(u32x4*)(gQ + s * 128 + p * 16 + 8) = o1;
      o0.x = pk2(yk[0] * kn, yk[1] * kn); o0.y = pk2(yk[2] * kn, yk[3] * kn); o0.z = pk2(yk[4] * kn, yk[5] * kn); o0.w = pk2(yk[6] * kn, yk[7] * kn);
      o1.x = pk2(yk[8] * kn, yk[9] * kn); o1.y = pk2(yk[10] * kn, yk[11] * kn); o1.z = pk2(yk[12] * kn, yk[13] * kn); o1.w = pk2(yk[14] * kn, yk[15] * kn);
      *(LAS u32x4*)(Ks + s * 136 + p * 16) = o0; *(LAS u32x4*)(Ks + s * 136 + p * 16 + 8) = o1;
#pragma unroll
      for (int e = 0; e < 16; ++e) { RT[(p * 16 + e) * 72 + s] = (bf16_t)f2bf(yv[e] * be); RT[(128 + p * 16 + e) * 72 + s] = (bf16_t)f2bf(yk[e] * kb); gKD[(p * 16 + e) * 64 + s] = (bf16_t)f2bf(yk[e] * kd); } }
    lds_barrier();
    { const int mt = w & 3, nh = w >> 2;
      f32x4 aK[2][1], aQ[2][1]; aK[0][0] = (f32x4){0.f, 0.f, 0.f, 0.f}; aK[1][0] = aK[0][0]; aQ[0][0] = aK[0][0]; aQ[1][0] = aK[0][0];
      mma_lds<2, 1, 4>(aK, Ks, 136, 32 * nh, Ks, 136, 16 * mt, lane);
      mma_lds<2, 1, 4>(aQ, Ks, 136, 32 * nh, Qs, 136, 16 * mt, lane);
      const int lidx = 16 * mt + (lane & 15); const float gl = sg[lidx], bel = sbe[lidx];
#pragma unroll
      for (int i = 0; i < 2; ++i) { const int s0 = 32 * nh + 16 * i + 4 * (lane >> 4); const f32x4 gs = *(const LAS f32x4*)(sg + s0); float q[4];
#pragma unroll
          for (int r = 0; r < 4; ++r) { const int sidx = s0 + r; const float dcy = sidx <= lidx ? __expf(gl - gs[r]) : 0.f;
              Am[lidx * 65 + sidx] = sidx < lidx ? bel * aK[i][0][r] * dcy : 0.f; q[r] = aQ[i][0][r] * dcy; }
          u32x2 o; o.x = pk2(q[0], q[1]); o.y = pk2(q[2], q[3]); *(u32x2*)(gAT + lidx * 64 + s0) = o; } }
    lds_barrier();
    tri_inv64(Am, Tm, Xt, tid, w, Tb);
    { f32x4 aU[1][4], aW[1][4];
#pragma unroll
      for (int j = 0; j < 4; ++j) { aU[0][j] = (f32x4){0.f, 0.f, 0.f, 0.f}; aW[0][j] = aU[0][j]; }
      const int mt = w & 3, vq = w >> 2;
      mma_lds<1, 4, 2>(aU, Tb, 72, 16 * mt, RT, 72, 64 * vq, lane);
      mma_lds<1, 4, 2>(aW, RT, 72, 128 + 16 * w, Tb, 72, 0, lane);
#pragma unroll
      for (int j = 0; j < 4; ++j) { u32x2 o; o.x = pk2(aU[0][j][0], aU[0][j][1]); o.y = pk2(aU[0][j][2], aU[0][j][3]);
          *(u32x2*)(gUT + (64 * vq + 16 * j + (lane & 15)) * 64 + 16 * mt + 4 * (lane >> 4)) = o;
          o.x = pk2(aW[0][j][0], aW[0][j][1]); o.y = pk2(aW[0][j][2], aW[0][j][3]);
          *(u32x2*)(gW + (16 * j + (lane & 15)) * 128 + 16 * w + 4 * (lane >> 4)) = o; } }
    lds_barrier();
}

__device__ __forceinline__ void gdn_seq_unit(const Ctx& c, int l, int b, int h) {
    int w = c.wave; asm volatile("" : "+s"(w)); const int lane = hw_lane(), tid = w * 64 + lane;
    const bf16_t* PROJ = (const bf16_t*)(c.ws + WS_PROJ); bf16_t* YBR = (bf16_t*)(c.ws + WS_YBR);
    LAS bf16_t* Qs = (LAS bf16_t*)c.lds; LAS bf16_t* Wm = Qs + 64 * 136; LAS bf16_t* UT = Wm + 64 * 136; LAS bf16_t* ATs = UT + 128 * 72; LAS bf16_t* KD = ATs + 64 * 72; LAS bf16_t* ST = KD + 128 * 72;
    LAS float* seg = (LAS float*)(ST + 128 * 136); LAS float* ssq = seg + 128; LAS float* gnws = ssq + 128;
    for (int i = tid; i < 128 * 136; i += NTHR) ST[i] = 0;
    if (tid < 128) gnws[tid] = inp(c, I_GNW)[l * DHB + tid];
    f32x4 Sst[1][8];
#pragma unroll
    for (int j = 0; j < 8; ++j) Sst[0][j] = (f32x4){0.f, 0.f, 0.f, 0.f};
    const int lt = w & 3, vq = w >> 2;
    const LAS float* gnwp = gnws + 64 * vq + 4 * (lane >> 4);
    u32x4 pQ[1][2], pW[1][2], pU[1][2], pK[1][2], pA[1]; float psc[1] = {0.f}; u32x2 pz[4];
#define GD_ISSUE(cc, S_) do { const int u_ = (b * HB + h) * NCH + (cc); \
        const bf16_t* gW_ = (const bf16_t*)(c.ws + WS_GD_W) + (size_t)u_ * 64 * 128; const bf16_t* gUT_ = (const bf16_t*)(c.ws + WS_GD_UT) + (size_t)u_ * 128 * 64; const bf16_t* gAT_ = (const bf16_t*)(c.ws + WS_GD_AT) + (size_t)u_ * 64 * 64; \
        const bf16_t* gQ_ = (const bf16_t*)(c.ws + WS_GD_Q) + (size_t)u_ * 64 * 128; const bf16_t* gKD_ = (const bf16_t*)(c.ws + WS_GD_KD) + (size_t)u_ * 128 * 64; const float* gSC_ = (const float*)(c.ws + WS_GD_SC) + (size_t)u_ * 128; \
        _Pragma("unroll") for (int k_ = 0; k_ < 2; ++k_) { const int i_ = tid + k_ * NTHR; pQ[S_][k_] = *(const u32x4*)(gQ_ + (i_ >> 4) * 128 + (i_ & 15) * 8); pW[S_][k_] = *(const u32x4*)(gW_ + (i_ >> 4) * 128 + (i_ & 15) * 8); \
            pU[S_][k_] = *(const u32x4*)(gUT_ + (i_ >> 3) * 64 + (i_ & 7) * 8); pK[S_][k_] = *(const u32x4*)(gKD_ + (i_ >> 3) * 64 + (i_ & 7) * 8); } \
        pA[S_] = *(const u32x4*)(gAT_ + (tid >> 3) * 64 + (tid & 7) * 8); psc[S_] = tid < 65 ? gSC_[tid] : 0.f; } while (0)
#define GD_ZISSUE(cc) do { int t0_, Lv_; chunk_range((cc), t0_, Lv_); const size_t row0_ = (size_t)b * TP + t0_; \
        _Pragma("unroll") for (int i_ = 0; i_ < 4; ++i_) { const int zr_ = 16 * lt + (lane & 15) < Lv_ ? 16 * lt + (lane & 15) : Lv_ - 1; pz[i_] = *(const u32x2*)(PROJ + (row0_ + zr_) * NPROJ + PB_Z + h * 128 + 64 * vq + 16 * i_ + 4 * (lane >> 4)); } } while (0)
#define GD_CHUNK(cch, S) do { \
        int t0, Lv; chunk_range((cch), t0, Lv); \
        const size_t row0 = (size_t)b * TP + t0; \
        _Pragma("unroll") \
        for (int k = 0; k < 2; ++k) { const int i = tid + k * NTHR; *(LAS u32x4*)(Qs + (i >> 4) * 136 + (i & 15) * 8) = pQ[S][k]; *(LAS u32x4*)(Wm + (i >> 4) * 136 + (i & 15) * 8) = pW[S][k]; \
            *(LAS u32x4*)(UT + (i >> 3) * 72 + (i & 7) * 8) = pU[S][k]; *(LAS u32x4*)(KD + (i >> 3) * 72 + (i & 7) * 8) = pK[S][k]; } \
        *(LAS u32x4*)(ATs + (tid >> 3) * 72 + (tid & 7) * 8) = pA[S]; \
        if (tid < 65) seg[tid] = psc[S]; \
        if ((cch) + 1 < NCH) GD_ISSUE((cch) + 1, S); \
        GD_ZISSUE(cch); \
        lds_barrier(); \
        f32x4 aq[4][1]; \
        _Pragma("unroll") for (int j = 0; j < 4; ++j) aq[j][0] = (f32x4){0.f, 0.f, 0.f, 0.f}; \
        _Pragma("unroll") for (int jh = 0; jh < 2; ++jh) { f32x4 ws_[1][2]; ws_[0][0] = (f32x4){0.f, 0.f, 0.f, 0.f}; ws_[0][1] = ws_[0][0]; \
          mma_lds<1, 2, 4>(ws_, Wm, 136, 16 * lt, ST, 136, 64 * vq + 32 * jh, lane); \
          { f32x4 (&aqh)[2][1] = *(f32x4 (*)[2][1])&aq[2 * jh]; mma_lds<2, 1, 4>(aqh, ST, 136, 64 * vq + 32 * jh, Qs, 136, 16 * lt, lane); } \
          _Pragma("unroll") for (int j2 = 0; j2 < 2; ++j2) { const int j = 2 * jh + j2; LAS u32x2* pu = (LAS u32x2*)(UT + (64 * vq + 16 * j + (lane & 15)) * 72 + 16 * lt + 4 * (lane >> 4)); const u32x2 uu = *pu; \
              u32x2 o; o.x = pk2(__uint_as_float(uu.x << 16) - ws_[0][j2][0], __uint_as_float(uu.x & 0xffff0000u) - ws_[0][j2][1]); \
              o.y = pk2(__uint_as_float(uu.y << 16) - ws_[0][j2][2], __uint_as_float(uu.y & 0xffff0000u) - ws_[0][j2][3]); *pu = o; } } \
        lds_barrier(); \
        { const int lidx = 16 * lt + (lane & 15); const float egl = seg[lidx], egL = seg[64]; \
        _Pragma("unroll") \
          for (int i = 0; i < 4; ++i) aq[i][0] = aq[i][0] * egl; \
          mma_lds<4, 1, 2>(aq, UT, 72, 64 * vq, ATs, 72, 16 * lt, lane); \
        _Pragma("unroll") \
          for (int j = 0; j < 8; ++j) Sst[0][j] = Sst[0][j] * egL; \
          mma_lds<1, 8, 2>(Sst, KD, 72, 16 * w, UT, 72, 0, lane); \
        _Pragma("unroll") \
          for (int j = 0; j < 8; ++j) { u32x2 o; o.x = pk2(Sst[0][j][0], Sst[0][j][1]); o.y = pk2(Sst[0][j][2], Sst[0][j][3]); *(LAS u32x2*)(ST + (16 * j + (lane & 15)) * 136 + 16 * w + 4 * (lane >> 4)) = o; } \
          float ss = 0.f; \
        _Pragma("unroll") \
          for (int i = 0; i < 4; ++i) ss += (aq[i][0][0] * aq[i][0][0] + aq[i][0][1] * aq[i][0][1]) + (aq[i][0][2] * aq[i][0][2] + aq[i][0][3] * aq[i][0][3]); \
          ss += __shfl_xor(ss, 16); ss += __shfl_xor(ss, 32); \
          if (lane < 16) ssq[vq * 64 + lidx] = ss; \
          lds_barrier(); \
          const float rs = rsqrtf((ssq[lidx] + ssq[64 + lidx]) * (1.f / 128.f) + 1e-6f); \
          if (lidx < Lv) { \
        _Pragma("unroll") \
              for (int i = 0; i < 4; ++i) { const int v0 = 64 * vq + 16 * i + 4 * (lane >> 4); const f32x4 gw4 = *(const LAS f32x4*)(gnwp + 16 * i); \
                  const u32x2 zz = pz[i]; \
                  u32x2 o; o.x = pk2(aq[i][0][0] * rs * gw4[0] * siluf_(__uint_as_float(zz.x << 16)), aq[i][0][1] * rs * gw4[1] * siluf_(__uint_as_float(zz.x & 0xffff0000u))); \
                  o.y = pk2(aq[i][0][2] * rs * gw4[2] * siluf_(__uint_as_float(zz.y << 16)), aq[i][0][3] * rs * gw4[3] * siluf_(__uint_as_float(zz.y & 0xffff0000u))); \
                  *(u32x2*)(YBR + (row0 + lidx) * YLD + 1024 + h * 128 + v0) = o; } } } \
        lds_barrier(); \
    } while (0)
    GD_ISSUE(0, 0);
    lds_barrier();
#pragma unroll 1
    for (int cch = 0; cch < NCH; ++cch) GD_CHUNK(cch, 0);
#undef GD_CHUNK
#undef GD_ZISSUE
#undef GD_ISSUE
    float* os = c.out + O_PGS + (((size_t)l * BATCH + b) * HB + h) * DHB * DHB;
#pragma unroll
    for (int j = 0; j < 8; ++j)
#pragma unroll
        for (int r = 0; r < 4; ++r) os[(size_t)(16 * w + 4 * (lane >> 4) + r) * 128 + 16 * j + (lane & 15)] = Sst[0][j][r];
    if (tid < 384) { const int cg = (tid >> 7) * 1024 + h * 128 + (tid & 127); float* ocv = c.out + O_PGC + ((size_t)l * BATCH + b) * 3 * 3072;
#pragma unroll
        for (int j = 0; j < 3; ++j) ocv[j * 3072 + cg] = bf2f(PROJ[((size_t)b * TP + TP - 3 + j) * NPROJ + PB_QKV + cg]); }
    __syncthreads();
}

__device__ __forceinline__ void rwkv_prep_unit(const Ctx& c, int l, int u) {
    int w = c.wave; asm volatile("" : "+s"(w)); const int lane = hw_lane(), tid = w * 64 + lane;
    const int cch = u % NCH, bh = u / NCH, h = bh % HC, b = bh / HC;
    int t0, Lv; chunk_range(cch, t0, Lv);
    const bf16_t* PROJ = (const bf16_t*)(c.ws + WS_PROJ);
    LAS bf16_t* XW = (LAS bf16_t*)c.lds; LAS bf16_t* XA = XW + 64 * 72; LAS bf16_t* XG = XA + 64 * 72; LAS bf16_t* W2T = XG + 64 * 136; LAS bf16_t* A2T = W2T + 64 * 72; LAS bf16_t* G2T = A2T + 64 * 72;
    LAS bf16_t* STG = (LAS bf16_t*)(c.lds + 73728); LAS float* LO = (LAS float*)(c.lds + 73728); LAS float* red = (LAS float*)(c.lds + 123648);
    LAS bf16_t* AR = (LAS bf16_t*)c.lds; LAS bf16_t* KB = AR + 128 * 72; LAS bf16_t* VT = KB + 128 * 72; LAS bf16_t* KhT = VT + 64 * 72; LAS bf16_t* R2T = KhT + 64 * 72;
    LAS bf16_t* AkR = (LAS bf16_t*)(c.lds + 73728); LAS float* Am = (LAS float*)(c.lds + 92160); LAS float* Tm = Am + 64 * 65; LAS float* Xt = Tm + 64 * 65; LAS bf16_t* Tb = AR;
    bf16_t* gU = (bf16_t*)(c.ws + WS_RW) + (size_t)u * RW_N * 4096;
    bf16_t* gTA = gU + RW_TA * 4096; bf16_t* gPVT = gU + RW_PVT * 4096; bf16_t* gRH = gU + RW_RH * 4096; bf16_t* gYV = gU + RW_YV * 4096;
    bf16_t* gARB = gU + RW_ARB * 4096; bf16_t* gBHT = gU + RW_BHT * 4096; bf16_t* gKVT = gU + RW_KVT * 4096; bf16_t* gV = gU + RW_V * 4096; bf16_t* gG = gU + RW_G * 4096;
    float* gSC = (float*)(c.ws + WS_RW_SC) + (size_t)u * 128;
    LAS float* PRM = (LAS float*)(c.lds + 127744);
    u32x4 st1[4], st2[5];
    { const float* w2p = inp(c, I_W2) + (size_t)l * 64 * 1024 + h * 64 + (tid >> 6) * 1024 + (tid & 63); const float* a2p = inp(c, I_A2) + (size_t)l * 64 * 1024 + h * 64 + (tid >> 6) * 1024 + (tid & 63);
      const float* g2p = inp(c, I_G2) + (size_t)l * 128 * 1024 + h * 64 + (tid >> 6) * 1024 + (tid & 63);
      float lw2[8], la2[8], lg2[16], pv_[2];
#pragma unroll
      for (int k = 0; k < 8; ++k) { lw2[k] = w2p[k * 8192]; la2[k] = a2p[k * 8192]; }
#pragma unroll
      for (int k = 0; k < 16; ++k) lg2[k] = g2p[k * 8192];
#pragma unroll
      for (int q = 0; q < 2; ++q) { const int idx = tid + q * NTHR; pv_[q] = 0.f;
          if (idx < 768) { const float* src;
              if (idx < 192) src = inp(c, I_MU) + (size_t)l * NCC + (idx >> 6) * 1024 + h * 64 + (idx & 63);
              else if (idx < 448) src = inp(c, I_MU) + (size_t)l * NCC + 3072 + (idx - 192);
              else { const int t_ = (idx - 448) >> 6, o_ = l * 1024 + h * 64 + ((idx - 448) & 63);
                  src = (t_ == 0 ? inp(c, I_W0) : t_ == 1 ? inp(c, I_A0) : t_ == 2 ? inp(c, I_KK) : t_ == 3 ? inp(c, I_KA) : inp(c, I_RK)) + o_; }
              pv_[q] = *src; } }
#pragma unroll
      for (int k = 0; k < 4; ++k) { const int i = tid + k * NTHR; st1[k] = (u32x4){0u, 0u, 0u, 0u};
          if (i < 65 * 24) { const int rr = i / 24, c8 = i % 24, part = c8 >> 3, d8 = c8 & 7; const int tt = t0 - 1 + rr;
              if (tt >= 0 && rr - 1 < Lv) st1[k] = *(const u32x4*)(PROJ + ((size_t)b * TP + tt) * NPROJ + PC0 + part * 1024 + h * 64 + d8 * 8); } }
#pragma unroll
      for (int k = 0; k < 5; ++k) { const int i = tid + k * NTHR; st2[k] = (u32x4){0u, 0u, 0u, 0u};
          if (i < 65 * 32) { const int rr = i >> 5, c8 = i & 31; const int tt = t0 - 1 + rr;
              if (tt >= 0 && rr - 1 < Lv) st2[k] = *(const u32x4*)(PROJ + ((size_t)b * TP + tt) * NPROJ + PC0 + 3072 + c8 * 8); } }
      LAS bf16_t* dw = W2T + (tid & 63) * 72 + (tid >> 6); LAS bf16_t* da = A2T + (tid & 63) * 72 + (tid >> 6); LAS bf16_t* dg = G2T + (tid & 63) * 136 + (tid >> 6);
#pragma unroll
      for (int k = 0; k < 8; ++k) { dw[8 * k] = (bf16_t)f2bf(lw2[k]); da[8 * k] = (bf16_t)f2bf(la2[k]); }
#pragma unroll
      for (int k = 0; k < 16; ++k) dg[8 * k] = (bf16_t)f2bf(lg2[k]);
#pragma unroll
      for (int q = 0; q < 2; ++q) { const int idx = tid + q * NTHR; if (idx < 768) PRM[idx] = pv_[q]; } }
    const int s = lane, p = w;
    const bool valid = s < Lv;
    float r8[8], k8[8], v8[8];
    auto mix8 = [&](const LAS bf16_t* st, int pitch, int col, int ch, float (&o)[8]) {
        const u32x4 a = *(const LAS u32x4*)(st + (s + 1) * pitch + col), bq = *(const LAS u32x4*)(st + s * pitch + col);
        const f32x4 m0 = *(const LAS f32x4*)(PRM + ch), m1 = *(const LAS f32x4*)(PRM + ch + 4);
        const unsigned aw[4] = {a.x, a.y, a.z, a.w}, bw[4] = {bq.x, bq.y, bq.z, bq.w};
#pragma unroll
        for (int e = 0; e < 4; ++e) { const float c0 = __uint_as_float(aw[e] << 16), c1 = __uint_as_float(aw[e] & 0xffff0000u), p0 = __uint_as_float(bw[e] << 16), p1 = __uint_as_float(bw[e] & 0xffff0000u);
            const float mm0 = (2 * e < 4) ? m0[2 * e] : m1[2 * e - 4], mm1 = (2 * e + 1 < 4) ? m0[2 * e + 1] : m1[2 * e + 1 - 4];
            o[2 * e] = valid ? c0 + (p0 - c0) * mm0 : 0.f; o[2 * e + 1] = valid ? c1 + (p1 - c1) * mm1 : 0.f; } };
#pragma unroll
    for (int k = 0; k < 4; ++k) { const int i = tid + k * NTHR; if (i < 65 * 24) { const int rr = i / 24, c8 = i % 24; *(LAS u32x4*)(STG + rr * 200 + (c8 >> 3) * 64 + (c8 & 7) * 8) = st1[k]; } }
    lds_barrier();
    mix8(STG, 200, p * 8, p * 8, r8); mix8(STG, 200, 64 + p * 8, 64 + p * 8, k8); mix8(STG, 200, 128 + p * 8, 128 + p * 8, v8);
#pragma unroll
    for (int e = 0; e < 8; ++e) asm volatile("" : "+v"(r8[e]), "+v"(k8[e]), "+v"(v8[e]));
    lds_barrier();
#pragma unroll
    for (int k = 0; k < 5; ++k) { const int i = tid + k * NTHR; if (i < 65 * 32) *(LAS u32x4*)(STG + (i >> 5) * 264 + (i & 31) * 8) = st2[k]; }
    lds_barrier();
    { float t8[8]; u32x4 o;
      mix8(STG, 264, p * 8, 192 + p * 8, t8);
      o.x = pk2(ftanh(t8[0]), ftanh(t8[1])); o.y = pk2(ftanh(t8[2]), ftanh(t8[3])); o.z = pk2(ftanh(t8[4]), ftanh(t8[5])); o.w = pk2(ftanh(t8[6]), ftanh(t8[7])); *(LAS u32x4*)(XW + s * 72 + p * 8) = o;
      mix8(STG, 264, 64 + p * 8, 256 + p * 8, t8);
      o.x = pk2(t8[0], t8[1]); o.y = pk2(t8[2], t8[3]); o.z = pk2(t8[4], t8[5]); o.w = pk2(t8[6], t8[7]); *(LAS u32x4*)(XA + s * 72 + p * 8) = o;
#pragma unroll
      for (int q = 0; q < 2; ++q) { mix8(STG, 264, 128 + p * 16 + q * 8, 320 + p * 16 + q * 8, t8);
          o.x = pk2(fsigmoid(t8[0]), fsigmoid(t8[1])); o.y = pk2(fsigmoid(t8[2]), fsigmoid(t8[3])); o.z = pk2(fsigmoid(t8[4]), fsigmoid(t8[5])); o.w = pk2(fsigmoid(t8[6]), fsigmoid(t8[7]));
          *(LAS u32x4*)(XG + s * 136 + p * 16 + q * 8) = o; } }
    lds_barrier();
    { const int mt = w & 3, nh = w >> 2; f32x4 a0[1][2], a1[1][2], a2[1][2];
#pragma unroll
      for (int j = 0; j < 2; ++j) { a0[0][j] = (f32x4){0.f, 0.f, 0.f, 0.f}; a1[0][j] = a0[0][j]; a2[0][j] = a0[0][j]; }
      mma_lds<1, 2, 2>(a0, XW, 72, 16 * mt, W2T, 72, 32 * nh, lane);
      mma_lds<1, 2, 2>(a1, XA, 72, 16 * mt, A2T, 72, 32 * nh, lane);
      mma_lds<1, 2, 4>(a2, XG, 136, 16 * mt, G2T, 136, 32 * nh, lane);
#pragma unroll
      for (int j = 0; j < 2; ++j)
#pragma unroll
          for (int r = 0; r < 4; ++r) { const int tok = 16 * mt + 4 * (lane >> 4) + r, cc = 32 * nh + 16 * j + (lane & 15);
              LO[tok * 65 + cc] = a0[0][j][r]; LO[4160 + tok * 65 + cc] = a1[0][j][r]; LO[8320 + tok * 65 + cc] = a2[0][j][r]; } }
    lds_barrier();
    const LAS float* pW0 = PRM + 448 + p * 8; const LAS float* pA0 = PRM + 512 + p * 8; const LAS float* pKK = PRM + 576 + p * 8; const LAS float* pKA = PRM + 640 + p * 8; const LAS float* pRK = PRM + 704 + p * 8;
    { float sq = 0.f, bn = 0.f;
#pragma unroll
      for (int e = 0; e < 8; ++e) { const int cc = p * 8 + e;
          const float et = fsigmoid(pA0[e] + LO[4160 + s * 65 + cc]);
          const float kkv = k8[e] * pKK[e]; sq += kkv * kkv;
          const float k2 = k8[e] * (1.f + (et - 1.f) * pKA[e]); bn += r8[e] * k2 * pRK[e]; }
      red[p * 64 + s] = sq; red[512 + p * 64 + s] = bn; }
    lds_barrier();
    { float sq = 0.f, bn = 0.f;
#pragma unroll
      for (int i = 0; i < 8; ++i) { sq += red[i * 64 + s]; bn += red[512 + i * 64 + s]; }
      const float kn = rsqrtf(sq + 1e-12f);
      if (p == 0) gSC[64 + s] = valid ? bn : 0.f;
#pragma unroll
      for (int e2 = 0; e2 < 4; ++e2) { float fa[2], fr[2], fk[2], fb[2], frh[2], fv[2], fg[2];
#pragma unroll
          for (int q = 0; q < 2; ++q) { const int e = 2 * e2 + q, cc = p * 8 + e;
              const float wl = pW0[e] + LO[s * 65 + cc]; const float lw = valid ? -0.6065306597126334f * fsigmoid(wl) : 0.f;
              const float et = fsigmoid(pA0[e] + LO[4160 + s * 65 + cc]);
              const float Lc = wave_incl_sum(lw, lane); const float Lex = Lc - lw; const float mid = lane_bcast(Lc, 31), LL = lane_bcast(Lc, 63);
              const float kk = k8[e] * pKK[e] * kn; const float k2 = k8[e] * (1.f + (et - 1.f) * pKA[e]);
              const float av = valid ? -kk : 0.f, bv = valid ? kk * et : 0.f, rv = valid ? r8[e] : 0.f, kv = valid ? k2 : 0.f;
              fv[q] = valid ? v8[e] : 0.f; fg[q] = valid ? LO[8320 + s * 65 + cc] : 0.f;
              fa[q] = av * __expf(Lex - mid); fr[q] = rv * __expf(Lc - mid); const float ek = __expf(mid - Lc); fk[q] = kv * ek; fb[q] = bv * ek;
              frh[q] = rv * __expf(Lc); const float eh = __expf(LL - Lc);
              if (s == 0) gSC[p * 8 + e] = __expf(LL);
              VT[(p * 8 + e) * 72 + s] = (bf16_t)f2bf(fv[q]); KhT[(p * 8 + e) * 72 + s] = (bf16_t)f2bf(kv * eh); R2T[(p * 8 + e) * 72 + s] = (bf16_t)f2bf(av * __expf(Lex));
              gBHT[(p * 8 + e) * 64 + s] = (bf16_t)f2bf(bv * eh); }
          const int co = p * 8 + 2 * e2;
          *(LAS unsigned*)(AR + s * 72 + co) = pk2(fa[0], fa[1]); *(LAS unsigned*)(AR + (64 + s) * 72 + co) = pk2(fr[0], fr[1]);
          *(LAS unsigned*)(KB + s * 72 + co) = pk2(fk[0], fk[1]); *(LAS unsigned*)(KB + (64 + s) * 72 + co) = pk2(fb[0], fb[1]);
          *(unsigned*)(gRH + s * 64 + co) = pk2(frh[0], frh[1]); *(unsigned*)(gV + s * 64 + co) = pk2(fv[0], fv[1]); *(unsigned*)(gG + s * 64 + co) = pk2(fg[0], fg[1]);
          asm volatile("" ::: "memory"); } }
    lds_barrier();
    { f32x4 acc[8][1];
#pragma unroll
      for (int j = 0; j < 8; ++j) acc[j][0] = (f32x4){0.f, 0.f, 0.f, 0.f};
      mma_lds<8, 1, 2>(acc, KB, 72, 0, AR, 72, 16 * w, lane);
      const int t = 16 * (w & 3) + (lane & 15);
#pragma unroll
      for (int j = 0; j < 8; ++j) { const int s0 = 16 * (j & 3) + 4 * (lane >> 4); float x[4];
#pragma unroll
          for (int r = 0; r < 4; ++r) x[r] = (w < 4 ? s0 + r < t : s0 + r <= t) ? acc[j][0][r] : 0.f;
          if (j < 4) { u32x2 o; o.x = pk2(x[0], x[1]); o.y = pk2(x[2], x[3]); *(LAS u32x2*)(AkR + ((w < 4 ? 0 : 64) + t) * 72 + s0) = o; }
          else if (w < 4) {
#pragma unroll
              for (int r = 0; r < 4; ++r) Am[t * 65 + s0 + r] = -x[r]; }
          else { u32x2 o; o.x = pk2(x[0], x[1]); o.y = pk2(x[2], x[3]); *(u32x2*)(gARB + t * 64 + s0) = o; } } }
    lds_barrier();
    tri_inv64(Am, Tm, Xt, tid, w, Tb);
    { const int mt = w & 3, nh = w >> 2; f32x4 av[1][2], yv[1][2], kv[1][2];
#pragma unroll
      for (int j = 0; j < 2; ++j) { av[0][j] = (f32x4){0.f, 0.f, 0.f, 0.f}; yv[0][j] = av[0][j]; kv[0][j] = av[0][j]; }
      mma_lds<1, 2, 2>(av, AkR, 72, 16 * mt, VT, 72, 32 * nh, lane);
      mma_lds<1, 2, 2>(yv, VT, 72, 16 * mt, AkR, 72, 64 + 32 * nh, lane);
      mma_lds<1, 2, 2>(kv, KhT, 72, 16 * mt, VT, 72, 32 * nh, lane);
#pragma unroll
      for (int j = 0; j < 2; ++j) { u32x2 o; const int cj = 32 * nh + 16 * j + (lane & 15), r0 = 16 * mt + 4 * (lane >> 4);
          o.x = pk2(av[0][j][0], av[0][j][1]); o.y = pk2(av[0][j][2], av[0][j][3]); *(LAS u32x2*)(R2T + (64 + cj) * 72 + r0) = o;
          o.x = pk2(yv[0][j][0], yv[0][j][1]); o.y = pk2(yv[0][j][2], yv[0][j][3]); *(u32x2*)(gYV + cj * 64 + r0) = o;
          o.x = pk2(kv[0][j][0], kv[0][j][1]); o.y = pk2(kv[0][j][2], kv[0][j][3]); *(u32x2*)(gKVT + cj * 64 + r0) = o; } }
    lds_barrier();
    { const int mt = w & 3, nh = w >> 2; f32x4 ta[1][2], pv[1][2];
#pragma unroll
      for (int j = 0; j < 2; ++j) { ta[0][j] = (f32x4){0.f, 0.f, 0.f, 0.f}; pv[0][j] = ta[0][j]; }
      mma_lds<1, 2, 2>(ta, R2T, 72, 16 * mt, Tb, 72, 32 * nh, lane);
      mma_lds<1, 2, 2>(pv, Tb, 72, 16 * mt, R2T, 72, 64 + 32 * nh, lane);
#pragma unroll
      for (int j = 0; j < 2; ++j) { u32x2 o; const int cj = 32 * nh + 16 * j + (lane & 15), r0 = 16 * mt + 4 * (lane >> 4);
          o.x = pk2(ta[0][j][0], ta[0][j][1]); o.y = pk2(ta[0][j][2], ta[0][j][3]); *(u32x2*)(gTA + cj * 64 + r0) = o;
          o.x = pk2(pv[0][j][0], pv[0][j][1]); o.y = pk2(pv[0][j][2], pv[0][j][3]); *(u32x2*)(gPVT + cj * 64 + r0) = o; } }
    lds_barrier();
}

__device__ __forceinline__ void rwkv_seq_unit(const Ctx& c, int l, int b, int h) {
    int w = c.wave; asm volatile("" : "+s"(w)); const int lane = hw_lane(), tid = w * 64 + lane;
    bf16_t* YBR = (bf16_t*)(c.ws + WS_YBR); const bf16_t* PROJ = (const bf16_t*)(c.ws + WS_PROJ);
    LAS bf16_t* TA = (LAS bf16_t*)c.lds; LAS bf16_t* RH = TA + 64 * 72; LAS bf16_t* ARB = RH + 64 * 72; LAS bf16_t* BHT = ARB + 64 * 72; LAS bf16_t* HT = BHT + 64 * 72; LAS bf16_t* PT = HT + 64 * 72;
    LAS float* ssc = (LAS float*)(PT + 64 * 72); LAS float* rsum = ssc + 128; LAS float* rsq = rsum + 128;
    for (int i = tid; i < 64 * 72; i += NTHR) HT[i] = 0;
    const int kt = w & 3, vh = w >> 2;
    f32x4 Hst[1][2]; Hst[0][0] = (f32x4){0.f, 0.f, 0.f, 0.f}; Hst[0][1] = Hst[0][0];
    f32x4 lnw[2], lnb[2];
#pragma unroll
    for (int i = 0; i < 2; ++i) { lnw[i] = *(const f32x4*)(inp(c, I_LNW) + l * 1024 + h * 64 + 32 * vh + 16 * i + 4 * (lane >> 4)); lnb[i] = *(const f32x4*)(inp(c, I_LNB) + l * 1024 + h * 64 + 32 * vh + 16 * i + 4 * (lane >> 4)); }
    u32x4 pT[3], pR[3], pAB[3], pBH[3]; float psc[3] = {0.f, 0.f, 0.f}; u32x2 pPV[3][2], pYV[3][2], pKV[3][2], pVV[3][2], pGG[3][2];
#define RW_ISSUE(cc, S_) do { const int u_ = (b * HC + h) * NCH + (cc); const bf16_t* gU_ = (const bf16_t*)(c.ws + WS_RW) + (size_t)u_ * RW_N * 4096; const float* gSC_ = (const float*)(c.ws + WS_RW_SC) + (size_t)u_ * 128; \
        const int o_ = (tid >> 3) * 64 + (tid & 7) * 8; pT[S_] = *(const u32x4*)(gU_ + RW_TA * 4096 + o_); pR[S_] = *(const u32x4*)(gU_ + RW_RH * 4096 + o_); pAB[S_] = *(const u32x4*)(gU_ + RW_ARB * 4096 + o_); pBH[S_] = *(const u32x4*)(gU_ + RW_BHT * 4096 + o_); \
        psc[S_] = tid < 128 ? gSC_[tid] : 0.f; \
        _Pragma("unroll") for (int j_ = 0; j_ < 2; ++j_) { const int dv_ = 32 * vh + 16 * j_ + (lane & 15), q4_ = 16 * kt + 4 * (lane >> 4); const int tc_ = 16 * kt + (lane & 15), dv0_ = 32 * vh + 16 * j_ + 4 * (lane >> 4); \
            pPV[S_][j_] = *(const u32x2*)(gU_ + RW_PVT * 4096 + dv_ * 64 + q4_); pKV[S_][j_] = *(const u32x2*)(gU_ + RW_KVT * 4096 + dv_ * 64 + q4_); \
            pYV[S_][j_] = *(const u32x2*)(gU_ + RW_YV * 4096 + tc_ * 64 + dv0_); pVV[S_][j_] = *(const u32x2*)(gU_ + RW_V * 4096 + tc_ * 64 + dv0_); pGG[S_][j_] = *(const u32x2*)(gU_ + RW_G * 4096 + tc_ * 64 + dv0_); } } while (0)
#define RW_CHUNK(cch, S) do { \
        int t0, Lv; chunk_range((cch), t0, Lv); \
        const size_t row0 = (size_t)b * TP + t0; \
        { const int o = (tid >> 3) * 72 + (tid & 7) * 8; *(LAS u32x4*)(TA + o) = pT[S]; *(LAS u32x4*)(RH + o) = pR[S]; *(LAS u32x4*)(ARB + o) = pAB[S]; *(LAS u32x4*)(BHT + o) = pBH[S]; } \
        if (tid < 128) ssc[tid] = psc[S]; \
        const u32x2 cPV0 = pPV[S][0], cPV1 = pPV[S][1], cYV0 = pYV[S][0], cYV1 = pYV[S][1], cKV0 = pKV[S][0], cKV1 = pKV[S][1], cVV0 = pVV[S][0], cVV1 = pVV[S][1], cGG0 = pGG[S][0], cGG1 = pGG[S][1]; \
        if ((cch) + 3 < NCH) RW_ISSUE((cch) + 3, S); \
        lds_barrier(); \
        f32x4 ay[2][1]; \
        { f32x4 ap[1][2]; ap[0][0] = (f32x4){0.f, 0.f, 0.f, 0.f}; ap[0][1] = ap[0][0]; ay[0][0] = ap[0][0]; ay[1][0] = ap[0][0]; \
          mma_lds<1, 2, 2>(ap, TA, 72, 16 * kt, HT, 72, 32 * vh, lane); \
          mma_lds<2, 1, 2>(ay, HT, 72, 32 * vh, RH, 72, 16 * kt, lane); \
        _Pragma("unroll") \
          for (int j = 0; j < 2; ++j) { const int dv = 32 * vh + 16 * j + (lane & 15), tq = 16 * kt + 4 * (lane >> 4); const u32x2 pv = j == 0 ? cPV0 : cPV1; \
              u32x2 o; o.x = pk2(ap[0][j][0] + __uint_as_float(pv.x << 16), ap[0][j][1] + __uint_as_float(pv.x & 0xffff0000u)); o.y = pk2(ap[0][j][2] + __uint_as_float(pv.y << 16), ap[0][j][3] + __uint_as_float(pv.y & 0xffff0000u)); \
              *(LAS u32x2*)(PT + dv * 72 + tq) = o; } \
        _Pragma("unroll") \
          for (int i = 0; i < 2; ++i) { const int tcol = 16 * kt + (lane & 15), dv0 = 32 * vh + 16 * i + 4 * (lane >> 4); const u32x2 yv = i == 0 ? cYV0 : cYV1; \
              ay[i][0][0] += __uint_as_float(yv.x << 16); ay[i][0][1] += __uint_as_float(yv.x & 0xffff0000u); ay[i][0][2] += __uint_as_float(yv.y << 16); ay[i][0][3] += __uint_as_float(yv.y & 0xffff0000u); } } \
        lds_barrier(); \
        { mma_lds<2, 1, 2>(ay, PT, 72, 32 * vh, ARB, 72, 16 * kt, lane); \
        _Pragma("unroll") \
          for (int j = 0; j < 2; ++j) { const int dv = 32 * vh + 16 * j + (lane & 15), dk0 = 16 * kt + 4 * (lane >> 4); const u32x2 kv = j == 0 ? cKV0 : cKV1; \
              Hst[0][j][0] = Hst[0][j][0] * ssc[dk0] + __uint_as_float(kv.x << 16); Hst[0][j][1] = Hst[0][j][1] * ssc[dk0 + 1] + __uint_as_float(kv.x & 0xffff0000u); \
              Hst[0][j][2] = Hst[0][j][2] * ssc[dk0 + 2] + __uint_as_float(kv.y << 16); Hst[0][j][3] = Hst[0][j][3] * ssc[dk0 + 3] + __uint_as_float(kv.y & 0xffff0000u); } \
          mma_lds<1, 2, 2>(Hst, BHT, 72, 16 * kt, PT, 72, 32 * vh, lane); \
        _Pragma("unroll") \
          for (int j = 0; j < 2; ++j) { u32x2 o; o.x = pk2(Hst[0][j][0], Hst[0][j][1]); o.y = pk2(Hst[0][j][2], Hst[0][j][3]); *(LAS u32x2*)(HT + (32 * vh + 16 * j + (lane & 15)) * 72 + 16 * kt + 4 * (lane >> 4)) = o; } \
          const int tcol = 16 * kt + (lane & 15); \
          float sm = 0.f, sq = 0.f; \
        _Pragma("unroll") \
          for (int i = 0; i < 2; ++i) \
        _Pragma("unroll") \
              for (int r = 0; r < 4; ++r) { sm += ay[i][0][r]; sq += ay[i][0][r] * ay[i][0][r]; } \
          sm += __shfl_xor(sm, 16); sm += __shfl_xor(sm, 32); sq += __shfl_xor(sq, 16); sq += __shfl_xor(sq, 32); \
          if (lane < 16) { rsum[vh * 64 + tcol] = sm; rsq[vh * 64 + tcol] = sq; } \
          lds_barrier(); \
          const float mean = (rsum[tcol] + rsum[64 + tcol]) * (1.f / 64.f); const float var = fmaxf((rsq[tcol] + rsq[64 + tcol]) * (1.f / 64.f) - mean * mean, 0.f); const float rstd = rsqrtf(var + 64e-5f); \
          const float bon = ssc[64 + tcol]; \
          if (tcol < Lv) { \
        _Pragma("unroll") \
              for (int i = 0; i < 2; ++i) { const int dv0 = 32 * vh + 16 * i + 4 * (lane >> 4); const u32x2 vv = i == 0 ? cVV0 : cVV1, gg = i == 0 ? cGG0 : cGG1; \
                  const float o0 = ((ay[i][0][0] - mean) * rstd * lnw[i][0] + lnb[i][0] + bon * __uint_as_float(vv.x << 16)) * __uint_as_float(gg.x << 16); \
                  const float o1 = ((ay[i][0][1] - mean) * rstd * lnw[i][1] + lnb[i][1] + bon * __uint_as_float(vv.x & 0xffff0000u)) * __uint_as_float(gg.x & 0xffff0000u); \
                  const float o2 = ((ay[i][0][2] - mean) * rstd * lnw[i][2] + lnb[i][2] + bon * __uint_as_float(vv.y << 16)) * __uint_as_float(gg.y << 16); \
                  const float o3 = ((ay[i][0][3] - mean) * rstd * lnw[i][3] + lnb[i][3] + bon * __uint_as_float(vv.y & 0xffff0000u)) * __uint_as_float(gg.y & 0xffff0000u); \
                  u32x2 o; o.x = pk2(o0, o1); o.y = pk2(o2, o3); *(u32x2*)(YBR + (row0 + tcol) * YLD + 2048 + h * 64 + dv0) = o; } } } \
        lds_barrier(); \
    } while (0)
    RW_ISSUE(0, 0); RW_ISSUE(1, 1); RW_ISSUE(2, 2);
    lds_barrier();
    for (int cch = 0; cch < NCH; cch += 3) { RW_CHUNK(cch, 0); RW_CHUNK(cch + 1, 1); RW_CHUNK(cch + 2, 2); }
#undef RW_CHUNK
#undef RW_ISSUE
    const int lane_e = hw_lane(), tid_e = w * 64 + lane_e;
    float* os = c.out + O_PRS + (((size_t)l * BATCH + b) * HC + h) * DHC * DHC;
#pragma unroll
    for (int j = 0; j < 2; ++j) *(f32x4*)(os + (size_t)(32 * vh + 16 * j + (lane_e & 15)) * 64 + 16 * kt + 4 * (lane_e >> 4)) = Hst[0][j];
    { float* osh = c.out + O_PRSH + ((size_t)l * BATCH + b) * NCC; const bf16_t* last = PROJ + ((size_t)b * TP + TP - 1) * NPROJ + PC0;
      int cidx = -1;
      if (tid_e < 64) cidx = h * 64 + tid_e; else if (tid_e < 128) cidx = 1024 + h * 64 + (tid_e - 64); else if (tid_e < 192) cidx = 2048 + h * 64 + (tid_e - 128); else if (tid_e < 448 && h == 0) cidx = 3072 + (tid_e - 192);
      if (cidx >= 0) osh[cidx] = bf2f(last[cidx]); }
    lds_barrier();
}

__device__ __forceinline__ void mlstm_post_rows(const Ctx& c, int l, int bb, int h, int vs) {
    int w = c.wave; asm volatile("" : "+s"(w)); const int lane = hw_lane();
    const float* HAo = (const float*)(c.ws + WS_HA); const bf16_t* PROJ = (const bf16_t*)(c.ws + WS_PROJ); bf16_t* YBR = (bf16_t*)(c.ws + WS_YBR);
    const f32x4 wv = *(const f32x4*)(inp(c, I_MNW) + l * 1024 + h * 256 + 4 * lane);
    constexpr int RQ = TP / 4;
    const size_t row0 = (size_t)bb * TP + (size_t)vs * RQ;
#pragma unroll 1
    for (int i = w; i < RQ; i += 4 * NWAVES) {
        f32x4 v[4]; u32x2 og[4];
#pragma unroll
        for (int k = 0; k < 4; ++k) { const int ii = i + NWAVES * k < RQ ? i + NWAVES * k : i; const size_t row = row0 + ii;
            v[k] = *(const f32x4*)(HAo + row * 1024 + h * 256 + 4 * lane); og[k] = *(const u32x2*)(PROJ + row * NPROJ + PA_O + h * 256 + 4 * lane); }
#pragma unroll
        for (int k = 0; k < 4; ++k) { if (i + NWAVES * k >= RQ) continue; const size_t row = row0 + i + NWAVES * k;
            const float ss = wave_sum((v[k].x * v[k].x + v[k].y * v[k].y) + (v[k].z * v[k].z + v[k].w * v[k].w)); const float rs = rsqrtf(ss * (1.f / 256.f) + 1e-6f);
            const float o0 = sigmoidf_(__uint_as_float(og[k].x << 16)), o1 = sigmoidf_(__uint_as_float(og[k].x & 0xffff0000u)), o2 = sigmoidf_(__uint_as_float(og[k].y << 16)), o3 = sigmoidf_(__uint_as_float(og[k].y & 0xffff0000u));
            u32x2 o; o.x = pk2(o0 * v[k].x * rs * wv.x, o1 * v[k].y * rs * wv.y); o.y = pk2(o2 * v[k].z * rs * wv.z, o3 * v[k].w * rs * wv.w);
            *(u32x2*)(YBR + row * YLD + h * 256 + 4 * lane) = o; }
    }
}
__device__ __forceinline__ void phase_mix_prep(const Ctx& c, int l) {
    unsigned* qctr = (unsigned*)(c.ws + WS_CTL) + 8192 + (12 + 3 * l) * 64;
    volatile LAS unsigned* MISC = (volatile LAS unsigned*)(c.lds + LDS_MISC);
#define QBEGIN(k, n) int qn_ = 0; if (c.wave == 0 && hw_lane() == 0) qn_ = (int)__hip_atomic_fetch_add(qctr + 64 * (k), (unsigned)(n), __ATOMIC_RELAXED, __HIP_MEMORY_SCOPE_AGENT)
#define QNEXT(k, n) ({ lds_barrier(); if (c.wave == 0 && hw_lane() == 0) MISC[12] = (unsigned)qn_; lds_barrier(); const int u_ = (int)MISC[12]; \
        if (c.wave == 0 && hw_lane() == 0) qn_ = (int)__hip_atomic_fetch_add(qctr + 64 * (k), (unsigned)(n), __ATOMIC_RELAXED, __HIP_MEMORY_SCOPE_AGENT); u_; })
#ifndef NO_RWP
    { QBEGIN(0, 1); for (;;) { const int u = QNEXT(0, 1); if (u >= NU_RW) break; rwkv_prep_unit(c, l, u); } }
#endif
#ifndef ONLY_RWP
    { QBEGIN(1, 1); for (;;) { const int u = QNEXT(1, 1); if (u >= NU_ML) break; mlstm_prep_unit(c, l, u); } }
    { QBEGIN(2, 1); for (;;) { const int u = QNEXT(2, 1); if (u >= NU_GD) break; gdn_prep_unit(c, l, u); } }
#endif
}

__device__ __forceinline__ void phase_mix_seq(const Ctx& c, int l, int rep = 0) {
    constexpr int W_ML = BATCH * HA * 4, W_GD = BATCH * HB, W_RW = BATCH * HC, NPU = W_ML + W_GD + W_RW;
    const int b = c.bid;
    if (b < W_ML && (rep < 2 || rep == 2)) mlstm_seq_unit(c, l, b >> 4, (b >> 2) & 3, b & 3);
    if (b < W_ML && rep == 0) {
        mini_barrier((unsigned*)(c.ws + WS_CTL) + 8192 + (32 + 16 * l + (b >> 2)) * 64, 4u, c.wave);
        mlstm_post_rows(c, l, b >> 4, (b >> 2) & 3, b & 3); }
    if (b >= W_ML && b < W_ML + W_GD && (rep < 2 || rep == 3)) { const int r = b - W_ML; gdn_seq_unit(c, l, r / HB, r % HB); }
#ifndef NO_RWS
    if (b >= W_ML + W_GD && b < NPU && (rep < 2 || rep == 4)) { const int r = b - W_ML - W_GD; rwkv_seq_unit(c, l, r / HC, r % HC); }
#endif
    unsigned* qctr = (unsigned*)(c.ws + WS_CTL) + 8192 + (3 * l + 6 * (rep == 1 ? 1 : 0)) * 64;
    volatile LAS unsigned* MISC = (volatile LAS unsigned*)(c.lds + LDS_MISC);
    { QBEGIN(0, 1); for (;;) { const int u = QNEXT(0, 1); if (u >= NB * HA) break; mlstm_unit_s(c, l, u / HA, u % HA); } }
    { QBEGIN(1, 2); for (;;) { const int u0 = QNEXT(1, 2); if (u0 >= NB * HB) break;
        gdn_unit_s2(c, l, u0 / HB, u0 % HB); } }
    int cached_h = -1;
    { QBEGIN(2, 4); for (;;) { const int u0 = QNEXT(2, 4); if (u0 >= NB * HC) break;
        rwkv_unit4(c, l, u0 % NB, u0 / NB, cached_h); } }
#undef QBEGIN
#undef QNEXT
}

__device__ __forceinline__ void phase_combine(const Ctx& c0, const int nblk) {
    Ctx c = c0; c.lane = hw_lane(); c.tid = c.wave * 64 + c.lane; c.G = nblk;
    const u32x4* B = (const u32x4*)(c.ws + WS_MRGF); u32x4* M = (u32x4*)(c.ws + WS_MRG);
    constexpr size_t NV = (size_t)MP * D / 8, V0 = (size_t)8192 * D / 8;
    for (size_t i = V0 + (size_t)c.bid * NTHR + c.tid; i < NV; i += (size_t)c.G * NTHR * 2) {
        const size_t i2 = i + (size_t)c.G * NTHR; const bool two = i2 < NV;
        u32x4 a[2][3];
#pragma unroll
        for (int z = 0; z < 3; ++z) { a[0][z] = B[i + z * NV]; a[1][z] = two ? B[i2 + z * NV] : (u32x4){0u, 0u, 0u, 0u}; }
#pragma unroll
        for (int q = 0; q < 2; ++q) { u32x4 o; unsigned* po = (unsigned*)&o;
            const unsigned* p0 = (const unsigned*)&a[q][0]; const unsigned* p1 = (const unsigned*)&a[q][1]; const unsigned* p2 = (const unsigned*)&a[q][2];
#pragma unroll
            for (int e = 0; e < 4; ++e) po[e] = pk2(__uint_as_float(p0[e] << 16) + __uint_as_float(p1[e] << 16) + __uint_as_float(p2[e] << 16),
                                                   __uint_as_float(p0[e] & 0xffff0000u) + __uint_as_float(p1[e] & 0xffff0000u) + __uint_as_float(p2[e] & 0xffff0000u));
            if (q == 0) M[i] = o; else if (two) M[i2] = o; }
    }
}

#define IN(k) (lo <= (k) && (k) < hi)
#ifdef ONLY_G
#define GSEL(k) ((k) == ONLY_G)
#else
#define GSEL(k) true
#endif
#if MK_MULTI
#define SEAM(k) do { } while (0)
#else
#define SEAM(k) do { if (IN(k) && IN((k) + 1)) xcd_barrier(bar, c.wave); } while (0)
#endif
template <int L> __device__ __forceinline__ void layer_phases(const Ctx& c, const XcdBarrier& bar, const int lo, const int hi) {
    constexpr int pb = 1 + 10 * L;
#ifndef SKIP_NORM
    if (IN(pb + 0)) { phase_norm_gates<L == 0>(c, inp(c, I_NMIX) + (size_t)L * D, (const float*)(c.ws + WS_WSG) + (size_t)L * NSG * D); if (REP_MISC > 1) phase_norm_gates<L == 0>(c, inp(c, I_NMIX) + (size_t)L * D, (const float*)(c.ws + WS_WSG) + (size_t)L * NSG * D); }
#endif
    SEAM(pb + 0);
    if (IN(pb + 1) && GSEL(1)) {
        pg8::Gemm<D, D, D> g{(const bf16_t*)(c.ws + WS_HN), (const bf16_t*)(c.ws + WS_WIN) + (size_t)L * NPROJ * D};
        pg8::TileOrder<MP, NPROJ, 1> S; S.init(c.G, c.bid);
        pg8::EpiBf16<0> E{(bf16_t*)(c.ws + WS_PROJ), NPROJ};
        pg8::gemm_phase(c.lds, c.wave, g, S, E);
        if (REP_G1 > 1) pg8::gemm_phase(c.lds, c.wave, g, S, E);
    }
    SEAM(pb + 1);
#ifndef SKIP_MIX
    if (IN(pb + 2)) { phase_mix_prep(c, L); if (REP_PREP > 1) phase_mix_prep(c, L); }
    SEAM(pb + 2);
#ifndef ONLY_RWP
    if (IN(pb + 3)) { phase_mix_seq(c, L); if (REP_SEQ > 1) { xcd_barrier(bar, c.wave); phase_mix_seq(c, L, REP_SEQ == 2 ? 1 : REP_SEQ == 3 ? 0 : REP_SEQ - 2); } }
#endif
    SEAM(pb + 3);
#endif
    if (IN(pb + 5) && GSEL(3)) {
        pg8::Gemm<YLD, 1024, 1024, 1024 * 2, (long)D * 1024 * 2> g{(const bf16_t*)(c.ws + WS_YBR), (const bf16_t*)(c.ws + WS_WBR) + (size_t)L * 3 * D * 1024};
        { pg8::TileOrder<8192, D, 3> S; S.init(c.G, c.bid);
          pg8::EpiGateAcc E{(const bf16_t*)(c.ws + WS_PROJ) + PG0, NPROJ, (bf16_t*)(c.ws + WS_MRG), D};
          pg8::gemm_phase(c.lds, c.wave, g, S, E); }
        { pg8::TailOrder<32, D, 3> S; S.init(c.G, c.bid);
          pg8::EpiGateBf16 E{(const bf16_t*)(c.ws + WS_PROJ) + PG0, NPROJ, (bf16_t*)(c.ws + WS_MRGF), D, (size_t)MP * D};
          pg8::gemm_phase(c.lds, c.wave, g, S, E); }
#if TAILCONV
        convert_items(c, L, CO_O, CO_U + CI_U / 4, (3 * 8) % c.G);
#endif
        if (c.G >= 24) {
            if (c.bid < 24) { unsigned* ctr = (unsigned*)(c.ws + WS_CTL) + 8192 + (96 + L) * 64; wg_signal(ctr, c.wave); wg_wait(ctr, 24u, c.wave); phase_combine(c, 24); }
        } else { xcd_barrier(bar, c.wave); phase_combine(c, c.G); }
    }
    SEAM(pb + 5);
    if (IN(pb + 6) && GSEL(4)) {
        pg8::Gemm<D, D, D> g{(const bf16_t*)(c.ws + WS_MRG), (const bf16_t*)(c.ws + WS_WOUT) + (size_t)L * D * D};
        pg8::TileOrder<MP, D, 1> S; S.init(c.G, c.bid);
        if (L == 0) { pg8::EpiResidSrc E{inp(c, I_META), inp(c, I_XP), inp(c, I_XS), (float*)(c.ws + WS_X), D}; pg8::gemm_phase(c.lds, c.wave, g, S, E); }
        else { pg8::EpiResid E{(const float*)(c.ws + WS_X), (float*)(c.ws + WS_X), D}; pg8::gemm_phase(c.lds, c.wave, g, S, E); }
#if TAILCONV
        convert_items(c, L, CO_U + CI_U / 4, CO_D, (33 * 8) % c.G);
#endif
    }
    SEAM(pb + 6);
#ifndef SKIP_NORM
    if (IN(pb + 7)) { phase_norm<false>(c, inp(c, I_NMLP) + (size_t)L * D, nullptr); if (REP_MISC > 1) phase_norm<false>(c, inp(c, I_NMLP) + (size_t)L * D, nullptr); }
#endif
    SEAM(pb + 7);
    if (IN(pb + 8) && GSEL(6)) {
        pg8::Gemm<D, D, D> g{(const bf16_t*)(c.ws + WS_HN), (const bf16_t*)(c.ws + WS_WUP) + (size_t)L * DFF * D};
        pg8::TileOrder<MP, DFF, 1> S; S.init(c.G, c.bid);
        pg8::EpiBf16<1> E{(bf16_t*)(c.ws + WS_PROJ), DFF};
        pg8::gemm_phase(c.lds, c.wave, g, S, E);
#if TAILCONV
        convert_items(c, L, CO_D, C_PER_L, (33 * 32) % c.G);
#endif
    }
    SEAM(pb + 8);
    if (IN(pb + 9) && GSEL(7)) {
        pg8::Gemm<DFF, DFF, DFF> g{(const bf16_t*)(c.ws + WS_PROJ), (const bf16_t*)(c.ws + WS_WDN) + (size_t)L * D * DFF};
        pg8::TileOrder<8192, D, 1> S; S.init(c.G, c.bid);
        pg8::EpiResid E{(const float*)(c.ws + WS_X), (float*)(c.ws + WS_X), D};
        pg8::gemm_phase(c.lds, c.wave, g, S, E);
        unsigned* pdone = (unsigned*)(c.ws + WS_CTL) + 8192 + 64 * 64;
        const bool fin_tail = FIN_IN_TAIL && L == 1 && c.G == 256;
        if (fin_tail) { pg8::Unit u0; if (S.next(0, u0)) wg_signal(pdone + 64 * u0.pm, c.wave); }
        const pg8::StreamX sx{(float*)(c.ws + WS_SLOTS), (unsigned*)(c.ws + WS_CTL) + FLAG_W0 + (3 * L + 2) * 256 * 64, (unsigned*)(c.ws + WS_CTL) + 4096 + XB_TMO};
        pg8::SplitOrder<32, D, 4, 32> S2; S2.init(c.G, c.bid);
        pg8::gemm_phase(c.lds, c.wave, g, S2, E, sx);
        if (c.bid >= 32 && c.bid < 40) pg8::split_reduce<0>(c.wave, (float*)(c.ws + WS_X), nullptr, D, sx, 32, c.bid - 32, 8, 4);
#if TAILCONV
        if (L == 0) convert_items(c, 1, 0, CI_IN, 40);
#endif
        if (fin_tail && c.bid >= 40) {
            const int r = c.bid - 40, p = r & 31, k = r >> 5, cnt = (216 - p + 31) >> 5;
            wg_wait(pdone + 64 * p, 8u, c.wave);
            final_rows(c, 256 * p, 256 * p + 256, k * NWAVES + c.wave, cnt * NWAVES);
        }
    }
    SEAM(pb + 9);
}

__global__ void __launch_bounds__(NTHR, 2) mega(Params p) {
    extern __shared__ __attribute__((aligned(16))) unsigned char lds_raw[];
    Ctx c{p.out, p.ws, (LAS unsigned char*)lds_raw, (int)threadIdx.x, (int)(threadIdx.x & 63), __builtin_amdgcn_readfirstlane((int)(threadIdx.x >> 6)), (int)gridDim.x, (int)blockIdx.x};
    volatile LAS unsigned* MISC = (volatile LAS unsigned*)(c.lds + LDS_MISC);
    if (c.tid < 16) MISC[c.tid] = 0u;
    if (c.tid < 38) ((LAS unsigned long long*)(c.lds + LDS_MISC + 64))[c.tid] = (unsigned long long)p.in[c.tid];
    __syncthreads();
    unsigned* barw = (unsigned*)(c.ws + WS_CTL) + 4096;
    XcdBarrier bar; bar.bar = barw; bar.x = 0; bar.st = MISC + 8;
#if !MK_MULTI
    bar = xcd_barrier_post(barw, MISC + 8);
#endif
    const int lo = p.ph_lo, hi = p.ph_hi;
#ifndef SKIP_PREP
    if (IN(0)) { phase_prep(c); if (REP_MISC > 1) phase_prep(c); }
#endif
    SEAM(0);
    layer_phases<0>(c, bar, lo, hi);
    layer_phases<1>(c, bar, lo, hi);
#ifndef SKIP_NORM
    if (IN(21)) { phase_final(c); if (REP_MISC > 1) phase_final(c); }
#endif
}
#undef IN
#undef SEAM

extern "C" void kernel_launch(void* const* d_in, const int* in_sizes, int n_in, void* d_out, int out_size, void* d_ws, size_t ws_size, hipStream_t stream) {
    static int grid = 0;
    if (grid == 0) {
        if (n_in != 38 || (size_t)out_size != O_END || ws_size < WS_END) { fprintf(stderr, "kernel_launch: unexpected shapes (n_in %d out %d ws %zu need %zu)\n", n_in, out_size, ws_size, (size_t)WS_END); grid = -1; return; }
        int dev = 0, cus = 0, per_cu = 0;
        if (hipGetDevice(&dev) != hipSuccess || hipDeviceGetAttribute(&cus, hipDeviceAttributeMultiprocessorCount, dev) != hipSuccess) { grid = -1; return; }
        if (hipFuncSetAttribute((const void*)mega, hipFuncAttributeMaxDynamicSharedMemorySize, LDS_BYTES) != hipSuccess) { fprintf(stderr, "kernel_launch: hipFuncSetAttribute failed\n"); grid = -1; return; }
        if (hipOccupancyMaxActiveBlocksPerMultiprocessor(&per_cu, (const void*)mega, NTHR, LDS_BYTES) != hipSuccess || per_cu < 1) { fprintf(stderr, "kernel_launch: occupancy query says %d\n", per_cu); (void)hipGetLastError(); grid = -1; return; }
        grid = cus;
    }
    if (grid < 0) return;
    (void)hipMemsetAsync((char*)d_ws + WS_CTL, 0, CTL_BYTES, stream);
    Params p{};
    for (int i = 0; i < 38; ++i) p.in[i] = (const float*)d_in[i];
    p.out = (float*)d_out; p.ws = (unsigned char*)d_ws;
#if MK_MULTI
    for (int k = 0; k < NPHASE; ++k) { p.ph_lo = k; p.ph_hi = k + 1; hipLaunchKernelGGL(mega, dim3(grid), dim3(NTHR), LDS_BYTES, stream, p); }
#else
    p.ph_lo = 0; p.ph_hi = NPHASE;
    hipLaunchKernelGGL(mega, dim3(grid), dim3(NTHR), LDS_BYTES, stream, p);
#endif
}
```

```cpp
#include <hip/hip_runtime.h>
#include <cstdio>
#include <cstdint>

#ifndef MK_MULTI
#define MK_MULTI 0
#endif

#ifndef REP_PREP
#define REP_PREP 1
#endif
#ifndef REP_MISC
#define REP_MISC 1
#endif
#ifndef REP_SEQ
#define REP_SEQ 1
#endif
#ifndef REP_G1
#define REP_G1 1
#endif
#ifndef REP_G4
#define REP_G4 1
#endif
#define LAS __attribute__((address_space(3)))
#define GAS __attribute__((address_space(1)))
typedef unsigned short bf16_t;
typedef short bf16x8 __attribute__((ext_vector_type(8)));
typedef float f32x4 __attribute__((ext_vector_type(4)));
typedef float f32x2 __attribute__((ext_vector_type(2)));
typedef unsigned u32x4 __attribute__((ext_vector_type(4)));
typedef unsigned u32x2 __attribute__((ext_vector_type(2)));

constexpr int D = 2048, BATCH = 4, SEQ = 2048, NMETA = 16, TP = SEQ + NMETA, NB = 128;
constexpr int MPROMPT = BATCH * TP;
constexpr int MREAL = MPROMPT + NB;
constexpr int MP = 8448;
constexpr int NSEQ = BATCH + NB;
constexpr int HA = 4, DHA = 256, HB = 8, DHB = 128, HC = 16, DHC = 64;
constexpr int NCC = 3328, NIN = 17688, NPROJ = 17664, DFF = 8192;
constexpr int PA_Q = 0, PA_K = 1024, PA_V = 2048, PA_O = 3072, PB_QKV = 4096, PB_Z = 7168, PC0 = 8192, PG0 = 11520;
constexpr int NSG = 24, SGLD = 32;
constexpr int YLD = 3072;

constexpr size_t O_YP = 0;
constexpr size_t O_YS = O_YP + (size_t)BATCH * SEQ * D;
constexpr size_t O_PC = O_YS + (size_t)NB * D;
constexpr size_t O_PN = O_PC + (size_t)2 * BATCH * HA * DHA * DHA;
constexpr size_t O_PM = O_PN + (size_t)2 * BATCH * HA * DHA;
constexpr size_t O_PGS = O_PM + (size_t)2 * BATCH * HA;
constexpr size_t O_PGC = O_PGS + (size_t)2 * BATCH * HB * DHB * DHB;
constexpr size_t O_PRS = O_PGC + (size_t)2 * BATCH * 3 * 3072;
constexpr size_t O_PRSH = O_PRS + (size_t)2 * BATCH * HC * DHC * DHC;
constexpr size_t O_SC = O_PRSH + (size_t)2 * BATCH * NCC;
constexpr size_t O_SN = O_SC + (size_t)2 * NB * HA * DHA * DHA;
constexpr size_t O_SM = O_SN + (size_t)2 * NB * HA * DHA;
constexpr size_t O_SGS = O_SM + (size_t)2 * NB * HA;
constexpr size_t O_SGC = O_SGS + (size_t)2 * NB * HB * DHB * DHB;
constexpr size_t O_SRS = O_SGC + (size_t)2 * NB * 3 * 3072;
constexpr size_t O_SRSH = O_SRS + (size_t)2 * NB * HC * DHC * DHC;
constexpr size_t O_END = O_SRSH + (size_t)2 * NB * NCC;
static_assert(O_END == 141732896ull, "output size");

constexpr size_t AL(size_t x) { return (x + 255) & ~(size_t)255; }
constexpr size_t WS_CTL = 0, CTL_BYTES = 1u << 20;
constexpr size_t WS_WIN = CTL_BYTES;
constexpr size_t WS_WSG = AL(WS_WIN + (size_t)2 * NPROJ * D * 2);
constexpr size_t WS_WBR = AL(WS_WSG + (size_t)2 * NSG * D * 4);
constexpr size_t WS_WOUT = AL(WS_WBR + (size_t)2 * 3 * D * 1024 * 2);
constexpr size_t WS_WUP = AL(WS_WOUT + (size_t)2 * D * D * 2);
constexpr size_t WS_WDN = AL(WS_WUP + (size_t)2 * DFF * D * 2);
constexpr size_t WS_X = AL(WS_WDN + (size_t)2 * D * DFF * 2);
constexpr size_t WS_HN = AL(WS_X + (size_t)MP * D * 4);
constexpr size_t WS_SG = AL(WS_HN + (size_t)MP * D * 2);
constexpr size_t WS_YBR = AL(WS_SG + (size_t)MP * SGLD * 4);
constexpr size_t WS_MRG = AL(WS_YBR + (size_t)MP * YLD * 2);
constexpr size_t WS_PROJ = AL(WS_MRG + (size_t)MP * D * 2);
constexpr size_t WS_MRGF = AL(WS_PROJ + (size_t)MP * NPROJ * 2);
constexpr int NCH = 33;
constexpr int NU_ML = BATCH * HA * NCH, NU_GD = BATCH * HB * NCH, NU_RW = BATCH * HC * NCH;
constexpr size_t WS_ML_KTW = WS_MRGF;
constexpr size_t WS_ML_VT = AL(WS_ML_KTW + (size_t)NU_ML * 256 * 64 * 2);
constexpr size_t WS_ML_NP = AL(WS_ML_VT + (size_t)NU_ML * 256 * 64 * 2);
constexpr size_t WS_ML_SC = AL(WS_ML_NP + (size_t)NU_ML * 64 * 256 * 4);
constexpr size_t WS_HA = AL(WS_ML_SC + (size_t)NU_ML * 256 * 4);
constexpr size_t WS_GD_W = AL(WS_HA + (size_t)MPROMPT * 1024 * 4);
constexpr size_t WS_GD_UT = AL(WS_GD_W + (size_t)NU_GD * 64 * 128 * 2);
constexpr size_t WS_GD_AT = AL(WS_GD_UT + (size_t)NU_GD * 128 * 64 * 2);
constexpr size_t WS_GD_Q = AL(WS_GD_AT + (size_t)NU_GD * 64 * 64 * 2);
constexpr size_t WS_GD_KD = AL(WS_GD_Q + (size_t)NU_GD * 64 * 128 * 2);
constexpr size_t WS_GD_SC = AL(WS_GD_KD + (size_t)NU_GD * 128 * 64 * 2);
constexpr size_t WS_RW = AL(WS_GD_SC + (size_t)NU_GD * 128 * 4);
enum { RW_TA = 0  , RW_PVT  , RW_RH  , RW_YV  , RW_ARB  , RW_BHT  , RW_KVT  , RW_V  , RW_G  , RW_N };
constexpr size_t WS_RW_SC = AL(WS_RW + (size_t)NU_RW * RW_N * 4096 * 2);
constexpr size_t WS_MIX_END = AL(WS_RW_SC + (size_t)NU_RW * 128 * 4);
constexpr size_t WS_SLOTS = WS_MRGF;
constexpr int FLAG_W0 = 16384;
static_assert((size_t)(FLAG_W0 + 6 * 256 * 64) * 4 <= CTL_BYTES && WS_SLOTS + (size_t)256 * 65536 * 4 <= WS_MIX_END, "stream-K scratch");
constexpr size_t WS_END = WS_MIX_END > AL(WS_MRGF + (size_t)MP * D * 4) ? WS_MIX_END : AL(WS_MRGF + (size_t)MP * D * 4);
static_assert((size_t)MP * DFF * 2 <= (size_t)MP * NPROJ * 2, "U overlays PROJ");

__device__ __forceinline__ float bf2f(bf16_t b) { return __uint_as_float(((unsigned)b) << 16); }
typedef __bf16 bf16x2_t __attribute__((ext_vector_type(2)));
__device__ __forceinline__ unsigned pk2(float lo, float hi) { const f32x2 v = {lo, hi}; return __builtin_bit_cast(unsigned, __builtin_convertvector(v, bf16x2_t)); }
__device__ __forceinline__ unsigned f2bf(float f) { return pk2(f, 0.f) & 0xffffu; }
__device__ __forceinline__ float sigmoidf_(float x) { return __builtin_amdgcn_rcpf(1.f + __expf(-x)); }
__device__ __forceinline__ float softplusf_(float x) { const float e = __expf(x); return x > 15.f ? x : (e < 1e-3f ? e * (1.f - 0.5f * e) : __logf(1.f + e)); }
__device__ __forceinline__ float siluf_(float x) { return x * __builtin_amdgcn_rcpf(1.f + __expf(-x)); }
__device__ __forceinline__ float fsigmoid(float x) { return __builtin_amdgcn_rcpf(1.f + __expf(-x)); }
__device__ __forceinline__ float fsoftplus(float x) { return x > 15.f ? x : __logf(1.f + __expf(x)); }
__device__ __forceinline__ float ftanh(float x) { return 1.f - 2.f * __builtin_amdgcn_rcpf(1.f + __expf(2.f * x)); }
__device__ __forceinline__ int hw_lane() { int l; asm volatile("v_mbcnt_lo_u32_b32 %0, -1, 0\n\tv_mbcnt_hi_u32_b32 %0, -1, %0" : "=v"(l)); return l; }
template <int CTRL, int ROWMASK>
__device__ __forceinline__ float dpp_mov(float old, float src) {
    return __builtin_bit_cast(float, __builtin_amdgcn_update_dpp(__builtin_bit_cast(int, old), __builtin_bit_cast(int, src), CTRL, ROWMASK, 0xf, false));
}
__device__ __forceinline__ float lane_bcast(float v, int l) { return __builtin_bit_cast(float, __builtin_amdgcn_readlane(__builtin_bit_cast(int, v), l)); }
__device__ __forceinline__ float wave_scan_sum(float v) {
    v += dpp_mov<0x111, 0xf>(0.f, v); v += dpp_mov<0x112, 0xf>(0.f, v); v += dpp_mov<0x114, 0xf>(0.f, v); v += dpp_mov<0x118, 0xf>(0.f, v);
    v += dpp_mov<0x142, 0xa>(0.f, v); v += dpp_mov<0x143, 0xc>(0.f, v);
    return v;
}
__device__ __forceinline__ float wave_sum(float v) { return lane_bcast(wave_scan_sum(v), 63); }
__device__ __forceinline__ float row16_sum(float v) {
    v += dpp_mov<0x121, 0xf>(0.f, v); v += dpp_mov<0x122, 0xf>(0.f, v); v += dpp_mov<0x124, 0xf>(0.f, v); v += dpp_mov<0x128, 0xf>(0.f, v);
    return v;
}
__device__ __forceinline__ void lds_barrier() { asm volatile("s_waitcnt lgkmcnt(0)" ::: "memory"); __builtin_amdgcn_s_barrier(); asm volatile("" ::: "memory"); }
__device__ __forceinline__ float block_sum(float v, LAS float* sc, const int wave) {
    v = wave_sum(v);
    if (hw_lane() == 0) sc[wave] = v;
    lds_barrier();
    float r = 0.f;
#pragma unroll
    for (int i = 0; i < 8; ++i) r += sc[i];
    lds_barrier();
    return r;
}

#define XB_TMO      128
#define XB_XCNT(j)  (256  + 64 * (j))
#define XB_XSUB(j)  (1280 + 64 * (j))
#define XB_XGEN(j)  (2304 + 64 * (j))
#define XB_TOP      3328
#define XB_TOPGEN   3392
#define XCD_BAR_WORDS 3456
#define XB_SPIN_CAP (1u << 22)

__device__ __forceinline__ unsigned xb_ld(unsigned* p)              { return __hip_atomic_load(p, __ATOMIC_RELAXED, __HIP_MEMORY_SCOPE_AGENT); }
__device__ __forceinline__ unsigned xb_add(unsigned* p, unsigned v) { return __hip_atomic_fetch_add(p, v, __ATOMIC_RELAXED, __HIP_MEMORY_SCOPE_AGENT); }
__device__ __forceinline__ unsigned xb_xcc_id() { return (unsigned)__builtin_amdgcn_s_getreg((3 << 11) | 20) & 0xFu; }
#define XB_SPIN(cond, bar) do { unsigned _sp = 0; while (cond) { __builtin_amdgcn_s_sleep(1); \
    if ((++_sp & 255u) == 0u) { if (xb_ld(&(bar)[XB_TMO])) break; if (_sp > XB_SPIN_CAP) { atomicAdd(&(bar)[XB_TMO], 1u); break; } } } } while (0)

struct XcdBarrier { unsigned* bar; unsigned x; volatile LAS unsigned* st; };

__device__ __forceinline__ XcdBarrier xcd_barrier_post(unsigned* bar, volatile LAS unsigned* st) {
    XcdBarrier b; b.bar = bar; b.x = xb_xcc_id(); b.st = st;
    if (threadIdx.x == 0) (void)xb_add(&bar[XB_XCNT(b.x)], 1u);
    return b;
}
__device__ __forceinline__ void xcd_barrier_complete(unsigned* bar, unsigned x, unsigned& nloc, unsigned& nx) {
    const unsigned G = gridDim.x * gridDim.y * gridDim.z;
    unsigned sum, cnt, mine, sp = 0u;
    for (;;) {
        sum = 0u; cnt = 0u; mine = 0u;
#pragma unroll
        for (unsigned j = 0; j < 16; ++j) { const unsigned c = xb_ld(&bar[XB_XCNT(j)]); sum += c; cnt += (c > 0u) ? 1u : 0u; mine = (j == x) ? c : mine; }
        if (sum == G) break;
        __builtin_amdgcn_s_sleep(1);
        if ((++sp & 255u) == 0u) { if (xb_ld(&bar[XB_TMO])) break; if (sp > XB_SPIN_CAP) { atomicAdd(&bar[XB_TMO], 1u); break; } }
    }
    nloc = mine > 0u ? mine : 1u; nx = cnt > 0u ? cnt : 1u;
}
__device__ __forceinline__ void xcd_barrier(const XcdBarrier& b, const int wave) {
    asm volatile("s_waitcnt vmcnt(0)" ::: "memory");
    __syncthreads();
    if (wave == 0 && hw_lane() == 0) {
        unsigned* bar = b.bar;
        __builtin_amdgcn_s_waitcnt(0);
        unsigned nloc = b.st[0], nx = b.st[1];
        if (nloc == 0u) { xcd_barrier_complete(bar, b.x, nloc, nx); b.st[0] = nloc; b.st[1] = nx; }
        const unsigned old = xb_add(&bar[XB_XSUB(b.x)], 1u);
        const unsigned gen = old / nloc;
        if (old + 1u == (gen + 1u) * nloc) {
            __builtin_amdgcn_fence(__ATOMIC_RELEASE, "agent");
            asm volatile("s_waitcnt vmcnt(0)" ::: "memory");
            const unsigned og = xb_add(&bar[XB_TOP], 1u);
            const unsigned tg = og / nx;
            if (og + 1u == (tg + 1u) * nx) xb_add(&bar[XB_TOPGEN], 1u);
            else XB_SPIN(xb_ld(&bar[XB_TOPGEN]) == tg, bar);
            __builtin_amdgcn_fence(__ATOMIC_ACQUIRE, "agent");
            xb_add(&bar[XB_XGEN(b.x)], 1u);
            asm volatile("s_waitcnt vmcnt(0)" ::: "memory");
        } else {
            XB_SPIN(xb_ld(&bar[XB_XGEN(b.x)]) == gen, bar);
            __builtin_amdgcn_fence(__ATOMIC_ACQUIRE, "agent");
            asm volatile("s_waitcnt vmcnt(0)" ::: "memory");
        }
    }
    __syncthreads();
}

__device__ __forceinline__ void mini_barrier(unsigned* ctr, unsigned n, const int wave) {
    asm volatile("s_waitcnt vmcnt(0)" ::: "memory");
    __syncthreads();
    if (wave == 0 && hw_lane() == 0) {
        __builtin_amdgcn_fence(__ATOMIC_RELEASE, "agent");
        asm volatile("s_waitcnt vmcnt(0)" ::: "memory");
        (void)xb_add(ctr, 1u);
        unsigned sp = 0u;
        while (xb_ld(ctr) < n) { __builtin_amdgcn_s_sleep(1); if (++sp > XB_SPIN_CAP) break; }
        __builtin_amdgcn_fence(__ATOMIC_ACQUIRE, "agent");
        asm volatile("s_waitcnt vmcnt(0)" ::: "memory");
    }
    __syncthreads();
}

__device__ __forceinline__ void wg_signal(unsigned* ctr, const int wave) {
    asm volatile("s_waitcnt vmcnt(0)" ::: "memory");
    __syncthreads();
    if (wave == 0 && hw_lane() == 0) { __builtin_amdgcn_fence(__ATOMIC_RELEASE, "agent"); asm volatile("s_waitcnt vmcnt(0)" ::: "memory"); (void)xb_add(ctr, 1u); }
}
__device__ __forceinline__ void wg_wait(unsigned* ctr, unsigned n, const int wave) {
    if (wave == 0 && hw_lane() == 0) { unsigned sp = 0u;
        while (xb_ld(ctr) < n) { __builtin_amdgcn_s_sleep(1); if (++sp > XB_SPIN_CAP) break; }
        __builtin_amdgcn_fence(__ATOMIC_ACQUIRE, "agent");
        asm volatile("s_waitcnt vmcnt(0)" ::: "memory"); }
    __syncthreads();
}

__device__ __forceinline__ const float* x0_row(const float* meta, const float* xp, const float* xs, int row) {
    const int b = row / TP, t = row - b * TP;
    const float* p = t < NMETA ? meta + (size_t)t * D : xp + ((size_t)b * SEQ + (t - NMETA)) * D;
    if (row >= MPROMPT) p = row < MREAL ? xs + (size_t)(row - MPROMPT) * D : meta;
    return p;
}
namespace pg8 {
constexpr int BM = 256, BK = 64, HALF = 128, HTB = HALF * BK * 2, STAGE_BYTES = 8 * HTB, NXCD = 8, WGM = 8;
__host__ __device__ __forceinline__ int lds_byte(int r, int c) { const int st = (r >> 4) * 2 + (c >> 5), rr = r & 15, cc = c & 31, ob = rr * 64 + cc * 2; return st * 1024 + (ob ^ (((ob >> 9) & 1) << 5)); }
__host__ __device__ __forceinline__ void stage_rc(int b, int& R, int& C) { const int st = b / 1024, sb = b % 1024, swz = sb ^ (((sb >> 9) & 1) << 5); R = (st >> 1) * 16 + swz / 64; C = (st & 1) * 32 + (swz % 64) / 2; }
__host__ __device__ __forceinline__ int perm32(int rho) { const int n = rho >> 4, i = rho & 15; return 8 * (i >> 2) + 4 * n + (i & 3); }

struct Unit { int pm, pn, z, kb, kn, role; };
template <int LDA_, int LDB_, int K_, long ZSA_ = 0, long ZSB_ = 0> struct Gemm { static constexpr int lda = LDA_, ldb = LDB_, K = K_; static constexpr size_t zsA = (size_t)ZSA_, zsB = (size_t)ZSB_; const bf16_t* A; const bf16_t* Bt; };

template <int M_, int N_, int NZ_> struct TileOrder {
    static constexpr bool STREAM = false;
    static constexpr int nM = M_ / BM, nN = N_ / BM, nz = NZ_, nwg = nM * nN;
    int G, c;
    __device__ void init(int G_, int c_) { G = G_; c = c_; }
    __device__ __forceinline__ bool next(int i, Unit& u) const {
        u.kb = 0; u.kn = 0; u.role = 0;
        const int ti = i / nz; u.z = i - ti * nz;
        const long L = (long)ti * G + c; if (L >= nwg) return false;
        int wgid = (int)L; { const int q = nwg / NXCD, r = nwg % NXCD, xcd = wgid % NXCD, off = wgid / NXCD; wgid = (xcd < r ? xcd * (q + 1) : r * (q + 1) + (xcd - r) * q) + off; }
        const int nig = WGM * nN, gid = wgid / nig, fm = gid * WGM, gsz = (nM - fm) < WGM ? (nM - fm) : WGM;
        u.pm = fm + ((wgid % nig) % gsz); u.pn = (wgid % nig) / gsz; return true;
    }
};

template <int M_, int N_, int NT_> struct StreamOrder {
    static constexpr bool STREAM = true;
    static constexpr int nN = N_ / BM, nU = (M_ / BM) * nN, UQ = NT_ / 4, Q = nU * UQ;
    int G, c, start, share;
    __device__ void init(int G_, int c_) { G = G_; c = c_; const int base = Q / G_, rem = Q % G_; share = base + (c_ < rem ? 1 : 0); start = c_ * base + (c_ < rem ? c_ : rem); }
    __device__ __forceinline__ bool next(int i, Unit& u) const {
        int p = start; const int e = start + share;
        for (int idx = 0; p < e; ++idx) { const int uu = p / UQ, off = p - uu * UQ; const int len = (UQ - off) < (e - p) ? (UQ - off) : (e - p);
            if (idx == i) { u.pm = uu / nN; u.pn = uu - u.pm * nN; u.z = 0; u.kb = 4 * off; u.kn = 4 * len; u.role = off > 0 ? 1 : (len < UQ ? 2 : 0); return true; }
            p += len; }
        return false;
    }
};
template <int M_, int N_, int NZ_> struct FlatOrder {
    static constexpr bool STREAM = false;
    static constexpr int nM = M_ / BM, nN = N_ / BM, nwg = nM * nN;
    int G, c;
    __device__ void init(int G_, int c_) { G = G_; c = c_; }
    __device__ __forceinline__ bool next(int i, Unit& u) const {
        u.kb = 0; u.kn = 0; u.role = 0;
        const int L = i * G + c; if (L >= nwg * NZ_) return false;
        u.z = L / nwg; int wgid = L - u.z * nwg;
        { const int q = nwg / NXCD, r = nwg % NXCD, xcd = wgid % NXCD, off = wgid / NXCD; wgid = (xcd < r ? xcd * (q + 1) : r * (q + 1) + (xcd - r) * q) + off; }
        const int nig = WGM * nN, gid = wgid / nig, fm = gid * WGM, gsz = (nM - fm) < WGM ? (nM - fm) : WGM;
        u.pm = fm + ((wgid % nig) % gsz); u.pn = (wgid % nig) / gsz; return true;
    }
};
template <int PM_, int N_, int NZ_> struct TailOrder {
    static constexpr bool STREAM = false;
    static constexpr int nN = N_ / BM;
    int G, c;
    __device__ void init(int G_, int c_) { G = G_; c = c_; }
    __device__ __forceinline__ bool next(int i, Unit& u) const { const int L = i * G + c; if (L >= nN * NZ_) return false; u.pm = PM_; u.pn = L % nN; u.z = L / nN; u.kb = 0; u.kn = 0; u.role = 0; return true; }
};
template <int PM_, int N_, int NP_, int KP_> struct SplitOrder {
    static constexpr bool STREAM = true;
    static constexpr int nN = N_ / BM, nprod = nN * NP_;
    int G, c;
    __device__ void init(int G_, int c_) { G = G_; c = c_; }
    __device__ __forceinline__ bool next(int i, Unit& u) const { if (i > 0 || c >= nprod) return false; u.pm = PM_; u.pn = c % nN; u.z = 0; u.kb = KP_ * (c / nN); u.kn = KP_; u.role = 1; return true; }
};
struct StreamX { float* slots; unsigned* flags; unsigned* tmo; };

__device__ __forceinline__ unsigned cvt_pk_bf16(float lo, float hi) { unsigned r; asm volatile("v_cvt_pk_bf16_f32 %0, %1, %2" : "=v"(r) : "v"(lo), "v"(hi)); return r; }

template <int ACT> struct EpiBf16 {
    static constexpr bool PERM = true;
    bf16_t* O; int ldc;
    __device__ __forceinline__ void operator()(const f32x4 (&acc)[2][2][4][2], const Unit& u, int wr, int wc, int fr, int fq) const {
        const int row0 = u.pm * BM + wr * 64 + fr; const int col0 = u.pn * BM + wc * 32 + 8 * fq;
#pragma unroll
        for (int ai = 0; ai < 2; ++ai)
#pragma unroll
            for (int m = 0; m < 4; ++m) { bf16_t* rowp = O + (size_t)(row0 + ai * HALF + m * 16) * ldc + col0;
#pragma unroll
                for (int bj = 0; bj < 2; ++bj) { f32x4 v0 = acc[ai][bj][m][0], v1 = acc[ai][bj][m][1];
                    if (ACT == 1) {
#pragma unroll
                        for (int j = 0; j < 4; ++j) { const float a = fmaxf(v0[j], 0.f), b = fmaxf(v1[j], 0.f); v0[j] = a * a; v1[j] = b * b; } }
                    u32x4 w; w.x = cvt_pk_bf16(v0[0], v0[1]); w.y = cvt_pk_bf16(v0[2], v0[3]); w.z = cvt_pk_bf16(v1[0], v1[1]); w.w = cvt_pk_bf16(v1[2], v1[3]);
                    *(u32x4*)(rowp + bj * HALF) = w; } }
    }
};
struct EpiGateBf16 {
    static constexpr bool PERM = true;
    const bf16_t* PG; int ldg; bf16_t* O; int ldc; size_t zstride;
    __device__ __forceinline__ void operator()(const f32x4 (&acc)[2][2][4][2], const Unit& u, int wr, int wc, int fr, int fq) const {
        const int row0 = u.pm * BM + wr * 64 + fr; const int col0 = u.pn * BM + wc * 32 + 8 * fq;
        bf16_t* Oz = O + (size_t)u.z * zstride;
#pragma unroll
        for (int ai = 0; ai < 2; ++ai)
#pragma unroll
            for (int m2 = 0; m2 < 2; ++m2) { u32x4 g[2][2];
#pragma unroll
                for (int mm = 0; mm < 2; ++mm)
#pragma unroll
                    for (int bj = 0; bj < 2; ++bj) g[mm][bj] = *(const u32x4*)(PG + (size_t)(row0 + ai * HALF + (2 * m2 + mm) * 16) * ldg + (size_t)u.z * 2048 + col0 + bj * HALF);
#pragma unroll
                for (int mm = 0; mm < 2; ++mm)
#pragma unroll
                    for (int bj = 0; bj < 2; ++bj) { const int m = 2 * m2 + mm; const u32x4 gg = g[mm][bj];
                        f32x4 v0 = acc[ai][bj][m][0], v1 = acc[ai][bj][m][1];
                        v0[0] *= fsigmoid(__uint_as_float(gg.x << 16)); v0[1] *= fsigmoid(__uint_as_float(gg.x & 0xffff0000u));
                        v0[2] *= fsigmoid(__uint_as_float(gg.y << 16)); v0[3] *= fsigmoid(__uint_as_float(gg.y & 0xffff0000u));
                        v1[0] *= fsigmoid(__uint_as_float(gg.z << 16)); v1[1] *= fsigmoid(__uint_as_float(gg.z & 0xffff0000u));
                        v1[2] *= fsigmoid(__uint_as_float(gg.w << 16)); v1[3] *= fsigmoid(__uint_as_float(gg.w & 0xffff0000u));
                        u32x4 w; w.x = cvt_pk_bf16(v0[0], v0[1]); w.y = cvt_pk_bf16(v0[2], v0[3]); w.z = cvt_pk_bf16(v1[0], v1[1]); w.w = cvt_pk_bf16(v1[2], v1[3]);
                        *(u32x4*)(Oz + (size_t)(row0 + ai * HALF + m * 16) * ldc + col0 + bj * HALF) = w; } }
    }
};
struct EpiGateAcc {
    static constexpr bool PERM = true;
    const bf16_t* PG; int ldg; bf16_t* O; int ldc;
    __device__ __forceinline__ void operator()(const f32x4 (&acc)[2][2][4][2], const Unit& u, int wr, int wc, int fr, int fq) const {
        const int row0 = u.pm * BM + wr * 64 + fr; const int col0 = u.pn * BM + wc * 32 + 8 * fq;
        const bool first = u.z == 0;
#pragma unroll
        for (int ai = 0; ai < 2; ++ai)
#pragma unroll
            for (int m2 = 0; m2 < 2; ++m2) { u32x4 g[2][2], p[2][2];
#pragma unroll
                for (int mm = 0; mm < 2; ++mm)
#pragma unroll
                    for (int bj = 0; bj < 2; ++bj) { const size_t row = (size_t)(row0 + ai * HALF + (2 * m2 + mm) * 16);
                        g[mm][bj] = *(const u32x4*)(PG + row * ldg + (size_t)u.z * 2048 + col0 + bj * HALF);
                        p[mm][bj] = (u32x4){0u, 0u, 0u, 0u};
                        if (!first) p[mm][bj] = *(const u32x4*)(O + row * ldc + col0 + bj * HALF); }
#pragma unroll
                for (int mm = 0; mm < 2; ++mm)
#pragma unroll
                    for (int bj = 0; bj < 2; ++bj) { const int m = 2 * m2 + mm; const u32x4 gg = g[mm][bj], pp = p[mm][bj];
                        f32x4 v0 = acc[ai][bj][m][0], v1 = acc[ai][bj][m][1];
                        v0[0] = v0[0] * fsigmoid(__uint_as_float(gg.x << 16)) + __uint_as_float(pp.x << 16); v0[1] = v0[1] * fsigmoid(__uint_as_float(gg.x & 0xffff0000u)) + __uint_as_float(pp.x & 0xffff0000u);
                        v0[2] = v0[2] * fsigmoid(__uint_as_float(gg.y << 16)) + __uint_as_float(pp.y << 16); v0[3] = v0[3] * fsigmoid(__uint_as_float(gg.y & 0xffff0000u)) + __uint_as_float(pp.y & 0xffff0000u);
                        v1[0] = v1[0] * fsigmoid(__uint_as_float(gg.z << 16)) + __uint_as_float(pp.z << 16); v1[1] = v1[1] * fsigmoid(__uint_as_float(gg.z & 0xffff0000u)) + __uint_as_float(pp.z & 0xffff0000u);
                        v1[2] = v1[2] * fsigmoid(__uint_as_float(gg.w << 16)) + __uint_as_float(pp.w << 16); v1[3] = v1[3] * fsigmoid(__uint_as_float(gg.w & 0xffff0000u)) + __uint_as_float(pp.w & 0xffff0000u);
                        u32x4 w; w.x = cvt_pk_bf16(v0[0], v0[1]); w.y = cvt_pk_bf16(v0[2], v0[3]); w.z = cvt_pk_bf16(v1[0], v1[1]); w.w = cvt_pk_bf16(v1[2], v1[3]);
                        *(u32x4*)(O + (size_t)(row0 + ai * HALF + m * 16) * ldc + col0 + bj * HALF) = w; }
                asm volatile("" ::: "memory"); }
    }
};
struct EpiGate {
    static constexpr bool PERM = true;
    const bf16_t* PG; int ldg;
    float* F; bf16_t* O; int ldc;
    __device__ __forceinline__ void operator()(const f32x4 (&acc)[2][2][4][2], const Unit& u, int wr, int wc, int fr, int fq) const {
        const int row0 = u.pm * BM + wr * 64 + fr; const int col0 = u.pn * BM + wc * 32 + 8 * fq;
#pragma unroll
        for (int ai = 0; ai < 2; ++ai)
#pragma unroll
            for (int m = 0; m < 4; ++m) { const size_t row = (size_t)(row0 + ai * HALF + m * 16);
                u32x4 g[2]; f32x4 f0[2], f1[2];
#pragma unroll
                for (int bj = 0; bj < 2; ++bj) { const int col = col0 + bj * HALF; g[bj] = *(const u32x4*)(PG + row * ldg + (size_t)u.z * 2048 + col);
                    f0[bj] = (f32x4){0.f, 0.f, 0.f, 0.f}; f1[bj] = f0[bj];
                    if (u.z > 0) { const float* fp = F + row * ldc + col; f0[bj] = *(const f32x4*)fp; f1[bj] = *(const f32x4*)(fp + 4); } }
#pragma unroll
                for (int bj = 0; bj < 2; ++bj) { const int col = col0 + bj * HALF;
                    f32x4 v0 = acc[ai][bj][m][0], v1 = acc[ai][bj][m][1];
                    v0[0] *= fsigmoid(__uint_as_float(g[bj].x << 16)); v0[1] *= fsigmoid(__uint_as_float(g[bj].x & 0xffff0000u));
                    v0[2] *= fsigmoid(__uint_as_float(g[bj].y << 16)); v0[3] *= fsigmoid(__uint_as_float(g[bj].y & 0xffff0000u));
                    v1[0] *= fsigmoid(__uint_as_float(g[bj].z << 16)); v1[1] *= fsigmoid(__uint_as_float(g[bj].z & 0xffff0000u));
                    v1[2] *= fsigmoid(__uint_as_float(g[bj].w << 16)); v1[3] *= fsigmoid(__uint_as_float(g[bj].w & 0xffff0000u));
                    v0 += f0[bj]; v1 += f1[bj];
                    float* fp = F + row * ldc + col;
                    if (u.z < 2) { *(f32x4*)fp = v0; *(f32x4*)(fp + 4) = v1; }
                    else { u32x4 w; w.x = cvt_pk_bf16(v0[0], v0[1]); w.y = cvt_pk_bf16(v0[2], v0[3]); w.z = cvt_pk_bf16(v1[0], v1[1]); w.w = cvt_pk_bf16(v1[2], v1[3]);
                           *(u32x4*)(O + row * ldc + col) = w; } } }
    }
};
struct EpiResid {
    static constexpr bool PERM = false;
    const float* Xin; float* Xout; int ldc;
    __device__ __forceinline__ void operator()(const f32x4 (&acc)[2][2][4][2], const Unit& u, int wr, int wc, int fr, int fq) const {
        const int row0 = u.pm * BM + wr * 64 + fr, col0 = u.pn * BM + wc * 32 + 4 * fq;
#pragma unroll
        for (int ai = 0; ai < 2; ++ai)
#pragma unroll
            for (int m = 0; m < 4; ++m) { f32x4 t[2][2]; const size_t ro = (size_t)(row0 + ai * HALF + m * 16) * ldc + col0;
#pragma unroll
                for (int bj = 0; bj < 2; ++bj)
#pragma unroll
                    for (int n = 0; n < 2; ++n) t[bj][n] = *(const f32x4*)(Xin + ro + bj * HALF + n * 16);
#pragma unroll
                for (int bj = 0; bj < 2; ++bj)
#pragma unroll
                    for (int n = 0; n < 2; ++n) *(f32x4*)(Xout + ro + bj * HALF + n * 16) = t[bj][n] + acc[ai][bj][m][n];
                asm volatile("" ::: "memory"); }
    }
};

struct EpiResidSrc {
    static constexpr bool PERM = false;
    const float* meta; const float* xp; const float* xs; float* Xout; int ldc;
    __device__ __forceinline__ void operator()(const f32x4 (&acc)[2][2][4][2], const Unit& u, int wr, int wc, int fr, int fq) const {
        const int row0 = u.pm * BM + wr * 64 + fr, col0 = u.pn * BM + wc * 32 + 4 * fq;
#pragma unroll
        for (int ai = 0; ai < 2; ++ai)
#pragma unroll
            for (int m = 0; m < 4; ++m) { f32x4 t[2][2]; const int row = row0 + ai * HALF + m * 16; const size_t ro = (size_t)row * ldc + col0;
                const float* src = x0_row(meta, xp, xs, row) + col0;
#pragma unroll
                for (int bj = 0; bj < 2; ++bj)
#pragma unroll
                    for (int n = 0; n < 2; ++n) t[bj][n] = *(const f32x4*)(src + bj * HALF + n * 16);
#pragma unroll
                for (int bj = 0; bj < 2; ++bj)
#pragma unroll
                    for (int n = 0; n < 2; ++n) *(f32x4*)(Xout + ro + bj * HALF + n * 16) = t[bj][n] + acc[ai][bj][m][n];
                asm volatile("" ::: "memory"); }
    }
};

template <int MODE>
__device__ __forceinline__ void split_reduce(const int wid, float* X, bf16_t* U, int ldc, const StreamX sx, int pm, int pn, int nN, int NP) {
    const int lane = hw_lane(), tid = wid * 64 + lane, wr = wid >> 2, wc = wid & 3, fr = lane & 15, fq = lane >> 4;
    if (wid == 0) {
#pragma unroll 1
        for (int j = 0; j < NP; ++j) { unsigned sp = 0;
            while ((unsigned)__builtin_amdgcn_readfirstlane(__hip_atomic_load(sx.flags + 64 * (pn + nN * j), __ATOMIC_RELAXED, __HIP_MEMORY_SCOPE_AGENT)) != 1u) {
                __builtin_amdgcn_s_sleep(1);
                if ((++sp & 255u) == 0u) { if (__builtin_amdgcn_readfirstlane(__hip_atomic_load(sx.tmo, __ATOMIC_RELAXED, __HIP_MEMORY_SCOPE_AGENT))) break; if (sp > (1u << 20)) { if (lane == 0) __hip_atomic_store(sx.tmo, 1u, __ATOMIC_RELAXED, __HIP_MEMORY_SCOPE_AGENT); break; } } } }
        __builtin_amdgcn_fence(__ATOMIC_ACQUIRE, "agent"); asm volatile("s_waitcnt vmcnt(0)" ::: "memory"); }
    __syncthreads();
    const float* s0 = sx.slots + (size_t)pn * 65536 + tid * 32; const size_t jstride = (size_t)nN * 65536;
#pragma unroll 2
    for (int am = 0; am < 16; ++am) {
        const int a = am >> 3, b = (am >> 2) & 1, m = am & 3;
        f32x4 v0 = (f32x4){0.f, 0.f, 0.f, 0.f}, v1 = v0;
        const float* p = s0 + (am >> 2) * 16384 + (am & 3) * 8;
#pragma unroll 4
        for (int j = 0; j < NP; ++j) { v0 += *(const f32x4*)(p + j * jstride); v1 += *(const f32x4*)(p + j * jstride + 4); }
        const size_t row = (size_t)(pm * BM + a * HALF + wr * 64 + m * 16 + fr);
        if (MODE == 0) { float* xp = X + row * ldc + pn * BM + b * HALF + wc * 32 + 4 * fq;
            *(f32x4*)xp = *(const f32x4*)xp + v0; *(f32x4*)(xp + 16) = *(const f32x4*)(xp + 16) + v1; }
        else {
#pragma unroll
            for (int e = 0; e < 4; ++e) { const float x0 = fmaxf(v0[e], 0.f), x1 = fmaxf(v1[e], 0.f); v0[e] = x0 * x0; v1[e] = x1 * x1; }
            u32x4 w; w.x = cvt_pk_bf16(v0[0], v0[1]); w.y = cvt_pk_bf16(v0[2], v0[3]); w.z = cvt_pk_bf16(v1[0], v1[1]); w.w = cvt_pk_bf16(v1[2], v1[3]);
            *(u32x4*)(U + row * ldc + pn * BM + b * HALF + wc * 32 + 8 * fq) = w; }
    }
    __syncthreads();
}

template <class Epi, class Sched, class GemmT>
__device__ __forceinline__ void gemm_phase(LAS unsigned char* lds, const int wid, const GemmT g, const Sched& S, const Epi& E, const StreamX sx = StreamX{nullptr, nullptr, nullptr}) {
    const int lane = hw_lane(), tid = wid * 64 + lane, wr = wid >> 2, wc = wid & 3, fr = lane & 15, fq = lane >> 4;
    constexpr int K = GemmT::K, nt = K / BK;
    unsigned voffA[2], voffB[2];
#pragma unroll
    for (int i = 0; i < 2; ++i) { int R, C; stage_rc(tid * 16 + i * 8192, R, C); const int Rb = Epi::PERM ? ((R & ~31) + perm32(R & 31)) : R;
        voffA[i] = (unsigned)(R * GemmT::lda + C) * 2u; voffB[i] = (unsigned)(Rb * GemmT::ldb + C) * 2u; }
    constexpr size_t kstep = (size_t)(BK * 2);
    constexpr size_t hstepA = (size_t)HALF * GemmT::lda * 2, hstepB = (size_t)HALF * GemmT::ldb * 2;
    constexpr size_t tstepA = 2 * hstepA, tstepB = 2 * hstepB;
    const unsigned ldsw = (unsigned)wid * 1024u;
    const int aoff = lds_byte(wr * 64 + fr, fq * 8), boff = lds_byte(wc * 32 + fr, fq * 8);
#define PG8_SA(b, h) (((b) * 2 + (h)) * HTB)
#define PG8_SB(b, h) ((4 + (b) * 2 + (h)) * HTB)
#define PG8_STAGE(bufoff, gbase, voff) do { _Pragma("unroll") for (int _i = 0; _i < 2; ++_i) \
        __builtin_amdgcn_global_load_lds((const unsigned*)((const char*)(gbase) + (voff)[_i]), (LAS unsigned*)(lds + (bufoff) + ldsw + _i * 8192), 16, 0, 0); } while (0)
#define PG8_LDA(dst, b, h) do { _Pragma("unroll") for (int m = 0; m < 4; ++m) _Pragma("unroll") for (int k = 0; k < 2; ++k) dst[m][k] = *(const LAS bf16x8*)(lds + PG8_SA(b, h) + aoff + m * 2048 + k * 1024); } while (0)
#define PG8_LDB(dst, b, h) do { _Pragma("unroll") for (int n = 0; n < 2; ++n) _Pragma("unroll") for (int k = 0; k < 2; ++k) dst[n][k] = *(const LAS bf16x8*)(lds + PG8_SB(b, h) + boff + n * 2048 + k * 1024); } while (0)
#define PG8_MMA(ai, bj, At, Bt) do { __builtin_amdgcn_s_setprio(1); _Pragma("unroll") for (int m = 0; m < 4; ++m) _Pragma("unroll") for (int n = 0; n < 2; ++n) _Pragma("unroll") for (int k = 0; k < 2; ++k) \
        acc[ai][bj][m][n] = __builtin_amdgcn_mfma_f32_16x16x32_bf16(Bt[n][k], At[m][k], acc[ai][bj][m][n], 0, 0, 0); __builtin_amdgcn_s_setprio(0); } while (0)
#define PG8_WAIT_V(n) asm volatile("s_waitcnt vmcnt(" #n ")" ::: "memory")
#define PG8_WAIT_L(n) asm volatile("s_waitcnt lgkmcnt(" #n ")" ::: "memory")
#define PG8_BAR __builtin_amdgcn_s_barrier()
#define PG8_SCHED __builtin_amdgcn_sched_barrier(0)
    Unit cur, nxt; int ui = 0;
    if (!S.next(0, cur)) return;
    f32x4 acc[2][2][4][2];
#pragma unroll
    for (int a = 0; a < 2; ++a)
#pragma unroll
        for (int b = 0; b < 2; ++b)
#pragma unroll
            for (int m = 0; m < 4; ++m)
#pragma unroll
                for (int n = 0; n < 2; ++n) acc[a][b][m][n] = (f32x4){0.f, 0.f, 0.f, 0.f};
    bf16x8 At[4][2], B0[2][2], B1[2][2];
    const char* cA = (const char*)g.A + (size_t)cur.pm * tstepA + (size_t)cur.z * GemmT::zsA + (size_t)cur.kb * kstep; const char* cB = (const char*)g.Bt + (size_t)cur.pn * tstepB + (size_t)cur.z * GemmT::zsB + (size_t)cur.kb * kstep;
    PG8_STAGE(PG8_SB(0, 0), cB, voffB); PG8_STAGE(PG8_SB(0, 1), cB + hstepB, voffB); PG8_STAGE(PG8_SA(0, 0), cA, voffA); PG8_STAGE(PG8_SA(0, 1), cA + hstepA, voffA);
    if (wr == 1) PG8_BAR;
    PG8_WAIT_V(2); PG8_BAR;
    PG8_STAGE(PG8_SB(1, 0), cB + kstep, voffB); PG8_STAGE(PG8_SA(1, 0), cA + kstep, voffA); PG8_STAGE(PG8_SB(1, 1), cB + hstepB + kstep, voffB);
    PG8_WAIT_V(6); PG8_BAR;
    for (;;) {
        const bool has_next = S.next(ui + 1, nxt);
        const char* nA = has_next ? (const char*)g.A + (size_t)nxt.pm * tstepA + (size_t)nxt.z * GemmT::zsA + (size_t)nxt.kb * kstep : cA;
        const char* nB = has_next ? (const char*)g.Bt + (size_t)nxt.pn * tstepB + (size_t)nxt.z * GemmT::zsB + (size_t)nxt.kb * kstep : cB;
        const int ntu = Sched::STREAM ? cur.kn : nt;
        for (int t = 0; t < ntu; t += 2) {
            const bool last = (t == ntu - 2);
            const char* a1 = cA + (size_t)(t + 1) * kstep;
            const char* a2 = last ? nA : cA + (size_t)(t + 2) * kstep; const char* b2 = last ? nB : cB + (size_t)(t + 2) * kstep;
            const char* a3 = a2 + kstep; const char* b3 = b2 + kstep;
            PG8_LDB(B0, 0, 0); PG8_LDB(B1, 0, 1); PG8_SCHED; PG8_LDA(At, 0, 0); PG8_STAGE(PG8_SA(1, 1), a1 + hstepA, voffA);
            PG8_WAIT_V(8); PG8_WAIT_L(0); PG8_BAR; PG8_MMA(0, 0, At, B0); PG8_MMA(0, 1, At, B1); PG8_BAR; PG8_SCHED;
            PG8_LDA(At, 0, 1); PG8_STAGE(PG8_SB(0, 0), b2, voffB); PG8_STAGE(PG8_SB(0, 1), b2 + hstepB, voffB); PG8_STAGE(PG8_SA(0, 0), a2, voffA);
            PG8_WAIT_V(8); PG8_WAIT_L(0); PG8_BAR; PG8_MMA(1, 0, At, B0); PG8_MMA(1, 1, At, B1); PG8_BAR; PG8_SCHED;
            PG8_LDB(B0, 1, 0); PG8_LDB(B1, 1, 1); PG8_SCHED; PG8_LDA(At, 1, 0); PG8_STAGE(PG8_SA(0, 1), a2 + hstepA, voffA);
            PG8_WAIT_V(8); PG8_WAIT_L(0); PG8_BAR; PG8_MMA(0, 0, At, B0); PG8_MMA(0, 1, At, B1); PG8_BAR; PG8_SCHED;
            PG8_LDA(At, 1, 1); PG8_STAGE(PG8_SB(1, 0), b3, voffB); PG8_STAGE(PG8_SB(1, 1), b3 + hstepB, voffB); PG8_STAGE(PG8_SA(1, 0), a3, voffA);
            PG8_WAIT_V(8); PG8_WAIT_L(0); PG8_BAR; PG8_MMA(1, 0, At, B0); PG8_MMA(1, 1, At, B1); PG8_BAR; PG8_SCHED;
        }
        if (wr == 0) PG8_BAR;
        const int lane_e = hw_lane(), tid_e = wid * 64 + lane_e, fr_e = lane_e & 15, fq_e = lane_e >> 4;
        if (Sched::STREAM && cur.role == 1) {
            const __amdgpu_buffer_rsrc_t rs = __builtin_amdgcn_make_buffer_rsrc(sx.slots, 0, 256 * 65536 * 4, 0x00020000);
            const unsigned sbase = (unsigned)S.c * 262144u + (unsigned)tid_e * 128u;
#pragma unroll
            for (int a = 0; a < 2; ++a)
#pragma unroll
                for (int b = 0; b < 2; ++b)
#pragma unroll
                    for (int m = 0; m < 4; ++m)
#pragma unroll
                        for (int n = 0; n < 2; ++n) { constexpr int dummy = 0; const int k = ((a * 2 + b) * 4 + m) * 2 + n;
                            __builtin_amdgcn_raw_buffer_store_b128(__builtin_bit_cast(u32x4, acc[a][b][m][n]), rs, sbase + (unsigned)((k >> 3) * 65536), (k & 7) * 16 + dummy, 16); }
            asm volatile("s_waitcnt vmcnt(0)" ::: "memory"); PG8_BAR; asm volatile("" ::: "memory");
            if (tid_e == 0) __hip_atomic_store(sx.flags + 64 * S.c, 1u, __ATOMIC_RELAXED, __HIP_MEMORY_SCOPE_AGENT);
        } else {
            E(acc, cur, wr, wc, fr_e, fq_e);
        }
        if (!has_next) break;
        if (Sched::STREAM && nxt.role == 2) {
            if (wid == 0) { unsigned sp = 0;
                while ((unsigned)__builtin_amdgcn_readfirstlane(__hip_atomic_load(sx.flags + 64 * (S.c + 1), __ATOMIC_RELAXED, __HIP_MEMORY_SCOPE_AGENT)) != 1u) {
                    __builtin_amdgcn_s_sleep(1);
                    if ((++sp & 255u) == 0u) { if (__builtin_amdgcn_readfirstlane(__hip_atomic_load(sx.tmo, __ATOMIC_RELAXED, __HIP_MEMORY_SCOPE_AGENT))) break; if (sp > (1u << 20)) { if (lane == 0) __hip_atomic_store(sx.tmo, 1u, __ATOMIC_RELAXED, __HIP_MEMORY_SCOPE_AGENT); break; } } }
                __builtin_amdgcn_fence(__ATOMIC_ACQUIRE, "agent"); asm volatile("s_waitcnt vmcnt(0)" ::: "memory"); }
            asm volatile("" ::: "memory"); PG8_BAR; asm volatile("" ::: "memory");
            const float* ps = sx.slots + (size_t)(S.c + 1) * 65536 + tid * 32;
#pragma unroll
            for (int a = 0; a < 2; ++a)
#pragma unroll
                for (int b = 0; b < 2; ++b)
#pragma unroll
                    for (int m = 0; m < 4; ++m)
#pragma unroll
                        for (int n = 0; n < 2; ++n) { const int k = ((a * 2 + b) * 4 + m) * 2 + n; acc[a][b][m][n] = *(const f32x4*)(ps + (k >> 3) * 16384 + (k & 7) * 4); }
        } else {
#pragma unroll
        for (int a = 0; a < 2; ++a)
#pragma unroll
            for (int b = 0; b < 2; ++b)
#pragma unroll
                for (int m = 0; m < 4; ++m)
#pragma unroll
                    for (int n = 0; n < 2; ++n) acc[a][b][m][n] = (f32x4){0.f, 0.f, 0.f, 0.f};
        }
        cur = nxt; cA = nA; cB = nB; ++ui;
        if (wr == 1) PG8_BAR;
    }
    PG8_WAIT_V(0);
    PG8_BAR;
#undef PG8_SA
#undef PG8_SB
#undef PG8_STAGE
#undef PG8_LDA
#undef PG8_LDB
#undef PG8_MMA
#undef PG8_WAIT_V
#undef PG8_WAIT_L
#undef PG8_BAR
#undef PG8_SCHED
}
}

constexpr int NWAVES = 8, NTHR = 512;
constexpr int LDS_BYTES = 147456;
constexpr int LDS_MISC = 131072;
constexpr int NPHASE = 22;

struct Params {
    const float* in[38];
    float* out;
    unsigned char* ws;
    int ph_lo, ph_hi;
};
struct Ctx {
    float* out; unsigned char* ws;
    LAS unsigned char* lds;
    int tid, lane, wave, G, bid;
};
__device__ __forceinline__ const float* inp(const Ctx& c, int i);
enum { I_XP = 0, I_XS, I_SC, I_SN, I_SM, I_SGS, I_SGC, I_SRS, I_SRSH, I_META, I_NMIX, I_WIN, I_BI, I_BF, I_MNW, I_CONVW, I_ALOG, I_DTB, I_GNW, I_MU, I_W0, I_W2, I_A0, I_A2, I_G2,
       I_KK, I_KA, I_RK, I_LNW, I_LNB, I_WBA, I_WBB, I_WBC, I_WOUT, I_NMLP, I_WUP, I_WDN, I_FNW };

__device__ __forceinline__ const float* inp(const Ctx& c, int i) {
    const LAS unsigned* t = (const LAS unsigned*)(c.lds + LDS_MISC + 64) + 2 * i;
    const unsigned lo = __builtin_amdgcn_readfirstlane(t[0]), hi = __builtin_amdgcn_readfirstlane(t[1]);
    typedef const float __attribute__((address_space(1)))* gptr_t;
    return (const float*)(gptr_t)(((unsigned long long)hi << 32) | lo);
}
__device__ __forceinline__ void transpose_item(const float* W, int K, int Nsrc, int src_col, bf16_t* WT, int dst_row, int k0, LAS float* scr, int lane) {
    float v[32];
    const float* src = W + (size_t)(k0 + (lane >> 5)) * Nsrc + src_col + (lane & 31);
#pragma unroll
    for (int i = 0; i < 32; ++i) v[i] = src[(size_t)(2 * i) * Nsrc];
#pragma unroll
    for (int i = 0; i < 32; ++i) scr[(2 * i + (lane >> 5)) * 33 + (lane & 31)] = v[i];
    asm volatile("s_waitcnt lgkmcnt(0)" ::: "memory");
    const int c = lane & 7;
#pragma unroll
    for (int j = 0; j < 4; ++j) { const int n = (lane >> 3) + 8 * j; const LAS float* s = scr + (8 * c) * 33 + n;
        u32x4 o; o.x = pk2(s[0 * 33], s[1 * 33]); o.y = pk2(s[2 * 33], s[3 * 33]); o.z = pk2(s[4 * 33], s[5 * 33]); o.w = pk2(s[6 * 33], s[7 * 33]);
        *(u32x4*)(WT + (size_t)(dst_row + n) * K + k0 + 8 * c) = o; }
    asm volatile("s_waitcnt lgkmcnt(0)" ::: "memory");
}
__device__ __forceinline__ int win_src_col(int n) {
    return n < 4096 ? n : (n < 8192 ? n + 8 : (n < 11520 ? n + 24 : n + 24));
}
constexpr int CI_IN = 32 * (NPROJ / 32), CI_BR = 16 * 64, CI_O = 32 * 64, CI_U = 32 * 256, CI_D = 128 * 64;
constexpr int CO_BR = CI_IN, CO_O = CO_BR + 3 * CI_BR, CO_U = CO_O + CI_O, CO_D = CO_U + CI_U, C_PER_L = CO_D + CI_D;
#ifndef TAILCONV
#define TAILCONV 1
#endif
#if TAILCONV
constexpr int PREP_L0_END = CO_BR, PREP_L1_BEG = 0, PREP_L1_END = 0;
constexpr int WBR_G1 = 1728, WBR_DYN = 3 * CI_BR - WBR_G1;
#else
constexpr int PREP_L0_END = C_PER_L, PREP_L1_BEG = 0, PREP_L1_END = C_PER_L, WBR_G1 = 0, WBR_DYN = 0;
#endif
__device__ __forceinline__ void convert_one(const Ctx& c0, const int l, const int it) {
    Ctx c = c0; c.lane = hw_lane();
    LAS float* scr = (LAS float*)(c.lds + c.wave * 16384);
    {
        int r = it;
        const float* W; bf16_t* WT; int K, Nsrc, scol, drow, k0;
        if (r < CI_IN) { const int nblk = NPROJ / 32, kb = r / nblk, nb = r % nblk;
            W = inp(c, I_WIN) + (size_t)l * D * NIN; K = D; Nsrc = NIN; scol = win_src_col(32 * nb); WT = (bf16_t*)(c.ws + WS_WIN) + (size_t)l * NPROJ * D; drow = 32 * nb; k0 = 64 * kb; }
        else if ((r -= CI_IN) < 3 * CI_BR) { const int br = r / CI_BR, rr = r % CI_BR, kb = rr / 64, nb = rr % 64;
            W = (br == 0 ? inp(c, I_WBA) : br == 1 ? inp(c, I_WBB) : inp(c, I_WBC)) + (size_t)l * 1024 * D; K = 1024; Nsrc = D; scol = 32 * nb; WT = (bf16_t*)(c.ws + WS_WBR) + ((size_t)l * 3 + br) * D * 1024; drow = 32 * nb; k0 = 64 * kb; }
        else if ((r -= 3 * CI_BR) < CI_O) { const int kb = r / 64, nb = r % 64;
            W = inp(c, I_WOUT) + (size_t)l * D * D; K = D; Nsrc = D; scol = 32 * nb; WT = (bf16_t*)(c.ws + WS_WOUT) + (size_t)l * D * D; drow = 32 * nb; k0 = 64 * kb; }
        else if ((r -= CI_O) < CI_U) { const int kb = r / 256, nb = r % 256;
            W = inp(c, I_WUP) + (size_t)l * D * DFF; K = D; Nsrc = DFF; scol = 32 * nb; WT = (bf16_t*)(c.ws + WS_WUP) + (size_t)l * DFF * D; drow = 32 * nb; k0 = 64 * kb; }
        else { r -= CI_U; const int kb = r / 64, nb = r % 64;
            W = inp(c, I_WDN) + (size_t)l * DFF * D; K = DFF; Nsrc = D; scol = 32 * nb; WT = (bf16_t*)(c.ws + WS_WDN) + (size_t)l * D * DFF; drow = 32 * nb; k0 = 64 * kb; }
        int ln = c.lane; asm volatile("" : "+v"(ln));
        transpose_item(W, K, Nsrc, scol, WT, drow, k0, scr, ln);
    }
}
__device__ __forceinline__ void convert_items(const Ctx& c0, const int l, const int r0, const int r1, const int b0) {
    if (c0.bid < b0) return;
    const int gw = (c0.bid - b0) * NWAVES + c0.wave, NGW = (c0.G - b0) * NWAVES;
#pragma unroll 1
    for (int it = r0 + gw; it < r1; it += NGW) convert_one(c0, l, it);
}
__device__ __forceinline__ void phase_prep(const Ctx& c0) {
    Ctx c = c0; c.lane = hw_lane(); c.tid = c.wave * 64 + c.lane;
    const int gw = c.bid * NWAVES + c.wave, NGW = c.G * NWAVES;
    convert_items(c0, 0, 0, PREP_L0_END, 0);
    convert_items(c0, 1, PREP_L1_BEG, PREP_L1_END, 0);
    float* wsg = (float*)(c.ws + WS_WSG);
    for (int i = c.bid * NTHR + c.tid; i < 2 * NSG * D; i += c.G * NTHR) {
        const int l = i / (NSG * D), r = i % (NSG * D), j = r / D, k = r % D;
        const int col = j < 8 ? 4096 + j : 8200 + (j - 8);
        wsg[i] = inp(c, I_WIN)[((size_t)l * D + k) * NIN + col];
    }
}

template <bool GATES>
__device__ __forceinline__ void phase_norm(const Ctx& c0, const float* w, const float* wsg) {
    Ctx c = c0; c.lane = hw_lane(); c.tid = c.wave * 64 + c.lane;
    const int gw = c.bid * NWAVES + c.wave, NGW = c.G * NWAVES;
    const float* X = (const float*)(c.ws + WS_X); bf16_t* HN = (bf16_t*)(c.ws + WS_HN); float* SG = (float*)(c.ws + WS_SG);
    f32x4 wv[8];
#pragma unroll
    for (int j = 0; j < 8; ++j) wv[j] = ((const f32x4*)w)[c.lane + 64 * j];
    for (int row = gw; row < MP; row += 2 * NGW) {
        const int row1 = row + NGW; const bool two = row1 < MP;
        const f32x4* xr0 = (const f32x4*)(X + (size_t)row * D) + c.lane; const f32x4* xr1 = (const f32x4*)(X + (size_t)(two ? row1 : row) * D) + c.lane;
        f32x4 v0[8], v1[8]; float s0 = 0.f, s1 = 0.f;
#pragma unroll
        for (int j = 0; j < 8; ++j) { v0[j] = xr0[64 * j]; v1[j] = xr1[64 * j]; }
#pragma unroll
        for (int j = 0; j < 8; ++j) { s0 += (v0[j].x * v0[j].x + v0[j].y * v0[j].y) + (v0[j].z * v0[j].z + v0[j].w * v0[j].w); s1 += (v1[j].x * v1[j].x + v1[j].y * v1[j].y) + (v1[j].z * v1[j].z + v1[j].w * v1[j].w); }
        const float r0 = rsqrtf(wave_sum(s0) * (1.f / D) + 1e-6f), r1 = rsqrtf(wave_sum(s1) * (1.f / D) + 1e-6f);
        u32x2* o0 = (u32x2*)(HN + (size_t)row * D) + c.lane; u32x2* o1 = (u32x2*)(HN + (size_t)(two ? row1 : row) * D) + c.lane;
#pragma unroll
        for (int j = 0; j < 8; ++j) { v0[j] = v0[j] * r0 * wv[j]; v1[j] = v1[j] * r1 * wv[j];
            u32x2 o; o.x = pk2(v0[j].x, v0[j].y); o.y = pk2(v0[j].z, v0[j].w); o0[64 * j] = o;
            if (two) { o.x = pk2(v1[j].x, v1[j].y); o.y = pk2(v1[j].z, v1[j].w); o1[64 * j] = o; } }
        if (GATES) {
#pragma unroll 1
            for (int g0 = 0; g0 < NSG; g0 += 2) {
                f32x4 q[2][8];
#pragma unroll
                for (int gg = 0; gg < 2; ++gg)
#pragma unroll
                    for (int j = 0; j < 8; ++j) q[gg][j] = ((const f32x4*)(wsg + (size_t)(g0 + gg) * D))[c.lane + 64 * j];
#pragma unroll
                for (int gg = 0; gg < 2; ++gg) { float a0 = 0.f, a1 = 0.f;
#pragma unroll
                    for (int j = 0; j < 8; ++j) { a0 += (v0[j].x * q[gg][j].x + v0[j].y * q[gg][j].y) + (v0[j].z * q[gg][j].z + v0[j].w * q[gg][j].w);
                                                  a1 += (v1[j].x * q[gg][j].x + v1[j].y * q[gg][j].y) + (v1[j].z * q[gg][j].z + v1[j].w * q[gg][j].w); }
                    a0 = wave_sum(a0); a1 = wave_sum(a1);
                    if (c.lane == 0) { SG[(size_t)row * SGLD + g0 + gg] = a0; if (two) SG[(size_t)row1 * SGLD + g0 + gg] = a1; } }
            }
        }
    }
}
constexpr int NR1 = 5;
template <int NV>
__device__ __forceinline__ void norm_gate_group(const f32x4 (&v)[NR1][8], const LAS f32x4* gb, float* SG, const int (&rows)[NR1], int g0, int lane) {
#pragma unroll 1
    for (int g = 0; g < 4; ++g) {
        float a[NR1];
#pragma unroll
        for (int r = 0; r < NR1; ++r) a[r] = 0.f;
#pragma unroll
        for (int j = 0; j < 8; ++j) { const f32x4 q = gb[g * 512 + lane + 64 * j];
#pragma unroll
            for (int r = 0; r < NV; ++r) a[r] += (v[r][j].x * q.x + v[r][j].y * q.y) + (v[r][j].z * q.z + v[r][j].w * q.w); }
#pragma unroll
        for (int r = 0; r < NV; ++r) { const float t = wave_sum(a[r]); if (lane == 0) SG[(size_t)rows[r] * SGLD + g0 + g] = t; }
    }
}
template <bool FIRST>
__device__ __forceinline__ void phase_norm_gates(const Ctx& c0, const float* w, const float* wsg) {
    Ctx c = c0; c.lane = hw_lane(); c.tid = c.wave * 64 + c.lane;
    const int gw = c.bid * NWAVES + c.wave, NGW = c.G * NWAVES;
    const float* X = (const float*)(c.ws + WS_X); bf16_t* HN = (bf16_t*)(c.ws + WS_HN); float* SG = (float*)(c.ws + WS_SG);
    LAS f32x4* GB = (LAS f32x4*)c.lds;
    const f32x4* wsg4 = (const f32x4*)wsg;
    const float* xmeta = FIRST ? inp(c, I_META) : nullptr; const float* xprm = FIRST ? inp(c, I_XP) : nullptr; const float* xsmp = FIRST ? inp(c, I_XS) : nullptr;
#pragma unroll 1
    for (int base = 0; base < MP; base += NR1 * NGW) {
        int rows[NR1]; f32x4 v[NR1][8]; f32x4 st[4];
        int nv = 0;
#pragma unroll
        for (int r = 0; r < NR1; ++r) { const int row = base + r * NGW + gw; nv += row < MP ? 1 : 0; rows[r] = row < MP ? row : MP - 1; }
        nv = __builtin_amdgcn_readfirstlane(nv);
#pragma unroll
        for (int r = 0; r < NR1; ++r) { const f32x4* xr = (const f32x4*)(FIRST ? x0_row(xmeta, xprm, xsmp, rows[r]) : X + (size_t)rows[r] * D) + c.lane;
#pragma unroll
            for (int j = 0; j < 8; ++j) v[r][j] = xr[64 * j]; }
#pragma unroll
        for (int k = 0; k < 4; ++k) st[k] = wsg4[c.tid + 512 * k];
        float rs[NR1];
#pragma unroll
        for (int r = 0; r < NR1; ++r) { float s = 0.f;
#pragma unroll
            for (int j = 0; j < 8; ++j) s += (v[r][j].x * v[r][j].x + v[r][j].y * v[r][j].y) + (v[r][j].z * v[r][j].z + v[r][j].w * v[r][j].w);
            rs[r] = rsqrtf(wave_sum(s) * (1.f / D) + 1e-6f); }
#pragma unroll
        for (int j = 0; j < 8; ++j) { const f32x4 wj = ((const f32x4*)w)[c.lane + 64 * j];
#pragma unroll
            for (int r = 0; r < NR1; ++r) { v[r][j] = v[r][j] * rs[r] * wj;
                if (r < nv) { u32x2 p; p.x = pk2(v[r][j].x, v[r][j].y); p.y = pk2(v[r][j].z, v[r][j].w); ((u32x2*)(HN + (size_t)rows[r] * D) + c.lane)[64 * j] = p; } } }
#pragma unroll
        for (int k = 0; k < 4; ++k) GB[c.tid + 512 * k] = st[k];
        lds_barrier();
#pragma unroll 1
        for (int ch = 0; ch < NSG / 4; ++ch) {
            if (ch + 1 < NSG / 4) {
#pragma unroll
                for (int k = 0; k < 4; ++k) st[k] = wsg4[(ch + 1) * 2048 + c.tid + 512 * k]; }
            const LAS f32x4* gb = GB + (ch & 1) * 2048;
            if (NR1 >= 5 && nv == 5) norm_gate_group<(NR1 >= 5 ? 5 : 1)>(v, gb, SG, rows, 4 * ch, c.lane);
            else if (NR1 >= 4 && nv == 4) norm_gate_group<(NR1 >= 4 ? 4 : 1)>(v, gb, SG, rows, 4 * ch, c.lane);
            else if (nv == 3) norm_gate_group<3>(v, gb, SG, rows, 4 * ch, c.lane);
            else if (nv == 2) norm_gate_group<2>(v, gb, SG, rows, 4 * ch, c.lane);
            else if (nv == 1) norm_gate_group<1>(v, gb, SG, rows, 4 * ch, c.lane);
            if (ch + 1 < NSG / 4) {
#pragma unroll
                for (int k = 0; k < 4; ++k) GB[((ch + 1) & 1) * 2048 + c.tid + 512 * k] = st[k]; }
            lds_barrier();
        }
    }
}
__device__ __forceinline__ void final_rows(const Ctx& c0, const int r0, const int r1, const int gw, const int NGW) {
    Ctx c = c0; c.lane = hw_lane(); c.tid = c.wave * 64 + c.lane;
    const float* X = (const float*)(c.ws + WS_X); const float* w = inp(c, I_FNW);
    f32x4 wv[8];
#pragma unroll
    for (int j = 0; j < 8; ++j) wv[j] = ((const f32x4*)w)[c.lane + 64 * j];
    for (int row = r0 + gw; row < r1; row += NGW) {
        float* dst;
        if (row < MPROMPT) { const int b = row / TP, t = row % TP; if (t < NMETA) continue; dst = c.out + O_YP + ((size_t)b * SEQ + (t - NMETA)) * D; }
        else dst = c.out + O_YS + (size_t)(row - MPROMPT) * D;
        const f32x4* xr = (const f32x4*)(X + (size_t)row * D) + c.lane;
        f32x4 v[8]; float s = 0.f;
#pragma unroll
        for (int j = 0; j < 8; ++j) { v[j] = xr[64 * j]; s += (v[j].x * v[j].x + v[j].y * v[j].y) + (v[j].z * v[j].z + v[j].w * v[j].w); }
        const float rstd = rsqrtf(wave_sum(s) * (1.f / D) + 1e-6f);
#pragma unroll
        for (int j = 0; j < 8; ++j) ((f32x4*)dst)[c.lane + 64 * j] = v[j] * rstd * wv[j];
    }
}
#ifndef FIN_IN_TAIL
#define FIN_IN_TAIL 1
#endif
__device__ __forceinline__ void phase_final(const Ctx& c0) {
    const bool tail_did = FIN_IN_TAIL && c0.G == 256;
    final_rows(c0, tail_did ? 8192 : 0, MREAL, c0.bid * NWAVES + c0.wave, c0.G * NWAVES);
}

__device__ __forceinline__ void mlstm_unit(const Ctx& c0, int l, int seq, int h) {
    Ctx c = c0; c.lane = hw_lane(); c.tid = c.wave * 64 + c.lane;
    const int tid = c.tid, v = tid & 255, kh = c.wave >> 2;
    const bool prompt = seq < BATCH; const int T = prompt ? TP : 1; const int row0 = prompt ? seq * TP : MPROMPT + (seq - BATCH);
    const bf16_t* PROJ = (const bf16_t*)(c.ws + WS_PROJ); const float* SG = (const float*)(c.ws + WS_SG); bf16_t* YBR = (bf16_t*)(c.ws + WS_YBR);
    LAS float* sm = (LAS float*)c.lds; LAS float* qs = sm, *ks = sm + 256, *vs = sm + 512, *red = sm + 768, *misc = sm + 1280, *sc = sm + 1296;
    float C[128]; float nreg = 0.f, m = 0.f;
    float *oc, *on, *om;
    if (prompt) { oc = c.out + O_PC + (((size_t)l * BATCH + seq) * HA + h) * DHA * DHA; on = c.out + O_PN + (((size_t)l * BATCH + seq) * HA + h) * DHA; om = c.out + O_PM + ((size_t)l * BATCH + seq) * HA + h;
#pragma unroll
        for (int j = 0; j < 128; ++j) C[j] = 0.f;
    } else { const int s = seq - BATCH; const size_t u = ((size_t)l * NB + s) * HA + h;
        oc = c.out + O_SC + u * DHA * DHA; on = c.out + O_SN + u * DHA; om = c.out + O_SM + u;
        const float* ci = inp(c, I_SC) + u * DHA * DHA;
        { const float* cp = ci + ((size_t)(kh * 128) * 256 + v);
#pragma unroll
          for (int jj = 0; jj < 32; ++jj) { asm volatile("" : "+v"(cp)); C[4 * jj] = cp[0]; C[4 * jj + 1] = cp[256]; C[4 * jj + 2] = cp[512]; C[4 * jj + 3] = cp[768]; cp += 1024; } }
        if (tid < 256) nreg = inp(c, I_SN)[u * DHA + tid];
        m = inp(c, I_SM)[u];
    }
    const float bi = inp(c, I_BI)[l * HA + h], bfv = inp(c, I_BF)[l * HA + h];
    const float nw = tid < 256 ? inp(c, I_MNW)[l * 1024 + h * 256 + tid] : 0.f;
    for (int t = 0; t < T; ++t) {
        const size_t row = (size_t)(row0 + t); const bf16_t* prow = PROJ + row * NPROJ;
        if (tid < 256) { qs[tid] = bf2f(prow[PA_Q + h * 256 + tid]); ks[tid] = bf2f(prow[PA_K + h * 256 + tid]) * 0.0625f; vs[tid] = bf2f(prow[PA_V + h * 256 + tid]); }
        if (tid == 0) { misc[0] = SG[row * SGLD + h] + bi; misc[1] = -softplusf_(-(SG[row * SGLD + 4 + h] + bfv)); }
        lds_barrier();
        const float gi = misc[0], gf = misc[1];
        const float mn = fmaxf(gf + m, gi), fw = __expf(gf + m - mn), iw = __expf(gi - mn); m = mn;
        const float vv = vs[v] * iw; float acc = 0.f;
#pragma unroll
        for (int jj = 0; jj < 16; ++jj) {
            const f32x4 k0 = *(const LAS f32x4*)(ks + kh * 128 + jj * 8), k1 = *(const LAS f32x4*)(ks + kh * 128 + jj * 8 + 4);
            const f32x4 q0 = *(const LAS f32x4*)(qs + kh * 128 + jj * 8), q1 = *(const LAS f32x4*)(qs + kh * 128 + jj * 8 + 4);
#pragma unroll
            for (int e = 0; e < 4; ++e) { C[jj * 8 + e] = fw * C[jj * 8 + e] + k0[e] * vv; acc += q0[e] * C[jj * 8 + e];
                                          C[jj * 8 + 4 + e] = fw * C[jj * 8 + 4 + e] + k1[e] * vv; acc += q1[e] * C[jj * 8 + 4 + e]; }
            asm volatile("" ::: "memory");
        }
        red[tid] = acc;
        float dpart = 0.f;
        if (tid < 256) { nreg = fw * nreg + iw * ks[tid]; dpart = qs[tid] * nreg; }
        const float den = block_sum(dpart, sc, c.wave);
        float hh = 0.f;
        if (tid < 256) hh = (red[tid] + red[256 + tid]) / fmaxf(fabsf(den), __expf(-m));
        const float ss = block_sum(hh * hh, sc, c.wave);
        if (tid < 256) { const float y = hh * rsqrtf(ss * (1.f / 256.f) + 1e-6f) * nw; const float o = bf2f(prow[PA_O + h * 256 + tid]);
            YBR[row * YLD + h * 256 + tid] = (bf16_t)f2bf(sigmoidf_(o) * y); }
        lds_barrier();
    }
    { float* op = oc + ((size_t)(kh * 128) * 256 + v);
#pragma unroll
      for (int jj = 0; jj < 32; ++jj) { asm volatile("" : "+v"(op)); op[0] = C[4 * jj]; op[256] = C[4 * jj + 1]; op[512] = C[4 * jj + 2]; op[768] = C[4 * jj + 3]; op += 1024; } }
    if (tid < 256) on[tid] = nreg;
    if (tid == 0) *om = m;
    lds_barrier();
}

__device__ __forceinline__ void mlstm_unit_s(const Ctx& c0, int l, int s, int h) {
    Ctx c = c0; c.lane = hw_lane(); c.tid = c.wave * 64 + c.lane;
    const int tid = c.tid, vq = c.lane, kg = c.wave;
    const size_t row = (size_t)(MPROMPT + s);
    const bf16_t* PROJ = (const bf16_t*)(c.ws + WS_PROJ); const float* SG = (const float*)(c.ws + WS_SG); bf16_t* YBR = (bf16_t*)(c.ws + WS_YBR);
    LAS float* sm = (LAS float*)c.lds; LAS float* qs = sm, *ks = sm + 256, *vs = sm + 512, *red = sm + 768  , *misc = sm + 2816, *sc = sm + 2832;
    const size_t u = ((size_t)l * NB + s) * HA + h;
    const f32x4* ci = (const f32x4*)(inp(c, I_SC) + u * DHA * DHA) + (size_t)(kg * 32) * 64 + vq;
    f32x4* oc = (f32x4*)(c.out + O_SC + u * DHA * DHA) + (size_t)(kg * 32) * 64 + vq;
    f32x4 C[32];
#pragma unroll
    for (int j = 0; j < 32; ++j) C[j] = ci[j * 64];
    float nreg = 0.f;
    if (tid < 256) nreg = inp(c, I_SN)[u * DHA + tid];
    float m = inp(c, I_SM)[u];
    const float bi = inp(c, I_BI)[l * HA + h], bfv = inp(c, I_BF)[l * HA + h];
    const float nw = tid < 256 ? inp(c, I_MNW)[l * 1024 + h * 256 + tid] : 0.f;
    const bf16_t* prow = PROJ + row * NPROJ;
    if (tid < 256) { qs[tid] = bf2f(prow[PA_Q + h * 256 + tid]); ks[tid] = bf2f(prow[PA_K + h * 256 + tid]) * 0.0625f; vs[tid] = bf2f(prow[PA_V + h * 256 + tid]); }
    if (tid == 0) { misc[0] = SG[row * SGLD + h] + bi; misc[1] = -softplusf_(-(SG[row * SGLD + 4 + h] + bfv)); }
    lds_barrier();
    const float gi = misc[0], gf = misc[1];
    const float mn = fmaxf(gf + m, gi), fw = __expf(gf + m - mn), iw = __expf(gi - mn); m = mn;
    const f32x4 vv = *(const LAS f32x4*)(vs + 4 * vq) * iw;
    f32x4 acc = (f32x4){0.f, 0.f, 0.f, 0.f};
#pragma unroll
    for (int jj = 0; jj < 8; ++jj) {
        const f32x4 k4 = *(const LAS f32x4*)(ks + kg * 32 + jj * 4), q4 = *(const LAS f32x4*)(qs + kg * 32 + jj * 4);
#pragma unroll
        for (int e = 0; e < 4; ++e) { C[jj * 4 + e] = C[jj * 4 + e] * fw + vv * k4[e]; acc += C[jj * 4 + e] * q4[e]; }
    }
#pragma unroll
    for (int j = 0; j < 32; ++j) oc[j * 64] = C[j];
    *(LAS f32x4*)(red + kg * 256 + 4 * vq) = acc;
    float dpart = 0.f;
    if (tid < 256) { nreg = fw * nreg + iw * ks[tid]; dpart = qs[tid] * nreg; }
    const float den = block_sum(dpart, sc, c.wave);
    float hh = 0.f;
    if (tid < 256) { float num = 0.f;
#pragma unroll
        for (int g = 0; g < 8; ++g) num += red[g * 256 + tid];
        hh = num / fmaxf(fabsf(den), __expf(-m)); }
    const float ss = block_sum(hh * hh, sc, c.wave);
    if (tid < 256) { const float y = hh * rsqrtf(ss * (1.f / 256.f) + 1e-6f) * nw; const float o = bf2f(prow[PA_O + h * 256 + tid]);
        YBR[row * YLD + h * 256 + tid] = (bf16_t)f2bf(sigmoidf_(o) * y);
        (c.out + O_SN + u * DHA)[tid] = nreg; }
    if (tid == 0) (c.out + O_SM)[u] = m;
    lds_barrier();
}

__device__ __forceinline__ void gdn_unit(const Ctx& c0, int l, int seq, int h) {
    Ctx c = c0; c.lane = hw_lane(); c.tid = c.wave * 64 + c.lane;
    const int tid = c.tid, v = tid & 127, kq = tid >> 7;
    const bool prompt = seq < BATCH; const int T = prompt ? TP : 1; const int row0 = prompt ? seq * TP : MPROMPT + (seq - BATCH);
    const bf16_t* PROJ = (const bf16_t*)(c.ws + WS_PROJ); const float* SG = (const float*)(c.ws + WS_SG); bf16_t* YBR = (bf16_t*)(c.ws + WS_YBR);
    LAS float* sm = (LAS float*)c.lds; LAS float* ring = sm  , *qk = sm + 1536  , *red = sm + 1920  , *part = sm + 2432  , *sc = sm + 2448;
    float S[32];
    float *os, *ocv; const float* cin = nullptr;
    const int cg = tid < 384 ? (tid >> 7) * 1024 + h * 128 + (tid & 127) : 0;
    if (prompt) { os = c.out + O_PGS + (((size_t)l * BATCH + seq) * HB + h) * DHB * DHB; ocv = c.out + O_PGC + ((size_t)l * BATCH + seq) * 3 * 3072;
#pragma unroll
        for (int j = 0; j < 32; ++j) S[j] = 0.f;
    } else { const int s = seq - BATCH; const size_t u = ((size_t)l * NB + s) * HB + h;
        os = c.out + O_SGS + u * DHB * DHB; ocv = c.out + O_SGC + ((size_t)l * NB + s) * 3 * 3072;
        const float* si = inp(c, I_SGS) + u * DHB * DHB;
#pragma unroll
        for (int j = 0; j < 32; ++j) S[j] = si[(size_t)(kq * 32 + j) * 128 + v];
        cin = inp(c, I_SGC) + ((size_t)l * NB + s) * 3 * 3072;
    }
    float cw0 = 0.f, cw1 = 0.f, cw2 = 0.f, cw3 = 0.f;
    if (tid < 384) { const float* cw = inp(c, I_CONVW) + (size_t)l * 4 * 3072; cw0 = cw[cg]; cw1 = cw[3072 + cg]; cw2 = cw[2 * 3072 + cg]; cw3 = cw[3 * 3072 + cg];
        ring[3 * 384 + tid] = cin ? cin[2 * 3072 + cg] : 0.f; ring[2 * 384 + tid] = cin ? cin[3072 + cg] : 0.f; ring[1 * 384 + tid] = cin ? cin[cg] : 0.f; ring[tid] = 0.f; }
    const float alog = inp(c, I_ALOG)[l * HB + h], dtb = inp(c, I_DTB)[l * HB + h];
    const float gnw = tid < 128 ? inp(c, I_GNW)[l * DHB + tid] : 0.f;
    lds_barrier();
    for (int t = 0; t < T; ++t) {
        const size_t row = (size_t)(row0 + t); const bf16_t* prow = PROJ + row * NPROJ;
        float y = 0.f;
        if (tid < 384) { const float u = bf2f(prow[PB_QKV + cg]); ring[(t & 3) * 384 + tid] = u;
            y = cw3 * u + cw2 * ring[((t - 1) & 3) * 384 + tid] + cw1 * ring[((t - 2) & 3) * 384 + tid] + cw0 * ring[((t - 3) & 3) * 384 + tid];
            y = siluf_(y); qk[tid] = y; }
        { const float s2 = wave_sum(y * y); if (c.lane == 0) part[c.wave] = s2; }
        lds_barrier();
        const float qn = rsqrtf(part[0] + part[1] + 1e-12f) * 0.08838834764831845f, kn = rsqrtf(part[2] + part[3] + 1e-12f);
        const float ga = SG[row * SGLD + 8 + h], gb = SG[row * SGLD + 16 + h];
        const float alpha = __expf(-__expf(alog) * softplusf_(ga + dtb)), beta = sigmoidf_(gb);
        float p = 0.f;
#pragma unroll
        for (int j = 0; j < 32; ++j) p += qk[128 + kq * 32 + j] * S[j];
        red[tid] = p * kn;
        lds_barrier();
        const float kS = red[v] + red[128 + v] + red[256 + v] + red[384 + v];
        const float vn = beta * (qk[256 + v] - alpha * kS);
        float o = 0.f;
#pragma unroll
        for (int j = 0; j < 32; ++j) { S[j] = alpha * S[j] + (qk[128 + kq * 32 + j] * kn) * vn; o += qk[kq * 32 + j] * S[j]; }
        lds_barrier();
        red[tid] = o * qn;
        lds_barrier();
        float oo = 0.f;
        if (tid < 128) oo = red[tid] + red[128 + tid] + red[256 + tid] + red[384 + tid];
        const float ss = block_sum(oo * oo, sc, c.wave);
        if (tid < 128) { const float z = bf2f(prow[PB_Z + h * 128 + tid]);
            YBR[row * YLD + 1024 + h * 128 + tid] = (bf16_t)f2bf(oo * rsqrtf(ss * (1.f / 128.f) + 1e-6f) * gnw * siluf_(z)); }
        lds_barrier();
    }
#pragma unroll
    for (int j = 0; j < 32; ++j) os[(size_t)(kq * 32 + j) * 128 + v] = S[j];
    if (tid < 384) {
#pragma unroll
        for (int j = 0; j < 3; ++j) ocv[j * 3072 + cg] = ring[((T - 3 + j) & 3) * 384 + tid];
    }
    lds_barrier();
}

__device__ __forceinline__ void gdn_unit_s(const Ctx& c0, int l, int s, int h) {
    Ctx c = c0; c.lane = hw_lane(); c.tid = c.wave * 64 + c.lane;
    const int tid = c.tid, vq = tid & 31, kg = tid >> 5;
    const size_t row = (size_t)(MPROMPT + s);
    const bf16_t* PROJ = (const bf16_t*)(c.ws + WS_PROJ); const float* SG = (const float*)(c.ws + WS_SG); bf16_t* YBR = (bf16_t*)(c.ws + WS_YBR);
    LAS float* sm = (LAS float*)c.lds; LAS float* qk = sm  , *red = sm + 384  , *red2 = sm + 2432  , *part = sm + 4480  , *sc = sm + 4496;
    const size_t u = ((size_t)l * NB + s) * HB + h;
    const f32x4* si = (const f32x4*)(inp(c, I_SGS) + u * DHB * DHB) + (size_t)(kg * 8) * 32 + vq;
    f32x4* os = (f32x4*)(c.out + O_SGS + u * DHB * DHB) + (size_t)(kg * 8) * 32 + vq;
    f32x4 S[8];
#pragma unroll
    for (int j = 0; j < 8; ++j) S[j] = si[j * 32];
    const bf16_t* prow = PROJ + row * NPROJ;
    float y = 0.f;
    if (tid < 384) { const int cg = (tid >> 7) * 1024 + h * 128 + (tid & 127);
        const float* cw = inp(c, I_CONVW) + (size_t)l * 4 * 3072; const float* cin = inp(c, I_SGC) + ((size_t)l * NB + s) * 3 * 3072; float* ocv = c.out + O_SGC + ((size_t)l * NB + s) * 3 * 3072;
        const float cw0 = cw[cg], cw1 = cw[3072 + cg], cw2 = cw[2 * 3072 + cg], cw3 = cw[3 * 3072 + cg];
        const float p0 = cin[cg], p1 = cin[3072 + cg], p2 = cin[2 * 3072 + cg]; const float uu = bf2f(prow[PB_QKV + cg]);
        y = siluf_(cw3 * uu + cw2 * p2 + cw1 * p1 + cw0 * p0); qk[tid] = y;
        ocv[cg] = p1; ocv[3072 + cg] = p2; ocv[2 * 3072 + cg] = uu; }
    { const float s2 = wave_sum(y * y); if (c.lane == 0) part[c.wave] = s2; }
    const float alog = inp(c, I_ALOG)[l * HB + h], dtb = inp(c, I_DTB)[l * HB + h];
    const float ga = SG[row * SGLD + 8 + h], gb = SG[row * SGLD + 16 + h];
    const float gnw = tid < 128 ? inp(c, I_GNW)[l * DHB + tid] : 0.f;
    const float z = tid < 128 ? bf2f(prow[PB_Z + h * 128 + tid]) : 0.f;
    lds_barrier();
    const float qn = rsqrtf(part[0] + part[1] + 1e-12f) * 0.08838834764831845f, kn = rsqrtf(part[2] + part[3] + 1e-12f);
    const float alpha = __expf(-__expf(alog) * softplusf_(ga + dtb)), beta = sigmoidf_(gb);
    const f32x4 ka = *(const LAS f32x4*)(qk + 128 + kg * 8), kb = *(const LAS f32x4*)(qk + 128 + kg * 8 + 4);
    const f32x4 qa = *(const LAS f32x4*)(qk + kg * 8), qb = *(const LAS f32x4*)(qk + kg * 8 + 4);
    { f32x4 p = S[0] * ka[0];
#pragma unroll
      for (int j = 1; j < 8; ++j) p += S[j] * (j < 4 ? ka[j] : kb[j - 4]);
      *(LAS f32x4*)(red + kg * 128 + 4 * vq) = p; }
    lds_barrier();
    f32x4 kS = *(const LAS f32x4*)(red + 4 * vq);
#pragma unroll
    for (int g = 1; g < 16; ++g) kS += *(const LAS f32x4*)(red + g * 128 + 4 * vq);
    const f32x4 vn = (*(const LAS f32x4*)(qk + 256 + 4 * vq) - kS * (alpha * kn)) * beta;
    { f32x4 o = (f32x4){0.f, 0.f, 0.f, 0.f};
#pragma unroll
      for (int j = 0; j < 8; ++j) { const float kj = (j < 4 ? ka[j] : kb[j - 4]) * kn, qj = j < 4 ? qa[j] : qb[j - 4]; S[j] = S[j] * alpha + vn * kj; o += S[j] * qj; }
#pragma unroll
      for (int j = 0; j < 8; ++j) os[j * 32] = S[j];
      *(LAS f32x4*)(red2 + kg * 128 + 4 * vq) = o; }
    lds_barrier();
    float oo = 0.f;
    if (tid < 128) {
#pragma unroll
        for (int g = 0; g < 16; ++g) oo += red2[g * 128 + tid];
        oo *= qn; }
    const float ss = block_sum(oo * oo, sc, c.wave);
    if (tid < 128) YBR[row * YLD + 1024 + h * 128 + tid] = (bf16_t)f2bf(oo * rsqrtf(ss * (1.f / 128.f) + 1e-6f) * gnw * siluf_(z));
    lds_barrier();
}

__device__ __forceinline__ void rwkv_unit(const Ctx& c0, int l, int seq, int h, int& cached_h) {
    Ctx c = c0; c.lane = hw_lane(); c.tid = c.wave * 64 + c.lane;
    const int tid = c.tid, k = tid & 63, vq = tid >> 6;
    const bool prompt = seq < BATCH; const int T = prompt ? TP : 1; const int row0 = prompt ? seq * TP : MPROMPT + (seq - BATCH);
    const bf16_t* PROJ = (const bf16_t*)(c.ws + WS_PROJ); bf16_t* YBR = (bf16_t*)(c.ws + WS_YBR);
    LAS float* sm = (LAS float*)c.lds;
    LAS float* w2s = sm, *a2s = sm + 4096, *g2s = sm + 8192  , *xs = sm + 16384  , *partl = sm + 16896  ;
    LAS float* dec = sm + 17408, *k2s = dec + 64, *avs = dec + 128, *bvs = dec + 192, *rrs = dec + 256, *vvs = dec + 320, *ggs = dec + 384, *ys = dec + 448, *misc = dec + 512;
    float S[8];
    float *os, *osh; const float* shin = nullptr;
    if (prompt) { os = c.out + O_PRS + (((size_t)l * BATCH + seq) * HC + h) * DHC * DHC; osh = c.out + O_PRSH + ((size_t)l * BATCH + seq) * NCC;
#pragma unroll
        for (int j = 0; j < 8; ++j) S[j] = 0.f;
    } else { const int s = seq - BATCH; const size_t u = ((size_t)l * NB + s) * HC + h;
        os = c.out + O_SRS + u * DHC * DHC; osh = c.out + O_SRSH + ((size_t)l * NB + s) * NCC;
        const float* si = inp(c, I_SRS) + u * DHC * DHC;
#pragma unroll
        for (int j = 0; j < 8; ++j) S[j] = si[(size_t)(vq * 8 + j) * 64 + k];
        shin = inp(c, I_SRSH) + ((size_t)l * NB + s) * NCC;
    }
    if (cached_h != h) { cached_h = h; const float* w2p = inp(c, I_W2) + (size_t)l * 64 * 1024 + h * 64; const float* a2p = inp(c, I_A2) + (size_t)l * 64 * 1024 + h * 64; const float* g2p = inp(c, I_G2) + (size_t)l * 128 * 1024 + h * 64;
      float lw2[8], la2[8], lg2[16];
#pragma unroll
      for (int k = 0; k < 8; ++k) { const int i = tid + k * NTHR; lw2[k] = w2p[(i >> 6) * 1024 + (i & 63)]; la2[k] = a2p[(i >> 6) * 1024 + (i & 63)]; }
#pragma unroll
      for (int k = 0; k < 16; ++k) { const int i = tid + k * NTHR; lg2[k] = g2p[(i >> 6) * 1024 + (i & 63)]; }
#pragma unroll
      for (int k = 0; k < 8; ++k) { const int i = tid + k * NTHR; w2s[i] = lw2[k]; a2s[i] = la2[k]; }
#pragma unroll
      for (int k = 0; k < 16; ++k) { const int i = tid + k * NTHR; g2s[i] = lg2[k]; } }
    int cidx = 0;
    if (tid < 64) cidx = h * 64 + tid; else if (tid < 128) cidx = 1024 + h * 64 + (tid - 64); else if (tid < 192) cidx = 2048 + h * 64 + (tid - 128); else if (tid < 448) cidx = 3072 + (tid - 192);
    float prev = 0.f, mu = 0.f;
    if (tid < 448) { prev = shin ? shin[cidx] : 0.f; mu = inp(c, I_MU)[(size_t)l * NCC + cidx]; }
    const int C = h * 64 + (tid & 63);
    float w0 = 0.f, a0 = 0.f, kkw = 0.f, kaw = 0.f, rkw = 0.f, lnw = 0.f, lnb = 0.f;
    if (tid < 64) { w0 = inp(c, I_W0)[l * 1024 + C]; a0 = inp(c, I_A0)[l * 1024 + C]; kkw = inp(c, I_KK)[l * 1024 + C]; kaw = inp(c, I_KA)[l * 1024 + C]; rkw = inp(c, I_RK)[l * 1024 + C];
        lnw = inp(c, I_LNW)[l * 1024 + C]; lnb = inp(c, I_LNB)[l * 1024 + C]; }
    lds_barrier();
    for (int t = 0; t < T; ++t) {
        const size_t row = (size_t)(row0 + t); const bf16_t* prow = PROJ + row * NPROJ;
        if (tid < 448) { const float cur = bf2f(prow[PC0 + cidx]); float xm = cur + (prev - cur) * mu; prev = cur;
            if (tid >= 192 && tid < 256) xm = ftanh(xm); else if (tid >= 320) xm = sigmoidf_(xm);
            xs[tid] = xm; }
        lds_barrier();
        { const int cc = tid & 63, pt = tid >> 6; float a = 0.f;
            if (pt < 2) { for (int j = 0; j < 32; ++j) a += xs[192 + pt * 32 + j] * w2s[(pt * 32 + j) * 64 + cc]; }
            else if (pt < 4) { for (int j = 0; j < 32; ++j) a += xs[256 + (pt - 2) * 32 + j] * a2s[((pt - 2) * 32 + j) * 64 + cc]; }
            else { for (int j = 0; j < 32; ++j) a += xs[320 + (pt - 4) * 32 + j] * g2s[((pt - 4) * 32 + j) * 64 + cc]; }
            partl[pt * 64 + cc] = a; }
        lds_barrier();
        if (tid < 64) {
            const float wl = w0 + partl[tid] + partl[64 + tid]; const float wlog = -softplusf_(-wl) - 0.5f; const float dc = __expf(-__expf(wlog));
            const float aa = sigmoidf_(a0 + partl[128 + tid] + partl[192 + tid]);
            const float gg = (partl[256 + tid] + partl[320 + tid]) + (partl[384 + tid] + partl[448 + tid]);
            const float kraw = xs[64 + tid], kkv = kraw * kkw; const float nrm = wave_sum(kkv * kkv); const float kk = kkv * rsqrtf(nrm + 1e-12f);
            const float k2 = kraw * (1.f + (aa - 1.f) * kaw);
            dec[tid] = dc; k2s[tid] = k2; avs[tid] = -kk; bvs[tid] = kk * aa; rrs[tid] = xs[tid]; vvs[tid] = xs[128 + tid]; ggs[tid] = gg;
            const float bs = wave_sum(xs[tid] * k2 * rkw); if (tid == 0) misc[0] = bs;
        }
        lds_barrier();
        { const float av = avs[k], bv = bvs[k], dk = dec[k], kk2 = k2s[k], rr = rrs[k];
#pragma unroll
            for (int j = 0; j < 8; ++j) { const int vi = vq * 8 + j; const float sa = wave_sum(S[j] * av); S[j] = S[j] * dk + sa * bv + vvs[vi] * kk2; const float yy = wave_sum(S[j] * rr); if (k == 0) ys[vi] = yy; } }
        lds_barrier();
        if (tid < 64) { const float y = ys[tid]; const float mean = wave_sum(y) * (1.f / 64.f); const float d = y - mean; const float var = wave_sum(d * d) * (1.f / 64.f);
            const float yn = d * rsqrtf(var + 64e-5f) * lnw + lnb; const float o = (yn + misc[0] * vvs[tid]) * ggs[tid];
            YBR[row * YLD + 2048 + h * 64 + tid] = (bf16_t)f2bf(o); }
        lds_barrier();
    }
#pragma unroll
    for (int j = 0; j < 8; ++j) os[(size_t)(vq * 8 + j) * 64 + k] = S[j];
    if (tid < 192 || (h == 0 && tid < 448)) osh[cidx] = prev;
    lds_barrier();
}


__device__ __forceinline__ void rwkv_unit4(const Ctx& c0, int l, int s0, int h, int& cached_h) {
    Ctx c = c0; c.lane = hw_lane(); c.tid = c.wave * 64 + c.lane;
    const int tid = c.tid, k = tid & 63, vq = tid >> 6;
    const bf16_t* PROJ = (const bf16_t*)(c.ws + WS_PROJ); bf16_t* YBR = (bf16_t*)(c.ws + WS_YBR);
    LAS float* sm = (LAS float*)c.lds;
    LAS float* W = sm  , *xs = sm + 16384  , *partl = sm + 18176  , *vec = sm + 20224  , *misc = sm + 22272  ;
    const size_t u0 = ((size_t)l * NB + s0) * HC + h;
    float S[4][8];
    { const float* si = inp(c, I_SRS) + u0 * DHC * DHC;
#pragma unroll
      for (int q = 0; q < 4; ++q)
#pragma unroll
        for (int j = 0; j < 8; ++j) S[q][j] = si[(size_t)q * HC * DHC * DHC + (size_t)(vq * 8 + j) * 64 + k]; }
    if (cached_h != h) { cached_h = h; const float* w2p = inp(c, I_W2) + (size_t)l * 64 * 1024 + h * 64; const float* a2p = inp(c, I_A2) + (size_t)l * 64 * 1024 + h * 64; const float* g2p = inp(c, I_G2) + (size_t)l * 128 * 1024 + h * 64;
      float lw2[8], la2[8], lg2[16];
#pragma unroll
      for (int kk = 0; kk < 8; ++kk) { const int i = tid + kk * NTHR; lw2[kk] = w2p[(i >> 6) * 1024 + (i & 63)]; la2[kk] = a2p[(i >> 6) * 1024 + (i & 63)]; }
#pragma unroll
      for (int kk = 0; kk < 16; ++kk) { const int i = tid + kk * NTHR; lg2[kk] = g2p[(i >> 6) * 1024 + (i & 63)]; }
#pragma unroll
      for (int kk = 0; kk < 8; ++kk) { const int i = tid + kk * NTHR; W[i] = lw2[kk]; W[4096 + i] = la2[kk]; }
#pragma unroll
      for (int kk = 0; kk < 16; ++kk) { const int i = tid + kk * NTHR; W[8192 + i] = lg2[kk]; } }
    int cidx = 0;
    if (tid < 64) cidx = h * 64 + tid; else if (tid < 128) cidx = 1024 + h * 64 + (tid - 64); else if (tid < 192) cidx = 2048 + h * 64 + (tid - 128); else if (tid < 448) cidx = 3072 + (tid - 192);
    const int C = h * 64 + k;
    float w0 = 0.f, a0 = 0.f, kkw = 0.f, kaw = 0.f, rkw = 0.f, lnw = 0.f, lnb = 0.f;
    if (tid < 256) { w0 = inp(c, I_W0)[l * 1024 + C]; a0 = inp(c, I_A0)[l * 1024 + C]; kkw = inp(c, I_KK)[l * 1024 + C]; kaw = inp(c, I_KA)[l * 1024 + C]; rkw = inp(c, I_RK)[l * 1024 + C];
        lnw = inp(c, I_LNW)[l * 1024 + C]; lnb = inp(c, I_LNB)[l * 1024 + C]; }
    if (tid < 448) { const float mu = inp(c, I_MU)[(size_t)l * NCC + cidx]; const float* shin = inp(c, I_SRSH) + ((size_t)l * NB + s0) * NCC + cidx; float* osh = c.out + O_SRSH + ((size_t)l * NB + s0) * NCC + cidx;
        float prev[4], cur[4];
#pragma unroll
        for (int q = 0; q < 4; ++q) { prev[q] = shin[(size_t)q * NCC]; cur[q] = bf2f(PROJ[(size_t)(MPROMPT + s0 + q) * NPROJ + PC0 + cidx]); }
#pragma unroll
        for (int q = 0; q < 4; ++q) { float xm = cur[q] + (prev[q] - cur[q]) * mu;
            if (tid >= 192 && tid < 256) xm = ftanh(xm); else if (tid >= 320) xm = sigmoidf_(xm);
            xs[q * 448 + tid] = xm;
            if (tid < 192 || h == 0) osh[(size_t)q * NCC] = cur[q]; } }
    lds_barrier();
    { const int pt = vq; float a[4] = {0.f, 0.f, 0.f, 0.f};
        const LAS float* wp = W + (pt * 32) * 64 + k; const LAS float* xp = xs + 192 + pt * 32;
#pragma unroll 8
        for (int j = 0; j < 32; ++j) { const float wv = wp[j * 64];
#pragma unroll
            for (int q = 0; q < 4; ++q) a[q] += xp[q * 448 + j] * wv; }
#pragma unroll
        for (int q = 0; q < 4; ++q) partl[q * 512 + pt * 64 + k] = a[q]; }
    lds_barrier();
    if (tid < 256) { const int q = vq; const LAS float* pl = partl + q * 512; const LAS float* x = xs + q * 448; LAS float* vv = vec + q * 512;
        const float wl = w0 + pl[k] + pl[64 + k]; const float wlog = -softplusf_(-wl) - 0.5f; const float dc = __expf(-__expf(wlog));
        const float aa = sigmoidf_(a0 + pl[128 + k] + pl[192 + k]);
        const float gg = (pl[256 + k] + pl[320 + k]) + (pl[384 + k] + pl[448 + k]);
        const float kraw = x[64 + k], kkv = kraw * kkw; const float nrm = wave_sum(kkv * kkv); const float kk = kkv * rsqrtf(nrm + 1e-12f);
        const float k2 = kraw * (1.f + (aa - 1.f) * kaw);
        vv[k] = dc; vv[64 + k] = k2; vv[128 + k] = -kk; vv[192 + k] = kk * aa; vv[256 + k] = x[k]; vv[320 + k] = x[128 + k]; vv[384 + k] = gg;
        const float bs = wave_sum(x[k] * k2 * rkw); if (k == 0) misc[q] = bs; }
    lds_barrier();
#pragma unroll
    for (int q = 0; q < 4; ++q) { const LAS float* vv = vec + q * 512; const float dk = vv[k], kk2 = vv[64 + k], av = vv[128 + k], bv = vv[192 + k], rr = vv[256 + k];
#pragma unroll
        for (int j = 0; j < 8; ++j) { const int vi = vq * 8 + j; const float sa = wave_sum(S[q][j] * av); S[q][j] = S[q][j] * dk + sa * bv + vv[320 + vi] * kk2; const float yy = wave_sum(S[q][j] * rr); if (k == 0) vec[q * 512 + 448 + vi] = yy; } }
    lds_barrier();
    if (tid < 256) { const int q = vq; const LAS float* vv = vec + q * 512; const float y = vv[448 + k]; const float mean = wave_sum(y) * (1.f / 64.f); const float d = y - mean; const float var = wave_sum(d * d) * (1.f / 64.f);
        const float yn = d * rsqrtf(var + 64e-5f) * lnw + lnb; const float o = (yn + misc[q] * vv[320 + k]) * vv[384 + k];
        YBR[(size_t)(MPROMPT + s0 + q) * YLD + 2048 + h * 64 + k] = (bf16_t)f2bf(o); }
    { float* os = c.out + O_SRS + u0 * DHC * DHC;
#pragma unroll
      for (int q = 0; q < 4; ++q)
#pragma unroll
        for (int j = 0; j < 8; ++j) os[(size_t)q * HC * DHC * DHC + (size_t)(vq * 8 + j) * 64 + k] = S[q][j]; }
    lds_barrier();
}

__device__ __forceinline__ f32x4 mfma16(bf16x8 a, bf16x8 b, f32x4 c) { return __builtin_amdgcn_mfma_f32_16x16x32_bf16(a, b, c, 0, 0, 0); }
__device__ __forceinline__ bf16x8 ldfrag(const LAS bf16_t* X, int ld, int r0, int k0, int lane) { return *(const LAS bf16x8*)(X + (r0 + (lane & 15)) * ld + k0 + ((lane >> 4) << 3)); }
template <int MT, int NT, int KS>
__device__ __forceinline__ void mma_lds(f32x4 (&acc)[MT][NT], const LAS bf16_t* A, int lda, int m0, const LAS bf16_t* Bt, int ldb, int n0, int lane) {
#pragma unroll
    for (int ks = 0; ks < KS; ++ks) {
        bf16x8 a[MT], b[NT];
#pragma unroll
        for (int i = 0; i < MT; ++i) a[i] = ldfrag(A, lda, m0 + 16 * i, 32 * ks, lane);
#pragma unroll
        for (int j = 0; j < NT; ++j) b[j] = ldfrag(Bt, ldb, n0 + 16 * j, 32 * ks, lane);
#pragma unroll
        for (int i = 0; i < MT; ++i)
#pragma unroll
            for (int j = 0; j < NT; ++j) acc[i][j] = mfma16(a[i], b[j], acc[i][j]);
    }
}
__device__ __forceinline__ float wave_incl_sum(float x, int lane) { (void)lane; return wave_scan_sum(x); }
__device__ __forceinline__ float wave_incl_max(float x, int lane) { (void)lane; const float NI = -__builtin_huge_valf();
    x = fmaxf(x, dpp_mov<0x111, 0xf>(NI, x)); x = fmaxf(x, dpp_mov<0x112, 0xf>(NI, x)); x = fmaxf(x, dpp_mov<0x114, 0xf>(NI, x)); x = fmaxf(x, dpp_mov<0x118, 0xf>(NI, x));
    x = fmaxf(x, dpp_mov<0x142, 0xa>(NI, x)); x = fmaxf(x, dpp_mov<0x143, 0xc>(NI, x));
    return x;
}
__device__ __forceinline__ void chunk_range(int c, int& t0, int& Lv) { if (c == 0) { t0 = 0; Lv = NMETA; } else { t0 = NMETA + 64 * (c - 1); Lv = 64; } }

__device__ __forceinline__ void mlstm_prep_unit(const Ctx& c, int l, int u) {
    int w = c.wave; asm volatile("" : "+s"(w)); const int lane = hw_lane(), tid = w * 64 + lane;
    const int cch = u % NCH, bh = u / NCH, h = bh % HA, b = bh / HA;
    int t0, Lv; chunk_range(cch, t0, Lv);
    const size_t row0 = (size_t)b * TP + t0;
    const bf16_t* PROJ = (const bf16_t*)(c.ws + WS_PROJ); const float* SG = (const float*)(c.ws + WS_SG);
    LAS bf16_t* Qs = (LAS bf16_t*)c.lds; LAS bf16_t* Ks = Qs + 64 * 264; LAS bf16_t* VTs = Ks + 64 * 264; LAS bf16_t* Ss = VTs + 256 * 72;
    LAS float* ga = (LAS float*)(Ss + 64 * 72); LAS float* gcm = ga + 64, *gb = ga + 128, *gwk = ga + 192, *dpart = ga + 256  ;
    bf16_t* gKTw = (bf16_t*)(c.ws + WS_ML_KTW) + (size_t)u * 256 * 64; bf16_t* gVT = (bf16_t*)(c.ws + WS_ML_VT) + (size_t)u * 256 * 64;
    float* gNP = (float*)(c.ws + WS_ML_NP) + (size_t)u * 64 * 256; float* gSC = (float*)(c.ws + WS_ML_SC) + (size_t)u * 256;
    if (w == 0) {
        float li = -1e30f, lf = 0.f;
        if (lane < Lv) { li = SG[(row0 + lane) * SGLD + h] + inp(c, I_BI)[l * HA + h]; lf = -softplusf_(-(SG[(row0 + lane) * SGLD + 4 + h] + inp(c, I_BF)[l * HA + h])); }
        const float bb = wave_incl_sum(lf, lane); const float a = li - bb; const float cm = wave_incl_max(a, lane);
        const float cml = lane_bcast(cm, 63);
        ga[lane] = a; gcm[lane] = cm; gb[lane] = bb; gwk[lane] = __expf(a - cml);
        gSC[lane] = bb; gSC[64 + lane] = cm;
    }
    { u32x4 q4[4], k4[4], v4[4];
#pragma unroll
      for (int k = 0; k < 4; ++k) { const int i = tid + k * NTHR; const int r = i >> 5, c8 = i & 31, rv = i & 63, cv = i >> 6;
          q4[k] = (u32x4){0u, 0u, 0u, 0u}; k4[k] = q4[k]; v4[k] = q4[k];
          if (r < Lv) { const bf16_t* pr = PROJ + (row0 + r) * NPROJ + h * 256 + c8 * 8; q4[k] = *(const u32x4*)(pr + PA_Q); k4[k] = *(const u32x4*)(pr + PA_K); }
          if (rv < Lv) v4[k] = *(const u32x4*)(PROJ + (row0 + rv) * NPROJ + PA_V + h * 256 + cv * 8); }
#pragma unroll
      for (int k = 0; k < 4; ++k) { const int i = tid + k * NTHR; const int r = i >> 5, c8 = i & 31, rv = i & 63, cv = i >> 6;
          *(LAS u32x4*)(Qs + r * 264 + c8 * 8) = q4[k]; *(LAS u32x4*)(Ks + r * 264 + c8 * 8) = k4[k];
          LAS bf16_t* d = VTs + (cv * 8) * 72 + rv; const u32x4 v = v4[k];
          d[0] = (bf16_t)(v.x & 0xffffu); d[72] = (bf16_t)(v.x >> 16); d[144] = (bf16_t)(v.y & 0xffffu); d[216] = (bf16_t)(v.y >> 16);
          d[288] = (bf16_t)(v.z & 0xffffu); d[360] = (bf16_t)(v.z >> 16); d[432] = (bf16_t)(v.w & 0xffffu); d[504] = (bf16_t)(v.w >> 16); } }
    lds_barrier();
    { const int mt = w & 3, nh = w >> 2;
      f32x4 acc[1][2]; acc[0][0] = (f32x4){0.f, 0.f, 0.f, 0.f}; acc[0][1] = acc[0][0];
      mma_lds<1, 2, 8>(acc, Qs, 264, 16 * mt, Ks, 264, 32 * nh, lane);
      float rs[4] = {0.f, 0.f, 0.f, 0.f};
#pragma unroll
      for (int j = 0; j < 2; ++j) { const int sidx = 32 * nh + 16 * j + (lane & 15); const float as = ga[sidx];
#pragma unroll
          for (int r = 0; r < 4; ++r) { const int lidx = 16 * mt + 4 * (lane >> 4) + r;
              const float val = sidx <= lidx ? acc[0][j][r] * 0.0625f * __expf(as - gcm[lidx]) : 0.f;
              rs[r] += val; Ss[lidx * 72 + sidx] = (bf16_t)f2bf(val); } }
#pragma unroll
      for (int r = 0; r < 4; ++r) { const float x = row16_sum(rs[r]);
          if ((lane & 15) == 0) dpart[nh * 64 + 16 * mt + 4 * (lane >> 4) + r] = x; }
    }
    for (int i = tid; i < 256 * 8; i += NTHR) { const int r = i >> 3, c8 = i & 7; *(u32x4*)(gVT + r * 64 + c8 * 8) = *(const LAS u32x4*)(VTs + r * 72 + c8 * 8); }
    for (int i = tid; i < 256 * 8; i += NTHR) { const int k = i & 255, c8 = i >> 8; u32x4 o; float x[8];
#pragma unroll
        for (int e = 0; e < 8; ++e) x[e] = bf2f(Ks[(c8 * 8 + e) * 264 + k]) * 0.0625f * gwk[c8 * 8 + e];
        o.x = pk2(x[0], x[1]); o.y = pk2(x[2], x[3]); o.z = pk2(x[4], x[5]); o.w = pk2(x[6], x[7]);
        *(u32x4*)(gKTw + k * 64 + c8 * 8) = o; }
    lds_barrier();
    if (tid < 64) gSC[128 + tid] = dpart[tid] + dpart[64 + tid];
    { f32x4 acc[2][4];
#pragma unroll
      for (int i = 0; i < 2; ++i)
#pragma unroll
          for (int j = 0; j < 4; ++j) acc[i][j] = (f32x4){0.f, 0.f, 0.f, 0.f};
      mma_lds<2, 4, 2>(acc, VTs, 72, 32 * w, Ss, 72, 0, lane);
#pragma unroll
      for (int i = 0; i < 2; ++i)
#pragma unroll
          for (int j = 0; j < 4; ++j) { const int v0 = 32 * w + 16 * i + 4 * (lane >> 4), lidx = 16 * j + (lane & 15); *(f32x4*)(gNP + lidx * 256 + v0) = acc[i][j]; }
    }
    lds_barrier();
}

__device__ __forceinline__ void mlstm_seq_unit(const Ctx& c, int l, int b, int h, int vs) {
    int w = c.wave; asm volatile("" : "+s"(w)); const int lane = hw_lane(), tid = w * 64 + lane;
    const bf16_t* PROJ = (const bf16_t*)(c.ws + WS_PROJ);
    LAS bf16_t* Qs = (LAS bf16_t*)c.lds; LAS bf16_t* KTw = Qs + 64 * 264; LAS bf16_t* VTs = KTw + 256 * 72; LAS bf16_t* CTs = VTs + 80 * 72;
    LAS float* sb = (LAS float*)(CTs + 80 * 264); LAS float* scm = sb + 64, *sdp = sb + 128, *sqn = sb + 192;
    float* HAo = (float*)(c.ws + WS_HA);
    for (int i = tid; i < 80 * 264; i += NTHR) CTs[i] = 0;
    for (int i = tid; i < 16 * 72; i += NTHR) VTs[64 * 72 + i] = (i < 72) ? (bf16_t)0x3f80 : (bf16_t)0;
    f32x4 Cst[2][5];
#pragma unroll
    for (int i = 0; i < 2; ++i)
#pragma unroll
        for (int j = 0; j < 5; ++j) Cst[i][j] = (f32x4){0.f, 0.f, 0.f, 0.f};
    float m = 0.f;
    const int lt = w & 3, vh = w >> 2;
    u32x4 pq[2][4], pk[2][4], pv[2]; float psc[2] = {0.f, 0.f}; f32x4 pn[2][2];
#define ML_ISSUE(cc, S_) do { int t0_, Lv_; chunk_range((cc), t0_, Lv_); const size_t row0_ = (size_t)b * TP + t0_; const int u_ = (b * HA + h) * NCH + (cc); \
        const bf16_t* gK_ = (const bf16_t*)(c.ws + WS_ML_KTW) + (size_t)u_ * 256 * 64; const bf16_t* gV_ = (const bf16_t*)(c.ws + WS_ML_VT) + (size_t)u_ * 256 * 64 + (size_t)vs * 64 * 64; \
        const float* gN_ = (const float*)(c.ws + WS_ML_NP) + (size_t)u_ * 64 * 256; const float* gS_ = (const float*)(c.ws + WS_ML_SC) + (size_t)u_ * 256; \
        _Pragma("unroll") for (int k_ = 0; k_ < 4; ++k_) { const int i_ = tid + k_ * NTHR; const int r_ = i_ >> 5, c8_ = i_ & 31; pq[S_][k_] = (u32x4){0u, 0u, 0u, 0u}; \
            if (r_ < Lv_) pq[S_][k_] = *(const u32x4*)(PROJ + (row0_ + r_) * NPROJ + PA_Q + h * 256 + c8_ * 8); pk[S_][k_] = *(const u32x4*)(gK_ + (i_ >> 3) * 64 + (i_ & 7) * 8); } \
        pv[S_] = *(const u32x4*)(gV_ + (tid >> 3) * 64 + (tid & 7) * 8); psc[S_] = tid < 192 ? gS_[tid] : 0.f; \
        _Pragma("unroll") for (int j_ = 0; j_ < 2; ++j_) pn[S_][j_] = *(const f32x4*)(gN_ + (16 * lt + (lane & 15)) * 256 + vs * 64 + 16 * (vh + 2 * j_) + 4 * (lane >> 4)); } while (0)
#define ML_CHUNK(cch, S) do { \
        int t0, Lv; chunk_range((cch), t0, Lv); \
        const size_t row0 = (size_t)b * TP + t0; \
        _Pragma("unroll") \
        for (int k = 0; k < 4; ++k) { const int i = tid + k * NTHR; *(LAS u32x4*)(Qs + (i >> 5) * 264 + (i & 31) * 8) = pq[S][k]; *(LAS u32x4*)(KTw + (i >> 3) * 72 + (i & 7) * 8) = pk[S][k]; } \
        *(LAS u32x4*)(VTs + (tid >> 3) * 72 + (tid & 7) * 8) = pv[S]; \
        if (tid < 192) sb[tid] = psc[S]; \
        const f32x4 np0 = pn[S][0], np1 = pn[S][1]; \
        if ((cch) + 2 < NCH) ML_ISSUE((cch) + 2, S); \
        lds_barrier(); \
        f32x4 ia[3]; ia[0] = (f32x4){0.f, 0.f, 0.f, 0.f}; ia[1] = ia[0]; ia[2] = ia[0]; \
        _Pragma("unroll") \
        for (int ks = 0; ks < 8; ++ks) { const bf16x8 qf = ldfrag(Qs, 264, 16 * lt, 32 * ks, lane); \
            ia[0] = mfma16(ldfrag(CTs, 264, 16 * vh, 32 * ks, lane), qf, ia[0]); \
            ia[1] = mfma16(ldfrag(CTs, 264, 16 * (vh + 2), 32 * ks, lane), qf, ia[1]); \
            if (vh == 0) ia[2] = mfma16(ldfrag(CTs, 264, 64, 32 * ks, lane), qf, ia[2]); } \
        if (vh == 0 && lane < 16) sqn[16 * lt + lane] = ia[2][0]; \
        lds_barrier(); \
        { const int lidx = 16 * lt + (lane & 15); \
          const float cm = scm[lidx], bl = sb[lidx]; const float M = fmaxf(m, cm), rho = __expf(cm - M), sig = __expf(m - M); \
          float den = rho * sdp[lidx] + sig * sqn[lidx]; den = fmaxf(fabsf(den), __expf(-(bl + M))); const float dinv = __builtin_amdgcn_rcpf(den); \
          if (lidx < Lv) { \
        _Pragma("unroll") \
              for (int j = 0; j < 2; ++j) { const int v0 = 16 * (vh + 2 * j) + 4 * (lane >> 4); \
                  const f32x4 np = j == 0 ? np0 : np1; \
                  *(f32x4*)(HAo + (row0 + lidx) * 1024 + h * 256 + vs * 64 + v0) = (np * rho + ia[j] * sig) * dinv; } } } \
        { const float cml = scm[63], Ml = fmaxf(m, cml), dec = __expf(m - Ml), rl = __expf(cml - Ml); \
          _Pragma("unroll") for (int i = 0; i < 2; ++i) { f32x4 d2[1][5]; \
              _Pragma("unroll") for (int j = 0; j < 5; ++j) d2[0][j] = (f32x4){0.f, 0.f, 0.f, 0.f}; \
              mma_lds<1, 5, 2>(d2, KTw, 72, 32 * w + 16 * i, VTs, 72, 0, lane); \
              _Pragma("unroll") for (int j = 0; j < 5; ++j) { Cst[i][j] = Cst[i][j] * dec + d2[0][j] * rl; \
                  u32x2 o; o.x = pk2(Cst[i][j][0], Cst[i][j][1]); o.y = pk2(Cst[i][j][2], Cst[i][j][3]); \
                  *(LAS u32x2*)(CTs + (16 * j + (lane & 15)) * 264 + 32 * w + 16 * i + 4 * (lane >> 4)) = o; } } \
          m = sb[63] + Ml; } \
        lds_barrier(); \
    } while (0)
    ML_ISSUE(0, 0); ML_ISSUE(1, 1);
    lds_barrier();
    for (int cch = 0; cch + 1 < NCH; cch += 2) { ML_CHUNK(cch, 0); ML_CHUNK(cch + 1, 1); }
    ML_CHUNK(NCH - 1, 0);
#undef ML_CHUNK
#undef ML_ISSUE
    float* oc = c.out + O_PC + (((size_t)l * BATCH + b) * HA + h) * DHA * DHA; float* on = c.out + O_PN + (((size_t)l * BATCH + b) * HA + h) * DHA;
#pragma unroll
    for (int i = 0; i < 2; ++i) { const int k0 = 32 * w + 16 * i + 4 * (lane >> 4);
#pragma unroll
        for (int j = 0; j < 4; ++j)
#pragma unroll
            for (int r = 0; r < 4; ++r) oc[(size_t)(k0 + r) * 256 + vs * 64 + 16 * j + (lane & 15)] = Cst[i][j][r];
        if (vs == 0 && (lane & 15) == 0) {
#pragma unroll
            for (int r = 0; r < 4; ++r) on[k0 + r] = Cst[i][4][r]; } }
    if (vs == 0 && tid == 0) c.out[O_PM + ((size_t)l * BATCH + b) * HA + h] = m;
    lds_barrier();
}

__device__ __forceinline__ f32x4 mfma4f(float a, float b, f32x4 c) { return __builtin_amdgcn_mfma_f32_16x16x4f32(a, b, c, 0, 0, 0); }
__device__ __forceinline__ void tri_inv64(const LAS float* Am, LAS float* Tm, LAS float* Xt, int tid, int w, LAS bf16_t* Tb) {
    for (int i = tid; i < 64 * 65; i += NTHR) Tm[i] = 0.f;
    for (int i = tid; i < 64 * 36; i += NTHR) ((LAS unsigned*)Tb)[i] = 0u;
    lds_barrier();
    if (tid < 64) { const int base = (tid >> 3) * 8, cc = tid & 7; float x[8];
#pragma unroll
        for (int r = 0; r < 8; ++r) { float a = 0.f;
#pragma unroll
            for (int j = 0; j < r; ++j) a += Am[(base + r) * 65 + base + j] * x[j];
            x[r] = (r == cc) ? 1.f : (r < cc ? 0.f : -a); }
#pragma unroll
        for (int r = 0; r < 8; ++r) { Tm[(base + r) * 65 + base + cc] = x[r]; Tb[(base + r) * 72 + base + cc] = (bf16_t)f2bf(x[r]); } }
    lds_barrier();
    const int lane = tid & 63, li = lane & 15, lk = lane >> 4;
    if (w < 2) {
        const int bi = 32 * w + (li < 8 ? 0 : 16), l7 = li & 7; LAS float* X = Xt + w * 512;
        f32x4 x = {0.f, 0.f, 0.f, 0.f};
#pragma unroll
        for (int ks = 0; ks < 2; ++ks) x = mfma4f(Am[(bi + 8 + l7) * 65 + bi + 4 * ks + lk], Tm[(bi + 4 * ks + lk) * 65 + bi + l7], x);
#pragma unroll
        for (int r = 0; r < 4; ++r) X[(4 * lk + r) * 16 + li] = x[r];
        asm volatile("s_waitcnt lgkmcnt(0)" ::: "memory");
        f32x4 y = {0.f, 0.f, 0.f, 0.f};
#pragma unroll
        for (int ks = 0; ks < 2; ++ks) y = mfma4f(Tm[(bi + 8 + l7) * 65 + bi + 8 + 4 * ks + lk], X[(4 * ks + lk + (li < 8 ? 0 : 8)) * 16 + li], y);
        if ((lk < 2) == (li < 8)) {
#pragma unroll
            for (int r = 0; r < 4; ++r) { const int rr = bi + 8 + ((4 * lk + r) & 7); Tm[rr * 65 + bi + l7] = -y[r]; Tb[rr * 72 + bi + l7] = (bf16_t)f2bf(-y[r]); } } }
    lds_barrier();
    if (w < 2) { const int lb = 32 * w, hb = lb + 16; LAS float* X = Xt + w * 512;
        f32x4 x = {0.f, 0.f, 0.f, 0.f};
#pragma unroll
        for (int ks = 0; ks < 4; ++ks) x = mfma4f(Am[(hb + li) * 65 + lb + 4 * ks + lk], Tm[(lb + 4 * ks + lk) * 65 + lb + li], x);
#pragma unroll
        for (int r = 0; r < 4; ++r) X[(4 * lk + r) * 16 + li] = x[r];
        asm volatile("s_waitcnt lgkmcnt(0)" ::: "memory");
        f32x4 y = {0.f, 0.f, 0.f, 0.f};
#pragma unroll
        for (int ks = 0; ks < 4; ++ks) y = mfma4f(Tm[(hb + li) * 65 + hb + 4 * ks + lk], X[(4 * ks + lk) * 16 + li], y);
#pragma unroll
        for (int r = 0; r < 4; ++r) { Tm[(hb + 4 * lk + r) * 65 + lb + li] = -y[r]; Tb[(hb + 4 * lk + r) * 72 + lb + li] = (bf16_t)f2bf(-y[r]); } }
    lds_barrier();
    if (w < 2) { LAS float* X = Xt + w * 512;
        f32x4 x0 = {0.f, 0.f, 0.f, 0.f}, x1 = x0;
#pragma unroll
        for (int ks = 0; ks < 8; ++ks) { const float bb = Tm[(4 * ks + lk) * 65 + 16 * w + li];
            x0 = mfma4f(Am[(32 + li) * 65 + 4 * ks + lk], bb, x0); x1 = mfma4f(Am[(48 + li) * 65 + 4 * ks + lk], bb, x1); }
#pragma unroll
        for (int r = 0; r < 4; ++r) { X[(4 * lk + r) * 16 + li] = x0[r]; X[(16 + 4 * lk + r) * 16 + li] = x1[r]; }
        asm volatile("s_waitcnt lgkmcnt(0)" ::: "memory");
        f32x4 y0 = {0.f, 0.f, 0.f, 0.f}, y1 = y0;
#pragma unroll
        for (int ks = 0; ks < 8; ++ks) { const float bb = X[(4 * ks + lk) * 16 + li];
            y0 = mfma4f(Tm[(32 + li) * 65 + 32 + 4 * ks + lk], bb, y0); y1 = mfma4f(Tm[(48 + li) * 65 + 32 + 4 * ks + lk], bb, y1); }
#pragma unroll
        for (int r = 0; r < 4; ++r) { Tb[(32 + 4 * lk + r) * 72 + 16 * w + li] = (bf16_t)f2bf(-y0[r]); Tb[(48 + 4 * lk + r) * 72 + 16 * w + li] = (bf16_t)f2bf(-y1[r]); } }
    lds_barrier();
}

__device__ __forceinline__ void gdn_prep_unit(const Ctx& c, int l, int u) {
    int w = c.wave; asm volatile("" : "+s"(w)); const int lane = hw_lane(), tid = w * 64 + lane;
    const int cch = u % NCH, bh = u / NCH, h = bh % HB, b = bh / HB;
    int t0, Lv; chunk_range(cch, t0, Lv);
    const size_t row0 = (size_t)b * TP + t0;
    const bf16_t* PROJ = (const bf16_t*)(c.ws + WS_PROJ); const float* SG = (const float*)(c.ws + WS_SG);
    LAS bf16_t* Qs = (LAS bf16_t*)c.lds; LAS bf16_t* Ks = Qs + 64 * 136; LAS bf16_t* RAW = Ks + 64 * 136; LAS bf16_t* RT = RAW; LAS bf16_t* Tb = RT + 256 * 72;
    LAS float* Am = (LAS float*)(c.lds + 86272); LAS float* Tm = Am + 64 * 65; LAS float* Xt = Tm + 64 * 65; LAS float* psq = Xt + 32 * 33; LAS float* sg = psq + 1024; LAS float* sbe = sg + 64;
    bf16_t* gW = (bf16_t*)(c.ws + WS_GD_W) + (size_t)u * 64 * 128; bf16_t* gUT = (bf16_t*)(c.ws + WS_GD_UT) + (size_t)u * 128 * 64; bf16_t* gAT = (bf16_t*)(c.ws + WS_GD_AT) + (size_t)u * 64 * 64;
    bf16_t* gQ = (bf16_t*)(c.ws + WS_GD_Q) + (size_t)u * 64 * 128; bf16_t* gKD = (bf16_t*)(c.ws + WS_GD_KD) + (size_t)u * 128 * 64; float* gSC = (float*)(c.ws + WS_GD_SC) + (size_t)u * 128;
    if (w == 0) { float ga = 0.f, be = 0.f;
        if (lane < Lv) { const float a = SG[(row0 + lane) * SGLD + 8 + h], bb = SG[(row0 + lane) * SGLD + 16 + h];
            ga = -__expf(inp(c, I_ALOG)[l * HB + h]) * softplusf_(a + inp(c, I_DTB)[l * HB + h]); be = sigmoidf_(bb); }
        const float g = wave_incl_sum(ga, lane); sg[lane] = g; sbe[lane] = be; gSC[lane] = __expf(g); if (lane == 63) gSC[64] = __expf(g); }
    { u32x4 rv[7]; float cwv[3];
#pragma unroll
      for (int k = 0; k < 3; ++k) { const int i = tid + k * NTHR; const int j = i / 384, ch = i % 384; cwv[k] = inp(c, I_CONVW)[(size_t)l * 4 * 3072 + j * 3072 + (ch >> 7) * 1024 + h * 128 + (ch & 127)]; }
#pragma unroll
      for (int k = 0; k < 7; ++k) { const int i = tid + k * NTHR; rv[k] = (u32x4){0u, 0u, 0u, 0u};
          if (i < 67 * 48) { const int rr = i / 48, c8 = i % 48, part = c8 >> 4, d8 = c8 & 15; const int tt = t0 - 3 + rr;
              if (tt >= 0 && rr - 3 < Lv) rv[k] = *(const u32x4*)(PROJ + ((size_t)b * TP + tt) * NPROJ + PB_QKV + part * 1024 + h * 128 + d8 * 8); } }
#pragma unroll
      for (int k = 0; k < 7; ++k) { const int i = tid + k * NTHR; if (i < 67 * 48) { const int rr = i / 48, c8 = i % 48; *(LAS u32x4*)(RAW + rr * 384 + c8 * 8) = rv[k]; } }
#pragma unroll
      for (int k = 0; k < 3; ++k) ((LAS float*)(c.lds + 102912))[tid + k * NTHR] = cwv[k]; }
    lds_barrier();
    const int s = lane, p = w;
    float yq[16], yk[16], yv[16];
    { const LAS float* cw = (const LAS float*)(c.lds + 102912); float sq = 0.f, sk = 0.f;
#pragma unroll
      for (int part = 0; part < 3; ++part) {
#pragma unroll
          for (int e4 = 0; e4 < 4; ++e4) { f32x4 a = (f32x4){0.f, 0.f, 0.f, 0.f};
#pragma unroll
              for (int j = 0; j < 4; ++j) { const f32x4 wv = *(const LAS f32x4*)(cw + j * 384 + part * 128 + p * 16 + e4 * 4);
                  const u32x2 rv = *(const LAS u32x2*)(RAW + (s + j) * 384 + part * 128 + p * 16 + e4 * 4);
                  a[0] += wv[0] * __uint_as_float(rv.x << 16); a[1] += wv[1] * __uint_as_float(rv.x & 0xffff0000u); a[2] += wv[2] * __uint_as_float(rv.y << 16); a[3] += wv[3] * __uint_as_float(rv.y & 0xffff0000u); }
#pragma unroll
              for (int e = 0; e < 4; ++e) { const float y = s < Lv ? siluf_(a[e]) : 0.f;
                  if (part == 0) { yq[e4 * 4 + e] = y; sq += y * y; } else if (part == 1) { yk[e4 * 4 + e] = y; sk += y * y; } else yv[e4 * 4 + e] = y; } } }
      psq[p * 64 + s] = sq; psq[512 + p * 64 + s] = sk; }
    lds_barrier();
    { float sq = 0.f, sk = 0.f;
#pragma unroll
      for (int i = 0; i < 8; ++i) { sq += psq[i * 64 + s]; sk += psq[512 + i * 64 + s]; }
      const float qn = rsqrtf(sq + 1e-12f) * 0.08838834764831845f, kn = rsqrtf(sk + 1e-12f);
      const float g = sg[s], be = sbe[s], gL = sg[63]; const float kb = kn * be * __expf(g), kd = kn * __expf(gL - g);
      u32x4 o0, o1;
      o0.x = pk2(yq[0] * qn, yq[1] * qn); o0.y = pk2(yq[2] * qn, yq[3] * qn); o0.z = pk2(yq[4] * qn, yq[5] * qn); o0.w = pk2(yq[6] * qn, yq[7] * qn);
      o1.x = pk2(yq[8] * qn, yq[9] * qn); o1.y = pk2(yq[10] * qn, yq[11] * qn); o1.z = pk2(yq[12] * qn, yq[13] * qn); o1.w = pk2(yq[14] * qn, yq[15] * qn);
      *(LAS u32x4*)(Qs + s * 136 + p * 16) = o0; *(LAS u32x4*)(Qs + s * 136 + p * 16 + 8) = o1; *(u32x4*)(gQ + s * 128 + p * 16) = o0; *(u32x4*)(gQ + s * 128 + p * 16 + 8) = o1;
      o0.x = pk2(yk[0] * kn, yk[1] * kn); o0.y = pk2(yk[2] * kn, yk[3] * kn); o0.z = pk2(yk[4] * kn, yk[5] * kn); o0.w = pk2(yk[6] * kn, yk[7] * kn);
      o1.x = pk2(yk[8] * kn, yk[9] * kn); o1.y = pk2(yk[10] * kn, yk[11] * kn); o1.z = pk2(yk[12] * kn, yk[13] * kn); o1.w = pk2(yk[14] * kn, yk[15] * kn);
      *(LAS u32x4*)(Ks + s * 136 + p * 16) = o0; *(LAS u32x4*)(Ks + s * 136 + p * 16 + 8) = o1;
#pragma unroll
      for (int e = 0; e < 16; ++e) { RT[(p * 16 + e) * 72 + s] = (bf16_t)f2bf(yv[e] * be); RT[(128 + p * 16 + e) * 72 + s] = (bf16_t)f2bf(yk[e] * kb); gKD[(p * 16 + e) * 64 + s] = (bf16_t)f2bf(yk[e] * kd); } }
    lds_barrier();
    { const int mt = w & 3, nh = w >> 2;
      f32x4 aK[2][1], aQ[2][1]; aK[0][0] = (f32x4){0.f, 0.f, 0.f, 0.f}; aK[1][0] = aK[0][0]; aQ[0][0] = aK[0][0]; aQ[1][0] = aK[0][0];
      mma_lds<2, 1, 4>(aK, Ks, 136, 32 * nh, Ks, 136, 16 * mt, lane);
      mma_lds<2, 1, 4>(aQ, Ks, 136, 32 * nh, Qs, 136, 16 * mt, lane);
      const int lidx = 16 * mt + (lane & 15); const float gl = sg[lidx], bel = sbe[lidx];
#pragma unroll
      for (int i = 0; i < 2; ++i) { const int s0 = 32 * nh + 16 * i + 4 * (lane >> 4); const f32x4 gs = *(const LAS f32x4*)(sg + s0); float q[4];
#pragma unroll
          for (int r = 0; r < 4; ++r) { const int sidx = s0 + r; const float dcy = sidx <= lidx ? __expf(gl - gs[r]) : 0.f;
              Am[lidx * 65 + sidx] = sidx < lidx ? bel * aK[i][0][r] * dcy : 0.f; q[r] = aQ[i][0][r] * dcy; }
          u32x2 o; o.x = pk2(q[0], q[1]); o.y = pk2(q[2], q[3]); *(u32x2*)(gAT + lidx * 64 + s0) = o; } }
    lds_barrier();
    tri_inv64(Am, Tm, Xt, tid, w, Tb);
    { f32x4 aU[1][4], aW[1][4];
#pragma unroll
      for (int j = 0; j < 4; ++j) { aU[0][j] = (f32x4){0.f, 0.f, 0.f, 0.f}; aW[0][j] = aU[0][j]; }
      const int mt = w & 3, vq = w >> 2;
      mma_lds<1, 4, 2>(aU, Tb, 72, 16 * mt, RT, 72, 64 * vq, lane);
      mma_lds<1, 4, 2>(aW, RT, 72, 128 + 16 * w, Tb, 72, 0, lane);
#pragma unroll
      for (int j = 0; j < 4; ++j) { u32x2 o; o.x = pk2(aU[0][j][0], aU[0][j][1]); o.y = pk2(aU[0][j][2], aU[0][j][3]);
          *(u32x2*)(gUT + (64 * vq + 16 * j + (lane & 15)) * 64 + 16 * mt + 4 * (lane >> 4)) = o;
          o.x = pk2(aW[0][j][0], aW[0][j][1]); o.y = pk2(aW[0][j][2], aW[0][j][3]);
          *(u32x2*)(gW + (16 * j + (lane & 15)) * 128 + 16 * w + 4 * (lane >> 4)) = o; } }
    lds_barrier();
}

__device__ __forceinline__ void gdn_seq_unit(const Ctx& c, int l, int b, int h) {
    int w = c.wave; asm volatile("" : "+s"(w)); const int lane = hw_lane(), tid = w * 64 + lane;
    const bf16_t* PROJ = (const bf16_t*)(c.ws + WS_PROJ); bf16_t* YBR = (bf16_t*)(c.ws + WS_YBR);
    LAS bf16_t* Qs = (LAS bf16_t*)c.lds; LAS bf16_t* Wm = Qs + 64 * 136; LAS bf16_t* UT = Wm + 64 * 136; LAS bf16_t* ATs = UT + 128 * 72; LAS bf16_t* KD = ATs + 64 * 72; LAS bf16_t* ST = KD + 128 * 72;
    LAS float* seg = (LAS float*)(ST + 128 * 136); LAS float* ssq = seg + 128; LAS float* gnws = ssq + 128;
    for (int i = tid; i < 128 * 136; i += NTHR) ST[i] = 0;
    if (tid < 128) gnws[tid] = inp(c, I_GNW)[l * DHB + tid];
    f32x4 Sst[1][8];
#pragma unroll
    for (int j = 0; j < 8; ++j) Sst[0][j] = (f32x4){0.f, 0.f, 0.f, 0.f};
    const int lt = w & 3, vq = w >> 2;
    const LAS float* gnwp = gnws + 64 * vq + 4 * (lane >> 4);
    u32x4 pQ[1][2], pW[1][2], pU[1][2], pK[1][2], pA[1]; float psc[1] = {0.f}; u32x2 pz[4];
#define GD_ISSUE(cc, S_) do { const int u_ = (b * HB + h) * NCH + (cc); \
        const bf16_t* gW_ = (const bf16_t*)(c.ws + WS_GD_W) + (size_t)u_ * 64 * 128; const bf16_t* gUT_ = (const bf16_t*)(c.ws + WS_GD_UT) + (size_t)u_ * 128 * 64; const bf16_t* gAT_ = (const bf16_t*)(c.ws + WS_GD_AT) + (size_t)u_ * 64 * 64; \
        const bf16_t* gQ_ = (const bf16_t*)(c.ws + WS_GD_Q) + (size_t)u_ * 64 * 128; const bf16_t* gKD_ = (const bf16_t*)(c.ws + WS_GD_KD) + (size_t)u_ * 128 * 64; const float* gSC_ = (const float*)(c.ws + WS_GD_SC) + (size_t)u_ * 128; \
        _Pragma("unroll") for (int k_ = 0; k_ < 2; ++k_) { const int i_ = tid + k_ * NTHR; pQ[S_][k_] = *(const u32x4*)(gQ_ + (i_ >> 4) * 128 + (i_ & 15) * 8); pW[S_][k_] = *(const u32x4*)(gW_ + (i_ >> 4) * 128 + (i_ & 15) * 8); \
            pU[S_][k_] = *(const u32x4*)(gUT_ + (i_ >> 3) * 64 + (i_ & 7) * 8); pK[S_][k_] = *(const u32x4*)(gKD_ + (i_ >> 3) * 64 + (i_ & 7) * 8); } \
        pA[S_] = *(const u32x4*)(gAT_ + (tid >> 3) * 64 + (tid & 7) * 8); psc[S_] = tid < 65 ? gSC_[tid] : 0.f; } while (0)
#define GD_ZISSUE(cc) do { int t0_, Lv_; chunk_range((cc), t0_, Lv_); const size_t row0_ = (size_t)b * TP + t0_; \
        _Pragma("unroll") for (int i_ = 0; i_ < 4; ++i_) { const int zr_ = 16 * lt + (lane & 15) < Lv_ ? 16 * lt + (lane & 15) : Lv_ - 1; pz[i_] = *(const u32x2*)(PROJ + (row0_ + zr_) * NPROJ + PB_Z + h * 128 + 64 * vq + 16 * i_ + 4 * (lane >> 4)); } } while (0)
#define GD_CHUNK(cch, S) do { \
        int t0, Lv; chunk_range((cch), t0, Lv); \
        const size_t row0 = (size_t)b * TP + t0; \
        _Pragma("unroll") \
        for (int k = 0; k < 2; ++k) { const int i = tid + k * NTHR; *(LAS u32x4*)(Qs + (i >> 4) * 136 + (i & 15) * 8) = pQ[S][k]; *(LAS u32x4*)(Wm + (i >> 4) * 136 + (i & 15) * 8) = pW[S][k]; \
            *(LAS u32x4*)(UT + (i >> 3) * 72 + (i & 7) * 8) = pU[S][k]; *(LAS u32x4*)(KD + (i >> 3) * 72 + (i & 7) * 8) = pK[S][k]; } \
        *(LAS u32x4*)(ATs + (tid >> 3) * 72 + (tid & 7) * 8) = pA[S]; \
        if (tid < 65) seg[tid] = psc[S]; \
        if ((cch) + 1 < NCH) GD_ISSUE((cch) + 1, S); \
        GD_ZISSUE(cch); \
        lds_barrier(); \
        f32x4 aq[4][1]; \
        _Pragma("unroll") for (int j = 0; j < 4; ++j) aq[j][0] = (f32x4){0.f, 0.f, 0.f, 0.f}; \
        _Pragma("unroll") for (int jh = 0; jh < 2; ++jh) { f32x4 ws_[1][2]; ws_[0][0] = (f32x4){0.f, 0.f, 0.f, 0.f}; ws_[0][1] = ws_[0][0]; \
          mma_lds<1, 2, 4>(ws_, Wm, 136, 16 * lt, ST, 136, 64 * vq + 32 * jh, lane); \
          { f32x4 (&aqh)[2][1] = *(f32x4 (*)[2][1])&aq[2 * jh]; mma_lds<2, 1, 4>(aqh, ST, 136, 64 * vq + 32 * jh, Qs, 136, 16 * lt, lane); } \
          _Pragma("unroll") for (int j2 = 0; j2 < 2; ++j2) { const int j = 2 * jh + j2; LAS u32x2* pu = (LAS u32x2*)(UT + (64 * vq + 16 * j + (lane & 15)) * 72 + 16 * lt + 4 * (lane >> 4)); const u32x2 uu = *pu; \
              u32x2 o; o.x = pk2(__uint_as_float(uu.x << 16) - ws_[0][j2][0], __uint_as_float(uu.x & 0xffff0000u) - ws_[0][j2][1]); \
              o.y = pk2(__uint_as_float(uu.y << 16) - ws_[0][j2][2], __uint_as_float(uu.y & 0xffff0000u) - ws_[0][j2][3]); *pu = o; } } \
        lds_barrier(); \
        { const int lidx = 16 * lt + (lane & 15); const float egl = seg[lidx], egL = seg[64]; \
        _Pragma("unroll") \
          for (int i = 0; i < 4; ++i) aq[i][0] = aq[i][0] * egl; \
          mma_lds<4, 1, 2>(aq, UT, 72, 64 * vq, ATs, 72, 16 * lt, lane); \
        _Pragma("unroll") \
          for (int j = 0; j < 8; ++j) Sst[0][j] = Sst[0][j] * egL; \
          mma_lds<1, 8, 2>(Sst, KD, 72, 16 * w, UT, 72, 0, lane); \
        _Pragma("unroll") \
          for (int j = 0; j < 8; ++j) { u32x2 o; o.x = pk2(Sst[0][j][0], Sst[0][j][1]); o.y = pk2(Sst[0][j][2], Sst[0][j][3]); *(LAS u32x2*)(ST + (16 * j + (lane & 15)) * 136 + 16 * w + 4 * (lane >> 4)) = o; } \
          float ss = 0.f; \
        _Pragma("unroll") \
          for (int i = 0; i < 4; ++i) ss += (aq[i][0][0] * aq[i][0][0] + aq[i][0][1] * aq[i][0][1]) + (aq[i][0][2] * aq[i][0][2] + aq[i][0][3] * aq[i][0][3]); \
          ss += __shfl_xor(ss, 16); ss += __shfl_xor(ss, 32); \
          if (lane < 16) ssq[vq * 64 + lidx] = ss; \
          lds_barrier(); \
          const float rs = rsqrtf((ssq[lidx] + ssq[64 + lidx]) * (1.f / 128.f) + 1e-6f); \
          if (lidx < Lv) { \
        _Pragma("unroll") \
              for (int i = 0; i < 4; ++i) { const int v0 = 64 * vq + 16 * i + 4 * (lane >> 4); const f32x4 gw4 = *(const LAS f32x4*)(gnwp + 16 * i); \
                  const u32x2 zz = pz[i]; \
                  u32x2 o; o.x = pk2(aq[i][0][0] * rs * gw4[0] * siluf_(__uint_as_float(zz.x << 16)), aq[i][0][1] * rs * gw4[1] * siluf_(__uint_as_float(zz.x & 0xffff0000u))); \
                  o.y = pk2(aq[i][0][2] * rs * gw4[2] * siluf_(__uint_as_float(zz.y << 16)), aq[i][0][3] * rs * gw4[3] * siluf_(__uint_as_float(zz.y & 0xffff0000u))); \
                  *(u32x2*)(YBR + (row0 + lidx) * YLD + 1024 + h * 128 + v0) = o; } } } \
        lds_barrier(); \
    } while (0)
    GD_ISSUE(0, 0);
    lds_barrier();
#pragma unroll 1
    for (int cch = 0; cch < NCH; ++cch) GD_CHUNK(cch, 0);
#undef GD_CHUNK
#undef GD_ZISSUE
#undef GD_ISSUE
    float* os = c.out + O_PGS + (((size_t)l * BATCH + b) * HB + h) * DHB * DHB;
#pragma unroll
    for (int j = 0; j < 8; ++j)
#pragma unroll
        for (int r = 0; r < 4; ++r) os[(size_t)(16 * w + 4 * (lane >> 4) + r) * 128 + 16 * j + (lane & 15)] = Sst[0][j][r];
    if (tid < 384) { const int cg = (tid >> 7) * 1024 + h * 128 + (tid & 127); float* ocv = c.out + O_PGC + ((size_t)l * BATCH + b) * 3 * 3072;
#pragma unroll
        for (int j = 0; j < 3; ++j) ocv[j * 3072 + cg] = bf2f(PROJ[((size_t)b * TP + TP - 3 + j) * NPROJ + PB_QKV + cg]); }
    __syncthreads();
}

__device__ __forceinline__ void rwkv_prep_unit(const Ctx& c, int l, int u) {
    int w = c.wave; asm volatile("" : "+s"(w)); const int lane = hw_lane(), tid = w * 64 + lane;
    const int cch = u % NCH, bh = u / NCH, h = bh % HC, b = bh / HC;
    int t0, Lv; chunk_range(cch, t0, Lv);
    const bf16_t* PROJ = (const bf16_t*)(c.ws + WS_PROJ);
    LAS bf16_t* XW = (LAS bf16_t*)c.lds; LAS bf16_t* XA = XW + 64 * 72; LAS bf16_t* XG = XA + 64 * 72; LAS bf16_t* W2T = XG + 64 * 136; LAS bf16_t* A2T = W2T + 64 * 72; LAS bf16_t* G2T = A2T + 64 * 72;
    LAS bf16_t* STG = (LAS bf16_t*)(c.lds + 73728); LAS float* LO = (LAS float*)(c.lds + 73728); LAS float* red = (LAS float*)(c.lds + 123648);
    LAS bf16_t* AR = (LAS bf16_t*)c.lds; LAS bf16_t* KB = AR + 128 * 72; LAS bf16_t* VT = KB + 128 * 72; LAS bf16_t* KhT = VT + 64 * 72; LAS bf16_t* R2T = KhT + 64 * 72;
    LAS bf16_t* AkR = (LAS bf16_t*)(c.lds + 73728); LAS float* Am = (LAS float*)(c.lds + 92160); LAS float* Tm = Am + 64 * 65; LAS float* Xt = Tm + 64 * 65; LAS bf16_t* Tb = AR;
    bf16_t* gU = (bf16_t*)(c.ws + WS_RW) + (size_t)u * RW_N * 4096;
    bf16_t* gTA = gU + RW_TA * 4096; bf16_t* gPVT = gU + RW_PVT * 4096; bf16_t* gRH = gU + RW_RH * 4096; bf16_t* gYV = gU + RW_YV * 4096;
    bf16_t* gARB = gU + RW_ARB * 4096; bf16_t* gBHT = gU + RW_BHT * 4096; bf16_t* gKVT = gU + RW_KVT * 4096; bf16_t* gV = gU + RW_V * 4096; bf16_t* gG = gU + RW_G * 4096;
    float* gSC = (float*)(c.ws + WS_RW_SC) + (size_t)u * 128;
    LAS float* PRM = (LAS float*)(c.lds + 127744);
    u32x4 st1[4], st2[5];
    { const float* w2p = inp(c, I_W2) + (size_t)l * 64 * 1024 + h * 64 + (tid >> 6) * 1024 + (tid & 63); const float* a2p = inp(c, I_A2) + (size_t)l * 64 * 1024 + h * 64 + (tid >> 6) * 1024 + (tid & 63);
      const float* g2p = inp(c, I_G2) + (size_t)l * 128 * 1024 + h * 64 + (tid >> 6) * 1024 + (tid & 63);
      float lw2[8], la2[8], lg2[16], pv_[2];
#pragma unroll
      for (int k = 0; k < 8; ++k) { lw2[k] = w2p[k * 8192]; la2[k] = a2p[k * 8192]; }
#pragma unroll
      for (int k = 0; k < 16; ++k) lg2[k] = g2p[k * 8192];
#pragma unroll
      for (int q = 0; q < 2; ++q) { const int idx = tid + q * NTHR; pv_[q] = 0.f;
          if (idx < 768) { const float* src;
              if (idx < 192) src = inp(c, I_MU) + (size_t)l * NCC + (idx >> 6) * 1024 + h * 64 + (idx & 63);
              else if (idx < 448) src = inp(c, I_MU) + (size_t)l * NCC + 3072 + (idx - 192);
              else { const int t_ = (idx - 448) >> 6, o_ = l * 1024 + h * 64 + ((idx - 448) & 63);
                  src = (t_ == 0 ? inp(c, I_W0) : t_ == 1 ? inp(c, I_A0) : t_ == 2 ? inp(c, I_KK) : t_ == 3 ? inp(c, I_KA) : inp(c, I_RK)) + o_; }
              pv_[q] = *src; } }
#pragma unroll
      for (int k = 0; k < 4; ++k) { const int i = tid + k * NTHR; st1[k] = (u32x4){0u, 0u, 0u, 0u};
          if (i < 65 * 24) { const int rr = i / 24, c8 = i % 24, part = c8 >> 3, d8 = c8 & 7; const int tt = t0 - 1 + rr;
              if (tt >= 0 && rr - 1 < Lv) st1[k] = *(const u32x4*)(PROJ + ((size_t)b * TP + tt) * NPROJ + PC0 + part * 1024 + h * 64 + d8 * 8); } }
#pragma unroll
      for (int k = 0; k < 5; ++k) { const int i = tid + k * NTHR; st2[k] = (u32x4){0u, 0u, 0u, 0u};
          if (i < 65 * 32) { const int rr = i >> 5, c8 = i & 31; const int tt = t0 - 1 + rr;
              if (tt >= 0 && rr - 1 < Lv) st2[k] = *(const u32x4*)(PROJ + ((size_t)b * TP + tt) * NPROJ + PC0 + 3072 + c8 * 8); } }
      LAS bf16_t* dw = W2T + (tid & 63) * 72 + (tid >> 6); LAS bf16_t* da = A2T + (tid & 63) * 72 + (tid >> 6); LAS bf16_t* dg = G2T + (tid & 63) * 136 + (tid >> 6);
#pragma unroll
      for (int k = 0; k < 8; ++k) { dw[8 * k] = (bf16_t)f2bf(lw2[k]); da[8 * k] = (bf16_t)f2bf(la2[k]); }
#pragma unroll
      for (int k = 0; k < 16; ++k) dg[8 * k] = (bf16_t)f2bf(lg2[k]);
#pragma unroll
      for (int q = 0; q < 2; ++q) { const int idx = tid + q * NTHR; if (idx < 768) PRM[idx] = pv_[q]; } }
    const int s = lane, p = w;
    const bool valid = s < Lv;
    float r8[8], k8[8], v8[8];
    auto mix8 = [&](const LAS bf16_t* st, int pitch, int col, int ch, float (&o)[8]) {
        const u32x4 a = *(const LAS u32x4*)(st + (s + 1) * pitch + col), bq = *(const LAS u32x4*)(st + s * pitch + col);
        const f32x4 m0 = *(const LAS f32x4*)(PRM + ch), m1 = *(const LAS f32x4*)(PRM + ch + 4);
        const unsigned aw[4] = {a.x, a.y, a.z, a.w}, bw[4] = {bq.x, bq.y, bq.z, bq.w};
#pragma unroll
        for (int e = 0; e < 4; ++e) { const float c0 = __uint_as_float(aw[e] << 16), c1 = __uint_as_float(aw[e] & 0xffff0000u), p0 = __uint_as_float(bw[e] << 16), p1 = __uint_as_float(bw[e] & 0xffff0000u);
            const float mm0 = (2 * e < 4) ? m0[2 * e] : m1[2 * e - 4], mm1 = (2 * e + 1 < 4) ? m0[2 * e + 1] : m1[2 * e + 1 - 4];
            o[2 * e] = valid ? c0 + (p0 - c0) * mm0 : 0.f; o[2 * e + 1] = valid ? c1 + (p1 - c1) * mm1 : 0.f; } };
#pragma unroll
    for (int k = 0; k < 4; ++k) { const int i = tid + k * NTHR; if (i < 65 * 24) { const int rr = i / 24, c8 = i % 24; *(LAS u32x4*)(STG + rr * 200 + (c8 >> 3) * 64 + (c8 & 7) * 8) = st1[k]; } }
    lds_barrier();
    mix8(STG, 200, p * 8, p * 8, r8); mix8(STG, 200, 64 + p * 8, 64 + p * 8, k8); mix8(STG, 200, 128 + p * 8, 128 + p * 8, v8);
#pragma unroll
    for (int e = 0; e < 8; ++e) asm volatile("" : "+v"(r8[e]), "+v"(k8[e]), "+v"(v8[e]));
    lds_barrier();
#pragma unroll
    for (int k = 0; k < 5; ++k) { const int i = tid + k * NTHR; if (i < 65 * 32) *(LAS u32x4*)(STG + (i >> 5) * 264 + (i & 31) * 8) = st2[k]; }
    lds_barrier();
    { float t8[8]; u32x4 o;
      mix8(STG, 264, p * 8, 192 + p * 8, t8);
      o.x = pk2(ftanh(t8[0]), ftanh(t8[1])); o.y = pk2(ftanh(t8[2]), ftanh(t8[3])); o.z = pk2(ftanh(t8[4]), ftanh(t8[5])); o.w = pk2(ftanh(t8[6]), ftanh(t8[7])); *(LAS u32x4*)(XW + s * 72 + p * 8) = o;
      mix8(STG, 264, 64 + p * 8, 256 + p * 8, t8);
      o.x = pk2(t8[0], t8[1]); o.y = pk2(t8[2], t8[3]); o.z = pk2(t8[4], t8[5]); o.w = pk2(t8[6], t8[7]); *(LAS u32x4*)(XA + s * 72 + p * 8) = o;
#pragma unroll
      for (int q = 0; q < 2; ++q) { mix8(STG, 264, 128 + p * 16 + q * 8, 320 + p * 16 + q * 8, t8);
          o.x = pk2(fsigmoid(t8[0]), fsigmoid(t8[1])); o.y = pk2(fsigmoid(t8[2]), fsigmoid(t8[3])); o.z = pk2(fsigmoid(t8[4]), fsigmoid(t8[5])); o.w = pk2(fsigmoid(t8[6]), fsigmoid(t8[7]));
          *(LAS u32x4*)(XG + s * 136 + p * 16 + q * 8) = o; } }
    lds_barrier();
    { const int mt = w & 3, nh = w >> 2; f32x4 a0[1][2], a1[1][2], a2[1][2];
#pragma unroll
      for (int j = 0; j < 2; ++j) { a0[0][j] = (f32x4){0.f, 0.f, 0.f, 0.f}; a1[0][j] = a0[0][j]; a2[0][j] = a0[0][j]; }
      mma_lds<1, 2, 2>(a0, XW, 72, 16 * mt, W2T, 72, 32 * nh, lane);
      mma_lds<1, 2, 2>(a1, XA, 72, 16 * mt, A2T, 72, 32 * nh, lane);
      mma_lds<1, 2, 4>(a2, XG, 136, 16 * mt, G2T, 136, 32 * nh, lane);
#pragma unroll
      for (int j = 0; j < 2; ++j)
#pragma unroll
          for (int r = 0; r < 4; ++r) { const int tok = 16 * mt + 4 * (lane >> 4) + r, cc = 32 * nh + 16 * j + (lane & 15);
              LO[tok * 65 + cc] = a0[0][j][r]; LO[4160 + tok * 65 + cc] = a1[0][j][r]; LO[8320 + tok * 65 + cc] = a2[0][j][r]; } }
    lds_barrier();
    const LAS float* pW0 = PRM + 448 + p * 8; const LAS float* pA0 = PRM + 512 + p * 8; const LAS float* pKK = PRM + 576 + p * 8; const LAS float* pKA = PRM + 640 + p * 8; const LAS float* pRK = PRM + 704 + p * 8;
    { float sq = 0.f, bn = 0.f;
#pragma unroll
      for (int e = 0; e < 8; ++e) { const int cc = p * 8 + e;
          const float et = fsigmoid(pA0[e] + LO[4160 + s * 65 + cc]);
          const float kkv = k8[e] * pKK[e]; sq += kkv * kkv;
          const float k2 = k8[e] * (1.f + (et - 1.f) * pKA[e]); bn += r8[e] * k2 * pRK[e]; }
      red[p * 64 + s] = sq; red[512 + p * 64 + s] = bn; }
    lds_barrier();
    { float sq = 0.f, bn = 0.f;
#pragma unroll
      for (int i = 0; i < 8; ++i) { sq += red[i * 64 + s]; bn += red[512 + i * 64 + s]; }
      const float kn = rsqrtf(sq + 1e-12f);
      if (p == 0) gSC[64 + s] = valid ? bn : 0.f;
#pragma unroll
      for (int e2 = 0; e2 < 4; ++e2) { float fa[2], fr[2], fk[2], fb[2], frh[2], fv[2], fg[2];
#pragma unroll
          for (int q = 0; q < 2; ++q) { const int e = 2 * e2 + q, cc = p * 8 + e;
              const float wl = pW0[e] + LO[s * 65 + cc]; const float lw = valid ? -0.6065306597126334f * fsigmoid(wl) : 0.f;
              const float et = fsigmoid(pA0[e] + LO[4160 + s * 65 + cc]);
              const float Lc = wave_incl_sum(lw, lane); const float Lex = Lc - lw; const float mid = lane_bcast(Lc, 31), LL = lane_bcast(Lc, 63);
              const float kk = k8[e] * pKK[e] * kn; const float k2 = k8[e] * (1.f + (et - 1.f) * pKA[e]);
              const float av = valid ? -kk : 0.f, bv = valid ? kk * et : 0.f, rv = valid ? r8[e] : 0.f, kv = valid ? k2 : 0.f;
              fv[q] = valid ? v8[e] : 0.f; fg[q] = valid ? LO[8320 + s * 65 + cc] : 0.f;
              fa[q] = av * __expf(Lex - mid); fr[q] = rv * __expf(Lc - mid); const float ek = __expf(mid - Lc); fk[q] = kv * ek; fb[q] = bv * ek;
              frh[q] = rv * __expf(Lc); const float eh = __expf(LL - Lc);
              if (s == 0) gSC[p * 8 + e] = __expf(LL);
              VT[(p * 8 + e) * 72 + s] = (bf16_t)f2bf(fv[q]); KhT[(p * 8 + e) * 72 + s] = (bf16_t)f2bf(kv * eh); R2T[(p * 8 + e) * 72 + s] = (bf16_t)f2bf(av * __expf(Lex));
              gBHT[(p * 8 + e) * 64 + s] = (bf16_t)f2bf(bv * eh); }
          const int co = p * 8 + 2 * e2;
          *(LAS unsigned*)(AR + s * 72 + co) = pk2(fa[0], fa[1]); *(LAS unsigned*)(AR + (64 + s) * 72 + co) = pk2(fr[0], fr[1]);
          *(LAS unsigned*)(KB + s * 72 + co) = pk2(fk[0], fk[1]); *(LAS unsigned*)(KB + (64 + s) * 72 + co) = pk2(fb[0], fb[1]);
          *(unsigned*)(gRH + s * 64 + co) = pk2(frh[0], frh[1]); *(unsigned*)(gV + s * 64 + co) = pk2(fv[0], fv[1]); *(unsigned*)(gG + s * 64 + co) = pk2(fg[0], fg[1]);
          asm volatile("" ::: "memory"); } }
    lds_barrier();
    { f32x4 acc[8][1];
#pragma unroll
      for (int j = 0; j < 8; ++j) acc[j][0] = (f32x4){0.f, 0.f, 0.f, 0.f};
      mma_lds<8, 1, 2>(acc, KB, 72, 0, AR, 72, 16 * w, lane);
      const int t = 16 * (w & 3) + (lane & 15);
#pragma unroll
      for (int j = 0; j < 8; ++j) { const int s0 = 16 * (j & 3) + 4 * (lane >> 4); float x[4];
#pragma unroll
          for (int r = 0; r < 4; ++r) x[r] = (w < 4 ? s0 + r < t : s0 + r <= t) ? acc[j][0][r] : 0.f;
          if (j < 4) { u32x2 o; o.x = pk2(x[0], x[1]); o.y = pk2(x[2], x[3]); *(LAS u32x2*)(AkR + ((w < 4 ? 0 : 64) + t) * 72 + s0) = o; }
          else if (w < 4) {
#pragma unroll
              for (int r = 0; r < 4; ++r) Am[t * 65 + s0 + r] = -x[r]; }
          else { u32x2 o; o.x = pk2(x[0], x[1]); o.y = pk2(x[2], x[3]); *(u32x2*)(gARB + t * 64 + s0) = o; } } }
    lds_barrier();
    tri_inv64(Am, Tm, Xt, tid, w, Tb);
    { const int mt = w & 3, nh = w >> 2; f32x4 av[1][2], yv[1][2], kv[1][2];
#pragma unroll
      for (int j = 0; j < 2; ++j) { av[0][j] = (f32x4){0.f, 0.f, 0.f, 0.f}; yv[0][j] = av[0][j]; kv[0][j] = av[0][j]; }
      mma_lds<1, 2, 2>(av, AkR, 72, 16 * mt, VT, 72, 32 * nh, lane);
      mma_lds<1, 2, 2>(yv, VT, 72, 16 * mt, AkR, 72, 64 + 32 * nh, lane);
      mma_lds<1, 2, 2>(kv, KhT, 72, 16 * mt, VT, 72, 32 * nh, lane);
#pragma unroll
      for (int j = 0; j < 2; ++j) { u32x2 o; const int cj = 32 * nh + 16 * j + (lane & 15), r0 = 16 * mt + 4 * (lane >> 4);
          o.x = pk2(av[0][j][0], av[0][j][1]); o.y = pk2(av[0][j][2], av[0][j][3]); *(LAS u32x2*)(R2T + (64 + cj) * 72 + r0) = o;
          o.x = pk2(yv[0][j][0], yv[0][j][1]); o.y = pk2(yv[0][j][2], yv[0][j][3]); *(u32x2*)(gYV + cj * 64 + r0) = o;
          o.x = pk2(kv[0][j][0], kv[0][j][1]); o.y = pk2(kv[0][j][2], kv[0][j][3]); *(u32x2*)(gKVT + cj * 64 + r0) = o; } }
    lds_barrier();
    { const int mt = w & 3, nh = w >> 2; f32x4 ta[1][2], pv[1][2];
#pragma unroll
      for (int j = 0; j < 2; ++j) { ta[0][j] = (f32x4){0.f, 0.f, 0.f, 0.f}; pv[0][j] = ta[0][j]; }
      mma_lds<1, 2, 2>(ta, R2T, 72, 16 * mt, Tb, 72, 32 * nh, lane);
      mma_lds<1, 2, 2>(pv, Tb, 72, 16 * mt, R2T, 72, 64 + 32 * nh, lane);
#pragma unroll
      for (int j = 0; j < 2; ++j) { u32x2 o; const int cj = 32 * nh + 16 * j + (lane & 15), r0 = 16 * mt + 4 * (lane >> 4);
          o.x = pk2(ta[0][j][0], ta[0][j][1]); o.y = pk2(ta[0][j][2], ta[0][j][3]); *(u32x2*)(gTA + cj * 64 + r0) = o;
          o.x = pk2(pv[0][j][0], pv[0][j][1]); o.y = pk2(pv[0][j][2], pv[0][j][3]); *(u32x2*)(gPVT + cj * 64 + r0) = o; } }
    lds_barrier();
}

__device__ __forceinline__ void rwkv_seq_unit(const Ctx& c, int l, int b, int h) {
    int w = c.wave; asm volatile("" : "+s"(w)); const int lane = hw_lane(), tid = w * 64 + lane;
    bf16_t* YBR = (bf16_t*)(c.ws + WS_YBR); const bf16_t* PROJ = (const bf16_t*)(c.ws + WS_PROJ);
    LAS bf16_t* TA = (LAS bf16_t*)c.lds; LAS bf16_t* RH = TA + 64 * 72; LAS bf16_t* ARB = RH + 64 * 72; LAS bf16_t* BHT = ARB + 64 * 72; LAS bf16_t* HT = BHT + 64 * 72; LAS bf16_t* PT = HT + 64 * 72;
    LAS float* ssc = (LAS float*)(PT + 64 * 72); LAS float* rsum = ssc + 128; LAS float* rsq = rsum + 128;
    for (int i = tid; i < 64 * 72; i += NTHR) HT[i] = 0;
    const int kt = w & 3, vh = w >> 2;
    f32x4 Hst[1][2]; Hst[0][0] = (f32x4){0.f, 0.f, 0.f, 0.f}; Hst[0][1] = Hst[0][0];
    f32x4 lnw[2], lnb[2];
#pragma unroll
    for (int i = 0; i < 2; ++i) { lnw[i] = *(const f32x4*)(inp(c, I_LNW) + l * 1024 + h * 64 + 32 * vh + 16 * i + 4 * (lane >> 4)); lnb[i] = *(const f32x4*)(inp(c, I_LNB) + l * 1024 + h * 64 + 32 * vh + 16 * i + 4 * (lane >> 4)); }
    u32x4 pT[3], pR[3], pAB[3], pBH[3]; float psc[3] = {0.f, 0.f, 0.f}; u32x2 pPV[3][2], pYV[3][2], pKV[3][2], pVV[3][2], pGG[3][2];
#define RW_ISSUE(cc, S_) do { const int u_ = (b * HC + h) * NCH + (cc); const bf16_t* gU_ = (const bf16_t*)(c.ws + WS_RW) + (size_t)u_ * RW_N * 4096; const float* gSC_ = (const float*)(c.ws + WS_RW_SC) + (size_t)u_ * 128; \
        const int o_ = (tid >> 3) * 64 + (tid & 7) * 8; pT[S_] = *(const u32x4*)(gU_ + RW_TA * 4096 + o_); pR[S_] = *(const u32x4*)(gU_ + RW_RH * 4096 + o_); pAB[S_] = *(const u32x4*)(gU_ + RW_ARB * 4096 + o_); pBH[S_] = *(const u32x4*)(gU_ + RW_BHT * 4096 + o_); \
        psc[S_] = tid < 128 ? gSC_[tid] : 0.f; \
        _Pragma("unroll") for (int j_ = 0; j_ < 2; ++j_) { const int dv_ = 32 * vh + 16 * j_ + (lane & 15), q4_ = 16 * kt + 4 * (lane >> 4); const int tc_ = 16 * kt + (lane & 15), dv0_ = 32 * vh + 16 * j_ + 4 * (lane >> 4); \
            pPV[S_][j_] = *(const u32x2*)(gU_ + RW_PVT * 4096 + dv_ * 64 + q4_); pKV[S_][j_] = *(const u32x2*)(gU_ + RW_KVT * 4096 + dv_ * 64 + q4_); \
            pYV[S_][j_] = *(const u32x2*)(gU_ + RW_YV * 4096 + tc_ * 64 + dv0_); pVV[S_][j_] = *(const u32x2*)(gU_ + RW_V * 4096 + tc_ * 64 + dv0_); pGG[S_][j_] = *(const u32x2*)(gU_ + RW_G * 4096 + tc_ * 64 + dv0_); } } while (0)
#define RW_CHUNK(cch, S) do { \
        int t0, Lv; chunk_range((cch), t0, Lv); \
        const size_t row0 = (size_t)b * TP + t0; \
        { const int o = (tid >> 3) * 72 + (tid & 7) * 8; *(LAS u32x4*)(TA + o) = pT[S]; *(LAS u32x4*)(RH + o) = pR[S]; *(LAS u32x4*)(ARB + o) = pAB[S]; *(LAS u32x4*)(BHT + o) = pBH[S]; } \
        if (tid < 128) ssc[tid] = psc[S]; \
        const u32x2 cPV0 = pPV[S][0], cPV1 = pPV[S][1], cYV0 = pYV[S][0], cYV1 = pYV[S][1], cKV0 = pKV[S][0], cKV1 = pKV[S][1], cVV0 = pVV[S][0], cVV1 = pVV[S][1], cGG0 = pGG[S][0], cGG1 = pGG[S][1]; \
        if ((cch) + 3 < NCH) RW_ISSUE((cch) + 3, S); \
        lds_barrier(); \
        f32x4 ay[2][1]; \
        { f32x4 ap[1][2]; ap[0][0] = (f32x4){0.f, 0.f, 0.f, 0.f}; ap[0][1] = ap[0][0]; ay[0][0] = ap[0][0]; ay[1][0] = ap[0][0]; \
          mma_lds<1, 2, 2>(ap, TA, 72, 16 * kt, HT, 72, 32 * vh, lane); \
          mma_lds<2, 1, 2>(ay, HT, 72, 32 * vh, RH, 72, 16 * kt, lane); \
        _Pragma("unroll") \
          for (int j = 0; j < 2; ++j) { const int dv = 32 * vh + 16 * j + (lane & 15), tq = 16 * kt + 4 * (lane >> 4); const u32x2 pv = j == 0 ? cPV0 : cPV1; \
              u32x2 o; o.x = pk2(ap[0][j][0] + __uint_as_float(pv.x << 16), ap[0][j][1] + __uint_as_float(pv.x & 0xffff0000u)); o.y = pk2(ap[0][j][2] + __uint_as_float(pv.y << 16), ap[0][j][3] + __uint_as_float(pv.y & 0xffff0000u)); \
              *(LAS u32x2*)(PT + dv * 72 + tq) = o; } \
        _Pragma("unroll") \
          for (int i = 0; i < 2; ++i) { const int tcol = 16 * kt + (lane & 15), dv0 = 32 * vh + 16 * i + 4 * (lane >> 4); const u32x2 yv = i == 0 ? cYV0 : cYV1; \
              ay[i][0][0] += __uint_as_float(yv.x << 16); ay[i][0][1] += __uint_as_float(yv.x & 0xffff0000u); ay[i][0][2] += __uint_as_float(yv.y << 16); ay[i][0][3] += __uint_as_float(yv.y & 0xffff0000u); } } \
        lds_barrier(); \
        { mma_lds<2, 1, 2>(ay, PT, 72, 32 * vh, ARB, 72, 16 * kt, lane); \
        _Pragma("unroll") \
          for (int j = 0; j < 2; ++j) { const int dv = 32 * vh + 16 * j + (lane & 15), dk0 = 16 * kt + 4 * (lane >> 4); const u32x2 kv = j == 0 ? cKV0 : cKV1; \
              Hst[0][j][0] = Hst[0][j][0] * ssc[dk0] + __uint_as_float(kv.x << 16); Hst[0][j][1] = Hst[0][j][1] * ssc[dk0 + 1] + __uint_as_float(kv.x & 0xffff0000u); \
              Hst[0][j][2] = Hst[0][j][2] * ssc[dk0 + 2] + __uint_as_float(kv.y << 16); Hst[0][j][3] = Hst[0][j][3] * ssc[dk0 + 3] + __uint_as_float(kv.y & 0xffff0000u); } \
          mma_lds<1, 2, 2>(Hst, BHT, 72, 16 * kt, PT, 72, 32 * vh, lane); \
        _Pragma("unroll") \
          for (int j = 0; j < 2; ++j) { u32x2 o; o.x = pk2(Hst[0][j][0], Hst[0][j][1]); o.y = pk2(Hst[0][j][2], Hst[0][j][3]); *(LAS u32x2*)(HT + (32 * vh + 16 * j + (lane & 15)) * 72 + 16 * kt + 4 * (lane >> 4)) = o; } \
          const int tcol = 16 * kt + (lane & 15); \
          float sm = 0.f, sq = 0.f; \
        _Pragma("unroll") \
          for (int i = 0; i < 2; ++i) \
        _Pragma("unroll") \
              for (int r = 0; r < 4; ++r) { sm += ay[i][0][r]; sq += ay[i][0][r] * ay[i][0][r]; } \
          sm += __shfl_xor(sm, 16); sm += __shfl_xor(sm, 32); sq += __shfl_xor(sq, 16); sq += __shfl_xor(sq, 32); \
          if (lane < 16) { rsum[vh * 64 + tcol] = sm; rsq[vh * 64 + tcol] = sq; } \
          lds_barrier(); \
          const float mean = (rsum[tcol] + rsum[64 + tcol]) * (1.f / 64.f); const float var = fmaxf((rsq[tcol] + rsq[64 + tcol]) * (1.f / 64.f) - mean * mean, 0.f); const float rstd = rsqrtf(var + 64e-5f); \
          const float bon = ssc[64 + tcol]; \
          if (tcol < Lv) { \
        _Pragma("unroll") \
              for (int i = 0; i < 2; ++i) { const int dv0 = 32 * vh + 16 * i + 4 * (lane >> 4); const u32x2 vv = i == 0 ? cVV0 : cVV1, gg = i == 0 ? cGG0 : cGG1; \
                  const float o0 = ((ay[i][0][0] - mean) * rstd * lnw[i][0] + lnb[i][0] + bon * __uint_as_float(vv.x << 16)) * __uint_as_float(gg.x << 16); \
                  const float o1 = ((ay[i][0][1] - mean) * rstd * lnw[i][1] + lnb[i][1] + bon * __uint_as_float(vv.x & 0xffff0000u)) * __uint_as_float(gg.x & 0xffff0000u); \
                  const float o2 = ((ay[i][0][2] - mean) * rstd * lnw[i][2] + lnb[i][2] + bon * __uint_as_float(vv.y << 16)) * __uint_as_float(gg.y << 16); \
                  const float o3 = ((ay[i][0][3] - mean) * rstd * lnw[i][3] + lnb[i][3] + bon * __uint_as_float(vv.y & 0xffff0000u)) * __uint_as_float(gg.y & 0xffff0000u); \
                  u32x2 o; o.x = pk2(o0, o1); o.y = pk2(o2, o3); *(u32x2*)(YBR + (row0 + tcol) * YLD + 2048 + h * 64 + dv0) = o; } } } \
        lds_barrier(); \
    } while (0)
    RW_ISSUE(0, 0); RW_ISSUE(1, 1); RW_ISSUE(2, 2);
    lds_barrier();
    for (int cch = 0; cch < NCH; cch += 3) { RW_CHUNK(cch, 0); RW_CHUNK(cch + 1, 1); RW_CHUNK(cch + 2, 2); }
#undef RW_CHUNK
#undef RW_ISSUE
    const int lane_e = hw_lane(), tid_e = w * 64 + lane_e;
    float* os = c.out + O_PRS + (((size_t)l * BATCH + b) * HC + h) * DHC * DHC;
#pragma unroll
    for (int j = 0; j < 2; ++j) *(f32x4*)(os + (size_t)(32 * vh + 16 * j + (lane_e & 15)) * 64 + 16 * kt + 4 * (lane_e >> 4)) = Hst[0][j];
    { float* osh = c.out + O_PRSH + ((size_t)l * BATCH + b) * NCC; const bf16_t* last = PROJ + ((size_t)b * TP + TP - 1) * NPROJ + PC0;
      int cidx = -1;
      if (tid_e < 64) cidx = h * 64 + tid_e; else if (tid_e < 128) cidx = 1024 + h * 64 + (tid_e - 64); else if (tid_e < 192) cidx = 2048 + h * 64 + (tid_e - 128); else if (tid_e < 448 && h == 0) cidx = 3072 + (tid_e - 192);
      if (cidx >= 0) osh[cidx] = bf2f(last[cidx]); }
    lds_barrier();
}

__device__ __forceinline__ void mlstm_post_rows(const Ctx& c, int l, int bb, int h, int vs) {
    int w = c.wave; asm volatile("" : "+s"(w)); const int lane = hw_lane();
    const float* HAo = (const float*)(c.ws + WS_HA); const bf16_t* PROJ = (const bf16_t*)(c.ws + WS_PROJ); bf16_t* YBR = (bf16_t*)(c.ws + WS_YBR);
    const f32x4 wv = *(const f32x4*)(inp(c, I_MNW) + l * 1024 + h * 256 + 4 * lane);
    constexpr int RQ = TP / 4;
    const size_t row0 = (size_t)bb * TP + (size_t)vs * RQ;
#pragma unroll 1
    for (int i = w; i < RQ; i += 4 * NWAVES) {
        f32x4 v[4]; u32x2 og[4];
#pragma unroll
        for (int k = 0; k < 4; ++k) { const int ii = i + NWAVES * k < RQ ? i + NWAVES * k : i; const size_t row = row0 + ii;
            v[k] = *(const f32x4*)(HAo + row * 1024 + h * 256 + 4 * lane); og[k] = *(const u32x2*)(PROJ + row * NPROJ + PA_O + h * 256 + 4 * lane); }
#pragma unroll
        for (int k = 0; k < 4; ++k) { if (i + NWAVES * k >= RQ) continue; const size_t row = row0 + i + NWAVES * k;
            const float ss = wave_sum((v[k].x * v[k].x + v[k].y * v[k].y) + (v[k].z * v[k].z + v[k].w * v[k].w)); const float rs = rsqrtf(ss * (1.f / 256.f) + 1e-6f);
            const float o0 = sigmoidf_(__uint_as_float(og[k].x << 16)), o1 = sigmoidf_(__uint_as_float(og[k].x & 0xffff0000u)), o2 = sigmoidf_(__uint_as_float(og[k].y << 16)), o3 = sigmoidf_(__uint_as_float(og[k].y & 0xffff0000u));
            u32x2 o; o.x = pk2(o0 * v[k].x * rs * wv.x, o1 * v[k].y * rs * wv.y); o.y = pk2(o2 * v[k].z * rs * wv.z, o3 * v[k].w * rs * wv.w);
            *(u32x2*)(YBR + row * YLD + h * 256 + 4 * lane) = o; }
    }
}
__device__ __forceinline__ void phase_mix_prep(const Ctx& c, int l) {
    unsigned* qctr = (unsigned*)(c.ws + WS_CTL) + 8192 + (12 + 3 * l) * 64;
    volatile LAS unsigned* MISC = (volatile LAS unsigned*)(c.lds + LDS_MISC);
#define QBEGIN(k, n) int qn_ = 0; if (c.wave == 0 && hw_lane() == 0) qn_ = (int)__hip_atomic_fetch_add(qctr + 64 * (k), (unsigned)(n), __ATOMIC_RELAXED, __HIP_MEMORY_SCOPE_AGENT)
#define QNEXT(k, n) ({ lds_barrier(); if (c.wave == 0 && hw_lane() == 0) MISC[12] = (unsigned)qn_; lds_barrier(); const int u_ = (int)MISC[12]; \
        if (c.wave == 0 && hw_lane() == 0) qn_ = (int)__hip_atomic_fetch_add(qctr + 64 * (k), (unsigned)(n), __ATOMIC_RELAXED, __HIP_MEMORY_SCOPE_AGENT); u_; })
#ifndef NO_RWP
    { QBEGIN(0, 1); for (;;) { const int u = QNEXT(0, 1); if (u >= NU_RW) break; rwkv_prep_unit(c, l, u); } }
#endif
#ifndef ONLY_RWP
    { QBEGIN(1, 1); for (;;) { const int u = QNEXT(1, 1); if (u >= NU_ML) break; mlstm_prep_unit(c, l, u); } }
    { QBEGIN(2, 1); for (;;) { const int u = QNEXT(2, 1); if (u >= NU_GD) break; gdn_prep_unit(c, l, u); } }
#endif
#if TAILCONV
    { QBEGIN(6 - 2 * l, 8); for (;;) { const int u = QNEXT(6 - 2 * l, 8); if (u >= WBR_DYN) break; convert_one(c, l, CO_BR + WBR_G1 + u + c.wave); } }
#endif
}

__device__ __forceinline__ void phase_mix_seq(const Ctx& c, int l, int rep = 0) {
    constexpr int W_ML = BATCH * HA * 4, W_GD = BATCH * HB, W_RW = BATCH * HC, NPU = W_ML + W_GD + W_RW;
    const int b = c.bid;
    if (b < W_ML && (rep < 2 || rep == 2)) mlstm_seq_unit(c, l, b >> 4, (b >> 2) & 3, b & 3);
    if (b < W_ML && rep == 0) {
        mini_barrier((unsigned*)(c.ws + WS_CTL) + 8192 + (32 + 16 * l + (b >> 2)) * 64, 4u, c.wave);
        mlstm_post_rows(c, l, b >> 4, (b >> 2) & 3, b & 3); }
    if (b >= W_ML && b < W_ML + W_GD && (rep < 2 || rep == 3)) { const int r = b - W_ML; gdn_seq_unit(c, l, r / HB, r % HB); }
#ifndef NO_RWS
    if (b >= W_ML + W_GD && b < NPU && (rep < 2 || rep == 4)) { const int r = b - W_ML - W_GD; rwkv_seq_unit(c, l, r / HC, r % HC); }
#endif
    unsigned* qctr = (unsigned*)(c.ws + WS_CTL) + 8192 + (3 * l + 6 * (rep == 1 ? 1 : 0)) * 64;
    volatile LAS unsigned* MISC = (volatile LAS unsigned*)(c.lds + LDS_MISC);
    { QBEGIN(0, 1); for (;;) { const int u = QNEXT(0, 1); if (u >= NB * HA) break; mlstm_unit_s(c, l, u / HA, u % HA); } }
    { QBEGIN(1, 2); for (;;) { const int u0 = QNEXT(1, 2); if (u0 >= NB * HB) break;
        for (int u = u0; u < u0 + 2 && u < NB * HB; ++u) gdn_unit_s(c, l, u / HB, u % HB); } }
    int cached_h = -1;
    { QBEGIN(2, 4); for (;;) { const int u0 = QNEXT(2, 4); if (u0 >= NB * HC) break;
        rwkv_unit4(c, l, u0 % NB, u0 / NB, cached_h); } }
#undef QBEGIN
#undef QNEXT
}

__device__ __forceinline__ void phase_combine(const Ctx& c0, const int nblk) {
    Ctx c = c0; c.lane = hw_lane(); c.tid = c.wave * 64 + c.lane; c.G = nblk;
    const u32x4* B = (const u32x4*)(c.ws + WS_MRGF); u32x4* M = (u32x4*)(c.ws + WS_MRG);
    constexpr size_t NV = (size_t)MP * D / 8, V0 = (size_t)8192 * D / 8;
    for (size_t i = V0 + (size_t)c.bid * NTHR + c.tid; i < NV; i += (size_t)c.G * NTHR * 2) {
        const size_t i2 = i + (size_t)c.G * NTHR; const bool two = i2 < NV;
        u32x4 a[2][3];
#pragma unroll
        for (int z = 0; z < 3; ++z) { a[0][z] = B[i + z * NV]; a[1][z] = two ? B[i2 + z * NV] : (u32x4){0u, 0u, 0u, 0u}; }
#pragma unroll
        for (int q = 0; q < 2; ++q) { u32x4 o; unsigned* po = (unsigned*)&o;
            const unsigned* p0 = (const unsigned*)&a[q][0]; const unsigned* p1 = (const unsigned*)&a[q][1]; const unsigned* p2 = (const unsigned*)&a[q][2];
#pragma unroll
            for (int e = 0; e < 4; ++e) po[e] = pk2(__uint_as_float(p0[e] << 16) + __uint_as_float(p1[e] << 16) + __uint_as_float(p2[e] << 16),
                                                   __uint_as_float(p0[e] & 0xffff0000u) + __uint_as_float(p1[e] & 0xffff0000u) + __uint_as_float(p2[e] & 0xffff0000u));
            if (q == 0) M[i] = o; else if (two) M[i2] = o; }
    }
}

#define IN(k) (lo <= (k) && (k) < hi)
#ifdef ONLY_G
#define GSEL(k) ((k) == ONLY_G)
#else
#define GSEL(k) true
#endif
#if MK_MULTI
#define SEAM(k) do { } while (0)
#else
#define SEAM(k) do { if (IN(k) && IN((k) + 1)) xcd_barrier(bar, c.wave); } while (0)
#endif
template <int L> __device__ __forceinline__ void layer_phases(const Ctx& c, const XcdBarrier& bar, const int lo, const int hi) {
    constexpr int pb = 1 + 10 * L;
#ifndef SKIP_NORM
    if (IN(pb + 0)) { phase_norm_gates<L == 0>(c, inp(c, I_NMIX) + (size_t)L * D, (const float*)(c.ws + WS_WSG) + (size_t)L * NSG * D); if (REP_MISC > 1) phase_norm_gates<L == 0>(c, inp(c, I_NMIX) + (size_t)L * D, (const float*)(c.ws + WS_WSG) + (size_t)L * NSG * D); }
#endif
    SEAM(pb + 0);
    if (IN(pb + 1) && GSEL(1)) {
        pg8::Gemm<D, D, D> g{(const bf16_t*)(c.ws + WS_HN), (const bf16_t*)(c.ws + WS_WIN) + (size_t)L * NPROJ * D};
        pg8::TileOrder<MP, NPROJ, 1> S; S.init(c.G, c.bid);
        pg8::EpiBf16<0> E{(bf16_t*)(c.ws + WS_PROJ), NPROJ};
        pg8::gemm_phase(c.lds, c.wave, g, S, E);
        if (REP_G1 > 1) pg8::gemm_phase(c.lds, c.wave, g, S, E);
#if TAILCONV
        convert_items(c, L, CO_BR, CO_BR + WBR_G1, (33 * 69) % c.G);
#endif
    }
    SEAM(pb + 1);
#ifndef SKIP_MIX
    if (IN(pb + 2)) { phase_mix_prep(c, L); if (REP_PREP > 1) phase_mix_prep(c, L); }
    SEAM(pb + 2);
#ifndef ONLY_RWP
    if (IN(pb + 3)) { phase_mix_seq(c, L); if (REP_SEQ > 1) { xcd_barrier(bar, c.wave); phase_mix_seq(c, L, REP_SEQ == 2 ? 1 : REP_SEQ == 3 ? 0 : REP_SEQ - 2); } }
#endif
    SEAM(pb + 3);
#endif
    if (IN(pb + 5) && GSEL(3)) {
        pg8::Gemm<YLD, 1024, 1024, 1024 * 2, (long)D * 1024 * 2> g{(const bf16_t*)(c.ws + WS_YBR), (const bf16_t*)(c.ws + WS_WBR) + (size_t)L * 3 * D * 1024};
        { pg8::TileOrder<8192, D, 3> S; S.init(c.G, c.bid);
          pg8::EpiGateAcc E{(const bf16_t*)(c.ws + WS_PROJ) + PG0, NPROJ, (bf16_t*)(c.ws + WS_MRG), D};
          pg8::gemm_phase(c.lds, c.wave, g, S, E); }
        { pg8::TailOrder<32, D, 3> S; S.init(c.G, c.bid);
          pg8::EpiGateBf16 E{(const bf16_t*)(c.ws + WS_PROJ) + PG0, NPROJ, (bf16_t*)(c.ws + WS_MRGF), D, (size_t)MP * D};
          pg8::gemm_phase(c.lds, c.wave, g, S, E); }
#if TAILCONV
        convert_items(c, L, CO_O, CO_U + CI_U / 4, (3 * 8) % c.G);
#endif
        if (c.G >= 24) {
            if (c.bid < 24) { unsigned* ctr = (unsigned*)(c.ws + WS_CTL) + 8192 + (96 + L) * 64; wg_signal(ctr, c.wave); wg_wait(ctr, 24u, c.wave); phase_combine(c, 24); }
        } else { xcd_barrier(bar, c.wave); phase_combine(c, c.G); }
    }
    SEAM(pb + 5);
    if (IN(pb + 6) && GSEL(4)) {
        pg8::Gemm<D, D, D> g{(const bf16_t*)(c.ws + WS_MRG), (const bf16_t*)(c.ws + WS_WOUT) + (size_t)L * D * D};
        pg8::TileOrder<MP, D, 1> S; S.init(c.G, c.bid);
        if (L == 0) { pg8::EpiResidSrc E{inp(c, I_META), inp(c, I_XP), inp(c, I_XS), (float*)(c.ws + WS_X), D}; pg8::gemm_phase(c.lds, c.wave, g, S, E); }
        else { pg8::EpiResid E{(const float*)(c.ws + WS_X), (float*)(c.ws + WS_X), D}; pg8::gemm_phase(c.lds, c.wave, g, S, E); }
#if TAILCONV
        convert_items(c, L, CO_U + CI_U / 4, CO_D, (33 * 8) % c.G);
#endif
    }
    SEAM(pb + 6);
#ifndef SKIP_NORM
    if (IN(pb + 7)) { phase_norm<false>(c, inp(c, I_NMLP) + (size_t)L * D, nullptr); if (REP_MISC > 1) phase_norm<false>(c, inp(c, I_NMLP) + (size_t)L * D, nullptr); }
#endif
    SEAM(pb + 7);
    if (IN(pb + 8) && GSEL(6)) {
        pg8::Gemm<D, D, D> g{(const bf16_t*)(c.ws + WS_HN), (const bf16_t*)(c.ws + WS_WUP) + (size_t)L * DFF * D};
        pg8::TileOrder<MP, DFF, 1> S; S.init(c.G, c.bid);
        pg8::EpiBf16<1> E{(bf16_t*)(c.ws + WS_PROJ), DFF};
        pg8::gemm_phase(c.lds, c.wave, g, S, E);
#if TAILCONV
        convert_items(c, L, CO_D, C_PER_L, (33 * 32) % c.G);
#endif
    }
    SEAM(pb + 8);
    if (IN(pb + 9) && GSEL(7)) {
        pg8::Gemm<DFF, DFF, DFF> g{(const bf16_t*)(c.ws + WS_PROJ), (const bf16_t*)(c.ws + WS_WDN) + (size_t)L * D * DFF};
        pg8::TileOrder<8192, D, 1> S; S.init(c.G, c.bid);
        pg8::EpiResid E{(const float*)(c.ws + WS_X), (float*)(c.ws + WS_X), D};
        pg8::gemm_phase(c.lds, c.wave, g, S, E);
        unsigned* pdone = (unsigned*)(c.ws + WS_CTL) + 8192 + 64 * 64;
        const bool fin_tail = FIN_IN_TAIL && L == 1 && c.G == 256;
        if (fin_tail) { pg8::Unit u0; if (S.next(0, u0)) wg_signal(pdone + 64 * u0.pm, c.wave); }
        const pg8::StreamX sx{(float*)(c.ws + WS_SLOTS), (unsigned*)(c.ws + WS_CTL) + FLAG_W0 + (3 * L + 2) * 256 * 64, (unsigned*)(c.ws + WS_CTL) + 4096 + XB_TMO};
        pg8::SplitOrder<32, D, 4, 32> S2; S2.init(c.G, c.bid);
        pg8::gemm_phase(c.lds, c.wave, g, S2, E, sx);
        if (c.bid >= 32 && c.bid < 40) pg8::split_reduce<0>(c.wave, (float*)(c.ws + WS_X), nullptr, D, sx, 32, c.bid - 32, 8, 4);
#if TAILCONV
        if (L == 0) convert_items(c, 1, 0, CI_IN, 40);
#endif
        if (fin_tail && c.bid >= 40) {
            const int r = c.bid - 40, p = r & 31, k = r >> 5, cnt = (216 - p + 31) >> 5;
            wg_wait(pdone + 64 * p, 8u, c.wave);
            final_rows(c, 256 * p, 256 * p + 256, k * NWAVES + c.wave, cnt * NWAVES);
        }
    }
    SEAM(pb + 9);
}

__global__ void __launch_bounds__(NTHR, 2) mega(Params p) {
    extern __shared__ __attribute__((aligned(16))) unsigned char lds_raw[];
    Ctx c{p.out, p.ws, (LAS unsigned char*)lds_raw, (int)threadIdx.x, (int)(threadIdx.x & 63), __builtin_amdgcn_readfirstlane((int)(threadIdx.x >> 6)), (int)gridDim.x, (int)blockIdx.x};
    volatile LAS unsigned* MISC = (volatile LAS unsigned*)(c.lds + LDS_MISC);
    if (c.tid < 16) MISC[c.tid] = 0u;
    if (c.tid < 38) ((LAS unsigned long long*)(c.lds + LDS_MISC + 64))[c.tid] = (unsigned long long)p.in[c.tid];
    __syncthreads();
    unsigned* barw = (unsigned*)(c.ws + WS_CTL) + 4096;
    XcdBarrier bar; bar.bar = barw; bar.x = 0; bar.st = MISC + 8;
#if !MK_MULTI
    bar = xcd_barrier_post(barw, MISC + 8);
#endif
    const int lo = p.ph_lo, hi = p.ph_hi;
#ifndef SKIP_PREP
    if (IN(0)) { phase_prep(c); if (REP_MISC > 1) phase_prep(c); }
#endif
    SEAM(0);
    layer_phases<0>(c, bar, lo, hi);
    layer_phases<1>(c, bar, lo, hi);
#ifndef SKIP_NORM
    if (IN(21)) { phase_final(c); if (REP_MISC > 1) phase_final(c); }
#endif
}
#undef IN
#undef SEAM

extern "C" void kernel_launch(void* const* d_in, const int* in_sizes, int n_in, void* d_out, int out_size, void* d_ws, size_t ws_size, hipStream_t stream) {
    static int grid = 0;
    if (grid == 0) {
        if (n_in != 38 || (size_t)out_size != O_END || ws_size < WS_END) { fprintf(stderr, "kernel_launch: unexpected shapes (n_in %d out %d ws %zu need %zu)\n", n_in, out_size, ws_size, (size_t)WS_END); grid = -1; return; }
        int dev = 0, cus = 0, per_cu = 0;
        if (hipGetDevice(&dev) != hipSuccess || hipDeviceGetAttribute(&cus, hipDeviceAttributeMultiprocessorCount, dev) != hipSuccess) { grid = -1; return; }
        if (hipFuncSetAttribute((const void*)mega, hipFuncAttributeMaxDynamicSharedMemorySize, LDS_BYTES) != hipSuccess) { fprintf(stderr, "kernel_launch: hipFuncSetAttribute failed\n"); grid = -1; return; }
        if (hipOccupancyMaxActiveBlocksPerMultiprocessor(&per_cu, (const void*)mega, NTHR, LDS_BYTES) != hipSuccess || per_cu < 1) { fprintf(stderr, "kernel_launch: occupancy query says %d\n", per_cu); (void)hipGetLastError(); grid = -1; return; }
        grid = cus;
    }
    if (grid < 0) return;
    (void)hipMemsetAsync((char*)d_ws + WS_CTL, 0, CTL_BYTES, stream);
    Params p{};
    for (int i = 0; i < 38; ++i) p.in[i] = (const float*)d_in[i];
    p.out = (float*)d_out; p.ws = (unsigned char*)d_ws;
#if MK_MULTI
    for (int k = 0; k < NPHASE; ++k) { p.ph_lo = k; p.ph_hi = k + 1; hipLaunchKernelGGL(mega, dim3(grid), dim3(NTHR), LDS_BYTES, stream, p); }
#else
    p.ph_lo = 0; p.ph_hi = NPHASE;
    hipLaunchKernelGGL(mega, dim3(grid), dim3(NTHR), LDS_BYTES, stream, p);
#endif
}
```

```cpp
#include <hip/hip_runtime.h>
#include <cstdio>
#include <cstdint>

#ifndef MK_MULTI
#define MK_MULTI 0
#endif

#ifndef REP_PREP
#define REP_PREP 1
#endif
#ifndef REP_MISC
#define REP_MISC 1
#endif
#ifndef REP_SEQ
#define REP_SEQ 1
#endif
#ifndef REP_G1
#define REP_G1 1
#endif
#ifndef REP_G4
#define REP_G4 1
#endif
#define LAS __attribute__((address_space(3)))
#define GAS __attribute__((address_space(1)))
typedef unsigned short bf16_t;
typedef short bf16x8 __attribute__((ext_vector_type(8)));
typedef float f32x4 __attribute__((ext_vector_type(4)));
typedef float f32x2 __attribute__((ext_vector_type(2)));
typedef unsigned u32x4 __attribute__((ext_vector_type(4)));
typedef unsigned u32x2 __attribute__((ext_vector_type(2)));

constexpr int D = 2048, BATCH = 4, SEQ = 2048, NMETA = 16, TP = SEQ + NMETA, NB = 128;
constexpr int MPROMPT = BATCH * TP;
constexpr int MREAL = MPROMPT + NB;
constexpr int MP = 8448;
constexpr int NSEQ = BATCH + NB;
constexpr int HA = 4, DHA = 256, HB = 8, DHB = 128, HC = 16, DHC = 64;
constexpr int NCC = 3328, NIN = 17688, NPROJ = 17664, DFF = 8192;
constexpr int PA_Q = 0, PA_K = 1024, PA_V = 2048, PA_O = 3072, PB_QKV = 4096, PB_Z = 7168, PC0 = 8192, PG0 = 11520;
constexpr int NSG = 24, SGLD = 32;
constexpr int YLD = 3072;

constexpr size_t O_YP = 0;
constexpr size_t O_YS = O_YP + (size_t)BATCH * SEQ * D;
constexpr size_t O_PC = O_YS + (size_t)NB * D;
constexpr size_t O_PN = O_PC + (size_t)2 * BATCH * HA * DHA * DHA;
constexpr size_t O_PM = O_PN + (size_t)2 * BATCH * HA * DHA;
constexpr size_t O_PGS = O_PM + (size_t)2 * BATCH * HA;
constexpr size_t O_PGC = O_PGS + (size_t)2 * BATCH * HB * DHB * DHB;
constexpr size_t O_PRS = O_PGC + (size_t)2 * BATCH * 3 * 3072;
constexpr size_t O_PRSH = O_PRS + (size_t)2 * BATCH * HC * DHC * DHC;
constexpr size_t O_SC = O_PRSH + (size_t)2 * BATCH * NCC;
constexpr size_t O_SN = O_SC + (size_t)2 * NB * HA * DHA * DHA;
constexpr size_t O_SM = O_SN + (size_t)2 * NB * HA * DHA;
constexpr size_t O_SGS = O_SM + (size_t)2 * NB * HA;
constexpr size_t O_SGC = O_SGS + (size_t)2 * NB * HB * DHB * DHB;
constexpr size_t O_SRS = O_SGC + (size_t)2 * NB * 3 * 3072;
constexpr size_t O_SRSH = O_SRS + (size_t)2 * NB * HC * DHC * DHC;
constexpr size_t O_END = O_SRSH + (size_t)2 * NB * NCC;
static_assert(O_END == 141732896ull, "output size");

constexpr size_t AL(size_t x) { return (x + 255) & ~(size_t)255; }
constexpr size_t WS_CTL = 0, CTL_BYTES = 1u << 20;
constexpr size_t WS_WIN = CTL_BYTES;
constexpr size_t WS_WSG = AL(WS_WIN + (size_t)2 * NPROJ * D * 2);
constexpr size_t WS_WBR = AL(WS_WSG + (size_t)2 * NSG * D * 4);
constexpr size_t WS_WOUT = AL(WS_WBR + (size_t)2 * 3 * D * 1024 * 2);
constexpr size_t WS_WUP = AL(WS_WOUT + (size_t)2 * D * D * 2);
constexpr size_t WS_WDN = AL(WS_WUP + (size_t)2 * DFF * D * 2);
constexpr size_t WS_X = AL(WS_WDN + (size_t)2 * D * DFF * 2);
constexpr size_t WS_HN = AL(WS_X + (size_t)MP * D * 4);
constexpr size_t WS_SG = AL(WS_HN + (size_t)MP * D * 2);
constexpr size_t WS_YBR = AL(WS_SG + (size_t)MP * SGLD * 4);
constexpr size_t WS_MRG = AL(WS_YBR + (size_t)MP * YLD * 2);
constexpr size_t WS_PROJ = AL(WS_MRG + (size_t)MP * D * 2);
constexpr size_t WS_MRGF = AL(WS_PROJ + (size_t)MP * NPROJ * 2);
constexpr int NCH = 33;
constexpr int NU_ML = BATCH * HA * NCH, NU_GD = BATCH * HB * NCH, NU_RW = BATCH * HC * NCH;
constexpr size_t WS_ML_KTW = WS_MRGF;
constexpr size_t WS_ML_VT = AL(WS_ML_KTW + (size_t)NU_ML * 256 * 64 * 2);
constexpr size_t WS_ML_NP = AL(WS_ML_VT + (size_t)NU_ML * 256 * 64 * 2);
constexpr size_t WS_ML_SC = AL(WS_ML_NP + (size_t)NU_ML * 64 * 256 * 4);
constexpr size_t WS_HA = AL(WS_ML_SC + (size_t)NU_ML * 256 * 4);
constexpr size_t WS_GD_W = AL(WS_HA + (size_t)MPROMPT * 1024 * 4);
constexpr size_t WS_GD_UT = AL(WS_GD_W + (size_t)NU_GD * 64 * 128 * 2);
constexpr size_t WS_GD_AT = AL(WS_GD_UT + (size_t)NU_GD * 128 * 64 * 2);
constexpr size_t WS_GD_Q = AL(WS_GD_AT + (size_t)NU_GD * 64 * 64 * 2);
constexpr size_t WS_GD_KD = AL(WS_GD_Q + (size_t)NU_GD * 64 * 128 * 2);
constexpr size_t WS_GD_SC = AL(WS_GD_KD + (size_t)NU_GD * 128 * 64 * 2);
constexpr size_t WS_RW = AL(WS_GD_SC + (size_t)NU_GD * 128 * 4);
enum { RW_TA = 0  , RW_PVT  , RW_RH  , RW_YV  , RW_ARB  , RW_BHT  , RW_KVT  , RW_V  , RW_G  , RW_N };
constexpr size_t WS_RW_SC = AL(WS_RW + (size_t)NU_RW * RW_N * 4096 * 2);
constexpr size_t WS_MIX_END = AL(WS_RW_SC + (size_t)NU_RW * 128 * 4);
constexpr size_t WS_SLOTS = WS_MRGF;
constexpr int FLAG_W0 = 16384;
static_assert((size_t)(FLAG_W0 + 6 * 256 * 64) * 4 <= CTL_BYTES && WS_SLOTS + (size_t)256 * 65536 * 4 <= WS_MIX_END, "stream-K scratch");
constexpr size_t WS_END = WS_MIX_END > AL(WS_MRGF + (size_t)MP * D * 4) ? WS_MIX_END : AL(WS_MRGF + (size_t)MP * D * 4);
static_assert((size_t)MP * DFF * 2 <= (size_t)MP * NPROJ * 2, "U overlays PROJ");

__device__ __forceinline__ float bf2f(bf16_t b) { return __uint_as_float(((unsigned)b) << 16); }
typedef __bf16 bf16x2_t __attribute__((ext_vector_type(2)));
__device__ __forceinline__ unsigned pk2(float lo, float hi) { const f32x2 v = {lo, hi}; return __builtin_bit_cast(unsigned, __builtin_convertvector(v, bf16x2_t)); }
__device__ __forceinline__ unsigned f2bf(float f) { return pk2(f, 0.f) & 0xffffu; }
__device__ __forceinline__ float sigmoidf_(float x) { return __builtin_amdgcn_rcpf(1.f + __expf(-x)); }
__device__ __forceinline__ float softplusf_(float x) { const float e = __expf(x); return x > 15.f ? x : (e < 1e-3f ? e * (1.f - 0.5f * e) : __logf(1.f + e)); }
__device__ __forceinline__ float siluf_(float x) { return x * __builtin_amdgcn_rcpf(1.f + __expf(-x)); }
__device__ __forceinline__ float fsigmoid(float x) { return __builtin_amdgcn_rcpf(1.f + __expf(-x)); }
__device__ __forceinline__ float fsoftplus(float x) { return x > 15.f ? x : __logf(1.f + __expf(x)); }
__device__ __forceinline__ float ftanh(float x) { return 1.f - 2.f * __builtin_amdgcn_rcpf(1.f + __expf(2.f * x)); }
__device__ __forceinline__ int hw_lane() { int l; asm volatile("v_mbcnt_lo_u32_b32 %0, -1, 0\n\tv_mbcnt_hi_u32_b32 %0, -1, %0" : "=v"(l)); return l; }
template <int CTRL, int ROWMASK>
__device__ __forceinline__ float dpp_mov(float old, float src) {
    return __builtin_bit_cast(float, __builtin_amdgcn_update_dpp(__builtin_bit_cast(int, old), __builtin_bit_cast(int, src), CTRL, ROWMASK, 0xf, false));
}
__device__ __forceinline__ float lane_bcast(float v, int l) { return __builtin_bit_cast(float, __builtin_amdgcn_readlane(__builtin_bit_cast(int, v), l)); }
__device__ __forceinline__ float wave_scan_sum(float v) {
    v += dpp_mov<0x111, 0xf>(0.f, v); v += dpp_mov<0x112, 0xf>(0.f, v); v += dpp_mov<0x114, 0xf>(0.f, v); v += dpp_mov<0x118, 0xf>(0.f, v);
    v += dpp_mov<0x142, 0xa>(0.f, v); v += dpp_mov<0x143, 0xc>(0.f, v);
    return v;
}
__device__ __forceinline__ float wave_sum(float v) { return lane_bcast(wave_scan_sum(v), 63); }
__device__ __forceinline__ float row16_sum(float v) {
    v += dpp_mov<0x121, 0xf>(0.f, v); v += dpp_mov<0x122, 0xf>(0.f, v); v += dpp_mov<0x124, 0xf>(0.f, v); v += dpp_mov<0x128, 0xf>(0.f, v);
    return v;
}
__device__ __forceinline__ void lds_barrier() { asm volatile("s_waitcnt lgkmcnt(0)" ::: "memory"); __builtin_amdgcn_s_barrier(); asm volatile("" ::: "memory"); }
__device__ __forceinline__ float block_sum(float v, LAS float* sc, const int wave) {
    v = wave_sum(v);
    if (hw_lane() == 0) sc[wave] = v;
    lds_barrier();
    float r = 0.f;
#pragma unroll
    for (int i = 0; i < 8; ++i) r += sc[i];
    lds_barrier();
    return r;
}

#define XB_TMO      128
#define XB_XCNT(j)  (256  + 64 * (j))
#define XB_XSUB(j)  (1280 + 64 * (j))
#define XB_XGEN(j)  (2304 + 64 * (j))
#define XB_TOP      3328
#define XB_TOPGEN   3392
#define XCD_BAR_WORDS 3456
#define XB_SPIN_CAP (1u << 22)

__device__ __forceinline__ unsigned xb_ld(unsigned* p)              { return __hip_atomic_load(p, __ATOMIC_RELAXED, __HIP_MEMORY_SCOPE_AGENT); }
__device__ __forceinline__ unsigned xb_add(unsigned* p, unsigned v) { return __hip_atomic_fetch_add(p, v, __ATOMIC_RELAXED, __HIP_MEMORY_SCOPE_AGENT); }
__device__ __forceinline__ unsigned xb_xcc_id() { return (unsigned)__builtin_amdgcn_s_getreg((3 << 11) | 20) & 0xFu; }
#define XB_SPIN(cond, bar) do { unsigned _sp = 0; while (cond) { __builtin_amdgcn_s_sleep(1); \
    if ((++_sp & 255u) == 0u) { if (xb_ld(&(bar)[XB_TMO])) break; if (_sp > XB_SPIN_CAP) { atomicAdd(&(bar)[XB_TMO], 1u); break; } } } } while (0)

struct XcdBarrier { unsigned* bar; unsigned x; volatile LAS unsigned* st; };

__device__ __forceinline__ XcdBarrier xcd_barrier_post(unsigned* bar, volatile LAS unsigned* st) {
    XcdBarrier b; b.bar = bar; b.x = xb_xcc_id(); b.st = st;
    if (threadIdx.x == 0) (void)xb_add(&bar[XB_XCNT(b.x)], 1u);
    return b;
}
__device__ __forceinline__ void xcd_barrier_complete(unsigned* bar, unsigned x, unsigned& nloc, unsigned& nx) {
    const unsigned G = gridDim.x * gridDim.y * gridDim.z;
    unsigned sum, cnt, mine, sp = 0u;
    for (;;) {
        sum = 0u; cnt = 0u; mine = 0u;
#pragma unroll
        for (unsigned j = 0; j < 16; ++j) { const unsigned c = xb_ld(&bar[XB_XCNT(j)]); sum += c; cnt += (c > 0u) ? 1u : 0u; mine = (j == x) ? c : mine; }
        if (sum == G) break;
        __builtin_amdgcn_s_sleep(1);
        if ((++sp & 255u) == 0u) { if (xb_ld(&bar[XB_TMO])) break; if (sp > XB_SPIN_CAP) { atomicAdd(&bar[XB_TMO], 1u); break; } }
    }
    nloc = mine > 0u ? mine : 1u; nx = cnt > 0u ? cnt : 1u;
}
__device__ __forceinline__ void xcd_barrier(const XcdBarrier& b, const int wave) {
    asm volatile("s_waitcnt vmcnt(0)" ::: "memory");
    __syncthreads();
    if (wave == 0 && hw_lane() == 0) {
        unsigned* bar = b.bar;
        __builtin_amdgcn_s_waitcnt(0);
        unsigned nloc = b.st[0], nx = b.st[1];
        if (nloc == 0u) { xcd_barrier_complete(bar, b.x, nloc, nx); b.st[0] = nloc; b.st[1] = nx; }
        const unsigned old = xb_add(&bar[XB_XSUB(b.x)], 1u);
        const unsigned gen = old / nloc;
        if (old + 1u == (gen + 1u) * nloc) {
            __builtin_amdgcn_fence(__ATOMIC_RELEASE, "agent");
            asm volatile("s_waitcnt vmcnt(0)" ::: "memory");
            const unsigned og = xb_add(&bar[XB_TOP], 1u);
            const unsigned tg = og / nx;
            if (og + 1u == (tg + 1u) * nx) xb_add(&bar[XB_TOPGEN], 1u);
            else XB_SPIN(xb_ld(&bar[XB_TOPGEN]) == tg, bar);
            __builtin_amdgcn_fence(__ATOMIC_ACQUIRE, "agent");
            xb_add(&bar[XB_XGEN(b.x)], 1u);
            asm volatile("s_waitcnt vmcnt(0)" ::: "memory");
        } else {
            XB_SPIN(xb_ld(&bar[XB_XGEN(b.x)]) == gen, bar);
            __builtin_amdgcn_fence(__ATOMIC_ACQUIRE, "agent");
            asm volatile("s_waitcnt vmcnt(0)" ::: "memory");
        }
    }
    __syncthreads();
}

__device__ __forceinline__ void mini_barrier(unsigned* ctr, unsigned n, const int wave) {
    asm volatile("s_waitcnt vmcnt(0)" ::: "memory");
    __syncthreads();
    if (wave == 0 && hw_lane() == 0) {
        __builtin_amdgcn_fence(__ATOMIC_RELEASE, "agent");
        asm volatile("s_waitcnt vmcnt(0)" ::: "memory");
        (void)xb_add(ctr, 1u);
        unsigned sp = 0u;
        while (xb_ld(ctr) < n) { __builtin_amdgcn_s_sleep(1); if (++sp > XB_SPIN_CAP) break; }
        __builtin_amdgcn_fence(__ATOMIC_ACQUIRE, "agent");
        asm volatile("s_waitcnt vmcnt(0)" ::: "memory");
    }
    __syncthreads();
}

__device__ __forceinline__ void wg_signal(unsigned* ctr, const int wave) {
    asm volatile("s_waitcnt vmcnt(0)" ::: "memory");
    __syncthreads();
    if (wave == 0 && hw_lane() == 0) { __builtin_amdgcn_fence(__ATOMIC_RELEASE, "agent"); asm volatile("s_waitcnt vmcnt(0)" ::: "memory"); (void)xb_add(ctr, 1u); }
}
__device__ __forceinline__ void wg_wait(unsigned* ctr, unsigned n, const int wave) {
    if (wave == 0 && hw_lane() == 0) { unsigned sp = 0u;
        while (xb_ld(ctr) < n) { __builtin_amdgcn_s_sleep(1); if (++sp > XB_SPIN_CAP) break; }
        __builtin_amdgcn_fence(__ATOMIC_ACQUIRE, "agent");
        asm volatile("s_waitcnt vmcnt(0)" ::: "memory"); }
    __syncthreads();
}

__device__ __forceinline__ const float* x0_row(const float* meta, const float* xp, const float* xs, int row) {
    const int b = row / TP, t = row - b * TP;
    const float* p = t < NMETA ? meta + (size_t)t * D : xp + ((size_t)b * SEQ + (t - NMETA)) * D;
    if (row >= MPROMPT) p = row < MREAL ? xs + (size_t)(row - MPROMPT) * D : meta;
    return p;
}
namespace pg8 {
constexpr int BM = 256, BK = 64, HALF = 128, HTB = HALF * BK * 2, STAGE_BYTES = 8 * HTB, NXCD = 8, WGM = 8;
__host__ __device__ __forceinline__ int lds_byte(int r, int c) { const int st = (r >> 4) * 2 + (c >> 5), rr = r & 15, cc = c & 31, ob = rr * 64 + cc * 2; return st * 1024 + (ob ^ (((ob >> 9) & 1) << 5)); }
__host__ __device__ __forceinline__ void stage_rc(int b, int& R, int& C) { const int st = b / 1024, sb = b % 1024, swz = sb ^ (((sb >> 9) & 1) << 5); R = (st >> 1) * 16 + swz / 64; C = (st & 1) * 32 + (swz % 64) / 2; }
__host__ __device__ __forceinline__ int perm32(int rho) { const int n = rho >> 4, i = rho & 15; return 8 * (i >> 2) + 4 * n + (i & 3); }

struct Unit { int pm, pn, z, kb, kn, role; };
template <int LDA_, int LDB_, int K_, long ZSA_ = 0, long ZSB_ = 0> struct Gemm { static constexpr int lda = LDA_, ldb = LDB_, K = K_; static constexpr size_t zsA = (size_t)ZSA_, zsB = (size_t)ZSB_; const bf16_t* A; const bf16_t* Bt; };

template <int M_, int N_, int NZ_> struct TileOrder {
    static constexpr bool STREAM = false;
    static constexpr int nM = M_ / BM, nN = N_ / BM, nz = NZ_, nwg = nM * nN;
    int G, c;
    __device__ void init(int G_, int c_) { G = G_; c = c_; }
    __device__ __forceinline__ bool next(int i, Unit& u) const {
        u.kb = 0; u.kn = 0; u.role = 0;
        const int ti = i / nz; u.z = i - ti * nz;
        const long L = (long)ti * G + c; if (L >= nwg) return false;
        int wgid = (int)L; { const int q = nwg / NXCD, r = nwg % NXCD, xcd = wgid % NXCD, off = wgid / NXCD; wgid = (xcd < r ? xcd * (q + 1) : r * (q + 1) + (xcd - r) * q) + off; }
        const int nig = WGM * nN, gid = wgid / nig, fm = gid * WGM, gsz = (nM - fm) < WGM ? (nM - fm) : WGM;
        u.pm = fm + ((wgid % nig) % gsz); u.pn = (wgid % nig) / gsz; return true;
    }
};

template <int M_, int N_, int NT_> struct StreamOrder {
    static constexpr bool STREAM = true;
    static constexpr int nN = N_ / BM, nU = (M_ / BM) * nN, UQ = NT_ / 4, Q = nU * UQ;
    int G, c, start, share;
    __device__ void init(int G_, int c_) { G = G_; c = c_; const int base = Q / G_, rem = Q % G_; share = base + (c_ < rem ? 1 : 0); start = c_ * base + (c_ < rem ? c_ : rem); }
    __device__ __forceinline__ bool next(int i, Unit& u) const {
        int p = start; const int e = start + share;
        for (int idx = 0; p < e; ++idx) { const int uu = p / UQ, off = p - uu * UQ; const int len = (UQ - off) < (e - p) ? (UQ - off) : (e - p);
            if (idx == i) { u.pm = uu / nN; u.pn = uu - u.pm * nN; u.z = 0; u.kb = 4 * off; u.kn = 4 * len; u.role = off > 0 ? 1 : (len < UQ ? 2 : 0); return true; }
            p += len; }
        return false;
    }
};
template <int M_, int N_, int NZ_> struct FlatOrder {
    static constexpr bool STREAM = false;
    static constexpr int nM = M_ / BM, nN = N_ / BM, nwg = nM * nN;
    int G, c;
    __device__ void init(int G_, int c_) { G = G_; c = c_; }
    __device__ __forceinline__ bool next(int i, Unit& u) const {
        u.kb = 0; u.kn = 0; u.role = 0;
        const int L = i * G + c; if (L >= nwg * NZ_) return false;
        u.z = L / nwg; int wgid = L - u.z * nwg;
        { const int q = nwg / NXCD, r = nwg % NXCD, xcd = wgid % NXCD, off = wgid / NXCD; wgid = (xcd < r ? xcd * (q + 1) : r * (q + 1) + (xcd - r) * q) + off; }
        const int nig = WGM * nN, gid = wgid / nig, fm = gid * WGM, gsz = (nM - fm) < WGM ? (nM - fm) : WGM;
        u.pm = fm + ((wgid % nig) % gsz); u.pn = (wgid % nig) / gsz; return true;
    }
};
template <int PM_, int N_, int NZ_> struct TailOrder {
    static constexpr bool STREAM = false;
    static constexpr int nN = N_ / BM;
    int G, c;
    __device__ void init(int G_, int c_) { G = G_; c = c_; }
    __device__ __forceinline__ bool next(int i, Unit& u) const { const int L = i * G + c; if (L >= nN * NZ_) return false; u.pm = PM_; u.pn = L % nN; u.z = L / nN; u.kb = 0; u.kn = 0; u.role = 0; return true; }
};
template <int PM_, int N_, int NP_, int KP_> struct SplitOrder {
    static constexpr bool STREAM = true;
    static constexpr int nN = N_ / BM, nprod = nN * NP_;
    int G, c;
    __device__ void init(int G_, int c_) { G = G_; c = c_; }
    __device__ __forceinline__ bool next(int i, Unit& u) const { if (i > 0 || c >= nprod) return false; u.pm = PM_; u.pn = c % nN; u.z = 0; u.kb = KP_ * (c / nN); u.kn = KP_; u.role = 1; return true; }
};
struct StreamX { float* slots; unsigned* flags; unsigned* tmo; };

__device__ __forceinline__ unsigned cvt_pk_bf16(float lo, float hi) { unsigned r; asm volatile("v_cvt_pk_bf16_f32 %0, %1, %2" : "=v"(r) : "v"(lo), "v"(hi)); return r; }

template <int ACT> struct EpiBf16 {
    static constexpr bool PERM = true;
    bf16_t* O; int ldc;
    __device__ __forceinline__ void operator()(const f32x4 (&acc)[2][2][4][2], const Unit& u, int wr, int wc, int fr, int fq) const {
        const int row0 = u.pm * BM + wr * 64 + fr; const int col0 = u.pn * BM + wc * 32 + 8 * fq;
#pragma unroll
        for (int ai = 0; ai < 2; ++ai)
#pragma unroll
            for (int m = 0; m < 4; ++m) { bf16_t* rowp = O + (size_t)(row0 + ai * HALF + m * 16) * ldc + col0;
#pragma unroll
                for (int bj = 0; bj < 2; ++bj) { f32x4 v0 = acc[ai][bj][m][0], v1 = acc[ai][bj][m][1];
                    if (ACT == 1) {
#pragma unroll
                        for (int j = 0; j < 4; ++j) { const float a = fmaxf(v0[j], 0.f), b = fmaxf(v1[j], 0.f); v0[j] = a * a; v1[j] = b * b; } }
                    u32x4 w; w.x = cvt_pk_bf16(v0[0], v0[1]); w.y = cvt_pk_bf16(v0[2], v0[3]); w.z = cvt_pk_bf16(v1[0], v1[1]); w.w = cvt_pk_bf16(v1[2], v1[3]);
                    *(u32x4*)(rowp + bj * HALF) = w; } }
    }
};
struct EpiGateBf16 {
    static constexpr bool PERM = true;
    const bf16_t* PG; int ldg; bf16_t* O; int ldc; size_t zstride;
    __device__ __forceinline__ void operator()(const f32x4 (&acc)[2][2][4][2], const Unit& u, int wr, int wc, int fr, int fq) const {
        const int row0 = u.pm * BM + wr * 64 + fr; const int col0 = u.pn * BM + wc * 32 + 8 * fq;
        bf16_t* Oz = O + (size_t)u.z * zstride;
#pragma unroll
        for (int ai = 0; ai < 2; ++ai)
#pragma unroll
            for (int m2 = 0; m2 < 2; ++m2) { u32x4 g[2][2];
#pragma unroll
                for (int mm = 0; mm < 2; ++mm)
#pragma unroll
                    for (int bj = 0; bj < 2; ++bj) g[mm][bj] = *(const u32x4*)(PG + (size_t)(row0 + ai * HALF + (2 * m2 + mm) * 16) * ldg + (size_t)u.z * 2048 + col0 + bj * HALF);
#pragma unroll
                for (int mm = 0; mm < 2; ++mm)
#pragma unroll
                    for (int bj = 0; bj < 2; ++bj) { const int m = 2 * m2 + mm; const u32x4 gg = g[mm][bj];
                        f32x4 v0 = acc[ai][bj][m][0], v1 = acc[ai][bj][m][1];
                        v0[0] *= fsigmoid(__uint_as_float(gg.x << 16)); v0[1] *= fsigmoid(__uint_as_float(gg.x & 0xffff0000u));
                        v0[2] *= fsigmoid(__uint_as_float(gg.y << 16)); v0[3] *= fsigmoid(__uint_as_float(gg.y & 0xffff0000u));
                        v1[0] *= fsigmoid(__uint_as_float(gg.z << 16)); v1[1] *= fsigmoid(__uint_as_float(gg.z & 0xffff0000u));
                        v1[2] *= fsigmoid(__uint_as_float(gg.w << 16)); v1[3] *= fsigmoid(__uint_as_float(gg.w & 0xffff0000u));
                        u32x4 w; w.x = cvt_pk_bf16(v0[0], v0[1]); w.y = cvt_pk_bf16(v0[2], v0[3]); w.z = cvt_pk_bf16(v1[0], v1[1]); w.w = cvt_pk_bf16(v1[2], v1[3]);
                        *(u32x4*)(Oz + (size_t)(row0 + ai * HALF + m * 16) * ldc + col0 + bj * HALF) = w; } }
    }
};
struct EpiGateAcc {
    static constexpr bool PERM = true;
    const bf16_t* PG; int ldg; bf16_t* O; int ldc;
    __device__ __forceinline__ void operator()(const f32x4 (&acc)[2][2][4][2], const Unit& u, int wr, int wc, int fr, int fq) const {
        const int row0 = u.pm * BM + wr * 64 + fr; const int col0 = u.pn * BM + wc * 32 + 8 * fq;
        const bool first = u.z == 0;
#pragma unroll
        for (int ai = 0; ai < 2; ++ai)
#pragma unroll
            for (int m2 = 0; m2 < 2; ++m2) { u32x4 g[2][2], p[2][2];
#pragma unroll
                for (int mm = 0; mm < 2; ++mm)
#pragma unroll
                    for (int bj = 0; bj < 2; ++bj) { const size_t row = (size_t)(row0 + ai * HALF + (2 * m2 + mm) * 16);
                        g[mm][bj] = *(const u32x4*)(PG + row * ldg + (size_t)u.z * 2048 + col0 + bj * HALF);
                        p[mm][bj] = (u32x4){0u, 0u, 0u, 0u};
                        if (!first) p[mm][bj] = *(const u32x4*)(O + row * ldc + col0 + bj * HALF); }
#pragma unroll
                for (int mm = 0; mm < 2; ++mm)
#pragma unroll
                    for (int bj = 0; bj < 2; ++bj) { const int m = 2 * m2 + mm; const u32x4 gg = g[mm][bj], pp = p[mm][bj];
                        f32x4 v0 = acc[ai][bj][m][0], v1 = acc[ai][bj][m][1];
                        v0[0] = v0[0] * fsigmoid(__uint_as_float(gg.x << 16)) + __uint_as_float(pp.x << 16); v0[1] = v0[1] * fsigmoid(__uint_as_float(gg.x & 0xffff0000u)) + __uint_as_float(pp.x & 0xffff0000u);
                        v0[2] = v0[2] * fsigmoid(__uint_as_float(gg.y << 16)) + __uint_as_float(pp.y << 16); v0[3] = v0[3] * fsigmoid(__uint_as_float(gg.y & 0xffff0000u)) + __uint_as_float(pp.y & 0xffff0000u);
                        v1[0] = v1[0] * fsigmoid(__uint_as_float(gg.z << 16)) + __uint_as_float(pp.z << 16); v1[1] = v1[1] * fsigmoid(__uint_as_float(gg.z & 0xffff0000u)) + __uint_as_float(pp.z & 0xffff0000u);
                        v1[2] = v1[2] * fsigmoid(__uint_as_float(gg.w << 16)) + __uint_as_float(pp.w << 16); v1[3] = v1[3] * fsigmoid(__uint_as_float(gg.w & 0xffff0000u)) + __uint_as_float(pp.w & 0xffff0000u);
                        u32x4 w; w.x = cvt_pk_bf16(v0[0], v0[1]); w.y = cvt_pk_bf16(v0[2], v0[3]); w.z = cvt_pk_bf16(v1[0], v1[1]); w.w = cvt_pk_bf16(v1[2], v1[3]);
                        *(u32x4*)(O + (size_t)(row0 + ai * HALF + m * 16) * ldc + col0 + bj * HALF) = w; }
                asm volatile("" ::: "memory"); }
    }
};
struct EpiGate {
    static constexpr bool PERM = true;
    const bf16_t* PG; int ldg;
    float* F; bf16_t* O; int ldc;
    __device__ __forceinline__ void operator()(const f32x4 (&acc)[2][2][4][2], const Unit& u, int wr, int wc, int fr, int fq) const {
        const int row0 = u.pm * BM + wr * 64 + fr; const int col0 = u.pn * BM + wc * 32 + 8 * fq;
#pragma unroll
        for (int ai = 0; ai < 2; ++ai)
#pragma unroll
            for (int m = 0; m < 4; ++m) { const size_t row = (size_t)(row0 + ai * HALF + m * 16);
                u32x4 g[2]; f32x4 f0[2], f1[2];
#pragma unroll
                for (int bj = 0; bj < 2; ++bj) { const int col = col0 + bj * HALF; g[bj] = *(const u32x4*)(PG + row * ldg + (size_t)u.z * 2048 + col);
                    f0[bj] = (f32x4){0.f, 0.f, 0.f, 0.f}; f1[bj] = f0[bj];
                    if (u.z > 0) { const float* fp = F + row * ldc + col; f0[bj] = *(const f32x4*)fp; f1[bj] = *(const f32x4*)(fp + 4); } }
#pragma unroll
                for (int bj = 0; bj < 2; ++bj) { const int col = col0 + bj * HALF;
                    f32x4 v0 = acc[ai][bj][m][0], v1 = acc[ai][bj][m][1];
                    v0[0] *= fsigmoid(__uint_as_float(g[bj].x << 16)); v0[1] *= fsigmoid(__uint_as_float(g[bj].x & 0xffff0000u));
                    v0[2] *= fsigmoid(__uint_as_float(g[bj].y << 16)); v0[3] *= fsigmoid(__uint_as_float(g[bj].y & 0xffff0000u));
                    v1[0] *= fsigmoid(__uint_as_float(g[bj].z << 16)); v1[1] *= fsigmoid(__uint_as_float(g[bj].z & 0xffff0000u));
                    v1[2] *= fsigmoid(__uint_as_float(g[bj].w << 16)); v1[3] *= fsigmoid(__uint_as_float(g[bj].w & 0xffff0000u));
                    v0 += f0[bj]; v1 += f1[bj];
                    float* fp = F + row * ldc + col;
                    if (u.z < 2) { *(f32x4*)fp = v0; *(f32x4*)(fp + 4) = v1; }
                    else { u32x4 w; w.x = cvt_pk_bf16(v0[0], v0[1]); w.y = cvt_pk_bf16(v0[2], v0[3]); w.z = cvt_pk_bf16(v1[0], v1[1]); w.w = cvt_pk_bf16(v1[2], v1[3]);
                           *(u32x4*)(O + row * ldc + col) = w; } } }
    }
};
struct EpiResid {
    static constexpr bool PERM = false;
    const float* Xin; float* Xout; int ldc;
    __device__ __forceinline__ void operator()(const f32x4 (&acc)[2][2][4][2], const Unit& u, int wr, int wc, int fr, int fq) const {
        const int row0 = u.pm * BM + wr * 64 + fr, col0 = u.pn * BM + wc * 32 + 4 * fq;
#pragma unroll
        for (int ai = 0; ai < 2; ++ai)
#pragma unroll
            for (int m = 0; m < 4; ++m) { f32x4 t[2][2]; const size_t ro = (size_t)(row0 + ai * HALF + m * 16) * ldc + col0;
#pragma unroll
                for (int bj = 0; bj < 2; ++bj)
#pragma unroll
                    for (int n = 0; n < 2; ++n) t[bj][n] = *(const f32x4*)(Xin + ro + bj * HALF + n * 16);
#pragma unroll
                for (int bj = 0; bj < 2; ++bj)
#pragma unroll
                    for (int n = 0; n < 2; ++n) *(f32x4*)(Xout + ro + bj * HALF + n * 16) = t[bj][n] + acc[ai][bj][m][n];
                asm volatile("" ::: "memory"); }
    }
};

struct EpiResidSrc {
    static constexpr bool PERM = false;
    const float* meta; const float* xp; const float* xs; float* Xout; int ldc;
    __device__ __forceinline__ void operator()(const f32x4 (&acc)[2][2][4][2], const Unit& u, int wr, int wc, int fr, int fq) const {
        const int row0 = u.pm * BM + wr * 64 + fr, col0 = u.pn * BM + wc * 32 + 4 * fq;
#pragma unroll
        for (int ai = 0; ai < 2; ++ai)
#pragma unroll
            for (int m = 0; m < 4; ++m) { f32x4 t[2][2]; const int row = row0 + ai * HALF + m * 16; const size_t ro = (size_t)row * ldc + col0;
                const float* src = x0_row(meta, xp, xs, row) + col0;
#pragma unroll
                for (int bj = 0; bj < 2; ++bj)
#pragma unroll
                    for (int n = 0; n < 2; ++n) t[bj][n] = *(const f32x4*)(src + bj * HALF + n * 16);
#pragma unroll
                for (int bj = 0; bj < 2; ++bj)
#pragma unroll
                    for (int n = 0; n < 2; ++n) *(f32x4*)(Xout + ro + bj * HALF + n * 16) = t[bj][n] + acc[ai][bj][m][n];
                asm volatile("" ::: "memory"); }
    }
};

template <int MODE>
__device__ __forceinline__ void split_reduce(const int wid, float* X, bf16_t* U, int ldc, const StreamX sx, int pm, int pn, int nN, int NP) {
    const int lane = hw_lane(), tid = wid * 64 + lane, wr = wid >> 2, wc = wid & 3, fr = lane & 15, fq = lane >> 4;
    if (wid == 0) {
#pragma unroll 1
        for (int j = 0; j < NP; ++j) { unsigned sp = 0;
            while ((unsigned)__builtin_amdgcn_readfirstlane(__hip_atomic_load(sx.flags + 64 * (pn + nN * j), __ATOMIC_RELAXED, __HIP_MEMORY_SCOPE_AGENT)) != 1u) {
                __builtin_amdgcn_s_sleep(1);
                if ((++sp & 255u) == 0u) { if (__builtin_amdgcn_readfirstlane(__hip_atomic_load(sx.tmo, __ATOMIC_RELAXED, __HIP_MEMORY_SCOPE_AGENT))) break; if (sp > (1u << 20)) { if (lane == 0) __hip_atomic_store(sx.tmo, 1u, __ATOMIC_RELAXED, __HIP_MEMORY_SCOPE_AGENT); break; } } } }
        __builtin_amdgcn_fence(__ATOMIC_ACQUIRE, "agent"); asm volatile("s_waitcnt vmcnt(0)" ::: "memory"); }
    __syncthreads();
    const float* s0 = sx.slots + (size_t)pn * 65536 + tid * 32; const size_t jstride = (size_t)nN * 65536;
#pragma unroll 2
    for (int am = 0; am < 16; ++am) {
        const int a = am >> 3, b = (am >> 2) & 1, m = am & 3;
        f32x4 v0 = (f32x4){0.f, 0.f, 0.f, 0.f}, v1 = v0;
        const float* p = s0 + (am >> 2) * 16384 + (am & 3) * 8;
#pragma unroll 4
        for (int j = 0; j < NP; ++j) { v0 += *(const f32x4*)(p + j * jstride); v1 += *(const f32x4*)(p + j * jstride + 4); }
        const size_t row = (size_t)(pm * BM + a * HALF + wr * 64 + m * 16 + fr);
        if (MODE == 0) { float* xp = X + row * ldc + pn * BM + b * HALF + wc * 32 + 4 * fq;
            *(f32x4*)xp = *(const f32x4*)xp + v0; *(f32x4*)(xp + 16) = *(const f32x4*)(xp + 16) + v1; }
        else {
#pragma unroll
            for (int e = 0; e < 4; ++e) { const float x0 = fmaxf(v0[e], 0.f), x1 = fmaxf(v1[e], 0.f); v0[e] = x0 * x0; v1[e] = x1 * x1; }
            u32x4 w; w.x = cvt_pk_bf16(v0[0], v0[1]); w.y = cvt_pk_bf16(v0[2], v0[3]); w.z = cvt_pk_bf16(v1[0], v1[1]); w.w = cvt_pk_bf16(v1[2], v1[3]);
            *(u32x4*)(U + row * ldc + pn * BM + b * HALF + wc * 32 + 8 * fq) = w; }
    }
    __syncthreads();
}

template <class Epi, class Sched, class GemmT>
__device__ __forceinline__ void gemm_phase(LAS unsigned char* lds, const int wid, const GemmT g, const Sched& S, const Epi& E, const StreamX sx = StreamX{nullptr, nullptr, nullptr}) {
    const int lane = hw_lane(), tid = wid * 64 + lane, wr = wid >> 2, wc = wid & 3, fr = lane & 15, fq = lane >> 4;
    constexpr int K = GemmT::K, nt = K / BK;
    unsigned voffA[2], voffB[2];
#pragma unroll
    for (int i = 0; i < 2; ++i) { int R, C; stage_rc(tid * 16 + i * 8192, R, C); const int Rb = Epi::PERM ? ((R & ~31) + perm32(R & 31)) : R;
        voffA[i] = (unsigned)(R * GemmT::lda + C) * 2u; voffB[i] = (unsigned)(Rb * GemmT::ldb + C) * 2u; }
    constexpr size_t kstep = (size_t)(BK * 2);
    constexpr size_t hstepA = (size_t)HALF * GemmT::lda * 2, hstepB = (size_t)HALF * GemmT::ldb * 2;
    constexpr size_t tstepA = 2 * hstepA, tstepB = 2 * hstepB;
    const unsigned ldsw = (unsigned)wid * 1024u;
    const int aoff = lds_byte(wr * 64 + fr, fq * 8), boff = lds_byte(wc * 32 + fr, fq * 8);
#define PG8_SA(b, h) (((b) * 2 + (h)) * HTB)
#define PG8_SB(b, h) ((4 + (b) * 2 + (h)) * HTB)
#define PG8_STAGE(bufoff, gbase, voff) do { _Pragma("unroll") for (int _i = 0; _i < 2; ++_i) \
        __builtin_amdgcn_global_load_lds((const unsigned*)((const char*)(gbase) + (voff)[_i]), (LAS unsigned*)(lds + (bufoff) + ldsw + _i * 8192), 16, 0, 0); } while (0)
#define PG8_LDA(dst, b, h) do { _Pragma("unroll") for (int m = 0; m < 4; ++m) _Pragma("unroll") for (int k = 0; k < 2; ++k) dst[m][k] = *(const LAS bf16x8*)(lds + PG8_SA(b, h) + aoff + m * 2048 + k * 1024); } while (0)
#define PG8_LDB(dst, b, h) do { _Pragma("unroll") for (int n = 0; n < 2; ++n) _Pragma("unroll") for (int k = 0; k < 2; ++k) dst[n][k] = *(const LAS bf16x8*)(lds + PG8_SB(b, h) + boff + n * 2048 + k * 1024); } while (0)
#define PG8_MMA(ai, bj, At, Bt) do { __builtin_amdgcn_s_setprio(1); _Pragma("unroll") for (int m = 0; m < 4; ++m) _Pragma("unroll") for (int n = 0; n < 2; ++n) _Pragma("unroll") for (int k = 0; k < 2; ++k) \
        acc[ai][bj][m][n] = __builtin_amdgcn_mfma_f32_16x16x32_bf16(Bt[n][k], At[m][k], acc[ai][bj][m][n], 0, 0, 0); __builtin_amdgcn_s_setprio(0); } while (0)
#define PG8_WAIT_V(n) asm volatile("s_waitcnt vmcnt(" #n ")" ::: "memory")
#define PG8_WAIT_L(n) asm volatile("s_waitcnt lgkmcnt(" #n ")" ::: "memory")
#define PG8_BAR __builtin_amdgcn_s_barrier()
#define PG8_SCHED __builtin_amdgcn_sched_barrier(0)
    Unit cur, nxt; int ui = 0;
    if (!S.next(0, cur)) return;
    f32x4 acc[2][2][4][2];
#pragma unroll
    for (int a = 0; a < 2; ++a)
#pragma unroll
        for (int b = 0; b < 2; ++b)
#pragma unroll
            for (int m = 0; m < 4; ++m)
#pragma unroll
                for (int n = 0; n < 2; ++n) acc[a][b][m][n] = (f32x4){0.f, 0.f, 0.f, 0.f};
    bf16x8 At[4][2], B0[2][2], B1[2][2];
    const char* cA = (const char*)g.A + (size_t)cur.pm * tstepA + (size_t)cur.z * GemmT::zsA + (size_t)cur.kb * kstep; const char* cB = (const char*)g.Bt + (size_t)cur.pn * tstepB + (size_t)cur.z * GemmT::zsB + (size_t)cur.kb * kstep;
    PG8_STAGE(PG8_SB(0, 0), cB, voffB); PG8_STAGE(PG8_SB(0, 1), cB + hstepB, voffB); PG8_STAGE(PG8_SA(0, 0), cA, voffA); PG8_STAGE(PG8_SA(0, 1), cA + hstepA, voffA);
    if (wr == 1) PG8_BAR;
    PG8_WAIT_V(2); PG8_BAR;
    PG8_STAGE(PG8_SB(1, 0), cB + kstep, voffB); PG8_STAGE(PG8_SA(1, 0), cA + kstep, voffA); PG8_STAGE(PG8_SB(1, 1), cB + hstepB + kstep, voffB);
    PG8_WAIT_V(6); PG8_BAR;
    for (;;) {
        const bool has_next = S.next(ui + 1, nxt);
        const char* nA = has_next ? (const char*)g.A + (size_t)nxt.pm * tstepA + (size_t)nxt.z * GemmT::zsA + (size_t)nxt.kb * kstep : cA;
        const char* nB = has_next ? (const char*)g.Bt + (size_t)nxt.pn * tstepB + (size_t)nxt.z * GemmT::zsB + (size_t)nxt.kb * kstep : cB;
        const int ntu = Sched::STREAM ? cur.kn : nt;
        for (int t = 0; t < ntu; t += 2) {
            const bool last = (t == ntu - 2);
            const char* a1 = cA + (size_t)(t + 1) * kstep;
            const char* a2 = last ? nA : cA + (size_t)(t + 2) * kstep; const char* b2 = last ? nB : cB + (size_t)(t + 2) * kstep;
            const char* a3 = a2 + kstep; const char* b3 = b2 + kstep;
            PG8_LDB(B0, 0, 0); PG8_LDB(B1, 0, 1); PG8_SCHED; PG8_LDA(At, 0, 0); PG8_STAGE(PG8_SA(1, 1), a1 + hstepA, voffA);
            PG8_WAIT_V(8); PG8_WAIT_L(0); PG8_BAR; PG8_MMA(0, 0, At, B0); PG8_MMA(0, 1, At, B1); PG8_BAR; PG8_SCHED;
            PG8_LDA(At, 0, 1); PG8_STAGE(PG8_SB(0, 0), b2, voffB); PG8_STAGE(PG8_SB(0, 1), b2 + hstepB, voffB); PG8_STAGE(PG8_SA(0, 0), a2, voffA);
            PG8_WAIT_V(8); PG8_WAIT_L(0); PG8_BAR; PG8_MMA(1, 0, At, B0); PG8_MMA(1, 1, At, B1); PG8_BAR; PG8_SCHED;
            PG8_LDB(B0, 1, 0); PG8_LDB(B1, 1, 1); PG8_SCHED; PG8_LDA(At, 1, 0); PG8_STAGE(PG8_SA(0, 1), a2 + hstepA, voffA);
            PG8_WAIT_V(8); PG8_WAIT_L(0); PG8_BAR; PG8_MMA(0, 0, At, B0); PG8_MMA(0, 1, At, B1); PG8_BAR; PG8_SCHED;
            PG8_LDA(At, 1, 1); PG8_STAGE(PG8_SB(1, 0), b3, voffB); PG8_STAGE(PG8_SB(1, 1), b3 + hstepB, voffB); PG8_STAGE(PG8_SA(1, 0), a3, voffA);
            PG8_WAIT_V(8); PG8_WAIT_L(0); PG8_BAR; PG8_MMA(1, 0, At, B0); PG8_MMA(1, 1, At, B1); PG8_BAR; PG8_SCHED;
        }
        if (wr == 0) PG8_BAR;
        const int lane_e = hw_lane(), tid_e = wid * 64 + lane_e, fr_e = lane_e & 15, fq_e = lane_e >> 4;
        if (Sched::STREAM && cur.role == 1) {
            const __amdgpu_buffer_rsrc_t rs = __builtin_amdgcn_make_buffer_rsrc(sx.slots, 0, 256 * 65536 * 4, 0x00020000);
            const unsigned sbase = (unsigned)S.c * 262144u + (unsigned)tid_e * 128u;
#pragma unroll
            for (int a = 0; a < 2; ++a)
#pragma unroll
                for (int b = 0; b < 2; ++b)
#pragma unroll
                    for (int m = 0; m < 4; ++m)
#pragma unroll
                        for (int n = 0; n < 2; ++n) { constexpr int dummy = 0; const int k = ((a * 2 + b) * 4 + m) * 2 + n;
                            __builtin_amdgcn_raw_buffer_store_b128(__builtin_bit_cast(u32x4, acc[a][b][m][n]), rs, sbase + (unsigned)((k >> 3) * 65536), (k & 7) * 16 + dummy, 16); }
            asm volatile("s_waitcnt vmcnt(0)" ::: "memory"); PG8_BAR; asm volatile("" ::: "memory");
            if (tid_e == 0) __hip_atomic_store(sx.flags + 64 * S.c, 1u, __ATOMIC_RELAXED, __HIP_MEMORY_SCOPE_AGENT);
        } else {
            E(acc, cur, wr, wc, fr_e, fq_e);
        }
        if (!has_next) break;
        if (Sched::STREAM && nxt.role == 2) {
            if (wid == 0) { unsigned sp = 0;
                while ((unsigned)__builtin_amdgcn_readfirstlane(__hip_atomic_load(sx.flags + 64 * (S.c + 1), __ATOMIC_RELAXED, __HIP_MEMORY_SCOPE_AGENT)) != 1u) {
                    __builtin_amdgcn_s_sleep(1);
                    if ((++sp & 255u) == 0u) { if (__builtin_amdgcn_readfirstlane(__hip_atomic_load(sx.tmo, __ATOMIC_RELAXED, __HIP_MEMORY_SCOPE_AGENT))) break; if (sp > (1u << 20)) { if (lane == 0) __hip_atomic_store(sx.tmo, 1u, __ATOMIC_RELAXED, __HIP_MEMORY_SCOPE_AGENT); break; } } }
                __builtin_amdgcn_fence(__ATOMIC_ACQUIRE, "agent"); asm volatile("s_waitcnt vmcnt(0)" ::: "memory"); }
            asm volatile("" ::: "memory"); PG8_BAR; asm volatile("" ::: "memory");
            const float* ps = sx.slots + (size_t)(S.c + 1) * 65536 + tid * 32;
#pragma unroll
            for (int a = 0; a < 2; ++a)
#pragma unroll
                for (int b = 0; b < 2; ++b)
#pragma unroll
                    for (int m = 0; m < 4; ++m)
#pragma unroll
                        for (int n = 0; n < 2; ++n) { const int k = ((a * 2 + b) * 4 + m) * 2 + n; acc[a][b][m][n] = *(const f32x4*)(ps + (k >> 3) * 16384 + (k & 7) * 4); }
        } else {
#pragma unroll
        for (int a = 0; a < 2; ++a)
#pragma unroll
            for (int b = 0; b < 2; ++b)
#pragma unroll
                for (int m = 0; m < 4; ++m)
#pragma unroll
                    for (int n = 0; n < 2; ++n) acc[a][b][m][n] = (f32x4){0.f, 0.f, 0.f, 0.f};
        }
        cur = nxt; cA = nA; cB = nB; ++ui;
        if (wr == 1) PG8_BAR;
    }
    PG8_WAIT_V(0);
    PG8_BAR;
#undef PG8_SA
#undef PG8_SB
#undef PG8_STAGE
#undef PG8_LDA
#undef PG8_LDB
#undef PG8_MMA
#undef PG8_WAIT_V
#undef PG8_WAIT_L
#undef PG8_BAR
#undef PG8_SCHED
}
}

constexpr int NWAVES = 8, NTHR = 512;
constexpr int LDS_BYTES = 147456;
constexpr int LDS_MISC = 131072;
constexpr int NPHASE = 22;

struct Params {
    const float* in[38];
    float* out;
    unsigned char* ws;
    int ph_lo, ph_hi;
};
struct Ctx {
    float* out; unsigned char* ws;
    LAS unsigned char* lds;
    int tid, lane, wave, G, bid;
};
__device__ __forceinline__ const float* inp(const Ctx& c, int i);
enum { I_XP = 0, I_XS, I_SC, I_SN, I_SM, I_SGS, I_SGC, I_SRS, I_SRSH, I_META, I_NMIX, I_WIN, I_BI, I_BF, I_MNW, I_CONVW, I_ALOG, I_DTB, I_GNW, I_MU, I_W0, I_W2, I_A0, I_A2, I_G2,
       I_KK, I_KA, I_RK, I_LNW, I_LNB, I_WBA, I_WBB, I_WBC, I_WOUT, I_NMLP, I_WUP, I_WDN, I_FNW };

__device__ __forceinline__ const float* inp(const Ctx& c, int i) {
    const LAS unsigned* t = (const LAS unsigned*)(c.lds + LDS_MISC + 64) + 2 * i;
    const unsigned lo = __builtin_amdgcn_readfirstlane(t[0]), hi = __builtin_amdgcn_readfirstlane(t[1]);
    typedef const float __attribute__((address_space(1)))* gptr_t;
    return (const float*)(gptr_t)(((unsigned long long)hi << 32) | lo);
}
__device__ __forceinline__ void transpose_item(const float* W, int K, int Nsrc, int src_col, bf16_t* WT, int dst_row, int k0, LAS float* scr, int lane) {
    float v[32];
    const float* src = W + (size_t)(k0 + (lane >> 5)) * Nsrc + src_col + (lane & 31);
#pragma unroll
    for (int i = 0; i < 32; ++i) v[i] = src[(size_t)(2 * i) * Nsrc];
#pragma unroll
    for (int i = 0; i < 32; ++i) scr[(2 * i + (lane >> 5)) * 33 + (lane & 31)] = v[i];
    asm volatile("s_waitcnt lgkmcnt(0)" ::: "memory");
    const int c = lane & 7;
#pragma unroll
    for (int j = 0; j < 4; ++j) { const int n = (lane >> 3) + 8 * j; const LAS float* s = scr + (8 * c) * 33 + n;
        u32x4 o; o.x = pk2(s[0 * 33], s[1 * 33]); o.y = pk2(s[2 * 33], s[3 * 33]); o.z = pk2(s[4 * 33], s[5 * 33]); o.w = pk2(s[6 * 33], s[7 * 33]);
        *(u32x4*)(WT + (size_t)(dst_row + n) * K + k0 + 8 * c) = o; }
    asm volatile("s_waitcnt lgkmcnt(0)" ::: "memory");
}
__device__ __forceinline__ int win_src_col(int n) {
    return n < 4096 ? n : (n < 8192 ? n + 8 : (n < 11520 ? n + 24 : n + 24));
}
constexpr int CI_IN = 32 * (NPROJ / 32), CI_BR = 16 * 64, CI_O = 32 * 64, CI_U = 32 * 256, CI_D = 128 * 64;
constexpr int CO_BR = CI_IN, CO_O = CO_BR + 3 * CI_BR, CO_U = CO_O + CI_O, CO_D = CO_U + CI_U, C_PER_L = CO_D + CI_D;
#ifndef TAILCONV
#define TAILCONV 1
#endif
#if TAILCONV
constexpr int PREP_L0_END = CO_BR, PREP_L1_BEG = 0, PREP_L1_END = 0;
constexpr int WIN1_SEQ = 6144, WIN1_G4 = 8192;
constexpr int WBR_G1 = 1728, WBR_DYN = 3 * CI_BR - WBR_G1;
#else
constexpr int PREP_L0_END = C_PER_L, PREP_L1_BEG = 0, PREP_L1_END = C_PER_L, WBR_G1 = 0, WBR_DYN = 0;
#endif
__device__ __forceinline__ void convert_one(const Ctx& c0, const int l, const int it) {
    Ctx c = c0; c.lane = hw_lane();
    LAS float* scr = (LAS float*)(c.lds + c.wave * 16384);
    {
        int r = it;
        const float* W; bf16_t* WT; int K, Nsrc, scol, drow, k0;
        if (r < CI_IN) { const int nblk = NPROJ / 32, kb = r / nblk, nb = r % nblk;
            W = inp(c, I_WIN) + (size_t)l * D * NIN; K = D; Nsrc = NIN; scol = win_src_col(32 * nb); WT = (bf16_t*)(c.ws + WS_WIN) + (size_t)l * NPROJ * D; drow = 32 * nb; k0 = 64 * kb; }
        else if ((r -= CI_IN) < 3 * CI_BR) { const int br = r / CI_BR, rr = r % CI_BR, kb = rr / 64, nb = rr % 64;
            W = (br == 0 ? inp(c, I_WBA) : br == 1 ? inp(c, I_WBB) : inp(c, I_WBC)) + (size_t)l * 1024 * D; K = 1024; Nsrc = D; scol = 32 * nb; WT = (bf16_t*)(c.ws + WS_WBR) + ((size_t)l * 3 + br) * D * 1024; drow = 32 * nb; k0 = 64 * kb; }
        else if ((r -= 3 * CI_BR) < CI_O) { const int kb = r / 64, nb = r % 64;
            W = inp(c, I_WOUT) + (size_t)l * D * D; K = D; Nsrc = D; scol = 32 * nb; WT = (bf16_t*)(c.ws + WS_WOUT) + (size_t)l * D * D; drow = 32 * nb; k0 = 64 * kb; }
        else if ((r -= CI_O) < CI_U) { const int kb = r / 256, nb = r % 256;
            W = inp(c, I_WUP) + (size_t)l * D * DFF; K = D; Nsrc = DFF; scol = 32 * nb; WT = (bf16_t*)(c.ws + WS_WUP) + (size_t)l * DFF * D; drow = 32 * nb; k0 = 64 * kb; }
        else { r -= CI_U; const int kb = r / 64, nb = r % 64;
            W = inp(c, I_WDN) + (size_t)l * DFF * D; K = DFF; Nsrc = D; scol = 32 * nb; WT = (bf16_t*)(c.ws + WS_WDN) + (size_t)l * D * DFF; drow = 32 * nb; k0 = 64 * kb; }
        int ln = c.lane; asm volatile("" : "+v"(ln));
        transpose_item(W, K, Nsrc, scol, WT, drow, k0, scr, ln);
    }
}
__device__ __forceinline__ void convert_items(const Ctx& c0, const int l, const int r0, const int r1, const int b0) {
    if (c0.bid < b0) return;
    const int gw = (c0.bid - b0) * NWAVES + c0.wave, NGW = (c0.G - b0) * NWAVES;
#pragma unroll 1
    for (int it = r0 + gw; it < r1; it += NGW) convert_one(c0, l, it);
}
__device__ __forceinline__ void phase_prep(const Ctx& c0) {
    Ctx c = c0; c.lane = hw_lane(); c.tid = c.wave * 64 + c.lane;
    const int gw = c.bid * NWAVES + c.wave, NGW = c.G * NWAVES;
    convert_items(c0, 0, 0, PREP_L0_END, 0);
    convert_items(c0, 1, PREP_L1_BEG, PREP_L1_END, 0);
    float* wsg = (float*)(c.ws + WS_WSG);
    for (int i = c.bid * NTHR + c.tid; i < 2 * NSG * D; i += c.G * NTHR) {
        const int l = i / (NSG * D), r = i % (NSG * D), j = r / D, k = r % D;
        const int col = j < 8 ? 4096 + j : 8200 + (j - 8);
        wsg[i] = inp(c, I_WIN)[((size_t)l * D + k) * NIN + col];
    }
}

template <bool GATES>
__device__ __forceinline__ void phase_norm(const Ctx& c0, const float* w, const float* wsg) {
    Ctx c = c0; c.lane = hw_lane(); c.tid = c.wave * 64 + c.lane;
    const int gw = c.bid * NWAVES + c.wave, NGW = c.G * NWAVES;
    const float* X = (const float*)(c.ws + WS_X); bf16_t* HN = (bf16_t*)(c.ws + WS_HN); float* SG = (float*)(c.ws + WS_SG);
    f32x4 wv[8];
#pragma unroll
    for (int j = 0; j < 8; ++j) wv[j] = ((const f32x4*)w)[c.lane + 64 * j];
    for (int row = gw; row < MP; row += 2 * NGW) {
        const int row1 = row + NGW; const bool two = row1 < MP;
        const f32x4* xr0 = (const f32x4*)(X + (size_t)row * D) + c.lane; const f32x4* xr1 = (const f32x4*)(X + (size_t)(two ? row1 : row) * D) + c.lane;
        f32x4 v0[8], v1[8]; float s0 = 0.f, s1 = 0.f;
#pragma unroll
        for (int j = 0; j < 8; ++j) { v0[j] = xr0[64 * j]; v1[j] = xr1[64 * j]; }
#pragma unroll
        for (int j = 0; j < 8; ++j) { s0 += (v0[j].x * v0[j].x + v0[j].y * v0[j].y) + (v0[j].z * v0[j].z + v0[j].w * v0[j].w); s1 += (v1[j].x * v1[j].x + v1[j].y * v1[j].y) + (v1[j].z * v1[j].z + v1[j].w * v1[j].w); }
        const float r0 = rsqrtf(wave_sum(s0) * (1.f / D) + 1e-6f), r1 = rsqrtf(wave_sum(s1) * (1.f / D) + 1e-6f);
        u32x2* o0 = (u32x2*)(HN + (size_t)row * D) + c.lane; u32x2* o1 = (u32x2*)(HN + (size_t)(two ? row1 : row) * D) + c.lane;
#pragma unroll
        for (int j = 0; j < 8; ++j) { v0[j] = v0[j] * r0 * wv[j]; v1[j] = v1[j] * r1 * wv[j];
            u32x2 o; o.x = pk2(v0[j].x, v0[j].y); o.y = pk2(v0[j].z, v0[j].w); o0[64 * j] = o;
            if (two) { o.x = pk2(v1[j].x, v1[j].y); o.y = pk2(v1[j].z, v1[j].w); o1[64 * j] = o; } }
        if (GATES) {
#pragma unroll 1
            for (int g0 = 0; g0 < NSG; g0 += 2) {
                f32x4 q[2][8];
#pragma unroll
                for (int gg = 0; gg < 2; ++gg)
#pragma unroll
                    for (int j = 0; j < 8; ++j) q[gg][j] = ((const f32x4*)(wsg + (size_t)(g0 + gg) * D))[c.lane + 64 * j];
#pragma unroll
                for (int gg = 0; gg < 2; ++gg) { float a0 = 0.f, a1 = 0.f;
#pragma unroll
                    for (int j = 0; j < 8; ++j) { a0 += (v0[j].x * q[gg][j].x + v0[j].y * q[gg][j].y) + (v0[j].z * q[gg][j].z + v0[j].w * q[gg][j].w);
                                                  a1 += (v1[j].x * q[gg][j].x + v1[j].y * q[gg][j].y) + (v1[j].z * q[gg][j].z + v1[j].w * q[gg][j].w); }
                    a0 = wave_sum(a0); a1 = wave_sum(a1);
                    if (c.lane == 0) { SG[(size_t)row * SGLD + g0 + gg] = a0; if (two) SG[(size_t)row1 * SGLD + g0 + gg] = a1; } }
            }
        }
    }
}
constexpr int NR1 = 5;
template <int NV>
__device__ __forceinline__ void norm_gate_group(const f32x4 (&v)[NR1][8], const LAS f32x4* gb, float* SG, const int (&rows)[NR1], int g0, int lane) {
#pragma unroll 1
    for (int g = 0; g < 4; ++g) {
        float a[NR1];
#pragma unroll
        for (int r = 0; r < NR1; ++r) a[r] = 0.f;
#pragma unroll
        for (int j = 0; j < 8; ++j) { const f32x4 q = gb[g * 512 + lane + 64 * j];
#pragma unroll
            for (int r = 0; r < NV; ++r) a[r] += (v[r][j].x * q.x + v[r][j].y * q.y) + (v[r][j].z * q.z + v[r][j].w * q.w); }
#pragma unroll
        for (int r = 0; r < NV; ++r) { const float t = wave_sum(a[r]); if (lane == 0) SG[(size_t)rows[r] * SGLD + g0 + g] = t; }
    }
}
template <bool FIRST>
__device__ __forceinline__ void phase_norm_gates(const Ctx& c0, const float* w, const float* wsg) {
    Ctx c = c0; c.lane = hw_lane(); c.tid = c.wave * 64 + c.lane;
    const int gw = c.bid * NWAVES + c.wave, NGW = c.G * NWAVES;
    const float* X = (const float*)(c.ws + WS_X); bf16_t* HN = (bf16_t*)(c.ws + WS_HN); float* SG = (float*)(c.ws + WS_SG);
    LAS f32x4* GB = (LAS f32x4*)c.lds;
    const f32x4* wsg4 = (const f32x4*)wsg;
    const float* xmeta = FIRST ? inp(c, I_META) : nullptr; const float* xprm = FIRST ? inp(c, I_XP) : nullptr; const float* xsmp = FIRST ? inp(c, I_XS) : nullptr;
#pragma unroll 1
    for (int base = 0; base < MP; base += NR1 * NGW) {
        int rows[NR1]; f32x4 v[NR1][8]; f32x4 st[4];
        int nv = 0;
#pragma unroll
        for (int r = 0; r < NR1; ++r) { const int row = base + r * NGW + gw; nv += row < MP ? 1 : 0; rows[r] = row < MP ? row : MP - 1; }
        nv = __builtin_amdgcn_readfirstlane(nv);
#pragma unroll
        for (int r = 0; r < NR1; ++r) { const f32x4* xr = (const f32x4*)(FIRST ? x0_row(xmeta, xprm, xsmp, rows[r]) : X + (size_t)rows[r] * D) + c.lane;
#pragma unroll
            for (int j = 0; j < 8; ++j) v[r][j] = xr[64 * j]; }
#pragma unroll
        for (int k = 0; k < 4; ++k) st[k] = wsg4[c.tid + 512 * k];
        float rs[NR1];
#pragma unroll
        for (int r = 0; r < NR1; ++r) { float s = 0.f;
#pragma unroll
            for (int j = 0; j < 8; ++j) s += (v[r][j].x * v[r][j].x + v[r][j].y * v[r][j].y) + (v[r][j].z * v[r][j].z + v[r][j].w * v[r][j].w);
            rs[r] = rsqrtf(wave_sum(s) * (1.f / D) + 1e-6f); }
#pragma unroll
        for (int j = 0; j < 8; ++j) { const f32x4 wj = ((const f32x4*)w)[c.lane + 64 * j];
#pragma unroll
            for (int r = 0; r < NR1; ++r) { v[r][j] = v[r][j] * rs[r] * wj;
                if (r < nv) { u32x2 p; p.x = pk2(v[r][j].x, v[r][j].y); p.y = pk2(v[r][j].z, v[r][j].w); ((u32x2*)(HN + (size_t)rows[r] * D) + c.lane)[64 * j] = p; } } }
#pragma unroll
        for (int k = 0; k < 4; ++k) GB[c.tid + 512 * k] = st[k];
        lds_barrier();
#pragma unroll 1
        for (int ch = 0; ch < NSG / 4; ++ch) {
            if (ch + 1 < NSG / 4) {
#pragma unroll
                for (int k = 0; k < 4; ++k) st[k] = wsg4[(ch + 1) * 2048 + c.tid + 512 * k]; }
            const LAS f32x4* gb = GB + (ch & 1) * 2048;
            if (NR1 >= 5 && nv == 5) norm_gate_group<(NR1 >= 5 ? 5 : 1)>(v, gb, SG, rows, 4 * ch, c.lane);
            else if (NR1 >= 4 && nv == 4) norm_gate_group<(NR1 >= 4 ? 4 : 1)>(v, gb, SG, rows, 4 * ch, c.lane);
            else if (nv == 3) norm_gate_group<3>(v, gb, SG, rows, 4 * ch, c.lane);
            else if (nv == 2) norm_gate_group<2>(v, gb, SG, rows, 4 * ch, c.lane);
            else if (nv == 1) norm_gate_group<1>(v, gb, SG, rows, 4 * ch, c.lane);
            if (ch + 1 < NSG / 4) {
#pragma unroll
                for (int k = 0; k < 4; ++k) GB[((ch + 1) & 1) * 2048 + c.tid + 512 * k] = st[k]; }
            lds_barrier();
        }
    }
}
__device__ __forceinline__ void final_rows(const Ctx& c0, const int r0, const int r1, const int gw, const int NGW) {
    Ctx c = c0; c.lane = hw_lane(); c.tid = c.wave * 64 + c.lane;
    const float* X = (const float*)(c.ws + WS_X); const float* w = inp(c, I_FNW);
    f32x4 wv[8];
#pragma unroll
    for (int j = 0; j < 8; ++j) wv[j] = ((const f32x4*)w)[c.lane + 64 * j];
    for (int row = r0 + gw; row < r1; row += NGW) {
        float* dst;
        if (row < MPROMPT) { const int b = row / TP, t = row % TP; if (t < NMETA) continue; dst = c.out + O_YP + ((size_t)b * SEQ + (t - NMETA)) * D; }
        else dst = c.out + O_YS + (size_t)(row - MPROMPT) * D;
        const f32x4* xr = (const f32x4*)(X + (size_t)row * D) + c.lane;
        f32x4 v[8]; float s = 0.f;
#pragma unroll
        for (int j = 0; j < 8; ++j) { v[j] = xr[64 * j]; s += (v[j].x * v[j].x + v[j].y * v[j].y) + (v[j].z * v[j].z + v[j].w * v[j].w); }
        const float rstd = rsqrtf(wave_sum(s) * (1.f / D) + 1e-6f);
#pragma unroll
        for (int j = 0; j < 8; ++j) ((f32x4*)dst)[c.lane + 64 * j] = v[j] * rstd * wv[j];
    }
}
#ifndef FIN_IN_TAIL
#define FIN_IN_TAIL 1
#endif
__device__ __forceinline__ void phase_final(const Ctx& c0) {
    const bool tail_did = FIN_IN_TAIL && c0.G == 256;
    final_rows(c0, tail_did ? 8192 : 0, MREAL, c0.bid * NWAVES + c0.wave, c0.G * NWAVES);
}

__device__ __forceinline__ void mlstm_unit(const Ctx& c0, int l, int seq, int h) {
    Ctx c = c0; c.lane = hw_lane(); c.tid = c.wave * 64 + c.lane;
    const int tid = c.tid, v = tid & 255, kh = c.wave >> 2;
    const bool prompt = seq < BATCH; const int T = prompt ? TP : 1; const int row0 = prompt ? seq * TP : MPROMPT + (seq - BATCH);
    const bf16_t* PROJ = (const bf16_t*)(c.ws + WS_PROJ); const float* SG = (const float*)(c.ws + WS_SG); bf16_t* YBR = (bf16_t*)(c.ws + WS_YBR);
    LAS float* sm = (LAS float*)c.lds; LAS float* qs = sm, *ks = sm + 256, *vs = sm + 512, *red = sm + 768, *misc = sm + 1280, *sc = sm + 1296;
    float C[128]; float nreg = 0.f, m = 0.f;
    float *oc, *on, *om;
    if (prompt) { oc = c.out + O_PC + (((size_t)l * BATCH + seq) * HA + h) * DHA * DHA; on = c.out + O_PN + (((size_t)l * BATCH + seq) * HA + h) * DHA; om = c.out + O_PM + ((size_t)l * BATCH + seq) * HA + h;
#pragma unroll
        for (int j = 0; j < 128; ++j) C[j] = 0.f;
    } else { const int s = seq - BATCH; const size_t u = ((size_t)l * NB + s) * HA + h;
        oc = c.out + O_SC + u * DHA * DHA; on = c.out + O_SN + u * DHA; om = c.out + O_SM + u;
        const float* ci = inp(c, I_SC) + u * DHA * DHA;
        { const float* cp = ci + ((size_t)(kh * 128) * 256 + v);
#pragma unroll
          for (int jj = 0; jj < 32; ++jj) { asm volatile("" : "+v"(cp)); C[4 * jj] = cp[0]; C[4 * jj + 1] = cp[256]; C[4 * jj + 2] = cp[512]; C[4 * jj + 3] = cp[768]; cp += 1024; } }
        if (tid < 256) nreg = inp(c, I_SN)[u * DHA + tid];
        m = inp(c, I_SM)[u];
    }
    const float bi = inp(c, I_BI)[l * HA + h], bfv = inp(c, I_BF)[l * HA + h];
    const float nw = tid < 256 ? inp(c, I_MNW)[l * 1024 + h * 256 + tid] : 0.f;
    for (int t = 0; t < T; ++t) {
        const size_t row = (size_t)(row0 + t); const bf16_t* prow = PROJ + row * NPROJ;
        if (tid < 256) { qs[tid] = bf2f(prow[PA_Q + h * 256 + tid]); ks[tid] = bf2f(prow[PA_K + h * 256 + tid]) * 0.0625f; vs[tid] = bf2f(prow[PA_V + h * 256 + tid]); }
        if (tid == 0) { misc[0] = SG[row * SGLD + h] + bi; misc[1] = -softplusf_(-(SG[row * SGLD + 4 + h] + bfv)); }
        lds_barrier();
        const float gi = misc[0], gf = misc[1];
        const float mn = fmaxf(gf + m, gi), fw = __expf(gf + m - mn), iw = __expf(gi - mn); m = mn;
        const float vv = vs[v] * iw; float acc = 0.f;
#pragma unroll
        for (int jj = 0; jj < 16; ++jj) {
            const f32x4 k0 = *(const LAS f32x4*)(ks + kh * 128 + jj * 8), k1 = *(const LAS f32x4*)(ks + kh * 128 + jj * 8 + 4);
            const f32x4 q0 = *(const LAS f32x4*)(qs + kh * 128 + jj * 8), q1 = *(const LAS f32x4*)(qs + kh * 128 + jj * 8 + 4);
#pragma unroll
            for (int e = 0; e < 4; ++e) { C[jj * 8 + e] = fw * C[jj * 8 + e] + k0[e] * vv; acc += q0[e] * C[jj * 8 + e];
                                          C[jj * 8 + 4 + e] = fw * C[jj * 8 + 4 + e] + k1[e] * vv; acc += q1[e] * C[jj * 8 + 4 + e]; }
            asm volatile("" ::: "memory");
        }
        red[tid] = acc;
        float dpart = 0.f;
        if (tid < 256) { nreg = fw * nreg + iw * ks[tid]; dpart = qs[tid] * nreg; }
        const float den = block_sum(dpart, sc, c.wave);
        float hh = 0.f;
        if (tid < 256) hh = (red[tid] + red[256 + tid]) / fmaxf(fabsf(den), __expf(-m));
        const float ss = block_sum(hh * hh, sc, c.wave);
        if (tid < 256) { const float y = hh * rsqrtf(ss * (1.f / 256.f) + 1e-6f) * nw; const float o = bf2f(prow[PA_O + h * 256 + tid]);
            YBR[row * YLD + h * 256 + tid] = (bf16_t)f2bf(sigmoidf_(o) * y); }
        lds_barrier();
    }
    { float* op = oc + ((size_t)(kh * 128) * 256 + v);
#pragma unroll
      for (int jj = 0; jj < 32; ++jj) { asm volatile("" : "+v"(op)); op[0] = C[4 * jj]; op[256] = C[4 * jj + 1]; op[512] = C[4 * jj + 2]; op[768] = C[4 * jj + 3]; op += 1024; } }
    if (tid < 256) on[tid] = nreg;
    if (tid == 0) *om = m;
    lds_barrier();
}

__device__ __forceinline__ void mlstm_unit_s(const Ctx& c0, int l, int s, int h) {
    Ctx c = c0; c.lane = hw_lane(); c.tid = c.wave * 64 + c.lane;
    const int tid = c.tid, vq = c.lane, kg = c.wave;
    const size_t row = (size_t)(MPROMPT + s);
    const bf16_t* PROJ = (const bf16_t*)(c.ws + WS_PROJ); const float* SG = (const float*)(c.ws + WS_SG); bf16_t* YBR = (bf16_t*)(c.ws + WS_YBR);
    LAS float* sm = (LAS float*)c.lds; LAS float* qs = sm, *ks = sm + 256, *vs = sm + 512, *red = sm + 768  , *misc = sm + 2816, *sc = sm + 2832;
    const size_t u = ((size_t)l * NB + s) * HA + h;
    const f32x4* ci = (const f32x4*)(inp(c, I_SC) + u * DHA * DHA) + (size_t)(kg * 32) * 64 + vq;
    f32x4* oc = (f32x4*)(c.out + O_SC + u * DHA * DHA) + (size_t)(kg * 32) * 64 + vq;
    f32x4 C[32];
#pragma unroll
    for (int j = 0; j < 32; ++j) C[j] = ci[j * 64];
    float nreg = 0.f;
    if (tid < 256) nreg = inp(c, I_SN)[u * DHA + tid];
    float m = inp(c, I_SM)[u];
    const float bi = inp(c, I_BI)[l * HA + h], bfv = inp(c, I_BF)[l * HA + h];
    const float nw = tid < 256 ? inp(c, I_MNW)[l * 1024 + h * 256 + tid] : 0.f;
    const bf16_t* prow = PROJ + row * NPROJ;
    if (tid < 256) { qs[tid] = bf2f(prow[PA_Q + h * 256 + tid]); ks[tid] = bf2f(prow[PA_K + h * 256 + tid]) * 0.0625f; vs[tid] = bf2f(prow[PA_V + h * 256 + tid]); }
    if (tid == 0) { misc[0] = SG[row * SGLD + h] + bi; misc[1] = -softplusf_(-(SG[row * SGLD + 4 + h] + bfv)); }
    lds_barrier();
    const float gi = misc[0], gf = misc[1];
    const float mn = fmaxf(gf + m, gi), fw = __expf(gf + m - mn), iw = __expf(gi - mn); m = mn;
    const f32x4 vv = *(const LAS f32x4*)(vs + 4 * vq) * iw;
    f32x4 acc = (f32x4){0.f, 0.f, 0.f, 0.f};
#pragma unroll
    for (int jj = 0; jj < 8; ++jj) {
        const f32x4 k4 = *(const LAS f32x4*)(ks + kg * 32 + jj * 4), q4 = *(const LAS f32x4*)(qs + kg * 32 + jj * 4);
#pragma unroll
        for (int e = 0; e < 4; ++e) { C[jj * 4 + e] = C[jj * 4 + e] * fw + vv * k4[e]; acc += C[jj * 4 + e] * q4[e]; }
    }
#pragma unroll
    for (int j = 0; j < 32; ++j) oc[j * 64] = C[j];
    *(LAS f32x4*)(red + kg * 256 + 4 * vq) = acc;
    float dpart = 0.f;
    if (tid < 256) { nreg = fw * nreg + iw * ks[tid]; dpart = qs[tid] * nreg; }
    const float den = block_sum(dpart, sc, c.wave);
    float hh = 0.f;
    if (tid < 256) { float num = 0.f;
#pragma unroll
        for (int g = 0; g < 8; ++g) num += red[g * 256 + tid];
        hh = num / fmaxf(fabsf(den), __expf(-m)); }
    const float ss = block_sum(hh * hh, sc, c.wave);
    if (tid < 256) { const float y = hh * rsqrtf(ss * (1.f / 256.f) + 1e-6f) * nw; const float o = bf2f(prow[PA_O + h * 256 + tid]);
        YBR[row * YLD + h * 256 + tid] = (bf16_t)f2bf(sigmoidf_(o) * y);
        (c.out + O_SN + u * DHA)[tid] = nreg; }
    if (tid == 0) (c.out + O_SM)[u] = m;
    lds_barrier();
}

__device__ __forceinline__ void gdn_unit(const Ctx& c0, int l, int seq, int h) {
    Ctx c = c0; c.lane = hw_lane(); c.tid = c.wave * 64 + c.lane;
    const int tid = c.tid, v = tid & 127, kq = tid >> 7;
    const bool prompt = seq < BATCH; const int T = prompt ? TP : 1; const int row0 = prompt ? seq * TP : MPROMPT + (seq - BATCH);
    const bf16_t* PROJ = (const bf16_t*)(c.ws + WS_PROJ); const float* SG = (const float*)(c.ws + WS_SG); bf16_t* YBR = (bf16_t*)(c.ws + WS_YBR);
    LAS float* sm = (LAS float*)c.lds; LAS float* ring = sm  , *qk = sm + 1536  , *red = sm + 1920  , *part = sm + 2432  , *sc = sm + 2448;
    float S[32];
    float *os, *ocv; const float* cin = nullptr;
    const int cg = tid < 384 ? (tid >> 7) * 1024 + h * 128 + (tid & 127) : 0;
    if (prompt) { os = c.out + O_PGS + (((size_t)l * BATCH + seq) * HB + h) * DHB * DHB; ocv = c.out + O_PGC + ((size_t)l * BATCH + seq) * 3 * 3072;
#pragma unroll
        for (int j = 0; j < 32; ++j) S[j] = 0.f;
    } else { const int s = seq - BATCH; const size_t u = ((size_t)l * NB + s) * HB + h;
        os = c.out + O_SGS + u * DHB * DHB; ocv = c.out + O_SGC + ((size_t)l * NB + s) * 3 * 3072;
        const float* si = inp(c, I_SGS) + u * DHB * DHB;
#pragma unroll
        for (int j = 0; j < 32; ++j) S[j] = si[(size_t)(kq * 32 + j) * 128 + v];
        cin = inp(c, I_SGC) + ((size_t)l * NB + s) * 3 * 3072;
    }
    float cw0 = 0.f, cw1 = 0.f, cw2 = 0.f, cw3 = 0.f;
    if (tid < 384) { const float* cw = inp(c, I_CONVW) + (size_t)l * 4 * 3072; cw0 = cw[cg]; cw1 = cw[3072 + cg]; cw2 = cw[2 * 3072 + cg]; cw3 = cw[3 * 3072 + cg];
        ring[3 * 384 + tid] = cin ? cin[2 * 3072 + cg] : 0.f; ring[2 * 384 + tid] = cin ? cin[3072 + cg] : 0.f; ring[1 * 384 + tid] = cin ? cin[cg] : 0.f; ring[tid] = 0.f; }
    const float alog = inp(c, I_ALOG)[l * HB + h], dtb = inp(c, I_DTB)[l * HB + h];
    const float gnw = tid < 128 ? inp(c, I_GNW)[l * DHB + tid] : 0.f;
    lds_barrier();
    for (int t = 0; t < T; ++t) {
        const size_t row = (size_t)(row0 + t); const bf16_t* prow = PROJ + row * NPROJ;
        float y = 0.f;
        if (tid < 384) { const float u = bf2f(prow[PB_QKV + cg]); ring[(t & 3) * 384 + tid] = u;
            y = cw3 * u + cw2 * ring[((t - 1) & 3) * 384 + tid] + cw1 * ring[((t - 2) & 3) * 384 + tid] + cw0 * ring[((t - 3) & 3) * 384 + tid];
            y = siluf_(y); qk[tid] = y; }
        { const float s2 = wave_sum(y * y); if (c.lane == 0) part[c.wave] = s2; }
        lds_barrier();
        const float qn = rsqrtf(part[0] + part[1] + 1e-12f) * 0.08838834764831845f, kn = rsqrtf(part[2] + part[3] + 1e-12f);
        const float ga = SG[row * SGLD + 8 + h], gb = SG[row * SGLD + 16 + h];
        const float alpha = __expf(-__expf(alog) * softplusf_(ga + dtb)), beta = sigmoidf_(gb);
        float p = 0.f;
#pragma unroll
        for (int j = 0; j < 32; ++j) p += qk[128 + kq * 32 + j] * S[j];
        red[tid] = p * kn;
        lds_barrier();
        const float kS = red[v] + red[128 + v] + red[256 + v] + red[384 + v];
        const float vn = beta * (qk[256 + v] - alpha * kS);
        float o = 0.f;
#pragma unroll
        for (int j = 0; j < 32; ++j) { S[j] = alpha * S[j] + (qk[128 + kq * 32 + j] * kn) * vn; o += qk[kq * 32 + j] * S[j]; }
        lds_barrier();
        red[tid] = o * qn;
        lds_barrier();
        float oo = 0.f;
        if (tid < 128) oo = red[tid] + red[128 + tid] + red[256 + tid] + red[384 + tid];
        const float ss = block_sum(oo * oo, sc, c.wave);
        if (tid < 128) { const float z = bf2f(prow[PB_Z + h * 128 + tid]);
            YBR[row * YLD + 1024 + h * 128 + tid] = (bf16_t)f2bf(oo * rsqrtf(ss * (1.f / 128.f) + 1e-6f) * gnw * siluf_(z)); }
        lds_barrier();
    }
#pragma unroll
    for (int j = 0; j < 32; ++j) os[(size_t)(kq * 32 + j) * 128 + v] = S[j];
    if (tid < 384) {
#pragma unroll
        for (int j = 0; j < 3; ++j) ocv[j * 3072 + cg] = ring[((T - 3 + j) & 3) * 384 + tid];
    }
    lds_barrier();
}

__device__ __forceinline__ void gdn_unit_s(const Ctx& c0, int l, int s, int h) {
    Ctx c = c0; c.lane = hw_lane(); c.tid = c.wave * 64 + c.lane;
    const int tid = c.tid, vq = tid & 31, kg = tid >> 5;
    const size_t row = (size_t)(MPROMPT + s);
    const bf16_t* PROJ = (const bf16_t*)(c.ws + WS_PROJ); const float* SG = (const float*)(c.ws + WS_SG); bf16_t* YBR = (bf16_t*)(c.ws + WS_YBR);
    LAS float* sm = (LAS float*)c.lds; LAS float* qk = sm  , *red = sm + 384  , *red2 = sm + 2432  , *part = sm + 4480  , *sc = sm + 4496;
    const size_t u = ((size_t)l * NB + s) * HB + h;
    const f32x4* si = (const f32x4*)(inp(c, I_SGS) + u * DHB * DHB) + (size_t)(kg * 8) * 32 + vq;
    f32x4* os = (f32x4*)(c.out + O_SGS + u * DHB * DHB) + (size_t)(kg * 8) * 32 + vq;
    f32x4 S[8];
#pragma unroll
    for (int j = 0; j < 8; ++j) S[j] = si[j * 32];
    const bf16_t* prow = PROJ + row * NPROJ;
    float y = 0.f;
    if (tid < 384) { const int cg = (tid >> 7) * 1024 + h * 128 + (tid & 127);
        const float* cw = inp(c, I_CONVW) + (size_t)l * 4 * 3072; const float* cin = inp(c, I_SGC) + ((size_t)l * NB + s) * 3 * 3072; float* ocv = c.out + O_SGC + ((size_t)l * NB + s) * 3 * 3072;
        const float cw0 = cw[cg], cw1 = cw[3072 + cg], cw2 = cw[2 * 3072 + cg], cw3 = cw[3 * 3072 + cg];
        const float p0 = cin[cg], p1 = cin[3072 + cg], p2 = cin[2 * 3072 + cg]; const float uu = bf2f(prow[PB_QKV + cg]);
        y = siluf_(cw3 * uu + cw2 * p2 + cw1 * p1 + cw0 * p0); qk[tid] = y;
        ocv[cg] = p1; ocv[3072 + cg] = p2; ocv[2 * 3072 + cg] = uu; }
    { const float s2 = wave_sum(y * y); if (c.lane == 0) part[c.wave] = s2; }
    const float alog = inp(c, I_ALOG)[l * HB + h], dtb = inp(c, I_DTB)[l * HB + h];
    const float ga = SG[row * SGLD + 8 + h], gb = SG[row * SGLD + 16 + h];
    const float gnw = tid < 128 ? inp(c, I_GNW)[l * DHB + tid] : 0.f;
    const float z = tid < 128 ? bf2f(prow[PB_Z + h * 128 + tid]) : 0.f;
    lds_barrier();
    const float qn = rsqrtf(part[0] + part[1] + 1e-12f) * 0.08838834764831845f, kn = rsqrtf(part[2] + part[3] + 1e-12f);
    const float alpha = __expf(-__expf(alog) * softplusf_(ga + dtb)), beta = sigmoidf_(gb);
    const f32x4 ka = *(const LAS f32x4*)(qk + 128 + kg * 8), kb = *(const LAS f32x4*)(qk + 128 + kg * 8 + 4);
    const f32x4 qa = *(const LAS f32x4*)(qk + kg * 8), qb = *(const LAS f32x4*)(qk + kg * 8 + 4);
    { f32x4 p = S[0] * ka[0];
#pragma unroll
      for (int j = 1; j < 8; ++j) p += S[j] * (j < 4 ? ka[j] : kb[j - 4]);
      *(LAS f32x4*)(red + kg * 128 + 4 * vq) = p; }
    lds_barrier();
    f32x4 kS = *(const LAS f32x4*)(red + 4 * vq);
#pragma unroll
    for (int g = 1; g < 16; ++g) kS += *(const LAS f32x4*)(red + g * 128 + 4 * vq);
    const f32x4 vn = (*(const LAS f32x4*)(qk + 256 + 4 * vq) - kS * (alpha * kn)) * beta;
    { f32x4 o = (f32x4){0.f, 0.f, 0.f, 0.f};
#pragma unroll
      for (int j = 0; j < 8; ++j) { const float kj = (j < 4 ? ka[j] : kb[j - 4]) * kn, qj = j < 4 ? qa[j] : qb[j - 4]; S[j] = S[j] * alpha + vn * kj; o += S[j] * qj; }
#pragma unroll
      for (int j = 0; j < 8; ++j) os[j * 32] = S[j];
      *(LAS f32x4*)(red2 + kg * 128 + 4 * vq) = o; }
    lds_barrier();
    float oo = 0.f;
    if (tid < 128) {
#pragma unroll
        for (int g = 0; g < 16; ++g) oo += red2[g * 128 + tid];
        oo *= qn; }
    const float ss = block_sum(oo * oo, sc, c.wave);
    if (tid < 128) YBR[row * YLD + 1024 + h * 128 + tid] = (bf16_t)f2bf(oo * rsqrtf(ss * (1.f / 128.f) + 1e-6f) * gnw * siluf_(z));
    lds_barrier();
}

__device__ __forceinline__ void rwkv_unit(const Ctx& c0, int l, int seq, int h, int& cached_h) {
    Ctx c = c0; c.lane = hw_lane(); c.tid = c.wave * 64 + c.lane;
    const int tid = c.tid, k = tid & 63, vq = tid >> 6;
    const bool prompt = seq < BATCH; const int T = prompt ? TP : 1; const int row0 = prompt ? seq * TP : MPROMPT + (seq - BATCH);
    const bf16_t* PROJ = (const bf16_t*)(c.ws + WS_PROJ); bf16_t* YBR = (bf16_t*)(c.ws + WS_YBR);
    LAS float* sm = (LAS float*)c.lds;
    LAS float* w2s = sm, *a2s = sm + 4096, *g2s = sm + 8192  , *xs = sm + 16384  , *partl = sm + 16896  ;
    LAS float* dec = sm + 17408, *k2s = dec + 64, *avs = dec + 128, *bvs = dec + 192, *rrs = dec + 256, *vvs = dec + 320, *ggs = dec + 384, *ys = dec + 448, *misc = dec + 512;
    float S[8];
    float *os, *osh; const float* shin = nullptr;
    if (prompt) { os = c.out + O_PRS + (((size_t)l * BATCH + seq) * HC + h) * DHC * DHC; osh = c.out + O_PRSH + ((size_t)l * BATCH + seq) * NCC;
#pragma unroll
        for (int j = 0; j < 8; ++j) S[j] = 0.f;
    } else { const int s = seq - BATCH; const size_t u = ((size_t)l * NB + s) * HC + h;
        os = c.out + O_SRS + u * DHC * DHC; osh = c.out + O_SRSH + ((size_t)l * NB + s) * NCC;
        const float* si = inp(c, I_SRS) + u * DHC * DHC;
#pragma unroll
        for (int j = 0; j < 8; ++j) S[j] = si[(size_t)(vq * 8 + j) * 64 + k];
        shin = inp(c, I_SRSH) + ((size_t)l * NB + s) * NCC;
    }
    if (cached_h != h) { cached_h = h; const float* w2p = inp(c, I_W2) + (size_t)l * 64 * 1024 + h * 64; const float* a2p = inp(c, I_A2) + (size_t)l * 64 * 1024 + h * 64; const float* g2p = inp(c, I_G2) + (size_t)l * 128 * 1024 + h * 64;
      float lw2[8], la2[8], lg2[16];
#pragma unroll
      for (int k = 0; k < 8; ++k) { const int i = tid + k * NTHR; lw2[k] = w2p[(i >> 6) * 1024 + (i & 63)]; la2[k] = a2p[(i >> 6) * 1024 + (i & 63)]; }
#pragma unroll
      for (int k = 0; k < 16; ++k) { const int i = tid + k * NTHR; lg2[k] = g2p[(i >> 6) * 1024 + (i & 63)]; }
#pragma unroll
      for (int k = 0; k < 8; ++k) { const int i = tid + k * NTHR; w2s[i] = lw2[k]; a2s[i] = la2[k]; }
#pragma unroll
      for (int k = 0; k < 16; ++k) { const int i = tid + k * NTHR; g2s[i] = lg2[k]; } }
    int cidx = 0;
    if (tid < 64) cidx = h * 64 + tid; else if (tid < 128) cidx = 1024 + h * 64 + (tid - 64); else if (tid < 192) cidx = 2048 + h * 64 + (tid - 128); else if (tid < 448) cidx = 3072 + (tid - 192);
    float prev = 0.f, mu = 0.f;
    if (tid < 448) { prev = shin ? shin[cidx] : 0.f; mu = inp(c, I_MU)[(size_t)l * NCC + cidx]; }
    const int C = h * 64 + (tid & 63);
    float w0 = 0.f, a0 = 0.f, kkw = 0.f, kaw = 0.f, rkw = 0.f, lnw = 0.f, lnb = 0.f;
    if (tid < 64) { w0 = inp(c, I_W0)[l * 1024 + C]; a0 = inp(c, I_A0)[l * 1024 + C]; kkw = inp(c, I_KK)[l * 1024 + C]; kaw = inp(c, I_KA)[l * 1024 + C]; rkw = inp(c, I_RK)[l * 1024 + C];
        lnw = inp(c, I_LNW)[l * 1024 + C]; lnb = inp(c, I_LNB)[l * 1024 + C]; }
    lds_barrier();
    for (int t = 0; t < T; ++t) {
        const size_t row = (size_t)(row0 + t); const bf16_t* prow = PROJ + row * NPROJ;
        if (tid < 448) { const float cur = bf2f(prow[PC0 + cidx]); float xm = cur + (prev - cur) * mu; prev = cur;
            if (tid >= 192 && tid < 256) xm = ftanh(xm); else if (tid >= 320) xm = sigmoidf_(xm);
            xs[tid] = xm; }
        lds_barrier();
        { const int cc = tid & 63, pt = tid >> 6; float a = 0.f;
            if (pt < 2) { for (int j = 0; j < 32; ++j) a += xs[192 + pt * 32 + j] * w2s[(pt * 32 + j) * 64 + cc]; }
            else if (pt < 4) { for (int j = 0; j < 32; ++j) a += xs[256 + (pt - 2) * 32 + j] * a2s[((pt - 2) * 32 + j) * 64 + cc]; }
            else { for (int j = 0; j < 32; ++j) a += xs[320 + (pt - 4) * 32 + j] * g2s[((pt - 4) * 32 + j) * 64 + cc]; }
            partl[pt * 64 + cc] = a; }
        lds_barrier();
        if (tid < 64) {
            const float wl = w0 + partl[tid] + partl[64 + tid]; const float wlog = -softplusf_(-wl) - 0.5f; const float dc = __expf(-__expf(wlog));
            const float aa = sigmoidf_(a0 + partl[128 + tid] + partl[192 + tid]);
            const float gg = (partl[256 + tid] + partl[320 + tid]) + (partl[384 + tid] + partl[448 + tid]);
            const float kraw = xs[64 + tid], kkv = kraw * kkw; const float nrm = wave_sum(kkv * kkv); const float kk = kkv * rsqrtf(nrm + 1e-12f);
            const float k2 = kraw * (1.f + (aa - 1.f) * kaw);
            dec[tid] = dc; k2s[tid] = k2; avs[tid] = -kk; bvs[tid] = kk * aa; rrs[tid] = xs[tid]; vvs[tid] = xs[128 + tid]; ggs[tid] = gg;
            const float bs = wave_sum(xs[tid] * k2 * rkw); if (tid == 0) misc[0] = bs;
        }
        lds_barrier();
        { const float av = avs[k], bv = bvs[k], dk = dec[k], kk2 = k2s[k], rr = rrs[k];
#pragma unroll
            for (int j = 0; j < 8; ++j) { const int vi = vq * 8 + j; const float sa = wave_sum(S[j] * av); S[j] = S[j] * dk + sa * bv + vvs[vi] * kk2; const float yy = wave_sum(S[j] * rr); if (k == 0) ys[vi] = yy; } }
        lds_barrier();
        if (tid < 64) { const float y = ys[tid]; const float mean = wave_sum(y) * (1.f / 64.f); const float d = y - mean; const float var = wave_sum(d * d) * (1.f / 64.f);
            const float yn = d * rsqrtf(var + 64e-5f) * lnw + lnb; const float o = (yn + misc[0] * vvs[tid]) * ggs[tid];
            YBR[row * YLD + 2048 + h * 64 + tid] = (bf16_t)f2bf(o); }
        lds_barrier();
    }
#pragma unroll
    for (int j = 0; j < 8; ++j) os[(size_t)(vq * 8 + j) * 64 + k] = S[j];
    if (tid < 192 || (h == 0 && tid < 448)) osh[cidx] = prev;
    lds_barrier();
}


__device__ __forceinline__ void rwkv_unit4(const Ctx& c0, int l, int s0, int h, int& cached_h) {
    Ctx c = c0; c.lane = hw_lane(); c.tid = c.wave * 64 + c.lane;
    const int tid = c.tid, k = tid & 63, vq = tid >> 6;
    const bf16_t* PROJ = (const bf16_t*)(c.ws + WS_PROJ); bf16_t* YBR = (bf16_t*)(c.ws + WS_YBR);
    LAS float* sm = (LAS float*)c.lds;
    LAS float* W = sm  , *xs = sm + 16384  , *partl = sm + 18176  , *vec = sm + 20224  , *misc = sm + 22272  ;
    const size_t u0 = ((size_t)l * NB + s0) * HC + h;
    float S[4][8];
    { const float* si = inp(c, I_SRS) + u0 * DHC * DHC;
#pragma unroll
      for (int q = 0; q < 4; ++q)
#pragma unroll
        for (int j = 0; j < 8; ++j) S[q][j] = si[(size_t)q * HC * DHC * DHC + (size_t)(vq * 8 + j) * 64 + k]; }
    if (cached_h != h) { cached_h = h; const float* w2p = inp(c, I_W2) + (size_t)l * 64 * 1024 + h * 64; const float* a2p = inp(c, I_A2) + (size_t)l * 64 * 1024 + h * 64; const float* g2p = inp(c, I_G2) + (size_t)l * 128 * 1024 + h * 64;
      float lw2[8], la2[8], lg2[16];
#pragma unroll
      for (int kk = 0; kk < 8; ++kk) { const int i = tid + kk * NTHR; lw2[kk] = w2p[(i >> 6) * 1024 + (i & 63)]; la2[kk] = a2p[(i >> 6) * 1024 + (i & 63)]; }
#pragma unroll
      for (int kk = 0; kk < 16; ++kk) { const int i = tid + kk * NTHR; lg2[kk] = g2p[(i >> 6) * 1024 + (i & 63)]; }
#pragma unroll
      for (int kk = 0; kk < 8; ++kk) { const int i = tid + kk * NTHR; W[i] = lw2[kk]; W[4096 + i] = la2[kk]; }
#pragma unroll
      for (int kk = 0; kk < 16; ++kk) { const int i = tid + kk * NTHR; W[8192 + i] = lg2[kk]; } }
    int cidx = 0;
    if (tid < 64) cidx = h * 64 + tid; else if (tid < 128) cidx = 1024 + h * 64 + (tid - 64); else if (tid < 192) cidx = 2048 + h * 64 + (tid - 128); else if (tid < 448) cidx = 3072 + (tid - 192);
    const int C = h * 64 + k;
    float w0 = 0.f, a0 = 0.f, kkw = 0.f, kaw = 0.f, rkw = 0.f, lnw = 0.f, lnb = 0.f;
    if (tid < 256) { w0 = inp(c, I_W0)[l * 1024 + C]; a0 = inp(c, I_A0)[l * 1024 + C]; kkw = inp(c, I_KK)[l * 1024 + C]; kaw = inp(c, I_KA)[l * 1024 + C]; rkw = inp(c, I_RK)[l * 1024 + C];
        lnw = inp(c, I_LNW)[l * 1024 + C]; lnb = inp(c, I_LNB)[l * 1024 + C]; }
    if (tid < 448) { const float mu = inp(c, I_MU)[(size_t)l * NCC + cidx]; const float* shin = inp(c, I_SRSH) + ((size_t)l * NB + s0) * NCC + cidx; float* osh = c.out + O_SRSH + ((size_t)l * NB + s0) * NCC + cidx;
        float prev[4], cur[4];
#pragma unroll
        for (int q = 0; q < 4; ++q) { prev[q] = shin[(size_t)q * NCC]; cur[q] = bf2f(PROJ[(size_t)(MPROMPT + s0 + q) * NPROJ + PC0 + cidx]); }
#pragma unroll
        for (int q = 0; q < 4; ++q) { float xm = cur[q] + (prev[q] - cur[q]) * mu;
            if (tid >= 192 && tid < 256) xm = ftanh(xm); else if (tid >= 320) xm = sigmoidf_(xm);
            xs[q * 448 + tid] = xm;
            if (tid < 192 || h == 0) osh[(size_t)q * NCC] = cur[q]; } }
    lds_barrier();
    { const int pt = vq; float a[4] = {0.f, 0.f, 0.f, 0.f};
        const LAS float* wp = W + (pt * 32) * 64 + k; const LAS float* xp = xs + 192 + pt * 32;
#pragma unroll 8
        for (int j = 0; j < 32; ++j) { const float wv = wp[j * 64];
#pragma unroll
            for (int q = 0; q < 4; ++q) a[q] += xp[q * 448 + j] * wv; }
#pragma unroll
        for (int q = 0; q < 4; ++q) partl[q * 512 + pt * 64 + k] = a[q]; }
    lds_barrier();
    if (tid < 256) { const int q = vq; const LAS float* pl = partl + q * 512; const LAS float* x = xs + q * 448; LAS float* vv = vec + q * 512;
        const float wl = w0 + pl[k] + pl[64 + k]; const float wlog = -softplusf_(-wl) - 0.5f; const float dc = __expf(-__expf(wlog));
        const float aa = sigmoidf_(a0 + pl[128 + k] + pl[192 + k]);
        const float gg = (pl[256 + k] + pl[320 + k]) + (pl[384 + k] + pl[448 + k]);
        const float kraw = x[64 + k], kkv = kraw * kkw; const float nrm = wave_sum(kkv * kkv); const float kk = kkv * rsqrtf(nrm + 1e-12f);
        const float k2 = kraw * (1.f + (aa - 1.f) * kaw);
        vv[k] = dc; vv[64 + k] = k2; vv[128 + k] = -kk; vv[192 + k] = kk * aa; vv[256 + k] = x[k]; vv[320 + k] = x[128 + k]; vv[384 + k] = gg;
        const float bs = wave_sum(x[k] * k2 * rkw); if (k == 0) misc[q] = bs; }
    lds_barrier();
#pragma unroll
    for (int q = 0; q < 4; ++q) { const LAS float* vv = vec + q * 512; const float dk = vv[k], kk2 = vv[64 + k], av = vv[128 + k], bv = vv[192 + k], rr = vv[256 + k];
#pragma unroll
        for (int j = 0; j < 8; ++j) { const int vi = vq * 8 + j; const float sa = wave_sum(S[q][j] * av); S[q][j] = S[q][j] * dk + sa * bv + vv[320 + vi] * kk2; const float yy = wave_sum(S[q][j] * rr); if (k == 0) vec[q * 512 + 448 + vi] = yy; } }
    lds_barrier();
    if (tid < 256) { const int q = vq; const LAS float* vv = vec + q * 512; const float y = vv[448 + k]; const float mean = wave_sum(y) * (1.f / 64.f); const float d = y - mean; const float var = wave_sum(d * d) * (1.f / 64.f);
        const float yn = d * rsqrtf(var + 64e-5f) * lnw + lnb; const float o = (yn + misc[q] * vv[320 + k]) * vv[384 + k];
        YBR[(size_t)(MPROMPT + s0 + q) * YLD + 2048 + h * 64 + k] = (bf16_t)f2bf(o); }
    { float* os = c.out + O_SRS + u0 * DHC * DHC;
#pragma unroll
      for (int q = 0; q < 4; ++q)
#pragma unroll
        for (int j = 0; j < 8; ++j) os[(size_t)q * HC * DHC * DHC + (size_t)(vq * 8 + j) * 64 + k] = S[q][j]; }
    lds_barrier();
}

__device__ __forceinline__ f32x4 mfma16(bf16x8 a, bf16x8 b, f32x4 c) { return __builtin_amdgcn_mfma_f32_16x16x32_bf16(a, b, c, 0, 0, 0); }
__device__ __forceinline__ bf16x8 ldfrag(const LAS bf16_t* X, int ld, int r0, int k0, int lane) { return *(const LAS bf16x8*)(X + (r0 + (lane & 15)) * ld + k0 + ((lane >> 4) << 3)); }
template <int MT, int NT, int KS>
__device__ __forceinline__ void mma_lds(f32x4 (&acc)[MT][NT], const LAS bf16_t* A, int lda, int m0, const LAS bf16_t* Bt, int ldb, int n0, int lane) {
#pragma unroll
    for (int ks = 0; ks < KS; ++ks) {
        bf16x8 a[MT], b[NT];
#pragma unroll
        for (int i = 0; i < MT; ++i) a[i] = ldfrag(A, lda, m0 + 16 * i, 32 * ks, lane);
#pragma unroll
        for (int j = 0; j < NT; ++j) b[j] = ldfrag(Bt, ldb, n0 + 16 * j, 32 * ks, lane);
#pragma unroll
        for (int i = 0; i < MT; ++i)
#pragma unroll
            for (int j = 0; j < NT; ++j) acc[i][j] = mfma16(a[i], b[j], acc[i][j]);
    }
}
__device__ __forceinline__ float wave_incl_sum(float x, int lane) { (void)lane; return wave_scan_sum(x); }
__device__ __forceinline__ float wave_incl_max(float x, int lane) { (void)lane; const float NI = -__builtin_huge_valf();
    x = fmaxf(x, dpp_mov<0x111, 0xf>(NI, x)); x = fmaxf(x, dpp_mov<0x112, 0xf>(NI, x)); x = fmaxf(x, dpp_mov<0x114, 0xf>(NI, x)); x = fmaxf(x, dpp_mov<0x118, 0xf>(NI, x));
    x = fmaxf(x, dpp_mov<0x142, 0xa>(NI, x)); x = fmaxf(x, dpp_mov<0x143, 0xc>(NI, x));
    return x;
}
__device__ __forceinline__ void chunk_range(int c, int& t0, int& Lv) { if (c == 0) { t0 = 0; Lv = NMETA; } else { t0 = NMETA + 64 * (c - 1); Lv = 64; } }

__device__ __forceinline__ void mlstm_prep_unit(const Ctx& c, int l, int u) {
    int w = c.wave; asm volatile("" : "+s"(w)); const int lane = hw_lane(), tid = w * 64 + lane;
    const int cch = u % NCH, bh = u / NCH, h = bh % HA, b = bh / HA;
    int t0, Lv; chunk_range(cch, t0, Lv);
    const size_t row0 = (size_t)b * TP + t0;
    const bf16_t* PROJ = (const bf16_t*)(c.ws + WS_PROJ); const float* SG = (const float*)(c.ws + WS_SG);
    LAS bf16_t* Qs = (LAS bf16_t*)c.lds; LAS bf16_t* Ks = Qs + 64 * 264; LAS bf16_t* VTs = Ks + 64 * 264; LAS bf16_t* Ss = VTs + 256 * 72;
    LAS float* ga = (LAS float*)(Ss + 64 * 72); LAS float* gcm = ga + 64, *gb = ga + 128, *gwk = ga + 192, *dpart = ga + 256  ;
    bf16_t* gKTw = (bf16_t*)(c.ws + WS_ML_KTW) + (size_t)u * 256 * 64; bf16_t* gVT = (bf16_t*)(c.ws + WS_ML_VT) + (size_t)u * 256 * 64;
    float* gNP = (float*)(c.ws + WS_ML_NP) + (size_t)u * 64 * 256; float* gSC = (float*)(c.ws + WS_ML_SC) + (size_t)u * 256;
    if (w == 0) {
        float li = -1e30f, lf = 0.f;
        if (lane < Lv) { li = SG[(row0 + lane) * SGLD + h] + inp(c, I_BI)[l * HA + h]; lf = -softplusf_(-(SG[(row0 + lane) * SGLD + 4 + h] + inp(c, I_BF)[l * HA + h])); }
        const float bb = wave_incl_sum(lf, lane); const float a = li - bb; const float cm = wave_incl_max(a, lane);
        const float cml = lane_bcast(cm, 63);
        ga[lane] = a; gcm[lane] = cm; gb[lane] = bb; gwk[lane] = __expf(a - cml);
        gSC[lane] = bb; gSC[64 + lane] = cm;
    }
    { u32x4 q4[4], k4[4], v4[4];
#pragma unroll
      for (int k = 0; k < 4; ++k) { const int i = tid + k * NTHR; const int r = i >> 5, c8 = i & 31, rv = i & 63, cv = i >> 6;
          q4[k] = (u32x4){0u, 0u, 0u, 0u}; k4[k] = q4[k]; v4[k] = q4[k];
          if (r < Lv) { const bf16_t* pr = PROJ + (row0 + r) * NPROJ + h * 256 + c8 * 8; q4[k] = *(const u32x4*)(pr + PA_Q); k4[k] = *(const u32x4*)(pr + PA_K); }
          if (rv < Lv) v4[k] = *(const u32x4*)(PROJ + (row0 + rv) * NPROJ + PA_V + h * 256 + cv * 8); }
#pragma unroll
      for (int k = 0; k < 4; ++k) { const int i = tid + k * NTHR; const int r = i >> 5, c8 = i & 31, rv = i & 63, cv = i >> 6;
          *(LAS u32x4*)(Qs + r * 264 + c8 * 8) = q4[k]; *(LAS u32x4*)(Ks + r * 264 + c8 * 8) = k4[k];
          LAS bf16_t* d = VTs + (cv * 8) * 72 + rv; const u32x4 v = v4[k];
          d[0] = (bf16_t)(v.x & 0xffffu); d[72] = (bf16_t)(v.x >> 16); d[144] = (bf16_t)(v.y & 0xffffu); d[216] = (bf16_t)(v.y >> 16);
          d[288] = (bf16_t)(v.z & 0xffffu); d[360] = (bf16_t)(v.z >> 16); d[432] = (bf16_t)(v.w & 0xffffu); d[504] = (bf16_t)(v.w >> 16); } }
    lds_barrier();
    { const int mt = w & 3, nh = w >> 2;
      f32x4 acc[1][2]; acc[0][0] = (f32x4){0.f, 0.f, 0.f, 0.f}; acc[0][1] = acc[0][0];
      mma_lds<1, 2, 8>(acc, Qs, 264, 16 * mt, Ks, 264, 32 * nh, lane);
      float rs[4] = {0.f, 0.f, 0.f, 0.f};
#pragma unroll
      for (int j = 0; j < 2; ++j) { const int sidx = 32 * nh + 16 * j + (lane & 15); const float as = ga[sidx];
#pragma unroll
          for (int r = 0; r < 4; ++r) { const int lidx = 16 * mt + 4 * (lane >> 4) + r;
              const float val = sidx <= lidx ? acc[0][j][r] * 0.0625f * __expf(as - gcm[lidx]) : 0.f;
              rs[r] += val; Ss[lidx * 72 + sidx] = (bf16_t)f2bf(val); } }
#pragma unroll
      for (int r = 0; r < 4; ++r) { const float x = row16_sum(rs[r]);
          if ((lane & 15) == 0) dpart[nh * 64 + 16 * mt + 4 * (lane >> 4) + r] = x; }
    }
    for (int i = tid; i < 256 * 8; i += NTHR) { const int r = i >> 3, c8 = i & 7; *(u32x4*)(gVT + r * 64 + c8 * 8) = *(const LAS u32x4*)(VTs + r * 72 + c8 * 8); }
    for (int i = tid; i < 256 * 8; i += NTHR) { const int k = i & 255, c8 = i >> 8; u32x4 o; float x[8];
#pragma unroll
        for (int e = 0; e < 8; ++e) x[e] = bf2f(Ks[(c8 * 8 + e) * 264 + k]) * 0.0625f * gwk[c8 * 8 + e];
        o.x = pk2(x[0], x[1]); o.y = pk2(x[2], x[3]); o.z = pk2(x[4], x[5]); o.w = pk2(x[6], x[7]);
        *(u32x4*)(gKTw + k * 64 + c8 * 8) = o; }
    lds_barrier();
    if (tid < 64) gSC[128 + tid] = dpart[tid] + dpart[64 + tid];
    { f32x4 acc[2][4];
#pragma unroll
      for (int i = 0; i < 2; ++i)
#pragma unroll
          for (int j = 0; j < 4; ++j) acc[i][j] = (f32x4){0.f, 0.f, 0.f, 0.f};
      mma_lds<2, 4, 2>(acc, VTs, 72, 32 * w, Ss, 72, 0, lane);
#pragma unroll
      for (int i = 0; i < 2; ++i)
#pragma unroll
          for (int j = 0; j < 4; ++j) { const int v0 = 32 * w + 16 * i + 4 * (lane >> 4), lidx = 16 * j + (lane & 15); *(f32x4*)(gNP + lidx * 256 + v0) = acc[i][j]; }
    }
    lds_barrier();
}

__device__ __forceinline__ void mlstm_seq_unit(const Ctx& c, int l, int b, int h, int vs) {
    int w = c.wave; asm volatile("" : "+s"(w)); const int lane = hw_lane(), tid = w * 64 + lane;
    const bf16_t* PROJ = (const bf16_t*)(c.ws + WS_PROJ);
    LAS bf16_t* Qs = (LAS bf16_t*)c.lds; LAS bf16_t* KTw = Qs + 64 * 264; LAS bf16_t* VTs = KTw + 256 * 72; LAS bf16_t* CTs = VTs + 80 * 72;
    LAS float* sb = (LAS float*)(CTs + 80 * 264); LAS float* scm = sb + 64, *sdp = sb + 128, *sqn = sb + 192;
    float* HAo = (float*)(c.ws + WS_HA);
    for (int i = tid; i < 80 * 264; i += NTHR) CTs[i] = 0;
    for (int i = tid; i < 16 * 72; i += NTHR) VTs[64 * 72 + i] = (i < 72) ? (bf16_t)0x3f80 : (bf16_t)0;
    f32x4 Cst[2][5];
#pragma unroll
    for (int i = 0; i < 2; ++i)
#pragma unroll
        for (int j = 0; j < 5; ++j) Cst[i][j] = (f32x4){0.f, 0.f, 0.f, 0.f};
    float m = 0.f;
    const int lt = w & 3, vh = w >> 2;
    u32x4 pq[2][4], pk[2][4], pv[2]; float psc[2] = {0.f, 0.f}; f32x4 pn[2][2];
#define ML_ISSUE(cc, S_) do { int t0_, Lv_; chunk_range((cc), t0_, Lv_); const size_t row0_ = (size_t)b * TP + t0_; const int u_ = (b * HA + h) * NCH + (cc); \
        const bf16_t* gK_ = (const bf16_t*)(c.ws + WS_ML_KTW) + (size_t)u_ * 256 * 64; const bf16_t* gV_ = (const bf16_t*)(c.ws + WS_ML_VT) + (size_t)u_ * 256 * 64 + (size_t)vs * 64 * 64; \
        const float* gN_ = (const float*)(c.ws + WS_ML_NP) + (size_t)u_ * 64 * 256; const float* gS_ = (const float*)(c.ws + WS_ML_SC) + (size_t)u_ * 256; \
        _Pragma("unroll") for (int k_ = 0; k_ < 4; ++k_) { const int i_ = tid + k_ * NTHR; const int r_ = i_ >> 5, c8_ = i_ & 31; pq[S_][k_] = (u32x4){0u, 0u, 0u, 0u}; \
            if (r_ < Lv_) pq[S_][k_] = *(const u32x4*)(PROJ + (row0_ + r_) * NPROJ + PA_Q + h * 256 + c8_ * 8); pk[S_][k_] = *(const u32x4*)(gK_ + (i_ >> 3) * 64 + (i_ & 7) * 8); } \
        pv[S_] = *(const u32x4*)(gV_ + (tid >> 3) * 64 + (tid & 7) * 8); psc[S_] = tid < 192 ? gS_[tid] : 0.f; \
        _Pragma("unroll") for (int j_ = 0; j_ < 2; ++j_) pn[S_][j_] = *(const f32x4*)(gN_ + (16 * lt + (lane & 15)) * 256 + vs * 64 + 16 * (vh + 2 * j_) + 4 * (lane >> 4)); } while (0)
#define ML_CHUNK(cch, S) do { \
        int t0, Lv; chunk_range((cch), t0, Lv); \
        const size_t row0 = (size_t)b * TP + t0; \
        _Pragma("unroll") \
        for (int k = 0; k < 4; ++k) { const int i = tid + k * NTHR; *(LAS u32x4*)(Qs + (i >> 5) * 264 + (i & 31) * 8) = pq[S][k]; *(LAS u32x4*)(KTw + (i >> 3) * 72 + (i & 7) * 8) = pk[S][k]; } \
        *(LAS u32x4*)(VTs + (tid >> 3) * 72 + (tid & 7) * 8) = pv[S]; \
        if (tid < 192) sb[tid] = psc[S]; \
        const f32x4 np0 = pn[S][0], np1 = pn[S][1]; \
        if ((cch) + 2 < NCH) ML_ISSUE((cch) + 2, S); \
        lds_barrier(); \
        f32x4 ia[3]; ia[0] = (f32x4){0.f, 0.f, 0.f, 0.f}; ia[1] = ia[0]; ia[2] = ia[0]; \
        _Pragma("unroll") \
        for (int ks = 0; ks < 8; ++ks) { const bf16x8 qf = ldfrag(Qs, 264, 16 * lt, 32 * ks, lane); \
            ia[0] = mfma16(ldfrag(CTs, 264, 16 * vh, 32 * ks, lane), qf, ia[0]); \
            ia[1] = mfma16(ldfrag(CTs, 264, 16 * (vh + 2), 32 * ks, lane), qf, ia[1]); \
            if (vh == 0) ia[2] = mfma16(ldfrag(CTs, 264, 64, 32 * ks, lane), qf, ia[2]); } \
        if (vh == 0 && lane < 16) sqn[16 * lt + lane] = ia[2][0]; \
        lds_barrier(); \
        { const int lidx = 16 * lt + (lane & 15); \
          const float cm = scm[lidx], bl = sb[lidx]; const float M = fmaxf(m, cm), rho = __expf(cm - M), sig = __expf(m - M); \
          float den = rho * sdp[lidx] + sig * sqn[lidx]; den = fmaxf(fabsf(den), __expf(-(bl + M))); const float dinv = __builtin_amdgcn_rcpf(den); \
          if (lidx < Lv) { \
        _Pragma("unroll") \
              for (int j = 0; j < 2; ++j) { const int v0 = 16 * (vh + 2 * j) + 4 * (lane >> 4); \
                  const f32x4 np = j == 0 ? np0 : np1; \
                  *(f32x4*)(HAo + (row0 + lidx) * 1024 + h * 256 + vs * 64 + v0) = (np * rho + ia[j] * sig) * dinv; } } } \
        { const float cml = scm[63], Ml = fmaxf(m, cml), dec = __expf(m - Ml), rl = __expf(cml - Ml); \
          _Pragma("unroll") for (int i = 0; i < 2; ++i) { f32x4 d2[1][5]; \
              _Pragma("unroll") for (int j = 0; j < 5; ++j) d2[0][j] = (f32x4){0.f, 0.f, 0.f, 0.f}; \
              mma_lds<1, 5, 2>(d2, KTw, 72, 32 * w + 16 * i, VTs, 72, 0, lane); \
              _Pragma("unroll") for (int j = 0; j < 5; ++j) { Cst[i][j] = Cst[i][j] * dec + d2[0][j] * rl; \
                  u32x2 o; o.x = pk2(Cst[i][j][0], Cst[i][j][1]); o.y = pk2(Cst[i][j][2], Cst[i][j][3]); \
                  *(LAS u32x2*)(CTs + (16 * j + (lane & 15)) * 264 + 32 * w + 16 * i + 4 * (lane >> 4)) = o; } } \
          m = sb[63] + Ml; } \
        lds_barrier(); \
    } while (0)
    ML_ISSUE(0, 0); ML_ISSUE(1, 1);
    lds_barrier();
    for (int cch = 0; cch + 1 < NCH; cch += 2) { ML_CHUNK(cch, 0); ML_CHUNK(cch + 1, 1); }
    ML_CHUNK(NCH - 1, 0);
#undef ML_CHUNK
#undef ML_ISSUE
    float* oc = c.out + O_PC + (((size_t)l * BATCH + b) * HA + h) * DHA * DHA; float* on = c.out + O_PN + (((size_t)l * BATCH + b) * HA + h) * DHA;
#pragma unroll
    for (int i = 0; i < 2; ++i) { const int k0 = 32 * w + 16 * i + 4 * (lane >> 4);
#pragma unroll
        for (int j = 0; j < 4; ++j)
#pragma unroll
            for (int r = 0; r < 4; ++r) oc[(size_t)(k0 + r) * 256 + vs * 64 + 16 * j + (lane & 15)] = Cst[i][j][r];
        if (vs == 0 && (lane & 15) == 0) {
#pragma unroll
            for (int r = 0; r < 4; ++r) on[k0 + r] = Cst[i][4][r]; } }
    if (vs == 0 && tid == 0) c.out[O_PM + ((size_t)l * BATCH + b) * HA + h] = m;
    lds_barrier();
}

__device__ __forceinline__ f32x4 mfma4f(float a, float b, f32x4 c) { return __builtin_amdgcn_mfma_f32_16x16x4f32(a, b, c, 0, 0, 0); }
__device__ __forceinline__ void tri_inv64(const LAS float* Am, LAS float* Tm, LAS float* Xt, int tid, int w, LAS bf16_t* Tb) {
    for (int i = tid; i < 64 * 65; i += NTHR) Tm[i] = 0.f;
    for (int i = tid; i < 64 * 36; i += NTHR) ((LAS unsigned*)Tb)[i] = 0u;
    lds_barrier();
    if (tid < 64) { const int base = (tid >> 3) * 8, cc = tid & 7; float x[8];
#pragma unroll
        for (int r = 0; r < 8; ++r) { float a = 0.f;
#pragma unroll
            for (int j = 0; j < r; ++j) a += Am[(base + r) * 65 + base + j] * x[j];
            x[r] = (r == cc) ? 1.f : (r < cc ? 0.f : -a); }
#pragma unroll
        for (int r = 0; r < 8; ++r) { Tm[(base + r) * 65 + base + cc] = x[r]; Tb[(base + r) * 72 + base + cc] = (bf16_t)f2bf(x[r]); } }
    lds_barrier();
    const int lane = tid & 63, li = lane & 15, lk = lane >> 4;
    if (w < 2) {
        const int bi = 32 * w + (li < 8 ? 0 : 16), l7 = li & 7; LAS float* X = Xt + w * 512;
        f32x4 x = {0.f, 0.f, 0.f, 0.f};
#pragma unroll
        for (int ks = 0; ks < 2; ++ks) x = mfma4f(Am[(bi + 8 + l7) * 65 + bi + 4 * ks + lk], Tm[(bi + 4 * ks + lk) * 65 + bi + l7], x);
#pragma unroll
        for (int r = 0; r < 4; ++r) X[(4 * lk + r) * 16 + li] = x[r];
        asm volatile("s_waitcnt lgkmcnt(0)" ::: "memory");
        f32x4 y = {0.f, 0.f, 0.f, 0.f};
#pragma unroll
        for (int ks = 0; ks < 2; ++ks) y = mfma4f(Tm[(bi + 8 + l7) * 65 + bi + 8 + 4 * ks + lk], X[(4 * ks + lk + (li < 8 ? 0 : 8)) * 16 + li], y);
        if ((lk < 2) == (li < 8)) {
#pragma unroll
            for (int r = 0; r < 4; ++r) { const int rr = bi + 8 + ((4 * lk + r) & 7); Tm[rr * 65 + bi + l7] = -y[r]; Tb[rr * 72 + bi + l7] = (bf16_t)f2bf(-y[r]); } } }
    lds_barrier();
    if (w < 2) { const int lb = 32 * w, hb = lb + 16; LAS float* X = Xt + w * 512;
        f32x4 x = {0.f, 0.f, 0.f, 0.f};
#pragma unroll
        for (int ks = 0; ks < 4; ++ks) x = mfma4f(Am[(hb + li) * 65 + lb + 4 * ks + lk], Tm[(lb + 4 * ks + lk) * 65 + lb + li], x);
#pragma unroll
        for (int r = 0; r < 4; ++r) X[(4 * lk + r) * 16 + li] = x[r];
        asm volatile("s_waitcnt lgkmcnt(0)" ::: "memory");
        f32x4 y = {0.f, 0.f, 0.f, 0.f};
#pragma unroll
        for (int ks = 0; ks < 4; ++ks) y = mfma4f(Tm[(hb + li) * 65 + hb + 4 * ks + lk], X[(4 * ks + lk) * 16 + li], y);
#pragma unroll
        for (int r = 0; r < 4; ++r) { Tm[(hb + 4 * lk + r) * 65 + lb + li] = -y[r]; Tb[(hb + 4 * lk + r) * 72 + lb + li] = (bf16_t)f2bf(-y[r]); } }
    lds_barrier();
    if (w < 2) { LAS float* X = Xt + w * 512;
        f32x4 x0 = {0.f, 0.f, 0.f, 0.f}, x1 = x0;
#pragma unroll
        for (int ks = 0; ks < 8; ++ks) { const float bb = Tm[(4 * ks + lk) * 65 + 16 * w + li];
            x0 = mfma4f(Am[(32 + li) * 65 + 4 * ks + lk], bb, x0); x1 = mfma4f(Am[(48 + li) * 65 + 4 * ks + lk], bb, x1); }
#pragma unroll
        for (int r = 0; r < 4; ++r) { X[(4 * lk + r) * 16 + li] = x0[r]; X[(16 + 4 * lk + r) * 16 + li] = x1[r]; }
        asm volatile("s_waitcnt lgkmcnt(0)" ::: "memory");
        f32x4 y0 = {0.f, 0.f, 0.f, 0.f}, y1 = y0;
#pragma unroll
        for (int ks = 0; ks < 8; ++ks) { const float bb = X[(4 * ks + lk) * 16 + li];
            y0 = mfma4f(Tm[(32 + li) * 65 + 32 + 4 * ks + lk], bb, y0); y1 = mfma4f(Tm[(48 + li) * 65 + 32 + 4 * ks + lk], bb, y1); }
#pragma unroll
        for (int r = 0; r < 4; ++r) { Tb[(32 + 4 * lk + r) * 72 + 16 * w + li] = (bf16_t)f2bf(-y0[r]); Tb[(48 + 4 * lk + r) * 72 + 16 * w + li] = (bf16_t)f2bf(-y1[r]); } }
    lds_barrier();
}

__device__ __forceinline__ void gdn_prep_unit(const Ctx& c, int l, int u) {
    int w = c.wave; asm volatile("" : "+s"(w)); const int lane = hw_lane(), tid = w * 64 + lane;
    const int cch = u % NCH, bh = u / NCH, h = bh % HB, b = bh / HB;
    int t0, Lv; chunk_range(cch, t0, Lv);
    const size_t row0 = (size_t)b * TP + t0;
    const bf16_t* PROJ = (const bf16_t*)(c.ws + WS_PROJ); const float* SG = (const float*)(c.ws + WS_SG);
    LAS bf16_t* Qs = (LAS bf16_t*)c.lds; LAS bf16_t* Ks = Qs + 64 * 136; LAS bf16_t* RAW = Ks + 64 * 136; LAS bf16_t* RT = RAW; LAS bf16_t* Tb = RT + 256 * 72;
    LAS float* Am = (LAS float*)(c.lds + 86272); LAS float* Tm = Am + 64 * 65; LAS float* Xt = Tm + 64 * 65; LAS float* psq = Xt + 32 * 33; LAS float* sg = psq + 1024; LAS float* sbe = sg + 64;
    bf16_t* gW = (bf16_t*)(c.ws + WS_GD_W) + (size_t)u * 64 * 128; bf16_t* gUT = (bf16_t*)(c.ws + WS_GD_UT) + (size_t)u * 128 * 64; bf16_t* gAT = (bf16_t*)(c.ws + WS_GD_AT) + (size_t)u * 64 * 64;
    bf16_t* gQ = (bf16_t*)(c.ws + WS_GD_Q) + (size_t)u * 64 * 128; bf16_t* gKD = (bf16_t*)(c.ws + WS_GD_KD) + (size_t)u * 128 * 64; float* gSC = (float*)(c.ws + WS_GD_SC) + (size_t)u * 128;
    if (w == 0) { float ga = 0.f, be = 0.f;
        if (lane < Lv) { const float a = SG[(row0 + lane) * SGLD + 8 + h], bb = SG[(row0 + lane) * SGLD + 16 + h];
            ga = -__expf(inp(c, I_ALOG)[l * HB + h]) * softplusf_(a + inp(c, I_DTB)[l * HB + h]); be = sigmoidf_(bb); }
        const float g = wave_incl_sum(ga, lane); sg[lane] = g; sbe[lane] = be; gSC[lane] = __expf(g); if (lane == 63) gSC[64] = __expf(g); }
    { u32x4 rv[7]; float cwv[3];
#pragma unroll
      for (int k = 0; k < 3; ++k) { const int i = tid + k * NTHR; const int j = i / 384, ch = i % 384; cwv[k] = inp(c, I_CONVW)[(size_t)l * 4 * 3072 + j * 3072 + (ch >> 7) * 1024 + h * 128 + (ch & 127)]; }
#pragma unroll
      for (int k = 0; k < 7; ++k) { const int i = tid + k * NTHR; rv[k] = (u32x4){0u, 0u, 0u, 0u};
          if (i < 67 * 48) { const int rr = i / 48, c8 = i % 48, part = c8 >> 4, d8 = c8 & 15; const int tt = t0 - 3 + rr;
              if (tt >= 0 && rr - 3 < Lv) rv[k] = *(const u32x4*)(PROJ + ((size_t)b * TP + tt) * NPROJ + PB_QKV + part * 1024 + h * 128 + d8 * 8); } }
#pragma unroll
      for (int k = 0; k < 7; ++k) { const int i = tid + k * NTHR; if (i < 67 * 48) { const int rr = i / 48, c8 = i % 48; *(LAS u32x4*)(RAW + rr * 384 + c8 * 8) = rv[k]; } }
#pragma unroll
      for (int k = 0; k < 3; ++k) ((LAS float*)(c.lds + 102912))[tid + k * NTHR] = cwv[k]; }
    lds_barrier();
    const int s = lane, p = w;
    float yq[16], yk[16], yv[16];
    { const LAS float* cw = (const LAS float*)(c.lds + 102912); float sq = 0.f, sk = 0.f;
#pragma unroll
      for (int part = 0; part < 3; ++part) {
#pragma unroll
          for (int e4 = 0; e4 < 4; ++e4) { f32x4 a = (f32x4){0.f, 0.f, 0.f, 0.f};
#pragma unroll
              for (int j = 0; j < 4; ++j) { const f32x4 wv = *(const LAS f32x4*)(cw + j * 384 + part * 128 + p * 16 + e4 * 4);
                  const u32x2 rv = *(const LAS u32x2*)(RAW + (s + j) * 384 + part * 128 + p * 16 + e4 * 4);
                  a[0] += wv[0] * __uint_as_float(rv.x << 16); a[1] += wv[1] * __uint_as_float(rv.x & 0xffff0000u); a[2] += wv[2] * __uint_as_float(rv.y << 16); a[3] += wv[3] * __uint_as_float(rv.y & 0xffff0000u); }
#pragma unroll
              for (int e = 0; e < 4; ++e) { const float y = s < Lv ? siluf_(a[e]) : 0.f;
                  if (part == 0) { yq[e4 * 4 + e] = y; sq += y * y; } else if (part == 1) { yk[e4 * 4 + e] = y; sk += y * y; } else yv[e4 * 4 + e] = y; } } }
      psq[p * 64 + s] = sq; psq[512 + p * 64 + s] = sk; }
    lds_barrier();
    { float sq = 0.f, sk = 0.f;
#pragma unroll
      for (int i = 0; i < 8; ++i) { sq += psq[i * 64 + s]; sk += psq[512 + i * 64 + s]; }
      const float qn = rsqrtf(sq + 1e-12f) * 0.08838834764831845f, kn = rsqrtf(sk + 1e-12f);
      const float g = sg[s], be = sbe[s], gL = sg[63]; const float kb = kn * be * __expf(g), kd = kn * __expf(gL - g);
      u32x4 o0, o1;
      o0.x = pk2(yq[0] * qn, yq[1] * qn); o0.y = pk2(yq[2] * qn, yq[3] * qn); o0.z = pk2(yq[4] * qn, yq[5] * qn); o0.w = pk2(yq[6] * qn, yq[7] * qn);
      o1.x = pk2(yq[8] * qn, yq[9] * qn); o1.y = pk2(yq[10] * qn, yq[11] * qn); o1.z = pk2(yq[12] * qn, yq[13] * qn); o1.w = pk2(yq[14] * qn, yq[15] * qn);
      *(LAS u32x4*)(Qs + s * 136 + p * 16) = o0; *(LAS u32x4*)(Qs + s * 136 + p * 16 + 8) = o1; *(u32x4*)(gQ + s * 128 + p * 16) = o0; *(u32x4*)(gQ + s * 128 + p * 16 + 8) = o1;
      o0.x = pk2(yk[0] * kn, yk[1] * kn); o0.y = pk2(yk[2] * kn, yk[3] * kn); o0.z = pk2(yk[4] * kn, yk[5] * kn); o0.w = pk2(yk[6] * kn, yk[7] * kn);
      o1.x = pk2(yk[8] * kn, yk[9] * kn); o1.y = pk2(yk[10] * kn, yk[11] * kn); o1.z = pk2(yk[12] * kn, yk[13] * kn); o1.w = pk2(yk[14] * kn, yk[15] * kn);
      *(LAS u32x4*)(Ks + s * 136 + p * 16) = o0; *(LAS u32x4*)(Ks + s * 136 + p * 16 + 8) = o1;
#pragma unroll
      for (int e = 0; e < 16; ++e) { RT[(p * 16 + e) * 72 + s] = (bf16_t)f2bf(yv[e] * be); RT[(128 + p * 16 + e) * 72 + s] = (bf16_t)f2bf(yk[e] * kb); gKD[(p * 16 + e) * 64 + s] = (bf16_t)f2bf(yk[e] * kd); } }
    lds_barrier();
    { const int mt = w & 3, nh = w >> 2;
      f32x4 aK[2][1], aQ[2][1]; aK[0][0] = (f32x4){0.f, 0.f, 0.f, 0.f}; aK[1][0] = aK[0][0]; aQ[0][0] = aK[0][0]; aQ[1][0] = aK[0][0];
      mma_lds<2, 1, 4>(aK, Ks, 136, 32 * nh, Ks, 136, 16 * mt, lane);
      mma_lds<2, 1, 4>(aQ, Ks, 136, 32 * nh, Qs, 136, 16 * mt, lane);
      const int lidx = 16 * mt + (lane & 15); const float gl = sg[lidx], bel = sbe[lidx];
#pragma unroll
      for (int i = 0; i < 2; ++i) { const int s0 = 32 * nh + 16 * i + 4 * (lane >> 4); const f32x4 gs = *(const LAS f32x4*)(sg + s0); float q[4];
#pragma unroll
          for (int r = 0; r < 4; ++r) { const int sidx = s0 + r; const float dcy = sidx <= lidx ? __expf(gl - gs[r]) : 0.f;
              Am[lidx * 65 + sidx] = sidx < lidx ? bel * aK[i][0][r] * dcy : 0.f; q[r] = aQ[i][0][r] * dcy; }
          u32x2 o; o.x = pk2(q[0], q[1]); o.y = pk2(q[2], q[3]); *(u32x2*)(gAT + lidx * 64 + s0) = o; } }
    lds_barrier();
    tri_inv64(Am, Tm, Xt, tid, w, Tb);
    { f32x4 aU[1][4], aW[1][4];
#pragma unroll
      for (int j = 0; j < 4; ++j) { aU[0][j] = (f32x4){0.f, 0.f, 0.f, 0.f}; aW[0][j] = aU[0][j]; }
      const int mt = w & 3, vq = w >> 2;
      mma_lds<1, 4, 2>(aU, Tb, 72, 16 * mt, RT, 72, 64 * vq, lane);
      mma_lds<1, 4, 2>(aW, RT, 72, 128 + 16 * w, Tb, 72, 0, lane);
#pragma unroll
      for (int j = 0; j < 4; ++j) { u32x2 o; o.x = pk2(aU[0][j][0], aU[0][j][1]); o.y = pk2(aU[0][j][2], aU[0][j][3]);
          *(u32x2*)(gUT + (64 * vq + 16 * j + (lane & 15)) * 64 + 16 * mt + 4 * (lane >> 4)) = o;
          o.x = pk2(aW[0][j][0], aW[0][j][1]); o.y = pk2(aW[0][j][2], aW[0][j][3]);
          *(u32x2*)(gW + (16 * j + (lane & 15)) * 128 + 16 * w + 4 * (lane >> 4)) = o; } }
    lds_barrier();
}

__device__ __forceinline__ void gdn_seq_unit(const Ctx& c, int l, int b, int h) {
    int w = c.wave; asm volatile("" : "+s"(w)); const int lane = hw_lane(), tid = w * 64 + lane;
    const bf16_t* PROJ = (const bf16_t*)(c.ws + WS_PROJ); bf16_t* YBR = (bf16_t*)(c.ws + WS_YBR);
    LAS bf16_t* Qs = (LAS bf16_t*)c.lds; LAS bf16_t* Wm = Qs + 64 * 136; LAS bf16_t* UT = Wm + 64 * 136; LAS bf16_t* ATs = UT + 128 * 72; LAS bf16_t* KD = ATs + 64 * 72; LAS bf16_t* ST = KD + 128 * 72;
    LAS float* seg = (LAS float*)(ST + 128 * 136); LAS float* ssq = seg + 128; LAS float* gnws = ssq + 128;
    for (int i = tid; i < 128 * 136; i += NTHR) ST[i] = 0;
    if (tid < 128) gnws[tid] = inp(c, I_GNW)[l * DHB + tid];
    f32x4 Sst[1][8];
#pragma unroll
    for (int j = 0; j < 8; ++j) Sst[0][j] = (f32x4){0.f, 0.f, 0.f, 0.f};
    const int lt = w & 3, vq = w >> 2;
    const LAS float* gnwp = gnws + 64 * vq + 4 * (lane >> 4);
    u32x4 pQ[1][2], pW[1][2], pU[1][2], pK[1][2], pA[1]; float psc[1] = {0.f}; u32x2 pz[4];
#define GD_ISSUE(cc, S_) do { const int u_ = (b * HB + h) * NCH + (cc); \
        const bf16_t* gW_ = (const bf16_t*)(c.ws + WS_GD_W) + (size_t)u_ * 64 * 128; const bf16_t* gUT_ = (const bf16_t*)(c.ws + WS_GD_UT) + (size_t)u_ * 128 * 64; const bf16_t* gAT_ = (const bf16_t*)(c.ws + WS_GD_AT) + (size_t)u_ * 64 * 64; \
        const bf16_t* gQ_ = (const bf16_t*)(c.ws + WS_GD_Q) + (size_t)u_ * 64 * 128; const bf16_t* gKD_ = (const bf16_t*)(c.ws + WS_GD_KD) + (size_t)u_ * 128 * 64; const float* gSC_ = (const float*)(c.ws + WS_GD_SC) + (size_t)u_ * 128; \
        _Pragma("unroll") for (int k_ = 0; k_ < 2; ++k_) { const int i_ = tid + k_ * NTHR; pQ[S_][k_] = *(const u32x4*)(gQ_ + (i_ >> 4) * 128 + (i_ & 15) * 8); pW[S_][k_] = *(const u32x4*)(gW_ + (i_ >> 4) * 128 + (i_ & 15) * 8); \
            pU[S_][k_] = *(const u32x4*)(gUT_ + (i_ >> 3) * 64 + (i_ & 7) * 8); pK[S_][k_] = *(const u32x4*)(gKD_ + (i_ >> 3) * 64 + (i_ & 7) * 8); } \
        pA[S_] = *(const u32x4*)(gAT_ + (tid >> 3) * 64 + (tid & 7) * 8); psc[S_] = tid < 65 ? gSC_[tid] : 0.f; } while (0)
#define GD_ZISSUE(cc) do { int t0_, Lv_; chunk_range((cc), t0_, Lv_); const size_t row0_ = (size_t)b * TP + t0_; \
        _Pragma("unroll") for (int i_ = 0; i_ < 4; ++i_) { const int zr_ = 16 * lt + (lane & 15) < Lv_ ? 16 * lt + (lane & 15) : Lv_ - 1; pz[i_] = *(const u32x2*)(PROJ + (row0_ + zr_) * NPROJ + PB_Z + h * 128 + 64 * vq + 16 * i_ + 4 * (lane >> 4)); } } while (0)
#define GD_CHUNK(cch, S) do { \
        int t0, Lv; chunk_range((cch), t0, Lv); \
        const size_t row0 = (size_t)b * TP + t0; \
        _Pragma("unroll") \
        for (int k = 0; k < 2; ++k) { const int i = tid + k * NTHR; *(LAS u32x4*)(Qs + (i >> 4) * 136 + (i & 15) * 8) = pQ[S][k]; *(LAS u32x4*)(Wm + (i >> 4) * 136 + (i & 15) * 8) = pW[S][k]; \
            *(LAS u32x4*)(UT + (i >> 3) * 72 + (i & 7) * 8) = pU[S][k]; *(LAS u32x4*)(KD + (i >> 3) * 72 + (i & 7) * 8) = pK[S][k]; } \
        *(LAS u32x4*)(ATs + (tid >> 3) * 72 + (tid & 7) * 8) = pA[S]; \
        if (tid < 65) seg[tid] = psc[S]; \
        if ((cch) + 1 < NCH) GD_ISSUE((cch) + 1, S); \
        GD_ZISSUE(cch); \
        lds_barrier(); \
        f32x4 aq[4][1]; \
        _Pragma("unroll") for (int j = 0; j < 4; ++j) aq[j][0] = (f32x4){0.f, 0.f, 0.f, 0.f}; \
        _Pragma("unroll") for (int jh = 0; jh < 2; ++jh) { f32x4 ws_[1][2]; ws_[0][0] = (f32x4){0.f, 0.f, 0.f, 0.f}; ws_[0][1] = ws_[0][0]; \
          mma_lds<1, 2, 4>(ws_, Wm, 136, 16 * lt, ST, 136, 64 * vq + 32 * jh, lane); \
          { f32x4 (&aqh)[2][1] = *(f32x4 (*)[2][1])&aq[2 * jh]; mma_lds<2, 1, 4>(aqh, ST, 136, 64 * vq + 32 * jh, Qs, 136, 16 * lt, lane); } \
          _Pragma("unroll") for (int j2 = 0; j2 < 2; ++j2) { const int j = 2 * jh + j2; LAS u32x2* pu = (LAS u32x2*)(UT + (64 * vq + 16 * j + (lane & 15)) * 72 + 16 * lt + 4 * (lane >> 4)); const u32x2 uu = *pu; \
              u32x2 o; o.x = pk2(__uint_as_float(uu.x << 16) - ws_[0][j2][0], __uint_as_float(uu.x & 0xffff0000u) - ws_[0][j2][1]); \
              o.y = pk2(__uint_as_float(uu.y << 16) - ws_[0][j2][2], __uint_as_float(uu.y & 0xffff0000u) - ws_[0][j2][3]); *pu = o; } } \
        lds_barrier(); \
        { const int lidx = 16 * lt + (lane & 15); const float egl = seg[lidx], egL = seg[64]; \
        _Pragma("unroll") \
          for (int i = 0; i < 4; ++i) aq[i][0] = aq[i][0] * egl; \
          mma_lds<4, 1, 2>(aq, UT, 72, 64 * vq, ATs, 72, 16 * lt, lane); \
        _Pragma("unroll") \
          for (int j = 0; j < 8; ++j) Sst[0][j] = Sst[0][j] * egL; \
          mma_lds<1, 8, 2>(Sst, KD, 72, 16 * w, UT, 72, 0, lane); \
        _Pragma("unroll") \
          for (int j = 0; j < 8; ++j) { u32x2 o; o.x = pk2(Sst[0][j][0], Sst[0][j][1]); o.y = pk2(Sst[0][j][2], Sst[0][j][3]); *(LAS u32x2*)(ST + (16 * j + (lane & 15)) * 136 + 16 * w + 4 * (lane >> 4)) = o; } \
          float ss = 0.f; \
        _Pragma("unroll") \
          for (int i = 0; i < 4; ++i) ss += (aq[i][0][0] * aq[i][0][0] + aq[i][0][1] * aq[i][0][1]) + (aq[i][0][2] * aq[i][0][2] + aq[i][0][3] * aq[i][0][3]); \
          ss += __shfl_xor(ss, 16); ss += __shfl_xor(ss, 32); \
          if (lane < 16) ssq[vq * 64 + lidx] = ss; \
          lds_barrier(); \
          const float rs = rsqrtf((ssq[lidx] + ssq[64 + lidx]) * (1.f / 128.f) + 1e-6f); \
          if (lidx < Lv) { \
        _Pragma("unroll") \
              for (int i = 0; i < 4; ++i) { const int v0 = 64 * vq + 16 * i + 4 * (lane >> 4); const f32x4 gw4 = *(const LAS f32x4*)(gnwp + 16 * i); \
                  const u32x2 zz = pz[i]; \
                  u32x2 o; o.x = pk2(aq[i][0][0] * rs * gw4[0] * siluf_(__uint_as_float(zz.x << 16)), aq[i][0][1] * rs * gw4[1] * siluf_(__uint_as_float(zz.x & 0xffff0000u))); \
                  o.y = pk2(aq[i][0][2] * rs * gw4[2] * siluf_(__uint_as_float(zz.y << 16)), aq[i][0][3] * rs * gw4[3] * siluf_(__uint_as_float(zz.y & 0xffff0000u))); \
                  *(u32x2*)(YBR + (row0 + lidx) * YLD + 1024 + h * 128 + v0) = o; } } } \
        lds_barrier(); \
    } while (0)
    GD_ISSUE(0, 0);
    lds_barrier();
#pragma unroll 1
    for (int cch = 0; cch < NCH; ++cch) GD_CHUNK(cch, 0);
#undef GD_CHUNK
#undef GD_ZISSUE
#undef GD_ISSUE
    float* os = c.out + O_PGS + (((size_t)l * BATCH + b) * HB + h) * DHB * DHB;
#pragma unroll
    for (int j = 0; j < 8; ++j)
#pragma unroll
        for (int r = 0; r < 4; ++r) os[(size_t)(16 * w + 4 * (lane >> 4) + r) * 128 + 16 * j + (lane & 15)] = Sst[0][j][r];
    if (tid < 384) { const int cg = (tid >> 7) * 1024 + h * 128 + (tid & 127); float* ocv = c.out + O_PGC + ((size_t)l * BATCH + b) * 3 * 3072;
#pragma unroll
        for (int j = 0; j < 3; ++j) ocv[j * 3072 + cg] = bf2f(PROJ[((size_t)b * TP + TP - 3 + j) * NPROJ + PB_QKV + cg]); }
    __syncthreads();
}

__device__ __forceinline__ void rwkv_prep_unit(const Ctx& c, int l, int u) {
    int w = c.wave; asm volatile("" : "+s"(w)); const int lane = hw_lane(), tid = w * 64 + lane;
    const int cch = u % NCH, bh = u / NCH, h = bh % HC, b = bh / HC;
    int t0, Lv; chunk_range(cch, t0, Lv);
    const bf16_t* PROJ = (const bf16_t*)(c.ws + WS_PROJ);
    LAS bf16_t* XW = (LAS bf16_t*)c.lds; LAS bf16_t* XA = XW + 64 * 72; LAS bf16_t* XG = XA + 64 * 72; LAS bf16_t* W2T = XG + 64 * 136; LAS bf16_t* A2T = W2T + 64 * 72; LAS bf16_t* G2T = A2T + 64 * 72;
    LAS bf16_t* STG = (LAS bf16_t*)(c.lds + 73728); LAS float* LO = (LAS float*)(c.lds + 73728); LAS float* red = (LAS float*)(c.lds + 123648);
    LAS bf16_t* AR = (LAS bf16_t*)c.lds; LAS bf16_t* KB = AR + 128 * 72; LAS bf16_t* VT = KB + 128 * 72; LAS bf16_t* KhT = VT + 64 * 72; LAS bf16_t* R2T = KhT + 64 * 72;
    LAS bf16_t* AkR = (LAS bf16_t*)(c.lds + 73728); LAS float* Am = (LAS float*)(c.lds + 92160); LAS float* Tm = Am + 64 * 65; LAS float* Xt = Tm + 64 * 65; LAS bf16_t* Tb = AR;
    bf16_t* gU = (bf16_t*)(c.ws + WS_RW) + (size_t)u * RW_N * 4096;
    bf16_t* gTA = gU + RW_TA * 4096; bf16_t* gPVT = gU + RW_PVT * 4096; bf16_t* gRH = gU + RW_RH * 4096; bf16_t* gYV = gU + RW_YV * 4096;
    bf16_t* gARB = gU + RW_ARB * 4096; bf16_t* gBHT = gU + RW_BHT * 4096; bf16_t* gKVT = gU + RW_KVT * 4096; bf16_t* gV = gU + RW_V * 4096; bf16_t* gG = gU + RW_G * 4096;
    float* gSC = (float*)(c.ws + WS_RW_SC) + (size_t)u * 128;
    LAS float* PRM = (LAS float*)(c.lds + 127744);
    u32x4 st1[4], st2[5];
    { const float* w2p = inp(c, I_W2) + (size_t)l * 64 * 1024 + h * 64 + (tid >> 6) * 1024 + (tid & 63); const float* a2p = inp(c, I_A2) + (size_t)l * 64 * 1024 + h * 64 + (tid >> 6) * 1024 + (tid & 63);
      const float* g2p = inp(c, I_G2) + (size_t)l * 128 * 1024 + h * 64 + (tid >> 6) * 1024 + (tid & 63);
      float lw2[8], la2[8], lg2[16], pv_[2];
#pragma unroll
      for (int k = 0; k < 8; ++k) { lw2[k] = w2p[k * 8192]; la2[k] = a2p[k * 8192]; }
#pragma unroll
      for (int k = 0; k < 16; ++k) lg2[k] = g2p[k * 8192];
#pragma unroll
      for (int q = 0; q < 2; ++q) { const int idx = tid + q * NTHR; pv_[q] = 0.f;
          if (idx < 768) { const float* src;
              if (idx < 192) src = inp(c, I_MU) + (size_t)l * NCC + (idx >> 6) * 1024 + h * 64 + (idx & 63);
              else if (idx < 448) src = inp(c, I_MU) + (size_t)l * NCC + 3072 + (idx - 192);
              else { const int t_ = (idx - 448) >> 6, o_ = l * 1024 + h * 64 + ((idx - 448) & 63);
                  src = (t_ == 0 ? inp(c, I_W0) : t_ == 1 ? inp(c, I_A0) : t_ == 2 ? inp(c, I_KK) : t_ == 3 ? inp(c, I_KA) : inp(c, I_RK)) + o_; }
              pv_[q] = *src; } }
#pragma unroll
      for (int k = 0; k < 4; ++k) { const int i = tid + k * NTHR; st1[k] = (u32x4){0u, 0u, 0u, 0u};
          if (i < 65 * 24) { const int rr = i / 24, c8 = i % 24, part = c8 >> 3, d8 = c8 & 7; const int tt = t0 - 1 + rr;
              if (tt >= 0 && rr - 1 < Lv) st1[k] = *(const u32x4*)(PROJ + ((size_t)b * TP + tt) * NPROJ + PC0 + part * 1024 + h * 64 + d8 * 8); } }
#pragma unroll
      for (int k = 0; k < 5; ++k) { const int i = tid + k * NTHR; st2[k] = (u32x4){0u, 0u, 0u, 0u};
          if (i < 65 * 32) { const int rr = i >> 5, c8 = i & 31; const int tt = t0 - 1 + rr;
              if (tt >= 0 && rr - 1 < Lv) st2[k] = *(const u32x4*)(PROJ + ((size_t)b * TP + tt) * NPROJ + PC0 + 3072 + c8 * 8); } }
      LAS bf16_t* dw = W2T + (tid & 63) * 72 + (tid >> 6); LAS bf16_t* da = A2T + (tid & 63) * 72 + (tid >> 6); LAS bf16_t* dg = G2T + (tid & 63) * 136 + (tid >> 6);
#pragma unroll
      for (int k = 0; k < 8; ++k) { dw[8 * k] = (bf16_t)f2bf(lw2[k]); da[8 * k] = (bf16_t)f2bf(la2[k]); }
#pragma unroll
      for (int k = 0; k < 16; ++k) dg[8 * k] = (bf16_t)f2bf(lg2[k]);
#pragma unroll
      for (int q = 0; q < 2; ++q) { const int idx = tid + q * NTHR; if (idx < 768) PRM[idx] = pv_[q]; } }
    const int s = lane, p = w;
    const bool valid = s < Lv;
    float r8[8], k8[8], v8[8];
    auto mix8 = [&](const LAS bf16_t* st, int pitch, int col, int ch, float (&o)[8]) {
        const u32x4 a = *(const LAS u32x4*)(st + (s + 1) * pitch + col), bq = *(const LAS u32x4*)(st + s * pitch + col);
        const f32x4 m0 = *(const LAS f32x4*)(PRM + ch), m1 = *(const LAS f32x4*)(PRM + ch + 4);
        const unsigned aw[4] = {a.x, a.y, a.z, a.w}, bw[4] = {bq.x, bq.y, bq.z, bq.w};
#pragma unroll
        for (int e = 0; e < 4; ++e) { const float c0 = __uint_as_float(aw[e] << 16), c1 = __uint_as_float(aw[e] & 0xffff0000u), p0 = __uint_as_float(bw[e] << 16), p1 = __uint_as_float(bw[e] & 0xffff0000u);
            const float mm0 = (2 * e < 4) ? m0[2 * e] : m1[2 * e - 4], mm1 = (2 * e + 1 < 4) ? m0[2 * e + 1] : m1[2 * e + 1 - 4];
            o[2 * e] = valid ? c0 + (p0 - c0) * mm0 : 0.f; o[2 * e + 1] = valid ? c1 + (p1 - c1) * mm1 : 0.f; } };
#pragma unroll
    for (int k = 0; k < 4; ++k) { const int i = tid + k * NTHR; if (i < 65 * 24) { const int rr = i / 24, c8 = i % 24; *(LAS u32x4*)(STG + rr * 200 + (c8 >> 3) * 64 + (c8 & 7) * 8) = st1[k]; } }
    lds_barrier();
    mix8(STG, 200, p * 8, p * 8, r8); mix8(STG, 200, 64 + p * 8, 64 + p * 8, k8); mix8(STG, 200, 128 + p * 8, 128 + p * 8, v8);
#pragma unroll
    for (int e = 0; e < 8; ++e) asm volatile("" : "+v"(r8[e]), "+v"(k8[e]), "+v"(v8[e]));
    lds_barrier();
#pragma unroll
    for (int k = 0; k < 5; ++k) { const int i = tid + k * NTHR; if (i < 65 * 32) *(LAS u32x4*)(STG + (i >> 5) * 264 + (i & 31) * 8) = st2[k]; }
    lds_barrier();
    { float t8[8]; u32x4 o;
      mix8(STG, 264, p * 8, 192 + p * 8, t8);
      o.x = pk2(ftanh(t8[0]), ftanh(t8[1])); o.y = pk2(ftanh(t8[2]), ftanh(t8[3])); o.z = pk2(ftanh(t8[4]), ftanh(t8[5])); o.w = pk2(ftanh(t8[6]), ftanh(t8[7])); *(LAS u32x4*)(XW + s * 72 + p * 8) = o;
      mix8(STG, 264, 64 + p * 8, 256 + p * 8, t8);
      o.x = pk2(t8[0], t8[1]); o.y = pk2(t8[2], t8[3]); o.z = pk2(t8[4], t8[5]); o.w = pk2(t8[6], t8[7]); *(LAS u32x4*)(XA + s * 72 + p * 8) = o;
#pragma unroll
      for (int q = 0; q < 2; ++q) { mix8(STG, 264, 128 + p * 16 + q * 8, 320 + p * 16 + q * 8, t8);
          o.x = pk2(fsigmoid(t8[0]), fsigmoid(t8[1])); o.y = pk2(fsigmoid(t8[2]), fsigmoid(t8[3])); o.z = pk2(fsigmoid(t8[4]), fsigmoid(t8[5])); o.w = pk2(fsigmoid(t8[6]), fsigmoid(t8[7]));
          *(LAS u32x4*)(XG + s * 136 + p * 16 + q * 8) = o; } }
    lds_barrier();
    { const int mt = w & 3, nh = w >> 2; f32x4 a0[1][2], a1[1][2], a2[1][2];
#pragma unroll
      for (int j = 0; j < 2; ++j) { a0[0][j] = (f32x4){0.f, 0.f, 0.f, 0.f}; a1[0][j] = a0[0][j]; a2[0][j] = a0[0][j]; }
      mma_lds<1, 2, 2>(a0, XW, 72, 16 * mt, W2T, 72, 32 * nh, lane);
      mma_lds<1, 2, 2>(a1, XA, 72, 16 * mt, A2T, 72, 32 * nh, lane);
      mma_lds<1, 2, 4>(a2, XG, 136, 16 * mt, G2T, 136, 32 * nh, lane);
#pragma unroll
      for (int j = 0; j < 2; ++j)
#pragma unroll
          for (int r = 0; r < 4; ++r) { const int tok = 16 * mt + 4 * (lane >> 4) + r, cc = 32 * nh + 16 * j + (lane & 15);
              LO[tok * 65 + cc] = a0[0][j][r]; LO[4160 + tok * 65 + cc] = a1[0][j][r]; LO[8320 + tok * 65 + cc] = a2[0][j][r]; } }
    lds_barrier();
    const LAS float* pW0 = PRM + 448 + p * 8; const LAS float* pA0 = PRM + 512 + p * 8; const LAS float* pKK = PRM + 576 + p * 8; const LAS float* pKA = PRM + 640 + p * 8; const LAS float* pRK = PRM + 704 + p * 8;
    { float sq = 0.f, bn = 0.f;
#pragma unroll
      for (int e = 0; e < 8; ++e) { const int cc = p * 8 + e;
          const float et = fsigmoid(pA0[e] + LO[4160 + s * 65 + cc]);
          const float kkv = k8[e] * pKK[e]; sq += kkv * kkv;
          const float k2 = k8[e] * (1.f + (et - 1.f) * pKA[e]); bn += r8[e] * k2 * pRK[e]; }
      red[p * 64 + s] = sq; red[512 + p * 64 + s] = bn; }
    lds_barrier();
    { float sq = 0.f, bn = 0.f;
#pragma unroll
      for (int i = 0; i < 8; ++i) { sq += red[i * 64 + s]; bn += red[512 + i * 64 + s]; }
      const float kn = rsqrtf(sq + 1e-12f);
      if (p == 0) gSC[64 + s] = valid ? bn : 0.f;
#pragma unroll
      for (int e2 = 0; e2 < 4; ++e2) { float fa[2], fr[2], fk[2], fb[2], frh[2], fv[2], fg[2];
#pragma unroll
          for (int q = 0; q < 2; ++q) { const int e = 2 * e2 + q, cc = p * 8 + e;
              const float wl = pW0[e] + LO[s * 65 + cc]; const float lw = valid ? -0.6065306597126334f * fsigmoid(wl) : 0.f;
              const float et = fsigmoid(pA0[e] + LO[4160 + s * 65 + cc]);
              const float Lc = wave_incl_sum(lw, lane); const float Lex = Lc - lw; const float mid = lane_bcast(Lc, 31), LL = lane_bcast(Lc, 63);
              const float kk = k8[e] * pKK[e] * kn; const float k2 = k8[e] * (1.f + (et - 1.f) * pKA[e]);
              const float av = valid ? -kk : 0.f, bv = valid ? kk * et : 0.f, rv = valid ? r8[e] : 0.f, kv = valid ? k2 : 0.f;
              fv[q] = valid ? v8[e] : 0.f; fg[q] = valid ? LO[8320 + s * 65 + cc] : 0.f;
              fa[q] = av * __expf(Lex - mid); fr[q] = rv * __expf(Lc - mid); const float ek = __expf(mid - Lc); fk[q] = kv * ek; fb[q] = bv * ek;
              frh[q] = rv * __expf(Lc); const float eh = __expf(LL - Lc);
              if (s == 0) gSC[p * 8 + e] = __expf(LL);
              VT[(p * 8 + e) * 72 + s] = (bf16_t)f2bf(fv[q]); KhT[(p * 8 + e) * 72 + s] = (bf16_t)f2bf(kv * eh); R2T[(p * 8 + e) * 72 + s] = (bf16_t)f2bf(av * __expf(Lex));
              gBHT[(p * 8 + e) * 64 + s] = (bf16_t)f2bf(bv * eh); }
          const int co = p * 8 + 2 * e2;
          *(LAS unsigned*)(AR + s * 72 + co) = pk2(fa[0], fa[1]); *(LAS unsigned*)(AR + (64 + s) * 72 + co) = pk2(fr[0], fr[1]);
          *(LAS unsigned*)(KB + s * 72 + co) = pk2(fk[0], fk[1]); *(LAS unsigned*)(KB + (64 + s) * 72 + co) = pk2(fb[0], fb[1]);
          *(unsigned*)(gRH + s * 64 + co) = pk2(frh[0], frh[1]); *(unsigned*)(gV + s * 64 + co) = pk2(fv[0], fv[1]); *(unsigned*)(gG + s * 64 + co) = pk2(fg[0], fg[1]);
          asm volatile("" ::: "memory"); } }
    lds_barrier();
    { f32x4 acc[8][1];
#pragma unroll
      for (int j = 0; j < 8; ++j) acc[j][0] = (f32x4){0.f, 0.f, 0.f, 0.f};
      mma_lds<8, 1, 2>(acc, KB, 72, 0, AR, 72, 16 * w, lane);
      const int t = 16 * (w & 3) + (lane & 15);
#pragma unroll
      for (int j = 0; j < 8; ++j) { const int s0 = 16 * (j & 3) + 4 * (lane >> 4); float x[4];
#pragma unroll
          for (int r = 0; r < 4; ++r) x[r] = (w < 4 ? s0 + r < t : s0 + r <= t) ? acc[j][0][r] : 0.f;
          if (j < 4) { u32x2 o; o.x = pk2(x[0], x[1]); o.y = pk2(x[2], x[3]); *(LAS u32x2*)(AkR + ((w < 4 ? 0 : 64) + t) * 72 + s0) = o; }
          else if (w < 4) {
#pragma unroll
              for (int r = 0; r < 4; ++r) Am[t * 65 + s0 + r] = -x[r]; }
          else { u32x2 o; o.x = pk2(x[0], x[1]); o.y = pk2(x[2], x[3]); *(u32x2*)(gARB + t * 64 + s0) = o; } } }
    lds_barrier();
    tri_inv64(Am, Tm, Xt, tid, w, Tb);
    { const int mt = w & 3, nh = w >> 2; f32x4 av[1][2], yv[1][2], kv[1][2];
#pragma unroll
      for (int j = 0; j < 2; ++j) { av[0][j] = (f32x4){0.f, 0.f, 0.f, 0.f}; yv[0][j] = av[0][j]; kv[0][j] = av[0][j]; }
      mma_lds<1, 2, 2>(av, AkR, 72, 16 * mt, VT, 72, 32 * nh, lane);
      mma_lds<1, 2, 2>(yv, VT, 72, 16 * mt, AkR, 72, 64 + 32 * nh, lane);
      mma_lds<1, 2, 2>(kv, KhT, 72, 16 * mt, VT, 72, 32 * nh, lane);
#pragma unroll
      for (int j = 0; j < 2; ++j) { u32x2 o; const int cj = 32 * nh + 16 * j + (lane & 15), r0 = 16 * mt + 4 * (lane >> 4);
          o.x = pk2(av[0][j][0], av[0][j][1]); o.y = pk2(av[0][j][2], av[0][j][3]); *(LAS u32x2*)(R2T + (64 + cj) * 72 + r0) = o;
          o.x = pk2(yv[0][j][0], yv[0][j][1]); o.y = pk2(yv[0][j][2], yv[0][j][3]); *(u32x2*)(gYV + cj * 64 + r0) = o;
          o.x = pk2(kv[0][j][0], kv[0][j][1]); o.y = pk2(kv[0][j][2], kv[0][j][3]); *(u32x2*)(gKVT + cj * 64 + r0) = o; } }
    lds_barrier();
    { const int mt = w & 3, nh = w >> 2; f32x4 ta[1][2], pv[1][2];
#pragma unroll
      for (int j = 0; j < 2; ++j) { ta[0][j] = (f32x4){0.f, 0.f, 0.f, 0.f}; pv[0][j] = ta[0][j]; }
      mma_lds<1, 2, 2>(ta, R2T, 72, 16 * mt, Tb, 72, 32 * nh, lane);
      mma_lds<1, 2, 2>(pv, Tb, 72, 16 * mt, R2T, 72, 64 + 32 * nh, lane);
#pragma unroll
      for (int j = 0; j < 2; ++j) { u32x2 o; const int cj = 32 * nh + 16 * j + (lane & 15), r0 = 16 * mt + 4 * (lane >> 4);
          o.x = pk2(ta[0][j][0], ta[0][j][1]); o.y = pk2(ta[0][j][2], ta[0][j][3]); *(u32x2*)(gTA + cj * 64 + r0) = o;
          o.x = pk2(pv[0][j][0], pv[0][j][1]); o.y = pk2(pv[0][j][2], pv[0][j][3]); *(u32x2*)(gPVT + cj * 64 + r0) = o; } }
    lds_barrier();
}

__device__ __forceinline__ void rwkv_seq_unit(const Ctx& c, int l, int b, int h) {
    int w = c.wave; asm volatile("" : "+s"(w)); const int lane = hw_lane(), tid = w * 64 + lane;
    bf16_t* YBR = (bf16_t*)(c.ws + WS_YBR); const bf16_t* PROJ = (const bf16_t*)(c.ws + WS_PROJ);
    LAS bf16_t* TA = (LAS bf16_t*)c.lds; LAS bf16_t* RH = TA + 64 * 72; LAS bf16_t* ARB = RH + 64 * 72; LAS bf16_t* BHT = ARB + 64 * 72; LAS bf16_t* HT = BHT + 64 * 72; LAS bf16_t* PT = HT + 64 * 72;
    LAS float* ssc = (LAS float*)(PT + 64 * 72); LAS float* rsum = ssc + 128; LAS float* rsq = rsum + 128;
    for (int i = tid; i < 64 * 72; i += NTHR) HT[i] = 0;
    const int kt = w & 3, vh = w >> 2;
    f32x4 Hst[1][2]; Hst[0][0] = (f32x4){0.f, 0.f, 0.f, 0.f}; Hst[0][1] = Hst[0][0];
    f32x4 lnw[2], lnb[2];
#pragma unroll
    for (int i = 0; i < 2; ++i) { lnw[i] = *(const f32x4*)(inp(c, I_LNW) + l * 1024 + h * 64 + 32 * vh + 16 * i + 4 * (lane >> 4)); lnb[i] = *(const f32x4*)(inp(c, I_LNB) + l * 1024 + h * 64 + 32 * vh + 16 * i + 4 * (lane >> 4)); }
    u32x4 pT[3], pR[3], pAB[3], pBH[3]; float psc[3] = {0.f, 0.f, 0.f}; u32x2 pPV[3][2], pYV[3][2], pKV[3][2], pVV[3][2], pGG[3][2];
#define RW_ISSUE(cc, S_) do { const int u_ = (b * HC + h) * NCH + (cc); const bf16_t* gU_ = (const bf16_t*)(c.ws + WS_RW) + (size_t)u_ * RW_N * 4096; const float* gSC_ = (const float*)(c.ws + WS_RW_SC) + (size_t)u_ * 128; \
        const int o_ = (tid >> 3) * 64 + (tid & 7) * 8; pT[S_] = *(const u32x4*)(gU_ + RW_TA * 4096 + o_); pR[S_] = *(const u32x4*)(gU_ + RW_RH * 4096 + o_); pAB[S_] = *(const u32x4*)(gU_ + RW_ARB * 4096 + o_); pBH[S_] = *(const u32x4*)(gU_ + RW_BHT * 4096 + o_); \
        psc[S_] = tid < 128 ? gSC_[tid] : 0.f; \
        _Pragma("unroll") for (int j_ = 0; j_ < 2; ++j_) { const int dv_ = 32 * vh + 16 * j_ + (lane & 15), q4_ = 16 * kt + 4 * (lane >> 4); const int tc_ = 16 * kt + (lane & 15), dv0_ = 32 * vh + 16 * j_ + 4 * (lane >> 4); \
            pPV[S_][j_] = *(const u32x2*)(gU_ + RW_PVT * 4096 + dv_ * 64 + q4_); pKV[S_][j_] = *(const u32x2*)(gU_ + RW_KVT * 4096 + dv_ * 64 + q4_); \
            pYV[S_][j_] = *(const u32x2*)(gU_ + RW_YV * 4096 + tc_ * 64 + dv0_); pVV[S_][j_] = *(const u32x2*)(gU_ + RW_V * 4096 + tc_ * 64 + dv0_); pGG[S_][j_] = *(const u32x2*)(gU_ + RW_G * 4096 + tc_ * 64 + dv0_); } } while (0)
#define RW_CHUNK(cch, S) do { \
        int t0, Lv; chunk_range((cch), t0, Lv); \
        const size_t row0 = (size_t)b * TP + t0; \
        { const int o = (tid >> 3) * 72 + (tid & 7) * 8; *(LAS u32x4*)(TA + o) = pT[S]; *(LAS u32x4*)(RH + o) = pR[S]; *(LAS u32x4*)(ARB + o) = pAB[S]; *(LAS u32x4*)(BHT + o) = pBH[S]; } \
        if (tid < 128) ssc[tid] = psc[S]; \
        const u32x2 cPV0 = pPV[S][0], cPV1 = pPV[S][1], cYV0 = pYV[S][0], cYV1 = pYV[S][1], cKV0 = pKV[S][0], cKV1 = pKV[S][1], cVV0 = pVV[S][0], cVV1 = pVV[S][1], cGG0 = pGG[S][0], cGG1 = pGG[S][1]; \
        if ((cch) + 3 < NCH) RW_ISSUE((cch) + 3, S); \
        lds_barrier(); \
        f32x4 ay[2][1]; \
        { f32x4 ap[1][2]; ap[0][0] = (f32x4){0.f, 0.f, 0.f, 0.f}; ap[0][1] = ap[0][0]; ay[0][0] = ap[0][0]; ay[1][0] = ap[0][0]; \
          mma_lds<1, 2, 2>(ap, TA, 72, 16 * kt, HT, 72, 32 * vh, lane); \
          mma_lds<2, 1, 2>(ay, HT, 72, 32 * vh, RH, 72, 16 * kt, lane); \
        _Pragma("unroll") \
          for (int j = 0; j < 2; ++j) { const int dv = 32 * vh + 16 * j + (lane & 15), tq = 16 * kt + 4 * (lane >> 4); const u32x2 pv = j == 0 ? cPV0 : cPV1; \
              u32x2 o; o.x = pk2(ap[0][j][0] + __uint_as_float(pv.x << 16), ap[0][j][1] + __uint_as_float(pv.x & 0xffff0000u)); o.y = pk2(ap[0][j][2] + __uint_as_float(pv.y << 16), ap[0][j][3] + __uint_as_float(pv.y & 0xffff0000u)); \
              *(LAS u32x2*)(PT + dv * 72 + tq) = o; } \
        _Pragma("unroll") \
          for (int i = 0; i < 2; ++i) { const int tcol = 16 * kt + (lane & 15), dv0 = 32 * vh + 16 * i + 4 * (lane >> 4); const u32x2 yv = i == 0 ? cYV0 : cYV1; \
              ay[i][0][0] += __uint_as_float(yv.x << 16); ay[i][0][1] += __uint_as_float(yv.x & 0xffff0000u); ay[i][0][2] += __uint_as_float(yv.y << 16); ay[i][0][3] += __uint_as_float(yv.y & 0xffff0000u); } } \
        lds_barrier(); \
        { mma_lds<2, 1, 2>(ay, PT, 72, 32 * vh, ARB, 72, 16 * kt, lane); \
        _Pragma("unroll") \
          for (int j = 0; j < 2; ++j) { const int dv = 32 * vh + 16 * j + (lane & 15), dk0 = 16 * kt + 4 * (lane >> 4); const u32x2 kv = j == 0 ? cKV0 : cKV1; \
              Hst[0][j][0] = Hst[0][j][0] * ssc[dk0] + __uint_as_float(kv.x << 16); Hst[0][j][1] = Hst[0][j][1] * ssc[dk0 + 1] + __uint_as_float(kv.x & 0xffff0000u); \
              Hst[0][j][2] = Hst[0][j][2] * ssc[dk0 + 2] + __uint_as_float(kv.y << 16); Hst[0][j][3] = Hst[0][j][3] * ssc[dk0 + 3] + __uint_as_float(kv.y & 0xffff0000u); } \
          mma_lds<1, 2, 2>(Hst, BHT, 72, 16 * kt, PT, 72, 32 * vh, lane); \
        _Pragma("unroll") \
          for (int j = 0; j < 2; ++j) { u32x2 o; o.x = pk2(Hst[0][j][0], Hst[0][j][1]); o.y = pk2(Hst[0][j][2], Hst[0][j][3]); *(LAS u32x2*)(HT + (32 * vh + 16 * j + (lane & 15)) * 72 + 16 * kt + 4 * (lane >> 4)) = o; } \
          const int tcol = 16 * kt + (lane & 15); \
          float sm = 0.f, sq = 0.f; \
        _Pragma("unroll") \
          for (int i = 0; i < 2; ++i) \
        _Pragma("unroll") \
              for (int r = 0; r < 4; ++r) { sm += ay[i][0][r]; sq += ay[i][0][r] * ay[i][0][r]; } \
          sm += __shfl_xor(sm, 16); sm += __shfl_xor(sm, 32); sq += __shfl_xor(sq, 16); sq += __shfl_xor(sq, 32); \
          if (lane < 16) { rsum[vh * 64 + tcol] = sm; rsq[vh * 64 + tcol] = sq; } \
          lds_barrier(); \
          const float mean = (rsum[tcol] + rsum[64 + tcol]) * (1.f / 64.f); const float var = fmaxf((rsq[tcol] + rsq[64 + tcol]) * (1.f / 64.f) - mean * mean, 0.f); const float rstd = rsqrtf(var + 64e-5f); \
          const float bon = ssc[64 + tcol]; \
          if (tcol < Lv) { \
        _Pragma("unroll") \
              for (int i = 0; i < 2; ++i) { const int dv0 = 32 * vh + 16 * i + 4 * (lane >> 4); const u32x2 vv = i == 0 ? cVV0 : cVV1, gg = i == 0 ? cGG0 : cGG1; \
                  const float o0 = ((ay[i][0][0] - mean) * rstd * lnw[i][0] + lnb[i][0] + bon * __uint_as_float(vv.x << 16)) * __uint_as_float(gg.x << 16); \
                  const float o1 = ((ay[i][0][1] - mean) * rstd * lnw[i][1] + lnb[i][1] + bon * __uint_as_float(vv.x & 0xffff0000u)) * __uint_as_float(gg.x & 0xffff0000u); \
                  const float o2 = ((ay[i][0][2] - mean) * rstd * lnw[i][2] + lnb[i][2] + bon * __uint_as_float(vv.y << 16)) * __uint_as_float(gg.y << 16); \
                  const float o3 = ((ay[i][0][3] - mean) * rstd * lnw[i][3] + lnb[i][3] + bon * __uint_as_float(vv.y & 0xffff0000u)) * __uint_as_float(gg.y & 0xffff0000u); \
                  u32x2 o; o.x = pk2(o0, o1); o.y = pk2(o2, o3); *(u32x2*)(YBR + (row0 + tcol) * YLD + 2048 + h * 64 + dv0) = o; } } } \
        lds_barrier(); \
    } while (0)
    RW_ISSUE(0, 0); RW_ISSUE(1, 1); RW_ISSUE(2, 2);
    lds_barrier();
    for (int cch = 0; cch < NCH; cch += 3) { RW_CHUNK(cch, 0); RW_CHUNK(cch + 1, 1); RW_CHUNK(cch + 2, 2); }
#undef RW_CHUNK
#undef RW_ISSUE
    const int lane_e = hw_lane(), tid_e = w * 64 + lane_e;
    float* os = c.out + O_PRS + (((size_t)l * BATCH + b) * HC + h) * DHC * DHC;
#pragma unroll
    for (int j = 0; j < 2; ++j) *(f32x4*)(os + (size_t)(32 * vh + 16 * j + (lane_e & 15)) * 64 + 16 * kt + 4 * (lane_e >> 4)) = Hst[0][j];
    { float* osh = c.out + O_PRSH + ((size_t)l * BATCH + b) * NCC; const bf16_t* last = PROJ + ((size_t)b * TP + TP - 1) * NPROJ + PC0;
      int cidx = -1;
      if (tid_e < 64) cidx = h * 64 + tid_e; else if (tid_e < 128) cidx = 1024 + h * 64 + (tid_e - 64); else if (tid_e < 192) cidx = 2048 + h * 64 + (tid_e - 128); else if (tid_e < 448 && h == 0) cidx = 3072 + (tid_e - 192);
      if (cidx >= 0) osh[cidx] = bf2f(last[cidx]); }
    lds_barrier();
}

__device__ __forceinline__ void mlstm_post_rows(const Ctx& c, int l, int bb, int h, int vs) {
    int w = c.wave; asm volatile("" : "+s"(w)); const int lane = hw_lane();
    const float* HAo = (const float*)(c.ws + WS_HA); const bf16_t* PROJ = (const bf16_t*)(c.ws + WS_PROJ); bf16_t* YBR = (bf16_t*)(c.ws + WS_YBR);
    const f32x4 wv = *(const f32x4*)(inp(c, I_MNW) + l * 1024 + h * 256 + 4 * lane);
    constexpr int RQ = TP / 4;
    const size_t row0 = (size_t)bb * TP + (size_t)vs * RQ;
#pragma unroll 1
    for (int i = w; i < RQ; i += 4 * NWAVES) {
        f32x4 v[4]; u32x2 og[4];
#pragma unroll
        for (int k = 0; k < 4; ++k) { const int ii = i + NWAVES * k < RQ ? i + NWAVES * k : i; const size_t row = row0 + ii;
            v[k] = *(const f32x4*)(HAo + row * 1024 + h * 256 + 4 * lane); og[k] = *(const u32x2*)(PROJ + row * NPROJ + PA_O + h * 256 + 4 * lane); }
#pragma unroll
        for (int k = 0; k < 4; ++k) { if (i + NWAVES * k >= RQ) continue; const size_t row = row0 + i + NWAVES * k;
            const float ss = wave_sum((v[k].x * v[k].x + v[k].y * v[k].y) + (v[k].z * v[k].z + v[k].w * v[k].w)); const float rs = rsqrtf(ss * (1.f / 256.f) + 1e-6f);
            const float o0 = sigmoidf_(__uint_as_float(og[k].x << 16)), o1 = sigmoidf_(__uint_as_float(og[k].x & 0xffff0000u)), o2 = sigmoidf_(__uint_as_float(og[k].y << 16)), o3 = sigmoidf_(__uint_as_float(og[k].y & 0xffff0000u));
            u32x2 o; o.x = pk2(o0 * v[k].x * rs * wv.x, o1 * v[k].y * rs * wv.y); o.y = pk2(o2 * v[k].z * rs * wv.z, o3 * v[k].w * rs * wv.w);
            *(u32x2*)(YBR + row * YLD + h * 256 + 4 * lane) = o; }
    }
}
__device__ __forceinline__ void phase_mix_prep(const Ctx& c, int l) {
    unsigned* qctr = (unsigned*)(c.ws + WS_CTL) + 8192 + (12 + 3 * l) * 64;
    volatile LAS unsigned* MISC = (volatile LAS unsigned*)(c.lds + LDS_MISC);
#define QBEGIN(k, n) int qn_ = 0; if (c.wave == 0 && hw_lane() == 0) qn_ = (int)__hip_atomic_fetch_add(qctr + 64 * (k), (unsigned)(n), __ATOMIC_RELAXED, __HIP_MEMORY_SCOPE_AGENT)
#define QNEXT(k, n) ({ lds_barrier(); if (c.wave == 0 && hw_lane() == 0) MISC[12] = (unsigned)qn_; lds_barrier(); const int u_ = (int)MISC[12]; \
        if (c.wave == 0 && hw_lane() == 0) qn_ = (int)__hip_atomic_fetch_add(qctr + 64 * (k), (unsigned)(n), __ATOMIC_RELAXED, __HIP_MEMORY_SCOPE_AGENT); u_; })
#ifndef NO_RWP
    { QBEGIN(0, 1); for (;;) { const int u = QNEXT(0, 1); if (u >= NU_RW) break; rwkv_prep_unit(c, l, u); } }
#endif
#ifndef ONLY_RWP
    { QBEGIN(1, 1); for (;;) { const int u = QNEXT(1, 1); if (u >= NU_ML) break; mlstm_prep_unit(c, l, u); } }
    { QBEGIN(2, 1); for (;;) { const int u = QNEXT(2, 1); if (u >= NU_GD) break; gdn_prep_unit(c, l, u); } }
#endif
#if TAILCONV
    { QBEGIN(6 - 2 * l, 8); for (;;) { const int u = QNEXT(6 - 2 * l, 8); if (u >= WBR_DYN) break; convert_one(c, l, CO_BR + WBR_G1 + u + c.wave); } }
#endif
}

__device__ __forceinline__ void phase_mix_seq(const Ctx& c, int l, int rep = 0) {
    constexpr int W_ML = BATCH * HA * 4, W_GD = BATCH * HB, W_RW = BATCH * HC, NPU = W_ML + W_GD + W_RW;
    const int b = c.bid;
    if (b < W_ML && (rep < 2 || rep == 2)) mlstm_seq_unit(c, l, b >> 4, (b >> 2) & 3, b & 3);
    if (b < W_ML && rep == 0) {
        mini_barrier((unsigned*)(c.ws + WS_CTL) + 8192 + (32 + 16 * l + (b >> 2)) * 64, 4u, c.wave);
        mlstm_post_rows(c, l, b >> 4, (b >> 2) & 3, b & 3); }
    if (b >= W_ML && b < W_ML + W_GD && (rep < 2 || rep == 3)) { const int r = b - W_ML; gdn_seq_unit(c, l, r / HB, r % HB); }
#ifndef NO_RWS
    if (b >= W_ML + W_GD && b < NPU && (rep < 2 || rep == 4)) { const int r = b - W_ML - W_GD; rwkv_seq_unit(c, l, r / HC, r % HC); }
#endif
    unsigned* qctr = (unsigned*)(c.ws + WS_CTL) + 8192 + (3 * l + 6 * (rep == 1 ? 1 : 0)) * 64;
    volatile LAS unsigned* MISC = (volatile LAS unsigned*)(c.lds + LDS_MISC);
    { QBEGIN(0, 1); for (;;) { const int u = QNEXT(0, 1); if (u >= NB * HA) break; mlstm_unit_s(c, l, u / HA, u % HA); } }
    { QBEGIN(1, 2); for (;;) { const int u0 = QNEXT(1, 2); if (u0 >= NB * HB) break;
        for (int u = u0; u < u0 + 2 && u < NB * HB; ++u) gdn_unit_s(c, l, u / HB, u % HB); } }
    int cached_h = -1;
    { QBEGIN(2, 4); for (;;) { const int u0 = QNEXT(2, 4); if (u0 >= NB * HC) break;
        rwkv_unit4(c, l, u0 % NB, u0 / NB, cached_h); } }
#if TAILCONV
    if (rep == 0) { unsigned* qctr = (unsigned*)(c.ws + WS_CTL) + 8192 + (20 + l) * 64; const int nq = CI_O + (l == 0 ? WIN1_SEQ : 0);
        QBEGIN(0, 8); for (;;) { const int u = QNEXT(0, 8); if (u >= nq) break; const int it = u + c.wave; if (it < CI_O) convert_one(c, l, CO_O + it); else convert_one(c, 1, it - CI_O); } }
#endif
#undef QBEGIN
#undef QNEXT
}

__device__ __forceinline__ void phase_combine(const Ctx& c0, const int nblk) {
    Ctx c = c0; c.lane = hw_lane(); c.tid = c.wave * 64 + c.lane; c.G = nblk;
    const u32x4* B = (const u32x4*)(c.ws + WS_MRGF); u32x4* M = (u32x4*)(c.ws + WS_MRG);
    constexpr size_t NV = (size_t)MP * D / 8, V0 = (size_t)8192 * D / 8;
    for (size_t i = V0 + (size_t)c.bid * NTHR + c.tid; i < NV; i += (size_t)c.G * NTHR * 2) {
        const size_t i2 = i + (size_t)c.G * NTHR; const bool two = i2 < NV;
        u32x4 a[2][3];
#pragma unroll
        for (int z = 0; z < 3; ++z) { a[0][z] = B[i + z * NV]; a[1][z] = two ? B[i2 + z * NV] : (u32x4){0u, 0u, 0u, 0u}; }
#pragma unroll
        for (int q = 0; q < 2; ++q) { u32x4 o; unsigned* po = (unsigned*)&o;
            const unsigned* p0 = (const unsigned*)&a[q][0]; const unsigned* p1 = (const unsigned*)&a[q][1]; const unsigned* p2 = (const unsigned*)&a[q][2];
#pragma unroll
            for (int e = 0; e < 4; ++e) po[e] = pk2(__uint_as_float(p0[e] << 16) + __uint_as_float(p1[e] << 16) + __uint_as_float(p2[e] << 16),
                                                   __uint_as_float(p0[e] & 0xffff0000u) + __uint_as_float(p1[e] & 0xffff0000u) + __uint_as_float(p2[e] & 0xffff0000u));
            if (q == 0) M[i] = o; else if (two) M[i2] = o; }
    }
}

#define IN(k) (lo <= (k) && (k) < hi)
#ifdef ONLY_G
#define GSEL(k) ((k) == ONLY_G)
#else
#define GSEL(k) true
#endif
#if MK_MULTI
#define SEAM(k) do { } while (0)
#else
#define SEAM(k) do { if (IN(k) && IN((k) + 1)) xcd_barrier(bar, c.wave); } while (0)
#endif
template <int L> __device__ __forceinline__ void layer_phases(const Ctx& c, const XcdBarrier& bar, const int lo, const int hi) {
    constexpr int pb = 1 + 10 * L;
#ifndef SKIP_NORM
    if (IN(pb + 0)) { phase_norm_gates<L == 0>(c, inp(c, I_NMIX) + (size_t)L * D, (const float*)(c.ws + WS_WSG) + (size_t)L * NSG * D); if (REP_MISC > 1) phase_norm_gates<L == 0>(c, inp(c, I_NMIX) + (size_t)L * D, (const float*)(c.ws + WS_WSG) + (size_t)L * NSG * D); }
#endif
    SEAM(pb + 0);
    if (IN(pb + 1) && GSEL(1)) {
        pg8::Gemm<D, D, D> g{(const bf16_t*)(c.ws + WS_HN), (const bf16_t*)(c.ws + WS_WIN) + (size_t)L * NPROJ * D};
        pg8::TileOrder<MP, NPROJ, 1> S; S.init(c.G, c.bid);
        pg8::EpiBf16<0> E{(bf16_t*)(c.ws + WS_PROJ), NPROJ};
        pg8::gemm_phase(c.lds, c.wave, g, S, E);
        if (REP_G1 > 1) pg8::gemm_phase(c.lds, c.wave, g, S, E);
#if TAILCONV
        convert_items(c, L, CO_BR, CO_BR + WBR_G1, (33 * 69) % c.G);
#endif
    }
    SEAM(pb + 1);
#ifndef SKIP_MIX
    if (IN(pb + 2)) { phase_mix_prep(c, L); if (REP_PREP > 1) phase_mix_prep(c, L); }
    SEAM(pb + 2);
#ifndef ONLY_RWP
    if (IN(pb + 3)) { phase_mix_seq(c, L); if (REP_SEQ > 1) { xcd_barrier(bar, c.wave); phase_mix_seq(c, L, REP_SEQ == 2 ? 1 : REP_SEQ == 3 ? 0 : REP_SEQ - 2); } }
#endif
    SEAM(pb + 3);
#endif
    if (IN(pb + 5) && GSEL(3)) {
        pg8::Gemm<YLD, 1024, 1024, 1024 * 2, (long)D * 1024 * 2> g{(const bf16_t*)(c.ws + WS_YBR), (const bf16_t*)(c.ws + WS_WBR) + (size_t)L * 3 * D * 1024};
        { pg8::TileOrder<8192, D, 3> S; S.init(c.G, c.bid);
          pg8::EpiGateAcc E{(const bf16_t*)(c.ws + WS_PROJ) + PG0, NPROJ, (bf16_t*)(c.ws + WS_MRG), D};
          pg8::gemm_phase(c.lds, c.wave, g, S, E); }
        { pg8::TailOrder<32, D, 3> S; S.init(c.G, c.bid);
          pg8::EpiGateBf16 E{(const bf16_t*)(c.ws + WS_PROJ) + PG0, NPROJ, (bf16_t*)(c.ws + WS_MRGF), D, (size_t)MP * D};
          pg8::gemm_phase(c.lds, c.wave, g, S, E); }
#if TAILCONV
        convert_items(c, L, CO_U, CO_U + CI_U / 2, (3 * 8) % c.G);
#endif
        if (c.G >= 24) {
            if (c.bid < 24) { unsigned* ctr = (unsigned*)(c.ws + WS_CTL) + 8192 + (96 + L) * 64; wg_signal(ctr, c.wave); wg_wait(ctr, 24u, c.wave); phase_combine(c, 24); }
        } else { xcd_barrier(bar, c.wave); phase_combine(c, c.G); }
    }
    SEAM(pb + 5);
    if (IN(pb + 6) && GSEL(4)) {
        pg8::Gemm<D, D, D> g{(const bf16_t*)(c.ws + WS_MRG), (const bf16_t*)(c.ws + WS_WOUT) + (size_t)L * D * D};
        pg8::TileOrder<MP, D, 1> S; S.init(c.G, c.bid);
        if (L == 0) { pg8::EpiResidSrc E{inp(c, I_META), inp(c, I_XP), inp(c, I_XS), (float*)(c.ws + WS_X), D}; pg8::gemm_phase(c.lds, c.wave, g, S, E); }
        else { pg8::EpiResid E{(const float*)(c.ws + WS_X), (float*)(c.ws + WS_X), D}; pg8::gemm_phase(c.lds, c.wave, g, S, E); }
#if TAILCONV
        convert_items(c, L, CO_U + CI_U / 2, CO_D + CI_D / 4, (33 * 8) % c.G);
#endif
    }
    SEAM(pb + 6);
#ifndef SKIP_NORM
    if (IN(pb + 7)) { phase_norm<false>(c, inp(c, I_NMLP) + (size_t)L * D, nullptr); if (REP_MISC > 1) phase_norm<false>(c, inp(c, I_NMLP) + (size_t)L * D, nullptr); }
#endif
    SEAM(pb + 7);
    if (IN(pb + 8) && GSEL(6)) {
        pg8::Gemm<D, D, D> g{(const bf16_t*)(c.ws + WS_HN), (const bf16_t*)(c.ws + WS_WUP) + (size_t)L * DFF * D};
        pg8::TileOrder<MP, DFF, 1> S; S.init(c.G, c.bid);
        pg8::EpiBf16<1> E{(bf16_t*)(c.ws + WS_PROJ), DFF};
        pg8::gemm_phase(c.lds, c.wave, g, S, E);
#if TAILCONV
        convert_items(c, L, CO_D + CI_D / 4, C_PER_L, (33 * 32) % c.G);
        if (L == 0) convert_items(c, 1, WIN1_SEQ, WIN1_G4, (33 * 32) % c.G);
#endif
    }
    SEAM(pb + 8);
    if (IN(pb + 9) && GSEL(7)) {
        pg8::Gemm<DFF, DFF, DFF> g{(const bf16_t*)(c.ws + WS_PROJ), (const bf16_t*)(c.ws + WS_WDN) + (size_t)L * D * DFF};
        pg8::TileOrder<8192, D, 1> S; S.init(c.G, c.bid);
        pg8::EpiResid E{(const float*)(c.ws + WS_X), (float*)(c.ws + WS_X), D};
        pg8::gemm_phase(c.lds, c.wave, g, S, E);
        unsigned* pdone = (unsigned*)(c.ws + WS_CTL) + 8192 + 64 * 64;
        const bool fin_tail = FIN_IN_TAIL && L == 1 && c.G == 256;
        if (fin_tail) { pg8::Unit u0; if (S.next(0, u0)) wg_signal(pdone + 64 * u0.pm, c.wave); }
        const pg8::StreamX sx{(float*)(c.ws + WS_SLOTS), (unsigned*)(c.ws + WS_CTL) + FLAG_W0 + (3 * L + 2) * 256 * 64, (unsigned*)(c.ws + WS_CTL) + 4096 + XB_TMO};
        pg8::SplitOrder<32, D, 4, 32> S2; S2.init(c.G, c.bid);
        pg8::gemm_phase(c.lds, c.wave, g, S2, E, sx);
        if (c.bid >= 32 && c.bid < 40) pg8::split_reduce<0>(c.wave, (float*)(c.ws + WS_X), nullptr, D, sx, 32, c.bid - 32, 8, 4);
#if TAILCONV
        if (L == 0) convert_items(c, 1, WIN1_G4, CI_IN, 40);
#endif
        if (fin_tail && c.bid >= 40) {
            const int r = c.bid - 40, p = r & 31, k = r >> 5, cnt = (216 - p + 31) >> 5;
            wg_wait(pdone + 64 * p, 8u, c.wave);
            final_rows(c, 256 * p, 256 * p + 256, k * NWAVES + c.wave, cnt * NWAVES);
        }
    }
    SEAM(pb + 9);
}

__global__ void __launch_bounds__(NTHR, 2) mega(Params p) {
    extern __shared__ __attribute__((aligned(16))) unsigned char lds_raw[];
    Ctx c{p.out, p.ws, (LAS unsigned char*)lds_raw, (int)threadIdx.x, (int)(threadIdx.x & 63), __builtin_amdgcn_readfirstlane((int)(threadIdx.x >> 6)), (int)gridDim.x, (int)blockIdx.x};
    volatile LAS unsigned* MISC = (volatile LAS unsigned*)(c.lds + LDS_MISC);
    if (c.tid < 16) MISC[c.tid] = 0u;
    if (c.tid < 38) ((LAS unsigned long long*)(c.lds + LDS_MISC + 64))[c.tid] = (unsigned long long)p.in[c.tid];
    __syncthreads();
    unsigned* barw = (unsigned*)(c.ws + WS_CTL) + 4096;
    XcdBarrier bar; bar.bar = barw; bar.x = 0; bar.st = MISC + 8;
#if !MK_MULTI
    bar = xcd_barrier_post(barw, MISC + 8);
#endif
    const int lo = p.ph_lo, hi = p.ph_hi;
#ifndef SKIP_PREP
    if (IN(0)) { phase_prep(c); if (REP_MISC > 1) phase_prep(c); }
#endif
    SEAM(0);
    layer_phases<0>(c, bar, lo, hi);
    layer_phases<1>(c, bar, lo, hi);
#ifndef SKIP_NORM
    if (IN(21)) { phase_final(c); if (REP_MISC > 1) phase_final(c); }
#endif
}
#undef IN
#undef SEAM

extern "C" void kernel_launch(void* const* d_in, const int* in_sizes, int n_in, void* d_out, int out_size, void* d_ws, size_t ws_size, hipStream_t stream) {
    static int grid = 0;
    if (grid == 0) {
        if (n_in != 38 || (size_t)out_size != O_END || ws_size < WS_END) { fprintf(stderr, "kernel_launch: unexpected shapes (n_in %d out %d ws %zu need %zu)\n", n_in, out_size, ws_size, (size_t)WS_END); grid = -1; return; }
        int dev = 0, cus = 0, per_cu = 0;
        if (hipGetDevice(&dev) != hipSuccess || hipDeviceGetAttribute(&cus, hipDeviceAttributeMultiprocessorCount, dev) != hipSuccess) { grid = -1; return; }
        if (hipFuncSetAttribute((const void*)mega, hipFuncAttributeMaxDynamicSharedMemorySize, LDS_BYTES) != hipSuccess) { fprintf(stderr, "kernel_launch: hipFuncSetAttribute failed\n"); grid = -1; return; }
        if (hipOccupancyMaxActiveBlocksPerMultiprocessor(&per_cu, (const void*)mega, NTHR, LDS_BYTES) != hipSuccess || per_cu < 1) { fprintf(stderr, "kernel_launch: occupancy query says %d\n", per_cu); (void)hipGetLastError(); grid = -1; return; }
        grid = cus;
    }
    if (grid < 0) return;
    (void)hipMemsetAsync((char*)d_ws + WS_CTL, 0, CTL_BYTES, stream);
    Params p{};
    for (int i = 0; i < 38; ++i) p.in[i] = (const float*)d_in[i];
    p.out = (float*)d_out; p.ws = (unsigned char*)d_ws;
#if MK_MULTI
    for (int k = 0; k < NPHASE; ++k) { p.ph_lo = k; p.ph_hi = k + 1; hipLaunchKernelGGL(mega, dim3(grid), dim3(NTHR), LDS_BYTES, stream, p); }
#else
    p.ph_lo = 0; p.ph_hi = NPHASE;
    hipLaunchKernelGGL(mega, dim3(grid), dim3(NTHR), LDS_BYTES, stream, p);
#endif
}
```

```cpp
#include <hip/hip_runtime.h>
#include <cstdio>
#include <cstdint>

#ifndef MK_MULTI
#define MK_MULTI 0
#endif

#ifndef REP_PREP
#define REP_PREP 1
#endif
#ifndef REP_MISC
#define REP_MISC 1
#endif
#ifndef REP_SEQ
#define REP_SEQ 1
#endif
#ifndef REP_G1
#define REP_G1 1
#endif
#ifndef REP_G4
#define REP_G4 1
#endif
#define LAS __attribute__((address_space(3)))
#define GAS __attribute__((address_space(1)))
typedef unsigned short bf16_t;
typedef short bf16x8 __attribute__((ext_vector_type(8)));
typedef float f32x4 __attribute__((ext_vector_type(4)));
typedef float f32x2 __attribute__((ext_vector_type(2)));
typedef unsigned u32x4 __attribute__((ext_vector_type(4)));
typedef unsigned u32x2 __attribute__((ext_vector_type(2)));

constexpr int D = 2048, BATCH = 4, SEQ = 2048, NMETA = 16, TP = SEQ + NMETA, NB = 128;
constexpr int MPROMPT = BATCH * TP;
constexpr int MREAL = MPROMPT + NB;
constexpr int MP = 8448;
constexpr int NSEQ = BATCH + NB;
constexpr int HA = 4, DHA = 256, HB = 8, DHB = 128, HC = 16, DHC = 64;
constexpr int NCC = 3328, NIN = 17688, NPROJ = 17664, DFF = 8192;
constexpr int PA_Q = 0, PA_K = 1024, PA_V = 2048, PA_O = 3072, PB_QKV = 4096, PB_Z = 7168, PC0 = 8192, PG0 = 11520;
constexpr int NSG = 24, SGLD = 32;
constexpr int YLD = 3072;

constexpr size_t O_YP = 0;
constexpr size_t O_YS = O_YP + (size_t)BATCH * SEQ * D;
constexpr size_t O_PC = O_YS + (size_t)NB * D;
constexpr size_t O_PN = O_PC + (size_t)2 * BATCH * HA * DHA * DHA;
constexpr size_t O_PM = O_PN + (size_t)2 * BATCH * HA * DHA;
constexpr size_t O_PGS = O_PM + (size_t)2 * BATCH * HA;
constexpr size_t O_PGC = O_PGS + (size_t)2 * BATCH * HB * DHB * DHB;
constexpr size_t O_PRS = O_PGC + (size_t)2 * BATCH * 3 * 3072;
constexpr size_t O_PRSH = O_PRS + (size_t)2 * BATCH * HC * DHC * DHC;
constexpr size_t O_SC = O_PRSH + (size_t)2 * BATCH * NCC;
constexpr size_t O_SN = O_SC + (size_t)2 * NB * HA * DHA * DHA;
constexpr size_t O_SM = O_SN + (size_t)2 * NB * HA * DHA;
constexpr size_t O_SGS = O_SM + (size_t)2 * NB * HA;
constexpr size_t O_SGC = O_SGS + (size_t)2 * NB * HB * DHB * DHB;
constexpr size_t O_SRS = O_SGC + (size_t)2 * NB * 3 * 3072;
constexpr size_t O_SRSH = O_SRS + (size_t)2 * NB * HC * DHC * DHC;
constexpr size_t O_END = O_SRSH + (size_t)2 * NB * NCC;
static_assert(O_END == 141732896ull, "output size");

constexpr size_t AL(size_t x) { return (x + 255) & ~(size_t)255; }
constexpr size_t WS_CTL = 0, CTL_BYTES = 1u << 20;
constexpr size_t WS_WIN = CTL_BYTES;
constexpr size_t WS_WSG = AL(WS_WIN + (size_t)2 * NPROJ * D * 2);
constexpr size_t WS_WBR = AL(WS_WSG + (size_t)2 * NSG * D * 4);
constexpr size_t WS_WOUT = AL(WS_WBR + (size_t)2 * 3 * D * 1024 * 2);
constexpr size_t WS_WUP = AL(WS_WOUT + (size_t)2 * D * D * 2);
constexpr size_t WS_WDN = AL(WS_WUP + (size_t)2 * DFF * D * 2);
constexpr size_t WS_X = AL(WS_WDN + (size_t)2 * D * DFF * 2);
constexpr size_t WS_HN = AL(WS_X + (size_t)MP * D * 4);
constexpr size_t WS_SG = AL(WS_HN + (size_t)MP * D * 2);
constexpr size_t WS_YBR = AL(WS_SG + (size_t)MP * SGLD * 4);
constexpr size_t WS_MRG = AL(WS_YBR + (size_t)MP * YLD * 2);
constexpr size_t WS_PROJ = AL(WS_MRG + (size_t)MP * D * 2);
constexpr size_t WS_MRGF = AL(WS_PROJ + (size_t)MP * NPROJ * 2);
constexpr int NCH = 33;
constexpr int NU_ML = BATCH * HA * NCH, NU_GD = BATCH * HB * NCH, NU_RW = BATCH * HC * NCH;
constexpr size_t WS_ML_KTW = WS_MRGF;
constexpr size_t WS_ML_VT = AL(WS_ML_KTW + (size_t)NU_ML * 256 * 64 * 2);
constexpr size_t WS_ML_NP = AL(WS_ML_VT + (size_t)NU_ML * 256 * 64 * 2);
constexpr size_t WS_ML_SC = AL(WS_ML_NP + (size_t)NU_ML * 64 * 256 * 4);
constexpr size_t WS_HA = AL(WS_ML_SC + (size_t)NU_ML * 256 * 4);
constexpr size_t WS_GD_W = AL(WS_HA + (size_t)MPROMPT * 1024 * 4);
constexpr size_t WS_GD_UT = AL(WS_GD_W + (size_t)NU_GD * 64 * 128 * 2);
constexpr size_t WS_GD_AT = AL(WS_GD_UT + (size_t)NU_GD * 128 * 64 * 2);
constexpr size_t WS_GD_Q = AL(WS_GD_AT + (size_t)NU_GD * 64 * 64 * 2);
constexpr size_t WS_GD_KD = AL(WS_GD_Q + (size_t)NU_GD * 64 * 128 * 2);
constexpr size_t WS_GD_SC = AL(WS_GD_KD + (size_t)NU_GD * 128 * 64 * 2);
constexpr size_t WS_RW = AL(WS_GD_SC + (size_t)NU_GD * 128 * 4);
enum { RW_TA = 0  , RW_PVT  , RW_RH  , RW_YV  , RW_ARB  , RW_BHT  , RW_KVT  , RW_V  , RW_G  , RW_N };
constexpr size_t WS_RW_SC = AL(WS_RW + (size_t)NU_RW * RW_N * 4096 * 2);
constexpr size_t WS_MIX_END = AL(WS_RW_SC + (size_t)NU_RW * 128 * 4);
constexpr size_t WS_SLOTS = WS_MRGF;
constexpr int FLAG_W0 = 16384;
static_assert((size_t)(FLAG_W0 + 6 * 256 * 64) * 4 <= CTL_BYTES && WS_SLOTS + (size_t)256 * 65536 * 4 <= WS_MIX_END, "stream-K scratch");
constexpr size_t WS_END = WS_MIX_END > AL(WS_MRGF + (size_t)MP * D * 4) ? WS_MIX_END : AL(WS_MRGF + (size_t)MP * D * 4);
static_assert((size_t)MP * DFF * 2 <= (size_t)MP * NPROJ * 2, "U overlays PROJ");

__device__ __forceinline__ float bf2f(bf16_t b) { return __uint_as_float(((unsigned)b) << 16); }
typedef __bf16 bf16x2_t __attribute__((ext_vector_type(2)));
__device__ __forceinline__ unsigned pk2(float lo, float hi) { const f32x2 v = {lo, hi}; return __builtin_bit_cast(unsigned, __builtin_convertvector(v, bf16x2_t)); }
__device__ __forceinline__ unsigned f2bf(float f) { return pk2(f, 0.f) & 0xffffu; }
__device__ __forceinline__ float sigmoidf_(float x) { return __builtin_amdgcn_rcpf(1.f + __expf(-x)); }
__device__ __forceinline__ float softplusf_(float x) { const float e = __expf(x); return x > 15.f ? x : (e < 1e-3f ? e * (1.f - 0.5f * e) : __logf(1.f + e)); }
__device__ __forceinline__ float siluf_(float x) { return x * __builtin_amdgcn_rcpf(1.f + __expf(-x)); }
__device__ __forceinline__ float fsigmoid(float x) { return __builtin_amdgcn_rcpf(1.f + __expf(-x)); }
__device__ __forceinline__ float fsoftplus(float x) { return x > 15.f ? x : __logf(1.f + __expf(x)); }
__device__ __forceinline__ float ftanh(float x) { return 1.f - 2.f * __builtin_amdgcn_rcpf(1.f + __expf(2.f * x)); }
__device__ __forceinline__ int hw_lane() { int l; asm volatile("v_mbcnt_lo_u32_b32 %0, -1, 0\n\tv_mbcnt_hi_u32_b32 %0, -1, %0" : "=v"(l)); return l; }
template <int CTRL, int ROWMASK>
__device__ __forceinline__ float dpp_mov(float old, float src) {
    return __builtin_bit_cast(float, __builtin_amdgcn_update_dpp(__builtin_bit_cast(int, old), __builtin_bit_cast(int, src), CTRL, ROWMASK, 0xf, false));
}
__device__ __forceinline__ float lane_bcast(float v, int l) { return __builtin_bit_cast(float, __builtin_amdgcn_readlane(__builtin_bit_cast(int, v), l)); }
__device__ __forceinline__ float wave_scan_sum(float v) {
    v += dpp_mov<0x111, 0xf>(0.f, v); v += dpp_mov<0x112, 0xf>(0.f, v); v += dpp_mov<0x114, 0xf>(0.f, v); v += dpp_mov<0x118, 0xf>(0.f, v);
    v += dpp_mov<0x142, 0xa>(0.f, v); v += dpp_mov<0x143, 0xc>(0.f, v);
    return v;
}
__device__ __forceinline__ float wave_sum(float v) { return lane_bcast(wave_scan_sum(v), 63); }
__device__ __forceinline__ float row16_sum(float v) {
    v += dpp_mov<0x121, 0xf>(0.f, v); v += dpp_mov<0x122, 0xf>(0.f, v); v += dpp_mov<0x124, 0xf>(0.f, v); v += dpp_mov<0x128, 0xf>(0.f, v);
    return v;
}
__device__ __forceinline__ void lds_barrier() { asm volatile("s_waitcnt lgkmcnt(0)" ::: "memory"); __builtin_amdgcn_s_barrier(); asm volatile("" ::: "memory"); }
__device__ __forceinline__ float block_sum(float v, LAS float* sc, const int wave) {
    v = wave_sum(v);
    if (hw_lane() == 0) sc[wave] = v;
    lds_barrier();
    float r = 0.f;
#pragma unroll
    for (int i = 0; i < 8; ++i) r += sc[i];
    lds_barrier();
    return r;
}

#define XB_TMO      128
#define XB_XCNT(j)  (256  + 64 * (j))
#define XB_XSUB(j)  (1280 + 64 * (j))
#define XB_XGEN(j)  (2304 + 64 * (j))
#define XB_TOP      3328
#define XB_TOPGEN   3392
#define XCD_BAR_WORDS 3456
#define XB_SPIN_CAP (1u << 22)

__device__ __forceinline__ unsigned xb_ld(unsigned* p)              { return __hip_atomic_load(p, __ATOMIC_RELAXED, __HIP_MEMORY_SCOPE_AGENT); }
__device__ __forceinline__ unsigned xb_add(unsigned* p, unsigned v) { return __hip_atomic_fetch_add(p, v, __ATOMIC_RELAXED, __HIP_MEMORY_SCOPE_AGENT); }
__device__ __forceinline__ unsigned xb_xcc_id() { return (unsigned)__builtin_amdgcn_s_getreg((3 << 11) | 20) & 0xFu; }
#define XB_SPIN(cond, bar) do { unsigned _sp = 0; while (cond) { __builtin_amdgcn_s_sleep(1); \
    if ((++_sp & 255u) == 0u) { if (xb_ld(&(bar)[XB_TMO])) break; if (_sp > XB_SPIN_CAP) { atomicAdd(&(bar)[XB_TMO], 1u); break; } } } } while (0)

struct XcdBarrier { unsigned* bar; unsigned x; volatile LAS unsigned* st; };

__device__ __forceinline__ XcdBarrier xcd_barrier_post(unsigned* bar, volatile LAS unsigned* st) {
    XcdBarrier b; b.bar = bar; b.x = xb_xcc_id(); b.st = st;
    if (threadIdx.x == 0) (void)xb_add(&bar[XB_XCNT(b.x)], 1u);
    return b;
}
__device__ __forceinline__ void xcd_barrier_complete(unsigned* bar, unsigned x, unsigned& nloc, unsigned& nx) {
    const unsigned G = gridDim.x * gridDim.y * gridDim.z;
    unsigned sum, cnt, mine, sp = 0u;
    for (;;) {
        sum = 0u; cnt = 0u; mine = 0u;
#pragma unroll
        for (unsigned j = 0; j < 16; ++j) { const unsigned c = xb_ld(&bar[XB_XCNT(j)]); sum += c; cnt += (c > 0u) ? 1u : 0u; mine = (j == x) ? c : mine; }
        if (sum == G) break;
        __builtin_amdgcn_s_sleep(1);
        if ((++sp & 255u) == 0u) { if (xb_ld(&bar[XB_TMO])) break; if (sp > XB_SPIN_CAP) { atomicAdd(&bar[XB_TMO], 1u); break; } }
    }
    nloc = mine > 0u ? mine : 1u; nx = cnt > 0u ? cnt : 1u;
}
__device__ __forceinline__ void xcd_barrier(const XcdBarrier& b, const int wave) {
    asm volatile("s_waitcnt vmcnt(0)" ::: "memory");
    __syncthreads();
    if (wave == 0 && hw_lane() == 0) {
        unsigned* bar = b.bar;
        __builtin_amdgcn_s_waitcnt(0);
        unsigned nloc = b.st[0], nx = b.st[1];
        if (nloc == 0u) { xcd_barrier_complete(bar, b.x, nloc, nx); b.st[0] = nloc; b.st[1] = nx; }
        const unsigned old = xb_add(&bar[XB_XSUB(b.x)], 1u);
        const unsigned gen = old / nloc;
        if (old + 1u == (gen + 1u) * nloc) {
            __builtin_amdgcn_fence(__ATOMIC_RELEASE, "agent");
            asm volatile("s_waitcnt vmcnt(0)" ::: "memory");
            const unsigned og = xb_add(&bar[XB_TOP], 1u);
            const unsigned tg = og / nx;
            if (og + 1u == (tg + 1u) * nx) xb_add(&bar[XB_TOPGEN], 1u);
            else XB_SPIN(xb_ld(&bar[XB_TOPGEN]) == tg, bar);
            __builtin_amdgcn_fence(__ATOMIC_ACQUIRE, "agent");
            xb_add(&bar[XB_XGEN(b.x)], 1u);
            asm volatile("s_waitcnt vmcnt(0)" ::: "memory");
        } else {
            XB_SPIN(xb_ld(&bar[XB_XGEN(b.x)]) == gen, bar);
            __builtin_amdgcn_fence(__ATOMIC_ACQUIRE, "agent");
            asm volatile("s_waitcnt vmcnt(0)" ::: "memory");
        }
    }
    __syncthreads();
}

__device__ __forceinline__ void mini_barrier(unsigned* ctr, unsigned n, const int wave) {
    asm volatile("s_waitcnt vmcnt(0)" ::: "memory");
    __syncthreads();
    if (wave == 0 && hw_lane() == 0) {
        __builtin_amdgcn_fence(__ATOMIC_RELEASE, "agent");
        asm volatile("s_waitcnt vmcnt(0)" ::: "memory");
        (void)xb_add(ctr, 1u);
        unsigned sp = 0u;
        while (xb_ld(ctr) < n) { __builtin_amdgcn_s_sleep(1); if (++sp > XB_SPIN_CAP) break; }
        __builtin_amdgcn_fence(__ATOMIC_ACQUIRE, "agent");
        asm volatile("s_waitcnt vmcnt(0)" ::: "memory");
    }
    __syncthreads();
}

__device__ __forceinline__ void wg_signal(unsigned* ctr, const int wave) {
    asm volatile("s_waitcnt vmcnt(0)" ::: "memory");
    __syncthreads();
    if (wave == 0 && hw_lane() == 0) { __builtin_amdgcn_fence(__ATOMIC_RELEASE, "agent"); asm volatile("s_waitcnt vmcnt(0)" ::: "memory"); (void)xb_add(ctr, 1u); }
}
__device__ __forceinline__ void wg_wait(unsigned* ctr, unsigned n, const int wave) {
    if (wave == 0 && hw_lane() == 0) { unsigned sp = 0u;
        while (xb_ld(ctr) < n) { __builtin_amdgcn_s_sleep(1); if (++sp > XB_SPIN_CAP) break; }
        __builtin_amdgcn_fence(__ATOMIC_ACQUIRE, "agent");
        asm volatile("s_waitcnt vmcnt(0)" ::: "memory"); }
    __syncthreads();
}

__device__ __forceinline__ const float* x0_row(const float* meta, const float* xp, const float* xs, int row) {
    const int b = row / TP, t = row - b * TP;
    const float* p = t < NMETA ? meta + (size_t)t * D : xp + ((size_t)b * SEQ + (t - NMETA)) * D;
    if (row >= MPROMPT) p = row < MREAL ? xs + (size_t)(row - MPROMPT) * D : meta;
    return p;
}
namespace pg8 {
constexpr int BM = 256, BK = 64, HALF = 128, HTB = HALF * BK * 2, STAGE_BYTES = 8 * HTB, NXCD = 8, WGM = 8;
__host__ __device__ __forceinline__ int lds_byte(int r, int c) { const int st = (r >> 4) * 2 + (c >> 5), rr = r & 15, cc = c & 31, ob = rr * 64 + cc * 2; return st * 1024 + (ob ^ (((ob >> 9) & 1) << 5)); }
__host__ __device__ __forceinline__ void stage_rc(int b, int& R, int& C) { const int st = b / 1024, sb = b % 1024, swz = sb ^ (((sb >> 9) & 1) << 5); R = (st >> 1) * 16 + swz / 64; C = (st & 1) * 32 + (swz % 64) / 2; }
__host__ __device__ __forceinline__ int perm32(int rho) { const int n = rho >> 4, i = rho & 15; return 8 * (i >> 2) + 4 * n + (i & 3); }

struct Unit { int pm, pn, z, kb, kn, role; };
template <int LDA_, int LDB_, int K_, long ZSA_ = 0, long ZSB_ = 0> struct Gemm { static constexpr int lda = LDA_, ldb = LDB_, K = K_; static constexpr size_t zsA = (size_t)ZSA_, zsB = (size_t)ZSB_; const bf16_t* A; const bf16_t* Bt; };

template <int M_, int N_, int NZ_> struct TileOrder {
    static constexpr bool STREAM = false;
    static constexpr int nM = M_ / BM, nN = N_ / BM, nz = NZ_, nwg = nM * nN;
    int G, c;
    __device__ void init(int G_, int c_) { G = G_; c = c_; }
    __device__ __forceinline__ bool next(int i, Unit& u) const {
        u.kb = 0; u.kn = 0; u.role = 0;
        const int ti = i / nz; u.z = i - ti * nz;
        const long L = (long)ti * G + c; if (L >= nwg) return false;
        int wgid = (int)L; { const int q = nwg / NXCD, r = nwg % NXCD, xcd = wgid % NXCD, off = wgid / NXCD; wgid = (xcd < r ? xcd * (q + 1) : r * (q + 1) + (xcd - r) * q) + off; }
        const int nig = WGM * nN, gid = wgid / nig, fm = gid * WGM, gsz = (nM - fm) < WGM ? (nM - fm) : WGM;
        u.pm = fm + ((wgid % nig) % gsz); u.pn = (wgid % nig) / gsz; return true;
    }
};

template <int M_, int N_, int NT_> struct StreamOrder {
    static constexpr bool STREAM = true;
    static constexpr int nN = N_ / BM, nU = (M_ / BM) * nN, UQ = NT_ / 4, Q = nU * UQ;
    int G, c, start, share;
    __device__ void init(int G_, int c_) { G = G_; c = c_; const int base = Q / G_, rem = Q % G_; share = base + (c_ < rem ? 1 : 0); start = c_ * base + (c_ < rem ? c_ : rem); }
    __device__ __forceinline__ bool next(int i, Unit& u) const {
        int p = start; const int e = start + share;
        for (int idx = 0; p < e; ++idx) { const int uu = p / UQ, off = p - uu * UQ; const int len = (UQ - off) < (e - p) ? (UQ - off) : (e - p);
            if (idx == i) { u.pm = uu / nN; u.pn = uu - u.pm * nN; u.z = 0; u.kb = 4 * off; u.kn = 4 * len; u.role = off > 0 ? 1 : (len < UQ ? 2 : 0); return true; }
            p += len; }
        return false;
    }
};
template <int M_, int N_, int NZ_> struct FlatOrder {
    static constexpr bool STREAM = false;
    static constexpr int nM = M_ / BM, nN = N_ / BM, nwg = nM * nN;
    int G, c;
    __device__ void init(int G_, int c_) { G = G_; c = c_; }
    __device__ __forceinline__ bool next(int i, Unit& u) const {
        u.kb = 0; u.kn = 0; u.role = 0;
        const int L = i * G + c; if (L >= nwg * NZ_) return false;
        u.z = L / nwg; int wgid = L - u.z * nwg;
        { const int q = nwg / NXCD, r = nwg % NXCD, xcd = wgid % NXCD, off = wgid / NXCD; wgid = (xcd < r ? xcd * (q + 1) : r * (q + 1) + (xcd - r) * q) + off; }
        const int nig = WGM * nN, gid = wgid / nig, fm = gid * WGM, gsz = (nM - fm) < WGM ? (nM - fm) : WGM;
        u.pm = fm + ((wgid % nig) % gsz); u.pn = (wgid % nig) / gsz; return true;
    }
};
template <int PM_, int N_, int NZ_> struct TailOrder {
    static constexpr bool STREAM = false;
    static constexpr int nN = N_ / BM;
    int G, c;
    __device__ void init(int G_, int c_) { G = G_; c = c_; }
    __device__ __forceinline__ bool next(int i, Unit& u) const { const int L = i * G + c; if (L >= nN * NZ_) return false; u.pm = PM_; u.pn = L % nN; u.z = L / nN; u.kb = 0; u.kn = 0; u.role = 0; return true; }
};
template <int PM_, int N_, int NP_, int KP_> struct SplitOrder {
    static constexpr bool STREAM = true;
    static constexpr int nN = N_ / BM, nprod = nN * NP_;
    int G, c;
    __device__ void init(int G_, int c_) { G = G_; c = c_; }
    __device__ __forceinline__ bool next(int i, Unit& u) const { if (i > 0 || c >= nprod) return false; u.pm = PM_; u.pn = c % nN; u.z = 0; u.kb = KP_ * (c / nN); u.kn = KP_; u.role = 1; return true; }
};
struct StreamX { float* slots; unsigned* flags; unsigned* tmo; };

__device__ __forceinline__ unsigned cvt_pk_bf16(float lo, float hi) { unsigned r; asm volatile("v_cvt_pk_bf16_f32 %0, %1, %2" : "=v"(r) : "v"(lo), "v"(hi)); return r; }

template <int ACT> struct EpiBf16 {
    static constexpr bool PERM = true;
    bf16_t* O; int ldc;
    __device__ __forceinline__ void operator()(const f32x4 (&acc)[2][2][4][2], const Unit& u, int wr, int wc, int fr, int fq) const {
        const int row0 = u.pm * BM + wr * 64 + fr; const int col0 = u.pn * BM + wc * 32 + 8 * fq;
#pragma unroll
        for (int ai = 0; ai < 2; ++ai)
#pragma unroll
            for (int m = 0; m < 4; ++m) { bf16_t* rowp = O + (size_t)(row0 + ai * HALF + m * 16) * ldc + col0;
#pragma unroll
                for (int bj = 0; bj < 2; ++bj) { f32x4 v0 = acc[ai][bj][m][0], v1 = acc[ai][bj][m][1];
                    if (ACT == 1) {
#pragma unroll
                        for (int j = 0; j < 4; ++j) { const float a = fmaxf(v0[j], 0.f), b = fmaxf(v1[j], 0.f); v0[j] = a * a; v1[j] = b * b; } }
                    u32x4 w; w.x = cvt_pk_bf16(v0[0], v0[1]); w.y = cvt_pk_bf16(v0[2], v0[3]); w.z = cvt_pk_bf16(v1[0], v1[1]); w.w = cvt_pk_bf16(v1[2], v1[3]);
                    *(u32x4*)(rowp + bj * HALF) = w; } }
    }
};
struct EpiGateBf16 {
    static constexpr bool PERM = true;
    const bf16_t* PG; int ldg; bf16_t* O; int ldc; size_t zstride;
    __device__ __forceinline__ void operator()(const f32x4 (&acc)[2][2][4][2], const Unit& u, int wr, int wc, int fr, int fq) const {
        const int row0 = u.pm * BM + wr * 64 + fr; const int col0 = u.pn * BM + wc * 32 + 8 * fq;
        bf16_t* Oz = O + (size_t)u.z * zstride;
#pragma unroll
        for (int ai = 0; ai < 2; ++ai)
#pragma unroll
            for (int m2 = 0; m2 < 2; ++m2) { u32x4 g[2][2];
#pragma unroll
                for (int mm = 0; mm < 2; ++mm)
#pragma unroll
                    for (int bj = 0; bj < 2; ++bj) g[mm][bj] = *(const u32x4*)(PG + (size_t)(row0 + ai * HALF + (2 * m2 + mm) * 16) * ldg + (size_t)u.z * 2048 + col0 + bj * HALF);
#pragma unroll
                for (int mm = 0; mm < 2; ++mm)
#pragma unroll
                    for (int bj = 0; bj < 2; ++bj) { const int m = 2 * m2 + mm; const u32x4 gg = g[mm][bj];
                        f32x4 v0 = acc[ai][bj][m][0], v1 = acc[ai][bj][m][1];
                        v0[0] *= fsigmoid(__uint_as_float(gg.x << 16)); v0[1] *= fsigmoid(__uint_as_float(gg.x & 0xffff0000u));
                        v0[2] *= fsigmoid(__uint_as_float(gg.y << 16)); v0[3] *= fsigmoid(__uint_as_float(gg.y & 0xffff0000u));
                        v1[0] *= fsigmoid(__uint_as_float(gg.z << 16)); v1[1] *= fsigmoid(__uint_as_float(gg.z & 0xffff0000u));
                        v1[2] *= fsigmoid(__uint_as_float(gg.w << 16)); v1[3] *= fsigmoid(__uint_as_float(gg.w & 0xffff0000u));
                        u32x4 w; w.x = cvt_pk_bf16(v0[0], v0[1]); w.y = cvt_pk_bf16(v0[2], v0[3]); w.z = cvt_pk_bf16(v1[0], v1[1]); w.w = cvt_pk_bf16(v1[2], v1[3]);
                        *(u32x4*)(Oz + (size_t)(row0 + ai * HALF + m * 16) * ldc + col0 + bj * HALF) = w; } }
    }
};
struct EpiGateAcc {
    static constexpr bool PERM = true;
    const bf16_t* PG; int ldg; bf16_t* O; int ldc;
    __device__ __forceinline__ void operator()(const f32x4 (&acc)[2][2][4][2], const Unit& u, int wr, int wc, int fr, int fq) const {
        const int row0 = u.pm * BM + wr * 64 + fr; const int col0 = u.pn * BM + wc * 32 + 8 * fq;
        const bool first = u.z == 0;
#pragma unroll
        for (int ai = 0; ai < 2; ++ai)
#pragma unroll
            for (int m2 = 0; m2 < 2; ++m2) { u32x4 g[2][2], p[2][2];
#pragma unroll
                for (int mm = 0; mm < 2; ++mm)
#pragma unroll
                    for (int bj = 0; bj < 2; ++bj) { const size_t row = (size_t)(row0 + ai * HALF + (2 * m2 + mm) * 16);
                        g[mm][bj] = *(const u32x4*)(PG + row * ldg + (size_t)u.z * 2048 + col0 + bj * HALF);
                        p[mm][bj] = (u32x4){0u, 0u, 0u, 0u};
                        if (!first) p[mm][bj] = *(const u32x4*)(O + row * ldc + col0 + bj * HALF); }
#pragma unroll
                for (int mm = 0; mm < 2; ++mm)
#pragma unroll
                    for (int bj = 0; bj < 2; ++bj) { const int m = 2 * m2 + mm; const u32x4 gg = g[mm][bj], pp = p[mm][bj];
                        f32x4 v0 = acc[ai][bj][m][0], v1 = acc[ai][bj][m][1];
                        v0[0] = v0[0] * fsigmoid(__uint_as_float(gg.x << 16)) + __uint_as_float(pp.x << 16); v0[1] = v0[1] * fsigmoid(__uint_as_float(gg.x & 0xffff0000u)) + __uint_as_float(pp.x & 0xffff0000u);
                        v0[2] = v0[2] * fsigmoid(__uint_as_float(gg.y << 16)) + __uint_as_float(pp.y << 16); v0[3] = v0[3] * fsigmoid(__uint_as_float(gg.y & 0xffff0000u)) + __uint_as_float(pp.y & 0xffff0000u);
                        v1[0] = v1[0] * fsigmoid(__uint_as_float(gg.z << 16)) + __uint_as_float(pp.z << 16); v1[1] = v1[1] * fsigmoid(__uint_as_float(gg.z & 0xffff0000u)) + __uint_as_float(pp.z & 0xffff0000u);
                        v1[2] = v1[2] * fsigmoid(__uint_as_float(gg.w << 16)) + __uint_as_float(pp.w << 16); v1[3] = v1[3] * fsigmoid(__uint_as_float(gg.w & 0xffff0000u)) + __uint_as_float(pp.w & 0xffff0000u);
                        u32x4 w; w.x = cvt_pk_bf16(v0[0], v0[1]); w.y = cvt_pk_bf16(v0[2], v0[3]); w.z = cvt_pk_bf16(v1[0], v1[1]); w.w = cvt_pk_bf16(v1[2], v1[3]);
                        *(u32x4*)(O + (size_t)(row0 + ai * HALF + m * 16) * ldc + col0 + bj * HALF) = w; }
                asm volatile("" ::: "memory"); }
    }
};
struct EpiGate {
    static constexpr bool PERM = true;
    const bf16_t* PG; int ldg;
    float* F; bf16_t* O; int ldc;
    __device__ __forceinline__ void operator()(const f32x4 (&acc)[2][2][4][2], const Unit& u, int wr, int wc, int fr, int fq) const {
        const int row0 = u.pm * BM + wr * 64 + fr; const int col0 = u.pn * BM + wc * 32 + 8 * fq;
#pragma unroll
        for (int ai = 0; ai < 2; ++ai)
#pragma unroll
            for (int m = 0; m < 4; ++m) { const size_t row = (size_t)(row0 + ai * HALF + m * 16);
                u32x4 g[2]; f32x4 f0[2], f1[2];
#pragma unroll
                for (int bj = 0; bj < 2; ++bj) { const int col = col0 + bj * HALF; g[bj] = *(const u32x4*)(PG + row * ldg + (size_t)u.z * 2048 + col);
                    f0[bj] = (f32x4){0.f, 0.f, 0.f, 0.f}; f1[bj] = f0[bj];
                    if (u.z > 0) { const float* fp = F + row * ldc + col; f0[bj] = *(const f32x4*)fp; f1[bj] = *(const f32x4*)(fp + 4); } }
#pragma unroll
                for (int bj = 0; bj < 2; ++bj) { const int col = col0 + bj * HALF;
                    f32x4 v0 = acc[ai][bj][m][0], v1 = acc[ai][bj][m][1];
                    v0[0] *= fsigmoid(__uint_as_float(g[bj].x << 16)); v0[1] *= fsigmoid(__uint_as_float(g[bj].x & 0xffff0000u));
                    v0[2] *= fsigmoid(__uint_as_float(g[bj].y << 16)); v0[3] *= fsigmoid(__uint_as_float(g[bj].y & 0xffff0000u));
                    v1[0] *= fsigmoid(__uint_as_float(g[bj].z << 16)); v1[1] *= fsigmoid(__uint_as_float(g[bj].z & 0xffff0000u));
                    v1[2] *= fsigmoid(__uint_as_float(g[bj].w << 16)); v1[3] *= fsigmoid(__uint_as_float(g[bj].w & 0xffff0000u));
                    v0 += f0[bj]; v1 += f1[bj];
                    float* fp = F + row * ldc + col;
                    if (u.z < 2) { *(f32x4*)fp = v0; *(f32x4*)(fp + 4) = v1; }
                    else { u32x4 w; w.x = cvt_pk_bf16(v0[0], v0[1]); w.y = cvt_pk_bf16(v0[2], v0[3]); w.z = cvt_pk_bf16(v1[0], v1[1]); w.w = cvt_pk_bf16(v1[2], v1[3]);
                           *(u32x4*)(O + row * ldc + col) = w; } } }
    }
};
struct EpiResid {
    static constexpr bool PERM = false;
    const float* Xin; float* Xout; int ldc;
    __device__ __forceinline__ void operator()(const f32x4 (&acc)[2][2][4][2], const Unit& u, int wr, int wc, int fr, int fq) const {
        const int row0 = u.pm * BM + wr * 64 + fr, col0 = u.pn * BM + wc * 32 + 4 * fq;
#pragma unroll
        for (int ai = 0; ai < 2; ++ai)
#pragma unroll
            for (int m = 0; m < 4; ++m) { f32x4 t[2][2]; const size_t ro = (size_t)(row0 + ai * HALF + m * 16) * ldc + col0;
#pragma unroll
                for (int bj = 0; bj < 2; ++bj)
#pragma unroll
                    for (int n = 0; n < 2; ++n) t[bj][n] = *(const f32x4*)(Xin + ro + bj * HALF + n * 16);
#pragma unroll
                for (int bj = 0; bj < 2; ++bj)
#pragma unroll
                    for (int n = 0; n < 2; ++n) *(f32x4*)(Xout + ro + bj * HALF + n * 16) = t[bj][n] + acc[ai][bj][m][n];
                asm volatile("" ::: "memory"); }
    }
};

struct EpiResidSrc {
    static constexpr bool PERM = false;
    const float* meta; const float* xp; const float* xs; float* Xout; int ldc;
    __device__ __forceinline__ void operator()(const f32x4 (&acc)[2][2][4][2], const Unit& u, int wr, int wc, int fr, int fq) const {
        const int row0 = u.pm * BM + wr * 64 + fr, col0 = u.pn * BM + wc * 32 + 4 * fq;
#pragma unroll
        for (int ai = 0; ai < 2; ++ai)
#pragma unroll
            for (int m = 0; m < 4; ++m) { f32x4 t[2][2]; const int row = row0 + ai * HALF + m * 16; const size_t ro = (size_t)row * ldc + col0;
                const float* src = x0_row(meta, xp, xs, row) + col0;
#pragma unroll
                for (int bj = 0; bj < 2; ++bj)
#pragma unroll
                    for (int n = 0; n < 2; ++n) t[bj][n] = *(const f32x4*)(src + bj * HALF + n * 16);
#pragma unroll
                for (int bj = 0; bj < 2; ++bj)
#pragma unroll
                    for (int n = 0; n < 2; ++n) *(f32x4*)(Xout + ro + bj * HALF + n * 16) = t[bj][n] + acc[ai][bj][m][n];
                asm volatile("" ::: "memory"); }
    }
};

template <int MODE>
__device__ __forceinline__ void split_reduce(const int wid, float* X, bf16_t* U, int ldc, const StreamX sx, int pm, int pn, int nN, int NP) {
    const int lane = hw_lane(), tid = wid * 64 + lane, wr = wid >> 2, wc = wid & 3, fr = lane & 15, fq = lane >> 4;
    if (wid == 0) {
#pragma unroll 1
        for (int j = 0; j < NP; ++j) { unsigned sp = 0;
            while ((unsigned)__builtin_amdgcn_readfirstlane(__hip_atomic_load(sx.flags + 64 * (pn + nN * j), __ATOMIC_RELAXED, __HIP_MEMORY_SCOPE_AGENT)) != 1u) {
                __builtin_amdgcn_s_sleep(1);
                if ((++sp & 255u) == 0u) { if (__builtin_amdgcn_readfirstlane(__hip_atomic_load(sx.tmo, __ATOMIC_RELAXED, __HIP_MEMORY_SCOPE_AGENT))) break; if (sp > (1u << 20)) { if (lane == 0) __hip_atomic_store(sx.tmo, 1u, __ATOMIC_RELAXED, __HIP_MEMORY_SCOPE_AGENT); break; } } } }
        __builtin_amdgcn_fence(__ATOMIC_ACQUIRE, "agent"); asm volatile("s_waitcnt vmcnt(0)" ::: "memory"); }
    __syncthreads();
    const float* s0 = sx.slots + (size_t)pn * 65536 + tid * 32; const size_t jstride = (size_t)nN * 65536;
#pragma unroll 2
    for (int am = 0; am < 16; ++am) {
        const int a = am >> 3, b = (am >> 2) & 1, m = am & 3;
        f32x4 v0 = (f32x4){0.f, 0.f, 0.f, 0.f}, v1 = v0;
        const float* p = s0 + (am >> 2) * 16384 + (am & 3) * 8;
#pragma unroll 4
        for (int j = 0; j < NP; ++j) { v0 += *(const f32x4*)(p + j * jstride); v1 += *(const f32x4*)(p + j * jstride + 4); }
        const size_t row = (size_t)(pm * BM + a * HALF + wr * 64 + m * 16 + fr);
        if (MODE == 0) { float* xp = X + row * ldc + pn * BM + b * HALF + wc * 32 + 4 * fq;
            *(f32x4*)xp = *(const f32x4*)xp + v0; *(f32x4*)(xp + 16) = *(const f32x4*)(xp + 16) + v1; }
        else {
#pragma unroll
            for (int e = 0; e < 4; ++e) { const float x0 = fmaxf(v0[e], 0.f), x1 = fmaxf(v1[e], 0.f); v0[e] = x0 * x0; v1[e] = x1 * x1; }
            u32x4 w; w.x = cvt_pk_bf16(v0[0], v0[1]); w.y = cvt_pk_bf16(v0[2], v0[3]); w.z = cvt_pk_bf16(v1[0], v1[1]); w.w = cvt_pk_bf16(v1[2], v1[3]);
            *(u32x4*)(U + row * ldc + pn * BM + b * HALF + wc * 32 + 8 * fq) = w; }
    }
    __syncthreads();
}

template <class Epi, class Sched, class GemmT>
__device__ __forceinline__ void gemm_phase(LAS unsigned char* lds, const int wid, const GemmT g, const Sched& S, const Epi& E, const StreamX sx = StreamX{nullptr, nullptr, nullptr}) {
    const int lane = hw_lane(), tid = wid * 64 + lane, wr = wid >> 2, wc = wid & 3, fr = lane & 15, fq = lane >> 4;
    constexpr int K = GemmT::K, nt = K / BK;
    unsigned voffA[2], voffB[2];
#pragma unroll
    for (int i = 0; i < 2; ++i) { int R, C; stage_rc(tid * 16 + i * 8192, R, C); const int Rb = Epi::PERM ? ((R & ~31) + perm32(R & 31)) : R;
        voffA[i] = (unsigned)(R * GemmT::lda + C) * 2u; voffB[i] = (unsigned)(Rb * GemmT::ldb + C) * 2u; }
    constexpr size_t kstep = (size_t)(BK * 2);
    constexpr size_t hstepA = (size_t)HALF * GemmT::lda * 2, hstepB = (size_t)HALF * GemmT::ldb * 2;
    constexpr size_t tstepA = 2 * hstepA, tstepB = 2 * hstepB;
    const unsigned ldsw = (unsigned)wid * 1024u;
    const int aoff = lds_byte(wr * 64 + fr, fq * 8), boff = lds_byte(wc * 32 + fr, fq * 8);
#define PG8_SA(b, h) (((b) * 2 + (h)) * HTB)
#define PG8_SB(b, h) ((4 + (b) * 2 + (h)) * HTB)
#define PG8_STAGE(bufoff, gbase, voff) do { _Pragma("unroll") for (int _i = 0; _i < 2; ++_i) \
        __builtin_amdgcn_global_load_lds((const unsigned*)((const char*)(gbase) + (voff)[_i]), (LAS unsigned*)(lds + (bufoff) + ldsw + _i * 8192), 16, 0, 0); } while (0)
#define PG8_LDA(dst, b, h) do { _Pragma("unroll") for (int m = 0; m < 4; ++m) _Pragma("unroll") for (int k = 0; k < 2; ++k) dst[m][k] = *(const LAS bf16x8*)(lds + PG8_SA(b, h) + aoff + m * 2048 + k * 1024); } while (0)
#define PG8_LDB(dst, b, h) do { _Pragma("unroll") for (int n = 0; n < 2; ++n) _Pragma("unroll") for (int k = 0; k < 2; ++k) dst[n][k] = *(const LAS bf16x8*)(lds + PG8_SB(b, h) + boff + n * 2048 + k * 1024); } while (0)
#define PG8_MMA(ai, bj, At, Bt) do { __builtin_amdgcn_s_setprio(1); _Pragma("unroll") for (int m = 0; m < 4; ++m) _Pragma("unroll") for (int n = 0; n < 2; ++n) _Pragma("unroll") for (int k = 0; k < 2; ++k) \
        acc[ai][bj][m][n] = __builtin_amdgcn_mfma_f32_16x16x32_bf16(Bt[n][k], At[m][k], acc[ai][bj][m][n], 0, 0, 0); __builtin_amdgcn_s_setprio(0); } while (0)
#define PG8_WAIT_V(n) asm volatile("s_waitcnt vmcnt(" #n ")" ::: "memory")
#define PG8_WAIT_L(n) asm volatile("s_waitcnt lgkmcnt(" #n ")" ::: "memory")
#define PG8_BAR __builtin_amdgcn_s_barrier()
#define PG8_SCHED __builtin_amdgcn_sched_barrier(0)
    Unit cur, nxt; int ui = 0;
    if (!S.next(0, cur)) return;
    f32x4 acc[2][2][4][2];
#pragma unroll
    for (int a = 0; a < 2; ++a)
#pragma unroll
        for (int b = 0; b < 2; ++b)
#pragma unroll
            for (int m = 0; m < 4; ++m)
#pragma unroll
                for (int n = 0; n < 2; ++n) acc[a][b][m][n] = (f32x4){0.f, 0.f, 0.f, 0.f};
    bf16x8 At[4][2], B0[2][2], B1[2][2];
    const char* cA = (const char*)g.A + (size_t)cur.pm * tstepA + (size_t)cur.z * GemmT::zsA + (size_t)cur.kb * kstep; const char* cB = (const char*)g.Bt + (size_t)cur.pn * tstepB + (size_t)cur.z * GemmT::zsB + (size_t)cur.kb * kstep;
    PG8_STAGE(PG8_SB(0, 0), cB, voffB); PG8_STAGE(PG8_SB(0, 1), cB + hstepB, voffB); PG8_STAGE(PG8_SA(0, 0), cA, voffA); PG8_STAGE(PG8_SA(0, 1), cA + hstepA, voffA);
    if (wr == 1) PG8_BAR;
    PG8_WAIT_V(2); PG8_BAR;
    PG8_STAGE(PG8_SB(1, 0), cB + kstep, voffB); PG8_STAGE(PG8_SA(1, 0), cA + kstep, voffA); PG8_STAGE(PG8_SB(1, 1), cB + hstepB + kstep, voffB);
    PG8_WAIT_V(6); PG8_BAR;
    for (;;) {
        const bool has_next = S.next(ui + 1, nxt);
        const char* nA = has_next ? (const char*)g.A + (size_t)nxt.pm * tstepA + (size_t)nxt.z * GemmT::zsA + (size_t)nxt.kb * kstep : cA;
        const char* nB = has_next ? (const char*)g.Bt + (size_t)nxt.pn * tstepB + (size_t)nxt.z * GemmT::zsB + (size_t)nxt.kb * kstep : cB;
        const int ntu = Sched::STREAM ? cur.kn : nt;
        for (int t = 0; t < ntu; t += 2) {
            const bool last = (t == ntu - 2);
            const char* a1 = cA + (size_t)(t + 1) * kstep;
            const char* a2 = last ? nA : cA + (size_t)(t + 2) * kstep; const char* b2 = last ? nB : cB + (size_t)(t + 2) * kstep;
            const char* a3 = a2 + kstep; const char* b3 = b2 + kstep;
            PG8_LDB(B0, 0, 0); PG8_LDB(B1, 0, 1); PG8_SCHED; PG8_LDA(At, 0, 0); PG8_STAGE(PG8_SA(1, 1), a1 + hstepA, voffA);
            PG8_WAIT_V(8); PG8_WAIT_L(0); PG8_BAR; PG8_MMA(0, 0, At, B0); PG8_MMA(0, 1, At, B1); PG8_BAR; PG8_SCHED;
            PG8_LDA(At, 0, 1); PG8_STAGE(PG8_SB(0, 0), b2, voffB); PG8_STAGE(PG8_SB(0, 1), b2 + hstepB, voffB); PG8_STAGE(PG8_SA(0, 0), a2, voffA);
            PG8_WAIT_V(8); PG8_WAIT_L(0); PG8_BAR; PG8_MMA(1, 0, At, B0); PG8_MMA(1, 1, At, B1); PG8_BAR; PG8_SCHED;
            PG8_LDB(B0, 1, 0); PG8_LDB(B1, 1, 1); PG8_SCHED; PG8_LDA(At, 1, 0); PG8_STAGE(PG8_SA(0, 1), a2 + hstepA, voffA);
            PG8_WAIT_V(8); PG8_WAIT_L(0); PG8_BAR; PG8_MMA(0, 0, At, B0); PG8_MMA(0, 1, At, B1); PG8_BAR; PG8_SCHED;
            PG8_LDA(At, 1, 1); PG8_STAGE(PG8_SB(1, 0), b3, voffB); PG8_STAGE(PG8_SB(1, 1), b3 + hstepB, voffB); PG8_STAGE(PG8_SA(1, 0), a3, voffA);
            PG8_WAIT_V(8); PG8_WAIT_L(0); PG8_BAR; PG8_MMA(1, 0, At, B0); PG8_MMA(1, 1, At, B1); PG8_BAR; PG8_SCHED;
        }
        if (wr == 0) PG8_BAR;
        const int lane_e = hw_lane(), tid_e = wid * 64 + lane_e, fr_e = lane_e & 15, fq_e = lane_e >> 4;
        if (Sched::STREAM && cur.role == 1) {
            const __amdgpu_buffer_rsrc_t rs = __builtin_amdgcn_make_buffer_rsrc(sx.slots, 0, 256 * 65536 * 4, 0x00020000);
            const unsigned sbase = (unsigned)S.c * 262144u + (unsigned)tid_e * 128u;
#pragma unroll
            for (int a = 0; a < 2; ++a)
#pragma unroll
                for (int b = 0; b < 2; ++b)
#pragma unroll
                    for (int m = 0; m < 4; ++m)
#pragma unroll
                        for (int n = 0; n < 2; ++n) { constexpr int dummy = 0; const int k = ((a * 2 + b) * 4 + m) * 2 + n;
                            __builtin_amdgcn_raw_buffer_store_b128(__builtin_bit_cast(u32x4, acc[a][b][m][n]), rs, sbase + (unsigned)((k >> 3) * 65536), (k & 7) * 16 + dummy, 16); }
            asm volatile("s_waitcnt vmcnt(0)" ::: "memory"); PG8_BAR; asm volatile("" ::: "memory");
            if (tid_e == 0) __hip_atomic_store(sx.flags + 64 * S.c, 1u, __ATOMIC_RELAXED, __HIP_MEMORY_SCOPE_AGENT);
        } else {
            E(acc, cur, wr, wc, fr_e, fq_e);
        }
        if (!has_next) break;
        if (Sched::STREAM && nxt.role == 2) {
            if (wid == 0) { unsigned sp = 0;
                while ((unsigned)__builtin_amdgcn_readfirstlane(__hip_atomic_load(sx.flags + 64 * (S.c + 1), __ATOMIC_RELAXED, __HIP_MEMORY_SCOPE_AGENT)) != 1u) {
                    __builtin_amdgcn_s_sleep(1);
                    if ((++sp & 255u) == 0u) { if (__builtin_amdgcn_readfirstlane(__hip_atomic_load(sx.tmo, __ATOMIC_RELAXED, __HIP_MEMORY_SCOPE_AGENT))) break; if (sp > (1u << 20)) { if (lane == 0) __hip_atomic_store(sx.tmo, 1u, __ATOMIC_RELAXED, __HIP_MEMORY_SCOPE_AGENT); break; } } }
                __builtin_amdgcn_fence(__ATOMIC_ACQUIRE, "agent"); asm volatile("s_waitcnt vmcnt(0)" ::: "memory"); }
            asm volatile("" ::: "memory"); PG8_BAR; asm volatile("" ::: "memory");
            const float* ps = sx.slots + (size_t)(S.c + 1) * 65536 + tid * 32;
#pragma unroll
            for (int a = 0; a < 2; ++a)
#pragma unroll
                for (int b = 0; b < 2; ++b)
#pragma unroll
                    for (int m = 0; m < 4; ++m)
#pragma unroll
                        for (int n = 0; n < 2; ++n) { const int k = ((a * 2 + b) * 4 + m) * 2 + n; acc[a][b][m][n] = *(const f32x4*)(ps + (k >> 3) * 16384 + (k & 7) * 4); }
        } else {
#pragma unroll
        for (int a = 0; a < 2; ++a)
#pragma unroll
            for (int b = 0; b < 2; ++b)
#pragma unroll
                for (int m = 0; m < 4; ++m)
#pragma unroll
                    for (int n = 0; n < 2; ++n) acc[a][b][m][n] = (f32x4){0.f, 0.f, 0.f, 0.f};
        }
        cur = nxt; cA = nA; cB = nB; ++ui;
        if (wr == 1) PG8_BAR;
    }
    PG8_WAIT_V(0);
    PG8_BAR;
#undef PG8_SA
#undef PG8_SB
#undef PG8_STAGE
#undef PG8_LDA
#undef PG8_LDB
#undef PG8_MMA
#undef PG8_WAIT_V
#undef PG8_WAIT_L
#undef PG8_BAR
#undef PG8_SCHED
}
}

constexpr int NWAVES = 8, NTHR = 512;
constexpr int LDS_BYTES = 147456;
constexpr int LDS_MISC = 131072;
constexpr int NPHASE = 22;

struct Params {
    const float* in[38];
    float* out;
    unsigned char* ws;
    int ph_lo, ph_hi;
};
struct Ctx {
    float* out; unsigned char* ws;
    LAS unsigned char* lds;
    int tid, lane, wave, G, bid;
};
__device__ __forceinline__ const float* inp(const Ctx& c, int i);
enum { I_XP = 0, I_XS, I_SC, I_SN, I_SM, I_SGS, I_SGC, I_SRS, I_SRSH, I_META, I_NMIX, I_WIN, I_BI, I_BF, I_MNW, I_CONVW, I_ALOG, I_DTB, I_GNW, I_MU, I_W0, I_W2, I_A0, I_A2, I_G2,
       I_KK, I_KA, I_RK, I_LNW, I_LNB, I_WBA, I_WBB, I_WBC, I_WOUT, I_NMLP, I_WUP, I_WDN, I_FNW };

__device__ __forceinline__ const float* inp(const Ctx& c, int i) {
    const LAS unsigned* t = (const LAS unsigned*)(c.lds + LDS_MISC + 64) + 2 * i;
    const unsigned lo = __builtin_amdgcn_readfirstlane(t[0]), hi = __builtin_amdgcn_readfirstlane(t[1]);
    typedef const float __attribute__((address_space(1)))* gptr_t;
    return (const float*)(gptr_t)(((unsigned long long)hi << 32) | lo);
}
__device__ __forceinline__ void transpose_item(const float* W, int K, int Nsrc, int src_col, bf16_t* WT, int dst_row, int k0, LAS float* scr, int lane) {
    float v[32];
    const float* src = W + (size_t)(k0 + (lane >> 5)) * Nsrc + src_col + (lane & 31);
#pragma unroll
    for (int i = 0; i < 32; ++i) v[i] = src[(size_t)(2 * i) * Nsrc];
#pragma unroll
    for (int i = 0; i < 32; ++i) scr[(2 * i + (lane >> 5)) * 33 + (lane & 31)] = v[i];
    asm volatile("s_waitcnt lgkmcnt(0)" ::: "memory");
    const int c = lane & 7;
#pragma unroll
    for (int j = 0; j < 4; ++j) { const int n = (lane >> 3) + 8 * j; const LAS float* s = scr + (8 * c) * 33 + n;
        u32x4 o; o.x = pk2(s[0 * 33], s[1 * 33]); o.y = pk2(s[2 * 33], s[3 * 33]); o.z = pk2(s[4 * 33], s[5 * 33]); o.w = pk2(s[6 * 33], s[7 * 33]);
        *(u32x4*)(WT + (size_t)(dst_row + n) * K + k0 + 8 * c) = o; }
    asm volatile("s_waitcnt lgkmcnt(0)" ::: "memory");
}
__device__ __forceinline__ int win_src_col(int n) {
    return n < 4096 ? n : (n < 8192 ? n + 8 : (n < 11520 ? n + 24 : n + 24));
}
constexpr int CI_IN = 32 * (NPROJ / 32), CI_BR = 16 * 64, CI_O = 32 * 64, CI_U = 32 * 256, CI_D = 128 * 64;
constexpr int CO_BR = CI_IN, CO_O = CO_BR + 3 * CI_BR, CO_U = CO_O + CI_O, CO_D = CO_U + CI_U, C_PER_L = CO_D + CI_D;
#ifndef TAILCONV
#define TAILCONV 1
#endif
#if TAILCONV
constexpr int PREP_L0_END = CO_BR, PREP_L1_BEG = 0, PREP_L1_END = 0;
constexpr int WIN1_SEQ = 6144, WIN1_G4 = 8192;
constexpr int WBR_G1 = 1728, WBR_DYN = 3 * CI_BR - WBR_G1;
#else
constexpr int PREP_L0_END = C_PER_L, PREP_L1_BEG = 0, PREP_L1_END = C_PER_L, WBR_G1 = 0, WBR_DYN = 0;
#endif
__device__ __forceinline__ void convert_one(const Ctx& c0, const int l, const int it) {
    Ctx c = c0; c.lane = hw_lane();
    LAS float* scr = (LAS float*)(c.lds + c.wave * 16384);
    {
        int r = it;
        const float* W; bf16_t* WT; int K, Nsrc, scol, drow, k0;
        if (r < CI_IN) { const int nblk = NPROJ / 32, kb = r / nblk, nb = r % nblk;
            W = inp(c, I_WIN) + (size_t)l * D * NIN; K = D; Nsrc = NIN; scol = win_src_col(32 * nb); WT = (bf16_t*)(c.ws + WS_WIN) + (size_t)l * NPROJ * D; drow = 32 * nb; k0 = 64 * kb; }
        else if ((r -= CI_IN) < 3 * CI_BR) { const int br = r / CI_BR, rr = r % CI_BR, kb = rr / 64, nb = rr % 64;
            W = (br == 0 ? inp(c, I_WBA) : br == 1 ? inp(c, I_WBB) : inp(c, I_WBC)) + (size_t)l * 1024 * D; K = 1024; Nsrc = D; scol = 32 * nb; WT = (bf16_t*)(c.ws + WS_WBR) + ((size_t)l * 3 + br) * D * 1024; drow = 32 * nb; k0 = 64 * kb; }
        else if ((r -= 3 * CI_BR) < CI_O) { const int kb = r / 64, nb = r % 64;
            W = inp(c, I_WOUT) + (size_t)l * D * D; K = D; Nsrc = D; scol = 32 * nb; WT = (bf16_t*)(c.ws + WS_WOUT) + (size_t)l * D * D; drow = 32 * nb; k0 = 64 * kb; }
        else if ((r -= CI_O) < CI_U) { const int kb = r / 256, nb = r % 256;
            W = inp(c, I_WUP) + (size_t)l * D * DFF; K = D; Nsrc = DFF; scol = 32 * nb; WT = (bf16_t*)(c.ws + WS_WUP) + (size_t)l * DFF * D; drow = 32 * nb; k0 = 64 * kb; }
        else { r -= CI_U; const int kb = r / 64, nb = r % 64;
            W = inp(c, I_WDN) + (size_t)l * DFF * D; K = DFF; Nsrc = D; scol = 32 * nb; WT = (bf16_t*)(c.ws + WS_WDN) + (size_t)l * D * DFF; drow = 32 * nb; k0 = 64 * kb; }
        int ln = c.lane; asm volatile("" : "+v"(ln));
        transpose_item(W, K, Nsrc, scol, WT, drow, k0, scr, ln);
    }
}
__device__ __forceinline__ void convert_items(const Ctx& c0, const int l, const int r0, const int r1, const int b0) {
    if (c0.bid < b0) return;
    const int gw = (c0.bid - b0) * NWAVES + c0.wave, NGW = (c0.G - b0) * NWAVES;
#pragma unroll 1
    for (int it = r0 + gw; it < r1; it += NGW) convert_one(c0, l, it);
}
__device__ __forceinline__ void phase_prep(const Ctx& c0) {
    Ctx c = c0; c.lane = hw_lane(); c.tid = c.wave * 64 + c.lane;
    const int gw = c.bid * NWAVES + c.wave, NGW = c.G * NWAVES;
    convert_items(c0, 0, 0, PREP_L0_END, 0);
    convert_items(c0, 1, PREP_L1_BEG, PREP_L1_END, 0);
    float* wsg = (float*)(c.ws + WS_WSG);
    for (int i = c.bid * NTHR + c.tid; i < 2 * NSG * D; i += c.G * NTHR) {
        const int l = i / (NSG * D), r = i % (NSG * D), j = r / D, k = r % D;
        const int col = j < 8 ? 4096 + j : 8200 + (j - 8);
        wsg[i] = inp(c, I_WIN)[((size_t)l * D + k) * NIN + col];
    }
}

template <bool GATES>
__device__ __forceinline__ void phase_norm(const Ctx& c0, const float* w, const float* wsg) {
    Ctx c = c0; c.lane = hw_lane(); c.tid = c.wave * 64 + c.lane;
    const int gw = c.bid * NWAVES + c.wave, NGW = c.G * NWAVES;
    const float* X = (const float*)(c.ws + WS_X); bf16_t* HN = (bf16_t*)(c.ws + WS_HN); float* SG = (float*)(c.ws + WS_SG);
    f32x4 wv[8];
#pragma unroll
    for (int j = 0; j < 8; ++j) wv[j] = ((const f32x4*)w)[c.lane + 64 * j];
    for (int row = gw; row < MP; row += 2 * NGW) {
        const int row1 = row + NGW; const bool two = row1 < MP;
        const f32x4* xr0 = (const f32x4*)(X + (size_t)row * D) + c.lane; const f32x4* xr1 = (const f32x4*)(X + (size_t)(two ? row1 : row) * D) + c.lane;
        f32x4 v0[8], v1[8]; float s0 = 0.f, s1 = 0.f;
#pragma unroll
        for (int j = 0; j < 8; ++j) { v0[j] = xr0[64 * j]; v1[j] = xr1[64 * j]; }
#pragma unroll
        for (int j = 0; j < 8; ++j) { s0 += (v0[j].x * v0[j].x + v0[j].y * v0[j].y) + (v0[j].z * v0[j].z + v0[j].w * v0[j].w); s1 += (v1[j].x * v1[j].x + v1[j].y * v1[j].y) + (v1[j].z * v1[j].z + v1[j].w * v1[j].w); }
        const float r0 = rsqrtf(wave_sum(s0) * (1.f / D) + 1e-6f), r1 = rsqrtf(wave_sum(s1) * (1.f / D) + 1e-6f);
        u32x2* o0 = (u32x2*)(HN + (size_t)row * D) + c.lane; u32x2* o1 = (u32x2*)(HN + (size_t)(two ? row1 : row) * D) + c.lane;
#pragma unroll
        for (int j = 0; j < 8; ++j) { v0[j] = v0[j] * r0 * wv[j]; v1[j] = v1[j] * r1 * wv[j];
            u32x2 o; o.x = pk2(v0[j].x, v0[j].y); o.y = pk2(v0[j].z, v0[j].w); o0[64 * j] = o;
            if (two) { o.x = pk2(v1[j].x, v1[j].y); o.y = pk2(v1[j].z, v1[j].w); o1[64 * j] = o; } }
        if (GATES) {
#pragma unroll 1
            for (int g0 = 0; g0 < NSG; g0 += 2) {
                f32x4 q[2][8];
#pragma unroll
                for (int gg = 0; gg < 2; ++gg)
#pragma unroll
                    for (int j = 0; j < 8; ++j) q[gg][j] = ((const f32x4*)(wsg + (size_t)(g0 + gg) * D))[c.lane + 64 * j];
#pragma unroll
                for (int gg = 0; gg < 2; ++gg) { float a0 = 0.f, a1 = 0.f;
#pragma unroll
                    for (int j = 0; j < 8; ++j) { a0 += (v0[j].x * q[gg][j].x + v0[j].y * q[gg][j].y) + (v0[j].z * q[gg][j].z + v0[j].w * q[gg][j].w);
                                                  a1 += (v1[j].x * q[gg][j].x + v1[j].y * q[gg][j].y) + (v1[j].z * q[gg][j].z + v1[j].w * q[gg][j].w); }
                    a0 = wave_sum(a0); a1 = wave_sum(a1);
                    if (c.lane == 0) { SG[(size_t)row * SGLD + g0 + gg] = a0; if (two) SG[(size_t)row1 * SGLD + g0 + gg] = a1; } }
            }
        }
    }
}
constexpr int NR1 = 5;
template <int NV>
__device__ __forceinline__ void norm_gate_group(const f32x4 (&v)[NR1][8], const LAS f32x4* gb, float* SG, const int (&rows)[NR1], int g0, int lane) {
#pragma unroll 1
    for (int g = 0; g < 4; ++g) {
        f32x2 a[NR1];
#pragma unroll
        for (int r = 0; r < NR1; ++r) a[r] = (f32x2){0.f, 0.f};
#pragma unroll
        for (int j = 0; j < 8; ++j) { const f32x4 q = gb[g * 512 + lane + 64 * j]; const f32x2 q01 = {q.x, q.y}, q23 = {q.z, q.w};
#pragma unroll
            for (int r = 0; r < NV; ++r) { const f32x2 v01 = {v[r][j].x, v[r][j].y}, v23 = {v[r][j].z, v[r][j].w};
                a[r] = __builtin_elementwise_fma(v01, q01, a[r]); a[r] = __builtin_elementwise_fma(v23, q23, a[r]); } }
#pragma unroll
        for (int r = 0; r < NV; ++r) { const float t = wave_sum(a[r].x + a[r].y); if (lane == 0) SG[(size_t)rows[r] * SGLD + g0 + g] = t; }
    }
}
template <bool FIRST>
__device__ __forceinline__ void phase_norm_gates(const Ctx& c0, const float* w, const float* wsg) {
    Ctx c = c0; c.lane = hw_lane(); c.tid = c.wave * 64 + c.lane;
    const int gw = c.bid * NWAVES + c.wave, NGW = c.G * NWAVES;
    const float* X = (const float*)(c.ws + WS_X); bf16_t* HN = (bf16_t*)(c.ws + WS_HN); float* SG = (float*)(c.ws + WS_SG);
    LAS f32x4* GB = (LAS f32x4*)c.lds;
    const f32x4* wsg4 = (const f32x4*)wsg;
    const float* xmeta = FIRST ? inp(c, I_META) : nullptr; const float* xprm = FIRST ? inp(c, I_XP) : nullptr; const float* xsmp = FIRST ? inp(c, I_XS) : nullptr;
#pragma unroll 1
    for (int base = 0; base < MP; base += NR1 * NGW) {
        int rows[NR1]; f32x4 v[NR1][8]; f32x4 st[4];
        int nv = 0;
#pragma unroll
        for (int r = 0; r < NR1; ++r) { const int row = base + r * NGW + gw; nv += row < MP ? 1 : 0; rows[r] = row < MP ? row : MP - 1; }
        nv = __builtin_amdgcn_readfirstlane(nv);
#pragma unroll
        for (int r = 0; r < NR1; ++r) { const f32x4* xr = (const f32x4*)(FIRST ? x0_row(xmeta, xprm, xsmp, rows[r]) : X + (size_t)rows[r] * D) + c.lane;
#pragma unroll
            for (int j = 0; j < 8; ++j) v[r][j] = xr[64 * j]; }
#pragma unroll
        for (int k = 0; k < 4; ++k) st[k] = wsg4[c.tid + 512 * k];
        float rs[NR1];
#pragma unroll
        for (int r = 0; r < NR1; ++r) { float s = 0.f;
#pragma unroll
            for (int j = 0; j < 8; ++j) s += (v[r][j].x * v[r][j].x + v[r][j].y * v[r][j].y) + (v[r][j].z * v[r][j].z + v[r][j].w * v[r][j].w);
            rs[r] = rsqrtf(wave_sum(s) * (1.f / D) + 1e-6f); }
#pragma unroll
        for (int j = 0; j < 8; ++j) { const f32x4 wj = ((const f32x4*)w)[c.lane + 64 * j];
#pragma unroll
            for (int r = 0; r < NR1; ++r) { v[r][j] = v[r][j] * rs[r] * wj;
                if (r < nv) { u32x2 p; p.x = pk2(v[r][j].x, v[r][j].y); p.y = pk2(v[r][j].z, v[r][j].w); ((u32x2*)(HN + (size_t)rows[r] * D) + c.lane)[64 * j] = p; } } }
#pragma unroll
        for (int k = 0; k < 4; ++k) GB[c.tid + 512 * k] = st[k];
        lds_barrier();
#pragma unroll 1
        for (int ch = 0; ch < NSG / 4; ++ch) {
            if (ch + 1 < NSG / 4) {
#pragma unroll
                for (int k = 0; k < 4; ++k) st[k] = wsg4[(ch + 1) * 2048 + c.tid + 512 * k]; }
            const LAS f32x4* gb = GB + (ch & 1) * 2048;
            if (NR1 >= 5 && nv == 5) norm_gate_group<(NR1 >= 5 ? 5 : 1)>(v, gb, SG, rows, 4 * ch, c.lane);
            else if (NR1 >= 4 && nv == 4) norm_gate_group<(NR1 >= 4 ? 4 : 1)>(v, gb, SG, rows, 4 * ch, c.lane);
            else if (nv == 3) norm_gate_group<3>(v, gb, SG, rows, 4 * ch, c.lane);
            else if (nv == 2) norm_gate_group<2>(v, gb, SG, rows, 4 * ch, c.lane);
            else if (nv == 1) norm_gate_group<1>(v, gb, SG, rows, 4 * ch, c.lane);
            if (ch + 1 < NSG / 4) {
#pragma unroll
                for (int k = 0; k < 4; ++k) GB[((ch + 1) & 1) * 2048 + c.tid + 512 * k] = st[k]; }
            lds_barrier();
        }
    }
}
__device__ __forceinline__ void final_rows(const Ctx& c0, const int r0, const int r1, const int gw, const int NGW) {
    Ctx c = c0; c.lane = hw_lane(); c.tid = c.wave * 64 + c.lane;
    const float* X = (const float*)(c.ws + WS_X); const float* w = inp(c, I_FNW);
    f32x4 wv[8];
#pragma unroll
    for (int j = 0; j < 8; ++j) wv[j] = ((const f32x4*)w)[c.lane + 64 * j];
    for (int row = r0 + gw; row < r1; row += NGW) {
        float* dst;
        if (row < MPROMPT) { const int b = row / TP, t = row % TP; if (t < NMETA) continue; dst = c.out + O_YP + ((size_t)b * SEQ + (t - NMETA)) * D; }
        else dst = c.out + O_YS + (size_t)(row - MPROMPT) * D;
        const f32x4* xr = (const f32x4*)(X + (size_t)row * D) + c.lane;
        f32x4 v[8]; float s = 0.f;
#pragma unroll
        for (int j = 0; j < 8; ++j) { v[j] = xr[64 * j]; s += (v[j].x * v[j].x + v[j].y * v[j].y) + (v[j].z * v[j].z + v[j].w * v[j].w); }
        const float rstd = rsqrtf(wave_sum(s) * (1.f / D) + 1e-6f);
#pragma unroll
        for (int j = 0; j < 8; ++j) ((f32x4*)dst)[c.lane + 64 * j] = v[j] * rstd * wv[j];
    }
}
#ifndef FIN_IN_TAIL
#define FIN_IN_TAIL 1
#endif
__device__ __forceinline__ void phase_final(const Ctx& c0) {
    const bool tail_did = FIN_IN_TAIL && c0.G == 256;
    final_rows(c0, tail_did ? 8192 : 0, MREAL, c0.bid * NWAVES + c0.wave, c0.G * NWAVES);
}

__device__ __forceinline__ void mlstm_unit(const Ctx& c0, int l, int seq, int h) {
    Ctx c = c0; c.lane = hw_lane(); c.tid = c.wave * 64 + c.lane;
    const int tid = c.tid, v = tid & 255, kh = c.wave >> 2;
    const bool prompt = seq < BATCH; const int T = prompt ? TP : 1; const int row0 = prompt ? seq * TP : MPROMPT + (seq - BATCH);
    const bf16_t* PROJ = (const bf16_t*)(c.ws + WS_PROJ); const float* SG = (const float*)(c.ws + WS_SG); bf16_t* YBR = (bf16_t*)(c.ws + WS_YBR);
    LAS float* sm = (LAS float*)c.lds; LAS float* qs = sm, *ks = sm + 256, *vs = sm + 512, *red = sm + 768, *misc = sm + 1280, *sc = sm + 1296;
    float C[128]; float nreg = 0.f, m = 0.f;
    float *oc, *on, *om;
    if (prompt) { oc = c.out + O_PC + (((size_t)l * BATCH + seq) * HA + h) * DHA * DHA; on = c.out + O_PN + (((size_t)l * BATCH + seq) * HA + h) * DHA; om = c.out + O_PM + ((size_t)l * BATCH + seq) * HA + h;
#pragma unroll
        for (int j = 0; j < 128; ++j) C[j] = 0.f;
    } else { const int s = seq - BATCH; const size_t u = ((size_t)l * NB + s) * HA + h;
        oc = c.out + O_SC + u * DHA * DHA; on = c.out + O_SN + u * DHA; om = c.out + O_SM + u;
        const float* ci = inp(c, I_SC) + u * DHA * DHA;
        { const float* cp = ci + ((size_t)(kh * 128) * 256 + v);
#pragma unroll
          for (int jj = 0; jj < 32; ++jj) { asm volatile("" : "+v"(cp)); C[4 * jj] = cp[0]; C[4 * jj + 1] = cp[256]; C[4 * jj + 2] = cp[512]; C[4 * jj + 3] = cp[768]; cp += 1024; } }
        if (tid < 256) nreg = inp(c, I_SN)[u * DHA + tid];
        m = inp(c, I_SM)[u];
    }
    const float bi = inp(c, I_BI)[l * HA + h], bfv = inp(c, I_BF)[l * HA + h];
    const float nw = tid < 256 ? inp(c, I_MNW)[l * 1024 + h * 256 + tid] : 0.f;
    for (int t = 0; t < T; ++t) {
        const size_t row = (size_t)(row0 + t); const bf16_t* prow = PROJ + row * NPROJ;
        if (tid < 256) { qs[tid] = bf2f(prow[PA_Q + h * 256 + tid]); ks[tid] = bf2f(prow[PA_K + h * 256 + tid]) * 0.0625f; vs[tid] = bf2f(prow[PA_V + h * 256 + tid]); }
        if (tid == 0) { misc[0] = SG[row * SGLD + h] + bi; misc[1] = -softplusf_(-(SG[row * SGLD + 4 + h] + bfv)); }
        lds_barrier();
        const float gi = misc[0], gf = misc[1];
        const float mn = fmaxf(gf + m, gi), fw = __expf(gf + m - mn), iw = __expf(gi - mn); m = mn;
        const float vv = vs[v] * iw; float acc = 0.f;
#pragma unroll
        for (int jj = 0; jj < 16; ++jj) {
            const f32x4 k0 = *(const LAS f32x4*)(ks + kh * 128 + jj * 8), k1 = *(const LAS f32x4*)(ks + kh * 128 + jj * 8 + 4);
            const f32x4 q0 = *(const LAS f32x4*)(qs + kh * 128 + jj * 8), q1 = *(const LAS f32x4*)(qs + kh * 128 + jj * 8 + 4);
#pragma unroll
            for (int e = 0; e < 4; ++e) { C[jj * 8 + e] = fw * C[jj * 8 + e] + k0[e] * vv; acc += q0[e] * C[jj * 8 + e];
                                          C[jj * 8 + 4 + e] = fw * C[jj * 8 + 4 + e] + k1[e] * vv; acc += q1[e] * C[jj * 8 + 4 + e]; }
            asm volatile("" ::: "memory");
        }
        red[tid] = acc;
        float dpart = 0.f;
        if (tid < 256) { nreg = fw * nreg + iw * ks[tid]; dpart = qs[tid] * nreg; }
        const float den = block_sum(dpart, sc, c.wave);
        float hh = 0.f;
        if (tid < 256) hh = (red[tid] + red[256 + tid]) / fmaxf(fabsf(den), __expf(-m));
        const float ss = block_sum(hh * hh, sc, c.wave);
        if (tid < 256) { const float y = hh * rsqrtf(ss * (1.f / 256.f) + 1e-6f) * nw; const float o = bf2f(prow[PA_O + h * 256 + tid]);
            YBR[row * YLD + h * 256 + tid] = (bf16_t)f2bf(sigmoidf_(o) * y); }
        lds_barrier();
    }
    { float* op = oc + ((size_t)(kh * 128) * 256 + v);
#pragma unroll
      for (int jj = 0; jj < 32; ++jj) { asm volatile("" : "+v"(op)); op[0] = C[4 * jj]; op[256] = C[4 * jj + 1]; op[512] = C[4 * jj + 2]; op[768] = C[4 * jj + 3]; op += 1024; } }
    if (tid < 256) on[tid] = nreg;
    if (tid == 0) *om = m;
    lds_barrier();
}

__device__ __forceinline__ void mlstm_unit_s(const Ctx& c0, int l, int s, int h) {
    Ctx c = c0; c.lane = hw_lane(); c.tid = c.wave * 64 + c.lane;
    const int tid = c.tid, vq = c.lane, kg = c.wave;
    const size_t row = (size_t)(MPROMPT + s);
    const bf16_t* PROJ = (const bf16_t*)(c.ws + WS_PROJ); const float* SG = (const float*)(c.ws + WS_SG); bf16_t* YBR = (bf16_t*)(c.ws + WS_YBR);
    LAS float* sm = (LAS float*)c.lds; LAS float* qs = sm, *ks = sm + 256, *vs = sm + 512, *red = sm + 768  , *misc = sm + 2816, *sc = sm + 2832;
    const size_t u = ((size_t)l * NB + s) * HA + h;
    const f32x4* ci = (const f32x4*)(inp(c, I_SC) + u * DHA * DHA) + (size_t)(kg * 32) * 64 + vq;
    f32x4* oc = (f32x4*)(c.out + O_SC + u * DHA * DHA) + (size_t)(kg * 32) * 64 + vq;
    f32x4 C[32];
#pragma unroll
    for (int j = 0; j < 32; ++j) C[j] = ci[j * 64];
    float nreg = 0.f;
    if (tid < 256) nreg = inp(c, I_SN)[u * DHA + tid];
    float m = inp(c, I_SM)[u];
    const float bi = inp(c, I_BI)[l * HA + h], bfv = inp(c, I_BF)[l * HA + h];
    const float nw = tid < 256 ? inp(c, I_MNW)[l * 1024 + h * 256 + tid] : 0.f;
    const bf16_t* prow = PROJ + row * NPROJ;
    if (tid < 256) { qs[tid] = bf2f(prow[PA_Q + h * 256 + tid]); ks[tid] = bf2f(prow[PA_K + h * 256 + tid]) * 0.0625f; vs[tid] = bf2f(prow[PA_V + h * 256 + tid]); }
    if (tid == 0) { misc[0] = SG[row * SGLD + h] + bi; misc[1] = -softplusf_(-(SG[row * SGLD + 4 + h] + bfv)); }
    lds_barrier();
    const float gi = misc[0], gf = misc[1];
    const float mn = fmaxf(gf + m, gi), fw = __expf(gf + m - mn), iw = __expf(gi - mn); m = mn;
    const f32x4 vv = *(const LAS f32x4*)(vs + 4 * vq) * iw;
    f32x4 acc = (f32x4){0.f, 0.f, 0.f, 0.f};
#pragma unroll
    for (int jj = 0; jj < 8; ++jj) {
        const f32x4 k4 = *(const LAS f32x4*)(ks + kg * 32 + jj * 4), q4 = *(const LAS f32x4*)(qs + kg * 32 + jj * 4);
#pragma unroll
        for (int e = 0; e < 4; ++e) { C[jj * 4 + e] = C[jj * 4 + e] * fw + vv * k4[e]; acc += C[jj * 4 + e] * q4[e]; }
    }
#pragma unroll
    for (int j = 0; j < 32; ++j) oc[j * 64] = C[j];
    *(LAS f32x4*)(red + kg * 256 + 4 * vq) = acc;
    float dpart = 0.f;
    if (tid < 256) { nreg = fw * nreg + iw * ks[tid]; dpart = qs[tid] * nreg; }
    const float den = block_sum(dpart, sc, c.wave);
    float hh = 0.f;
    if (tid < 256) { float num = 0.f;
#pragma unroll
        for (int g = 0; g < 8; ++g) num += red[g * 256 + tid];
        hh = num / fmaxf(fabsf(den), __expf(-m)); }
    const float ss = block_sum(hh * hh, sc, c.wave);
    if (tid < 256) { const float y = hh * rsqrtf(ss * (1.f / 256.f) + 1e-6f) * nw; const float o = bf2f(prow[PA_O + h * 256 + tid]);
        YBR[row * YLD + h * 256 + tid] = (bf16_t)f2bf(sigmoidf_(o) * y);
        (c.out + O_SN + u * DHA)[tid] = nreg; }
    if (tid == 0) (c.out + O_SM)[u] = m;
    lds_barrier();
}

__device__ __forceinline__ void gdn_unit(const Ctx& c0, int l, int seq, int h) {
    Ctx c = c0; c.lane = hw_lane(); c.tid = c.wave * 64 + c.lane;
    const int tid = c.tid, v = tid & 127, kq = tid >> 7;
    const bool prompt = seq < BATCH; const int T = prompt ? TP : 1; const int row0 = prompt ? seq * TP : MPROMPT + (seq - BATCH);
    const bf16_t* PROJ = (const bf16_t*)(c.ws + WS_PROJ); const float* SG = (const float*)(c.ws + WS_SG); bf16_t* YBR = (bf16_t*)(c.ws + WS_YBR);
    LAS float* sm = (LAS float*)c.lds; LAS float* ring = sm  , *qk = sm + 1536  , *red = sm + 1920  , *part = sm + 2432  , *sc = sm + 2448;
    float S[32];
    float *os, *ocv; const float* cin = nullptr;
    const int cg = tid < 384 ? (tid >> 7) * 1024 + h * 128 + (tid & 127) : 0;
    if (prompt) { os = c.out + O_PGS + (((size_t)l * BATCH + seq) * HB + h) * DHB * DHB; ocv = c.out + O_PGC + ((size_t)l * BATCH + seq) * 3 * 3072;
#pragma unroll
        for (int j = 0; j < 32; ++j) S[j] = 0.f;
    } else { const int s = seq - BATCH; const size_t u = ((size_t)l * NB + s) * HB + h;
        os = c.out + O_SGS + u * DHB * DHB; ocv = c.out + O_SGC + ((size_t)l * NB + s) * 3 * 3072;
        const float* si = inp(c, I_SGS) + u * DHB * DHB;
#pragma unroll
        for (int j = 0; j < 32; ++j) S[j] = si[(size_t)(kq * 32 + j) * 128 + v];
        cin = inp(c, I_SGC) + ((size_t)l * NB + s) * 3 * 3072;
    }
    float cw0 = 0.f, cw1 = 0.f, cw2 = 0.f, cw3 = 0.f;
    if (tid < 384) { const float* cw = inp(c, I_CONVW) + (size_t)l * 4 * 3072; cw0 = cw[cg]; cw1 = cw[3072 + cg]; cw2 = cw[2 * 3072 + cg]; cw3 = cw[3 * 3072 + cg];
        ring[3 * 384 + tid] = cin ? cin[2 * 3072 + cg] : 0.f; ring[2 * 384 + tid] = cin ? cin[3072 + cg] : 0.f; ring[1 * 384 + tid] = cin ? cin[cg] : 0.f; ring[tid] = 0.f; }
    const float alog = inp(c, I_ALOG)[l * HB + h], dtb = inp(c, I_DTB)[l * HB + h];
    const float gnw = tid < 128 ? inp(c, I_GNW)[l * DHB + tid] : 0.f;
    lds_barrier();
    for (int t = 0; t < T; ++t) {
        const size_t row = (size_t)(row0 + t); const bf16_t* prow = PROJ + row * NPROJ;
        float y = 0.f;
        if (tid < 384) { const float u = bf2f(prow[PB_QKV + cg]); ring[(t & 3) * 384 + tid] = u;
            y = cw3 * u + cw2 * ring[((t - 1) & 3) * 384 + tid] + cw1 * ring[((t - 2) & 3) * 384 + tid] + cw0 * ring[((t - 3) & 3) * 384 + tid];
            y = siluf_(y); qk[tid] = y; }
        { const float s2 = wave_sum(y * y); if (c.lane == 0) part[c.wave] = s2; }
        lds_barrier();
        const float qn = rsqrtf(part[0] + part[1] + 1e-12f) * 0.08838834764831845f, kn = rsqrtf(part[2] + part[3] + 1e-12f);
        const float ga = SG[row * SGLD + 8 + h], gb = SG[row * SGLD + 16 + h];
        const float alpha = __expf(-__expf(alog) * softplusf_(ga + dtb)), beta = sigmoidf_(gb);
        float p = 0.f;
#pragma unroll
        for (int j = 0; j < 32; ++j) p += qk[128 + kq * 32 + j] * S[j];
        red[tid] = p * kn;
        lds_barrier();
        const float kS = red[v] + red[128 + v] + red[256 + v] + red[384 + v];
        const float vn = beta * (qk[256 + v] - alpha * kS);
        float o = 0.f;
#pragma unroll
        for (int j = 0; j < 32; ++j) { S[j] = alpha * S[j] + (qk[128 + kq * 32 + j] * kn) * vn; o += qk[kq * 32 + j] * S[j]; }
        lds_barrier();
        red[tid] = o * qn;
        lds_barrier();
        float oo = 0.f;
        if (tid < 128) oo = red[tid] + red[128 + tid] + red[256 + tid] + red[384 + tid];
        const float ss = block_sum(oo * oo, sc, c.wave);
        if (tid < 128) { const float z = bf2f(prow[PB_Z + h * 128 + tid]);
            YBR[row * YLD + 1024 + h * 128 + tid] = (bf16_t)f2bf(oo * rsqrtf(ss * (1.f / 128.f) + 1e-6f) * gnw * siluf_(z)); }
        lds_barrier();
    }
#pragma unroll
    for (int j = 0; j < 32; ++j) os[(size_t)(kq * 32 + j) * 128 + v] = S[j];
    if (tid < 384) {
#pragma unroll
        for (int j = 0; j < 3; ++j) ocv[j * 3072 + cg] = ring[((T - 3 + j) & 3) * 384 + tid];
    }
    lds_barrier();
}

__device__ __forceinline__ void gdn_unit_s(const Ctx& c0, int l, int s, int h) {
    Ctx c = c0; c.lane = hw_lane(); c.tid = c.wave * 64 + c.lane;
    const int tid = c.tid, vq = tid & 31, kg = tid >> 5;
    const size_t row = (size_t)(MPROMPT + s);
    const bf16_t* PROJ = (const bf16_t*)(c.ws + WS_PROJ); const float* SG = (const float*)(c.ws + WS_SG); bf16_t* YBR = (bf16_t*)(c.ws + WS_YBR);
    LAS float* sm = (LAS float*)c.lds; LAS float* qk = sm  , *red = sm + 384  , *red2 = sm + 2432  , *part = sm + 4480  , *sc = sm + 4496;
    const size_t u = ((size_t)l * NB + s) * HB + h;
    const f32x4* si = (const f32x4*)(inp(c, I_SGS) + u * DHB * DHB) + (size_t)(kg * 8) * 32 + vq;
    f32x4* os = (f32x4*)(c.out + O_SGS + u * DHB * DHB) + (size_t)(kg * 8) * 32 + vq;
    f32x4 S[8];
#pragma unroll
    for (int j = 0; j < 8; ++j) S[j] = si[j * 32];
    const bf16_t* prow = PROJ + row * NPROJ;
    float y = 0.f;
    if (tid < 384) { const int cg = (tid >> 7) * 1024 + h * 128 + (tid & 127);
        const float* cw = inp(c, I_CONVW) + (size_t)l * 4 * 3072; const float* cin = inp(c, I_SGC) + ((size_t)l * NB + s) * 3 * 3072; float* ocv = c.out + O_SGC + ((size_t)l * NB + s) * 3 * 3072;
        const float cw0 = cw[cg], cw1 = cw[3072 + cg], cw2 = cw[2 * 3072 + cg], cw3 = cw[3 * 3072 + cg];
        const float p0 = cin[cg], p1 = cin[3072 + cg], p2 = cin[2 * 3072 + cg]; const float uu = bf2f(prow[PB_QKV + cg]);
        y = siluf_(cw3 * uu + cw2 * p2 + cw1 * p1 + cw0 * p0); qk[tid] = y;
        ocv[cg] = p1; ocv[3072 + cg] = p2; ocv[2 * 3072 + cg] = uu; }
    { const float s2 = wave_sum(y * y); if (c.lane == 0) part[c.wave] = s2; }
    const float alog = inp(c, I_ALOG)[l * HB + h], dtb = inp(c, I_DTB)[l * HB + h];
    const float ga = SG[row * SGLD + 8 + h], gb = SG[row * SGLD + 16 + h];
    const float gnw = tid < 128 ? inp(c, I_GNW)[l * DHB + tid] : 0.f;
    const float z = tid < 128 ? bf2f(prow[PB_Z + h * 128 + tid]) : 0.f;
    lds_barrier();
    const float qn = rsqrtf(part[0] + part[1] + 1e-12f) * 0.08838834764831845f, kn = rsqrtf(part[2] + part[3] + 1e-12f);
    const float alpha = __expf(-__expf(alog) * softplusf_(ga + dtb)), beta = sigmoidf_(gb);
    const f32x4 ka = *(const LAS f32x4*)(qk + 128 + kg * 8), kb = *(const LAS f32x4*)(qk + 128 + kg * 8 + 4);
    const f32x4 qa = *(const LAS f32x4*)(qk + kg * 8), qb = *(const LAS f32x4*)(qk + kg * 8 + 4);
    { f32x4 p = S[0] * ka[0];
#pragma unroll
      for (int j = 1; j < 8; ++j) p += S[j] * (j < 4 ? ka[j] : kb[j - 4]);
      *(LAS f32x4*)(red + kg * 128 + 4 * vq) = p; }
    lds_barrier();
    f32x4 kS = *(const LAS f32x4*)(red + 4 * vq);
#pragma unroll
    for (int g = 1; g < 16; ++g) kS += *(const LAS f32x4*)(red + g * 128 + 4 * vq);
    const f32x4 vn = (*(const LAS f32x4*)(qk + 256 + 4 * vq) - kS * (alpha * kn)) * beta;
    { f32x4 o = (f32x4){0.f, 0.f, 0.f, 0.f};
#pragma unroll
      for (int j = 0; j < 8; ++j) { const float kj = (j < 4 ? ka[j] : kb[j - 4]) * kn, qj = j < 4 ? qa[j] : qb[j - 4]; S[j] = S[j] * alpha + vn * kj; o += S[j] * qj; }
#pragma unroll
      for (int j = 0; j < 8; ++j) os[j * 32] = S[j];
      *(LAS f32x4*)(red2 + kg * 128 + 4 * vq) = o; }
    lds_barrier();
    float oo = 0.f;
    if (tid < 128) {
#pragma unroll
        for (int g = 0; g < 16; ++g) oo += red2[g * 128 + tid];
        oo *= qn; }
    const float ss = block_sum(oo * oo, sc, c.wave);
    if (tid < 128) YBR[row * YLD + 1024 + h * 128 + tid] = (bf16_t)f2bf(oo * rsqrtf(ss * (1.f / 128.f) + 1e-6f) * gnw * siluf_(z));
    lds_barrier();
}

__device__ __forceinline__ void rwkv_unit(const Ctx& c0, int l, int seq, int h, int& cached_h) {
    Ctx c = c0; c.lane = hw_lane(); c.tid = c.wave * 64 + c.lane;
    const int tid = c.tid, k = tid & 63, vq = tid >> 6;
    const bool prompt = seq < BATCH; const int T = prompt ? TP : 1; const int row0 = prompt ? seq * TP : MPROMPT + (seq - BATCH);
    const bf16_t* PROJ = (const bf16_t*)(c.ws + WS_PROJ); bf16_t* YBR = (bf16_t*)(c.ws + WS_YBR);
    LAS float* sm = (LAS float*)c.lds;
    LAS float* w2s = sm, *a2s = sm + 4096, *g2s = sm + 8192  , *xs = sm + 16384  , *partl = sm + 16896  ;
    LAS float* dec = sm + 17408, *k2s = dec + 64, *avs = dec + 128, *bvs = dec + 192, *rrs = dec + 256, *vvs = dec + 320, *ggs = dec + 384, *ys = dec + 448, *misc = dec + 512;
    float S[8];
    float *os, *osh; const float* shin = nullptr;
    if (prompt) { os = c.out + O_PRS + (((size_t)l * BATCH + seq) * HC + h) * DHC * DHC; osh = c.out + O_PRSH + ((size_t)l * BATCH + seq) * NCC;
#pragma unroll
        for (int j = 0; j < 8; ++j) S[j] = 0.f;
    } else { const int s = seq - BATCH; const size_t u = ((size_t)l * NB + s) * HC + h;
        os = c.out + O_SRS + u * DHC * DHC; osh = c.out + O_SRSH + ((size_t)l * NB + s) * NCC;
        const float* si = inp(c, I_SRS) + u * DHC * DHC;
#pragma unroll
        for (int j = 0; j < 8; ++j) S[j] = si[(size_t)(vq * 8 + j) * 64 + k];
        shin = inp(c, I_SRSH) + ((size_t)l * NB + s) * NCC;
    }
    if (cached_h != h) { cached_h = h; const float* w2p = inp(c, I_W2) + (size_t)l * 64 * 1024 + h * 64; const float* a2p = inp(c, I_A2) + (size_t)l * 64 * 1024 + h * 64; const float* g2p = inp(c, I_G2) + (size_t)l * 128 * 1024 + h * 64;
      float lw2[8], la2[8], lg2[16];
#pragma unroll
      for (int k = 0; k < 8; ++k) { const int i = tid + k * NTHR; lw2[k] = w2p[(i >> 6) * 1024 + (i & 63)]; la2[k] = a2p[(i >> 6) * 1024 + (i & 63)]; }
#pragma unroll
      for (int k = 0; k < 16; ++k) { const int i = tid + k * NTHR; lg2[k] = g2p[(i >> 6) * 1024 + (i & 63)]; }
#pragma unroll
      for (int k = 0; k < 8; ++k) { const int i = tid + k * NTHR; w2s[i] = lw2[k]; a2s[i] = la2[k]; }
#pragma unroll
      for (int k = 0; k < 16; ++k) { const int i = tid + k * NTHR; g2s[i] = lg2[k]; } }
    int cidx = 0;
    if (tid < 64) cidx = h * 64 + tid; else if (tid < 128) cidx = 1024 + h * 64 + (tid - 64); else if (tid < 192) cidx = 2048 + h * 64 + (tid - 128); else if (tid < 448) cidx = 3072 + (tid - 192);
    float prev = 0.f, mu = 0.f;
    if (tid < 448) { prev = shin ? shin[cidx] : 0.f; mu = inp(c, I_MU)[(size_t)l * NCC + cidx]; }
    const int C = h * 64 + (tid & 63);
    float w0 = 0.f, a0 = 0.f, kkw = 0.f, kaw = 0.f, rkw = 0.f, lnw = 0.f, lnb = 0.f;
    if (tid < 64) { w0 = inp(c, I_W0)[l * 1024 + C]; a0 = inp(c, I_A0)[l * 1024 + C]; kkw = inp(c, I_KK)[l * 1024 + C]; kaw = inp(c, I_KA)[l * 1024 + C]; rkw = inp(c, I_RK)[l * 1024 + C];
        lnw = inp(c, I_LNW)[l * 1024 + C]; lnb = inp(c, I_LNB)[l * 1024 + C]; }
    lds_barrier();
    for (int t = 0; t < T; ++t) {
        const size_t row = (size_t)(row0 + t); const bf16_t* prow = PROJ + row * NPROJ;
        if (tid < 448) { const float cur = bf2f(prow[PC0 + cidx]); float xm = cur + (prev - cur) * mu; prev = cur;
            if (tid >= 192 && tid < 256) xm = ftanh(xm); else if (tid >= 320) xm = sigmoidf_(xm);
            xs[tid] = xm; }
        lds_barrier();
        { const int cc = tid & 63, pt = tid >> 6; float a = 0.f;
            if (pt < 2) { for (int j = 0; j < 32; ++j) a += xs[192 + pt * 32 + j] * w2s[(pt * 32 + j) * 64 + cc]; }
            else if (pt < 4) { for (int j = 0; j < 32; ++j) a += xs[256 + (pt - 2) * 32 + j] * a2s[((pt - 2) * 32 + j) * 64 + cc]; }
            else { for (int j = 0; j < 32; ++j) a += xs[320 + (pt - 4) * 32 + j] * g2s[((pt - 4) * 32 + j) * 64 + cc]; }
            partl[pt * 64 + cc] = a; }
        lds_barrier();
        if (tid < 64) {
            const float wl = w0 + partl[tid] + partl[64 + tid]; const float wlog = -softplusf_(-wl) - 0.5f; const float dc = __expf(-__expf(wlog));
            const float aa = sigmoidf_(a0 + partl[128 + tid] + partl[192 + tid]);
            const float gg = (partl[256 + tid] + partl[320 + tid]) + (partl[384 + tid] + partl[448 + tid]);
            const float kraw = xs[64 + tid], kkv = kraw * kkw; const float nrm = wave_sum(kkv * kkv); const float kk = kkv * rsqrtf(nrm + 1e-12f);
            const float k2 = kraw * (1.f + (aa - 1.f) * kaw);
            dec[tid] = dc; k2s[tid] = k2; avs[tid] = -kk; bvs[tid] = kk * aa; rrs[tid] = xs[tid]; vvs[tid] = xs[128 + tid]; ggs[tid] = gg;
            const float bs = wave_sum(xs[tid] * k2 * rkw); if (tid == 0) misc[0] = bs;
        }
        lds_barrier();
        { const float av = avs[k], bv = bvs[k], dk = dec[k], kk2 = k2s[k], rr = rrs[k];
#pragma unroll
            for (int j = 0; j < 8; ++j) { const int vi = vq * 8 + j; const float sa = wave_sum(S[j] * av); S[j] = S[j] * dk + sa * bv + vvs[vi] * kk2; const float yy = wave_sum(S[j] * rr); if (k == 0) ys[vi] = yy; } }
        lds_barrier();
        if (tid < 64) { const float y = ys[tid]; const float mean = wave_sum(y) * (1.f / 64.f); const float d = y - mean; const float var = wave_sum(d * d) * (1.f / 64.f);
            const float yn = d * rsqrtf(var + 64e-5f) * lnw + lnb; const float o = (yn + misc[0] * vvs[tid]) * ggs[tid];
            YBR[row * YLD + 2048 + h * 64 + tid] = (bf16_t)f2bf(o); }
        lds_barrier();
    }
#pragma unroll
    for (int j = 0; j < 8; ++j) os[(size_t)(vq * 8 + j) * 64 + k] = S[j];
    if (tid < 192 || (h == 0 && tid < 448)) osh[cidx] = prev;
    lds_barrier();
}


__device__ __forceinline__ void rwkv_unit4(const Ctx& c0, int l, int s0, int h, int& cached_h) {
    Ctx c = c0; c.lane = hw_lane(); c.tid = c.wave * 64 + c.lane;
    const int tid = c.tid, k = tid & 63, vq = tid >> 6;
    const bf16_t* PROJ = (const bf16_t*)(c.ws + WS_PROJ); bf16_t* YBR = (bf16_t*)(c.ws + WS_YBR);
    LAS float* sm = (LAS float*)c.lds;
    LAS float* W = sm  , *xs = sm + 16384  , *partl = sm + 18176  , *vec = sm + 20224  , *misc = sm + 22272  ;
    const size_t u0 = ((size_t)l * NB + s0) * HC + h;
    float S[4][8];
    { const float* si = inp(c, I_SRS) + u0 * DHC * DHC;
#pragma unroll
      for (int q = 0; q < 4; ++q)
#pragma unroll
        for (int j = 0; j < 8; ++j) S[q][j] = si[(size_t)q * HC * DHC * DHC + (size_t)(vq * 8 + j) * 64 + k]; }
    if (cached_h != h) { cached_h = h; const float* w2p = inp(c, I_W2) + (size_t)l * 64 * 1024 + h * 64; const float* a2p = inp(c, I_A2) + (size_t)l * 64 * 1024 + h * 64; const float* g2p = inp(c, I_G2) + (size_t)l * 128 * 1024 + h * 64;
      float lw2[8], la2[8], lg2[16];
#pragma unroll
      for (int kk = 0; kk < 8; ++kk) { const int i = tid + kk * NTHR; lw2[kk] = w2p[(i >> 6) * 1024 + (i & 63)]; la2[kk] = a2p[(i >> 6) * 1024 + (i & 63)]; }
#pragma unroll
      for (int kk = 0; kk < 16; ++kk) { const int i = tid + kk * NTHR; lg2[kk] = g2p[(i >> 6) * 1024 + (i & 63)]; }
#pragma unroll
      for (int kk = 0; kk < 8; ++kk) { const int i = tid + kk * NTHR; W[i] = lw2[kk]; W[4096 + i] = la2[kk]; }
#pragma unroll
      for (int kk = 0; kk < 16; ++kk) { const int i = tid + kk * NTHR; W[8192 + i] = lg2[kk]; } }
    int cidx = 0;
    if (tid < 64) cidx = h * 64 + tid; else if (tid < 128) cidx = 1024 + h * 64 + (tid - 64); else if (tid < 192) cidx = 2048 + h * 64 + (tid - 128); else if (tid < 448) cidx = 3072 + (tid - 192);
    const int C = h * 64 + k;
    float w0 = 0.f, a0 = 0.f, kkw = 0.f, kaw = 0.f, rkw = 0.f, lnw = 0.f, lnb = 0.f;
    if (tid < 256) { w0 = inp(c, I_W0)[l * 1024 + C]; a0 = inp(c, I_A0)[l * 1024 + C]; kkw = inp(c, I_KK)[l * 1024 + C]; kaw = inp(c, I_KA)[l * 1024 + C]; rkw = inp(c, I_RK)[l * 1024 + C];
        lnw = inp(c, I_LNW)[l * 1024 + C]; lnb = inp(c, I_LNB)[l * 1024 + C]; }
    if (tid < 448) { const float mu = inp(c, I_MU)[(size_t)l * NCC + cidx]; const float* shin = inp(c, I_SRSH) + ((size_t)l * NB + s0) * NCC + cidx; float* osh = c.out + O_SRSH + ((size_t)l * NB + s0) * NCC + cidx;
        float prev[4], cur[4];
#pragma unroll
        for (int q = 0; q < 4; ++q) { prev[q] = shin[(size_t)q * NCC]; cur[q] = bf2f(PROJ[(size_t)(MPROMPT + s0 + q) * NPROJ + PC0 + cidx]); }
#pragma unroll
        for (int q = 0; q < 4; ++q) { float xm = cur[q] + (prev[q] - cur[q]) * mu;
            if (tid >= 192 && tid < 256) xm = ftanh(xm); else if (tid >= 320) xm = sigmoidf_(xm);
            xs[q * 448 + tid] = xm;
            if (tid < 192 || h == 0) osh[(size_t)q * NCC] = cur[q]; } }
    lds_barrier();
    { const int pt = vq; float a[4] = {0.f, 0.f, 0.f, 0.f};
        const LAS float* wp = W + (pt * 32) * 64 + k; const LAS float* xp = xs + 192 + pt * 32;
#pragma unroll 8
        for (int j = 0; j < 32; ++j) { const float wv = wp[j * 64];
#pragma unroll
            for (int q = 0; q < 4; ++q) a[q] += xp[q * 448 + j] * wv; }
#pragma unroll
        for (int q = 0; q < 4; ++q) partl[q * 512 + pt * 64 + k] = a[q]; }
    lds_barrier();
    if (tid < 256) { const int q = vq; const LAS float* pl = partl + q * 512; const LAS float* x = xs + q * 448; LAS float* vv = vec + q * 512;
        const float wl = w0 + pl[k] + pl[64 + k]; const float wlog = -softplusf_(-wl) - 0.5f; const float dc = __expf(-__expf(wlog));
        const float aa = sigmoidf_(a0 + pl[128 + k] + pl[192 + k]);
        const float gg = (pl[256 + k] + pl[320 + k]) + (pl[384 + k] + pl[448 + k]);
        const float kraw = x[64 + k], kkv = kraw * kkw; const float nrm = wave_sum(kkv * kkv); const float kk = kkv * rsqrtf(nrm + 1e-12f);
        const float k2 = kraw * (1.f + (aa - 1.f) * kaw);
        vv[k] = dc; vv[64 + k] = k2; vv[128 + k] = -kk; vv[192 + k] = kk * aa; vv[256 + k] = x[k]; vv[320 + k] = x[128 + k]; vv[384 + k] = gg;
        const float bs = wave_sum(x[k] * k2 * rkw); if (k == 0) misc[q] = bs; }
    lds_barrier();
#pragma unroll
    for (int q = 0; q < 4; ++q) { const LAS float* vv = vec + q * 512; const float dk = vv[k], kk2 = vv[64 + k], av = vv[128 + k], bv = vv[192 + k], rr = vv[256 + k];
#pragma unroll
        for (int j = 0; j < 8; ++j) { const int vi = vq * 8 + j; const float sa = wave_sum(S[q][j] * av); S[q][j] = S[q][j] * dk + sa * bv + vv[320 + vi] * kk2; const float yy = wave_sum(S[q][j] * rr); if (k == 0) vec[q * 512 + 448 + vi] = yy; } }
    lds_barrier();
    if (tid < 256) { const int q = vq; const LAS float* vv = vec + q * 512; const float y = vv[448 + k]; const float mean = wave_sum(y) * (1.f / 64.f); const float d = y - mean; const float var = wave_sum(d * d) * (1.f / 64.f);
        const float yn = d * rsqrtf(var + 64e-5f) * lnw + lnb; const float o = (yn + misc[q] * vv[320 + k]) * vv[384 + k];
        YBR[(size_t)(MPROMPT + s0 + q) * YLD + 2048 + h * 64 + k] = (bf16_t)f2bf(o); }
    { float* os = c.out + O_SRS + u0 * DHC * DHC;
#pragma unroll
      for (int q = 0; q < 4; ++q)
#pragma unroll
        for (int j = 0; j < 8; ++j) os[(size_t)q * HC * DHC * DHC + (size_t)(vq * 8 + j) * 64 + k] = S[q][j]; }
    lds_barrier();
}

__device__ __forceinline__ f32x4 mfma16(bf16x8 a, bf16x8 b, f32x4 c) { return __builtin_amdgcn_mfma_f32_16x16x32_bf16(a, b, c, 0, 0, 0); }
__device__ __forceinline__ bf16x8 ldfrag(const LAS bf16_t* X, int ld, int r0, int k0, int lane) { return *(const LAS bf16x8*)(X + (r0 + (lane & 15)) * ld + k0 + ((lane >> 4) << 3)); }
template <int MT, int NT, int KS>
__device__ __forceinline__ void mma_lds(f32x4 (&acc)[MT][NT], const LAS bf16_t* A, int lda, int m0, const LAS bf16_t* Bt, int ldb, int n0, int lane) {
#pragma unroll
    for (int ks = 0; ks < KS; ++ks) {
        bf16x8 a[MT], b[NT];
#pragma unroll
        for (int i = 0; i < MT; ++i) a[i] = ldfrag(A, lda, m0 + 16 * i, 32 * ks, lane);
#pragma unroll
        for (int j = 0; j < NT; ++j) b[j] = ldfrag(Bt, ldb, n0 + 16 * j, 32 * ks, lane);
#pragma unroll
        for (int i = 0; i < MT; ++i)
#pragma unroll
            for (int j = 0; j < NT; ++j) acc[i][j] = mfma16(a[i], b[j], acc[i][j]);
    }
}
__device__ __forceinline__ float wave_incl_sum(float x, int lane) { (void)lane; return wave_scan_sum(x); }
__device__ __forceinline__ float wave_incl_max(float x, int lane) { (void)lane; const float NI = -__builtin_huge_valf();
    x = fmaxf(x, dpp_mov<0x111, 0xf>(NI, x)); x = fmaxf(x, dpp_mov<0x112, 0xf>(NI, x)); x = fmaxf(x, dpp_mov<0x114, 0xf>(NI, x)); x = fmaxf(x, dpp_mov<0x118, 0xf>(NI, x));
    x = fmaxf(x, dpp_mov<0x142, 0xa>(NI, x)); x = fmaxf(x, dpp_mov<0x143, 0xc>(NI, x));
    return x;
}
__device__ __forceinline__ void chunk_range(int c, int& t0, int& Lv) { if (c == 0) { t0 = 0; Lv = NMETA; } else { t0 = NMETA + 64 * (c - 1); Lv = 64; } }

__device__ __forceinline__ void mlstm_prep_unit(const Ctx& c, int l, int u) {
    int w = c.wave; asm volatile("" : "+s"(w)); const int lane = hw_lane(), tid = w * 64 + lane;
    const int cch = u % NCH, bh = u / NCH, h = bh % HA, b = bh / HA;
    int t0, Lv; chunk_range(cch, t0, Lv);
    const size_t row0 = (size_t)b * TP + t0;
    const bf16_t* PROJ = (const bf16_t*)(c.ws + WS_PROJ); const float* SG = (const float*)(c.ws + WS_SG);
    LAS bf16_t* Qs = (LAS bf16_t*)c.lds; LAS bf16_t* Ks = Qs + 64 * 264; LAS bf16_t* VTs = Ks + 64 * 264; LAS bf16_t* Ss = VTs + 256 * 72;
    LAS float* ga = (LAS float*)(Ss + 64 * 72); LAS float* gcm = ga + 64, *gb = ga + 128, *gwk = ga + 192, *dpart = ga + 256  ;
    bf16_t* gKTw = (bf16_t*)(c.ws + WS_ML_KTW) + (size_t)u * 256 * 64; bf16_t* gVT = (bf16_t*)(c.ws + WS_ML_VT) + (size_t)u * 256 * 64;
    float* gNP = (float*)(c.ws + WS_ML_NP) + (size_t)u * 64 * 256; float* gSC = (float*)(c.ws + WS_ML_SC) + (size_t)u * 256;
    if (w == 0) {
        float li = -1e30f, lf = 0.f;
        if (lane < Lv) { li = SG[(row0 + lane) * SGLD + h] + inp(c, I_BI)[l * HA + h]; lf = -softplusf_(-(SG[(row0 + lane) * SGLD + 4 + h] + inp(c, I_BF)[l * HA + h])); }
        const float bb = wave_incl_sum(lf, lane); const float a = li - bb; const float cm = wave_incl_max(a, lane);
        const float cml = lane_bcast(cm, 63);
        ga[lane] = a; gcm[lane] = cm; gb[lane] = bb; gwk[lane] = __expf(a - cml);
        gSC[lane] = bb; gSC[64 + lane] = cm;
    }
    { u32x4 q4[4], k4[4], v4[4];
#pragma unroll
      for (int k = 0; k < 4; ++k) { const int i = tid + k * NTHR; const int r = i >> 5, c8 = i & 31, rv = i & 63, cv = i >> 6;
          q4[k] = (u32x4){0u, 0u, 0u, 0u}; k4[k] = q4[k]; v4[k] = q4[k];
          if (r < Lv) { const bf16_t* pr = PROJ + (row0 + r) * NPROJ + h * 256 + c8 * 8; q4[k] = *(const u32x4*)(pr + PA_Q); k4[k] = *(const u32x4*)(pr + PA_K); }
          if (rv < Lv) v4[k] = *(const u32x4*)(PROJ + (row0 + rv) * NPROJ + PA_V + h * 256 + cv * 8); }
#pragma unroll
      for (int k = 0; k < 4; ++k) { const int i = tid + k * NTHR; const int r = i >> 5, c8 = i & 31, rv = i & 63, cv = i >> 6;
          *(LAS u32x4*)(Qs + r * 264 + c8 * 8) = q4[k]; *(LAS u32x4*)(Ks + r * 264 + c8 * 8) = k4[k];
          LAS bf16_t* d = VTs + (cv * 8) * 72 + rv; const u32x4 v = v4[k];
          d[0] = (bf16_t)(v.x & 0xffffu); d[72] = (bf16_t)(v.x >> 16); d[144] = (bf16_t)(v.y & 0xffffu); d[216] = (bf16_t)(v.y >> 16);
          d[288] = (bf16_t)(v.z & 0xffffu); d[360] = (bf16_t)(v.z >> 16); d[432] = (bf16_t)(v.w & 0xffffu); d[504] = (bf16_t)(v.w >> 16); } }
    lds_barrier();
    { const int mt = w & 3, nh = w >> 2;
      f32x4 acc[1][2]; acc[0][0] = (f32x4){0.f, 0.f, 0.f, 0.f}; acc[0][1] = acc[0][0];
      mma_lds<1, 2, 8>(acc, Qs, 264, 16 * mt, Ks, 264, 32 * nh, lane);
      float rs[4] = {0.f, 0.f, 0.f, 0.f};
#pragma unroll
      for (int j = 0; j < 2; ++j) { const int sidx = 32 * nh + 16 * j + (lane & 15); const float as = ga[sidx];
#pragma unroll
          for (int r = 0; r < 4; ++r) { const int lidx = 16 * mt + 4 * (lane >> 4) + r;
              const float val = sidx <= lidx ? acc[0][j][r] * 0.0625f * __expf(as - gcm[lidx]) : 0.f;
              rs[r] += val; Ss[lidx * 72 + sidx] = (bf16_t)f2bf(val); } }
#pragma unroll
      for (int r = 0; r < 4; ++r) { const float x = row16_sum(rs[r]);
          if ((lane & 15) == 0) dpart[nh * 64 + 16 * mt + 4 * (lane >> 4) + r] = x; }
    }
    for (int i = tid; i < 256 * 8; i += NTHR) { const int r = i >> 3, c8 = i & 7; *(u32x4*)(gVT + r * 64 + c8 * 8) = *(const LAS u32x4*)(VTs + r * 72 + c8 * 8); }
    for (int i = tid; i < 256 * 8; i += NTHR) { const int k = i & 255, c8 = i >> 8; u32x4 o; float x[8];
#pragma unroll
        for (int e = 0; e < 8; ++e) x[e] = bf2f(Ks[(c8 * 8 + e) * 264 + k]) * 0.0625f * gwk[c8 * 8 + e];
        o.x = pk2(x[0], x[1]); o.y = pk2(x[2], x[3]); o.z = pk2(x[4], x[5]); o.w = pk2(x[6], x[7]);
        *(u32x4*)(gKTw + k * 64 + c8 * 8) = o; }
    lds_barrier();
    if (tid < 64) gSC[128 + tid] = dpart[tid] + dpart[64 + tid];
    { f32x4 acc[2][4];
#pragma unroll
      for (int i = 0; i < 2; ++i)
#pragma unroll
          for (int j = 0; j < 4; ++j) acc[i][j] = (f32x4){0.f, 0.f, 0.f, 0.f};
      mma_lds<2, 4, 2>(acc, VTs, 72, 32 * w, Ss, 72, 0, lane);
#pragma unroll
      for (int i = 0; i < 2; ++i)
#pragma unroll
          for (int j = 0; j < 4; ++j) { const int v0 = 32 * w + 16 * i + 4 * (lane >> 4), lidx = 16 * j + (lane & 15); *(f32x4*)(gNP + lidx * 256 + v0) = acc[i][j]; }
    }
    lds_barrier();
}

__device__ __forceinline__ void mlstm_seq_unit(const Ctx& c, int l, int b, int h, int vs) {
    int w = c.wave; asm volatile("" : "+s"(w)); const int lane = hw_lane(), tid = w * 64 + lane;
    const bf16_t* PROJ = (const bf16_t*)(c.ws + WS_PROJ);
    LAS bf16_t* Qs = (LAS bf16_t*)c.lds; LAS bf16_t* KTw = Qs + 64 * 264; LAS bf16_t* VTs = KTw + 256 * 72; LAS bf16_t* CTs = VTs + 80 * 72;
    LAS float* sb = (LAS float*)(CTs + 80 * 264); LAS float* scm = sb + 64, *sdp = sb + 128, *sqn = sb + 192;
    float* HAo = (float*)(c.ws + WS_HA);
    for (int i = tid; i < 80 * 264; i += NTHR) CTs[i] = 0;
    for (int i = tid; i < 16 * 72; i += NTHR) VTs[64 * 72 + i] = (i < 72) ? (bf16_t)0x3f80 : (bf16_t)0;
    f32x4 Cst[2][5];
#pragma unroll
    for (int i = 0; i < 2; ++i)
#pragma unroll
        for (int j = 0; j < 5; ++j) Cst[i][j] = (f32x4){0.f, 0.f, 0.f, 0.f};
    float m = 0.f;
    const int lt = w & 3, vh = w >> 2;
    u32x4 pq[2][4], pk[2][4], pv[2]; float psc[2] = {0.f, 0.f}; f32x4 pn[2][2];
#define ML_ISSUE(cc, S_) do { int t0_, Lv_; chunk_range((cc), t0_, Lv_); const size_t row0_ = (size_t)b * TP + t0_; const int u_ = (b * HA + h) * NCH + (cc); \
        const bf16_t* gK_ = (const bf16_t*)(c.ws + WS_ML_KTW) + (size_t)u_ * 256 * 64; const bf16_t* gV_ = (const bf16_t*)(c.ws + WS_ML_VT) + (size_t)u_ * 256 * 64 + (size_t)vs * 64 * 64; \
        const float* gN_ = (const float*)(c.ws + WS_ML_NP) + (size_t)u_ * 64 * 256; const float* gS_ = (const float*)(c.ws + WS_ML_SC) + (size_t)u_ * 256; \
        _Pragma("unroll") for (int k_ = 0; k_ < 4; ++k_) { const int i_ = tid + k_ * NTHR; const int r_ = i_ >> 5, c8_ = i_ & 31; pq[S_][k_] = (u32x4){0u, 0u, 0u, 0u}; \
            if (r_ < Lv_) pq[S_][k_] = *(const u32x4*)(PROJ + (row0_ + r_) * NPROJ + PA_Q + h * 256 + c8_ * 8); pk[S_][k_] = *(const u32x4*)(gK_ + (i_ >> 3) * 64 + (i_ & 7) * 8); } \
        pv[S_] = *(const u32x4*)(gV_ + (tid >> 3) * 64 + (tid & 7) * 8); psc[S_] = tid < 192 ? gS_[tid] : 0.f; \
        _Pragma("unroll") for (int j_ = 0; j_ < 2; ++j_) pn[S_][j_] = *(const f32x4*)(gN_ + (16 * lt + (lane & 15)) * 256 + vs * 64 + 16 * (vh + 2 * j_) + 4 * (lane >> 4)); } while (0)
#define ML_CHUNK(cch, S) do { \
        int t0, Lv; chunk_range((cch), t0, Lv); \
        const size_t row0 = (size_t)b * TP + t0; \
        _Pragma("unroll") \
        for (int k = 0; k < 4; ++k) { const int i = tid + k * NTHR; *(LAS u32x4*)(Qs + (i >> 5) * 264 + (i & 31) * 8) = pq[S][k]; *(LAS u32x4*)(KTw + (i >> 3) * 72 + (i & 7) * 8) = pk[S][k]; } \
        *(LAS u32x4*)(VTs + (tid >> 3) * 72 + (tid & 7) * 8) = pv[S]; \
        if (tid < 192) sb[tid] = psc[S]; \
        const f32x4 np0 = pn[S][0], np1 = pn[S][1]; \
        if ((cch) + 2 < NCH) ML_ISSUE((cch) + 2, S); \
        lds_barrier(); \
        f32x4 ia[3]; ia[0] = (f32x4){0.f, 0.f, 0.f, 0.f}; ia[1] = ia[0]; ia[2] = ia[0]; \
        _Pragma("unroll") \
        for (int ks = 0; ks < 8; ++ks) { const bf16x8 qf = ldfrag(Qs, 264, 16 * lt, 32 * ks, lane); \
            ia[0] = mfma16(ldfrag(CTs, 264, 16 * vh, 32 * ks, lane), qf, ia[0]); \
            ia[1] = mfma16(ldfrag(CTs, 264, 16 * (vh + 2), 32 * ks, lane), qf, ia[1]); \
            if (vh == 0) ia[2] = mfma16(ldfrag(CTs, 264, 64, 32 * ks, lane), qf, ia[2]); } \
        if (vh == 0 && lane < 16) sqn[16 * lt + lane] = ia[2][0]; \
        lds_barrier(); \
        { const int lidx = 16 * lt + (lane & 15); \
          const float cm = scm[lidx], bl = sb[lidx]; const float M = fmaxf(m, cm), rho = __expf(cm - M), sig = __expf(m - M); \
          float den = rho * sdp[lidx] + sig * sqn[lidx]; den = fmaxf(fabsf(den), __expf(-(bl + M))); const float dinv = __builtin_amdgcn_rcpf(den); \
          if (lidx < Lv) { \
        _Pragma("unroll") \
              for (int j = 0; j < 2; ++j) { const int v0 = 16 * (vh + 2 * j) + 4 * (lane >> 4); \
                  const f32x4 np = j == 0 ? np0 : np1; \
                  *(f32x4*)(HAo + (row0 + lidx) * 1024 + h * 256 + vs * 64 + v0) = (np * rho + ia[j] * sig) * dinv; } } } \
        { const float cml = scm[63], Ml = fmaxf(m, cml), dec = __expf(m - Ml), rl = __expf(cml - Ml); \
          _Pragma("unroll") for (int i = 0; i < 2; ++i) { f32x4 d2[1][5]; \
              _Pragma("unroll") for (int j = 0; j < 5; ++j) d2[0][j] = (f32x4){0.f, 0.f, 0.f, 0.f}; \
              mma_lds<1, 5, 2>(d2, KTw, 72, 32 * w + 16 * i, VTs, 72, 0, lane); \
              _Pragma("unroll") for (int j = 0; j < 5; ++j) { Cst[i][j] = Cst[i][j] * dec + d2[0][j] * rl; \
                  u32x2 o; o.x = pk2(Cst[i][j][0], Cst[i][j][1]); o.y = pk2(Cst[i][j][2], Cst[i][j][3]); \
                  *(LAS u32x2*)(CTs + (16 * j + (lane & 15)) * 264 + 32 * w + 16 * i + 4 * (lane >> 4)) = o; } } \
          m = sb[63] + Ml; } \
        lds_barrier(); \
    } while (0)
    ML_ISSUE(0, 0); ML_ISSUE(1, 1);
    lds_barrier();
    for (int cch = 0; cch + 1 < NCH; cch += 2) { ML_CHUNK(cch, 0); ML_CHUNK(cch + 1, 1); }
    ML_CHUNK(NCH - 1, 0);
#undef ML_CHUNK
#undef ML_ISSUE
    float* oc = c.out + O_PC + (((size_t)l * BATCH + b) * HA + h) * DHA * DHA; float* on = c.out + O_PN + (((size_t)l * BATCH + b) * HA + h) * DHA;
#pragma unroll
    for (int i = 0; i < 2; ++i) { const int k0 = 32 * w + 16 * i + 4 * (lane >> 4);
#pragma unroll
        for (int j = 0; j < 4; ++j)
#pragma unroll
            for (int r = 0; r < 4; ++r) oc[(size_t)(k0 + r) * 256 + vs * 64 + 16 * j + (lane & 15)] = Cst[i][j][r];
        if (vs == 0 && (lane & 15) == 0) {
#pragma unroll
            for (int r = 0; r < 4; ++r) on[k0 + r] = Cst[i][4][r]; } }
    if (vs == 0 && tid == 0) c.out[O_PM + ((size_t)l * BATCH + b) * HA + h] = m;
    lds_barrier();
}

__device__ __forceinline__ f32x4 mfma4f(float a, float b, f32x4 c) { return __builtin_amdgcn_mfma_f32_16x16x4f32(a, b, c, 0, 0, 0); }
__device__ __forceinline__ void tri_inv64(const LAS float* Am, LAS float* Tm, LAS float* Xt, int tid, int w, LAS bf16_t* Tb) {
    for (int i = tid; i < 64 * 65; i += NTHR) Tm[i] = 0.f;
    for (int i = tid; i < 64 * 36; i += NTHR) ((LAS unsigned*)Tb)[i] = 0u;
    lds_barrier();
    if (tid < 64) { const int base = (tid >> 3) * 8, cc = tid & 7; float x[8];
#pragma unroll
        for (int r = 0; r < 8; ++r) { float a = 0.f;
#pragma unroll
            for (int j = 0; j < r; ++j) a += Am[(base + r) * 65 + base + j] * x[j];
            x[r] = (r == cc) ? 1.f : (r < cc ? 0.f : -a); }
#pragma unroll
        for (int r = 0; r < 8; ++r) { Tm[(base + r) * 65 + base + cc] = x[r]; Tb[(base + r) * 72 + base + cc] = (bf16_t)f2bf(x[r]); } }
    lds_barrier();
    const int lane = tid & 63, li = lane & 15, lk = lane >> 4;
    if (w < 2) {
        const int bi = 32 * w + (li < 8 ? 0 : 16), l7 = li & 7; LAS float* X = Xt + w * 512;
        f32x4 x = {0.f, 0.f, 0.f, 0.f};
#pragma unroll
        for (int ks = 0; ks < 2; ++ks) x = mfma4f(Am[(bi + 8 + l7) * 65 + bi + 4 * ks + lk], Tm[(bi + 4 * ks + lk) * 65 + bi + l7], x);
#pragma unroll
        for (int r = 0; r < 4; ++r) X[(4 * lk + r) * 16 + li] = x[r];
        asm volatile("s_waitcnt lgkmcnt(0)" ::: "memory");
        f32x4 y = {0.f, 0.f, 0.f, 0.f};
#pragma unroll
        for (int ks = 0; ks < 2; ++ks) y = mfma4f(Tm[(bi + 8 + l7) * 65 + bi + 8 + 4 * ks + lk], X[(4 * ks + lk + (li < 8 ? 0 : 8)) * 16 + li], y);
        if ((lk < 2) == (li < 8)) {
#pragma unroll
            for (int r = 0; r < 4; ++r) { const int rr = bi + 8 + ((4 * lk + r) & 7); Tm[rr * 65 + bi + l7] = -y[r]; Tb[rr * 72 + bi + l7] = (bf16_t)f2bf(-y[r]); } } }
    lds_barrier();
    if (w < 2) { const int lb = 32 * w, hb = lb + 16; LAS float* X = Xt + w * 512;
        f32x4 x = {0.f, 0.f, 0.f, 0.f};
#pragma unroll
        for (int ks = 0; ks < 4; ++ks) x = mfma4f(Am[(hb + li) * 65 + lb + 4 * ks + lk], Tm[(lb + 4 * ks + lk) * 65 + lb + li], x);
#pragma unroll
        for (int r = 0; r < 4; ++r) X[(4 * lk + r) * 16 + li] = x[r];
        asm volatile("s_waitcnt lgkmcnt(0)" ::: "memory");
        f32x4 y = {0.f, 0.f, 0.f, 0.f};
#pragma unroll
        for (int ks = 0; ks < 4; ++ks) y = mfma4f(Tm[(hb + li) * 65 + hb + 4 * ks + lk], X[(4 * ks + lk) * 16 + li], y);
#pragma unroll
        for (int r = 0; r < 4; ++r) { Tm[(hb + 4 * lk + r) * 65 + lb + li] = -y[r]; Tb[(hb + 4 * lk + r) * 72 + lb + li] = (bf16_t)f2bf(-y[r]); } }
    lds_barrier();
    if (w < 2) { LAS float* X = Xt + w * 512;
        f32x4 x0 = {0.f, 0.f, 0.f, 0.f}, x1 = x0;
#pragma unroll
        for (int ks = 0; ks < 8; ++ks) { const float bb = Tm[(4 * ks + lk) * 65 + 16 * w + li];
            x0 = mfma4f(Am[(32 + li) * 65 + 4 * ks + lk], bb, x0); x1 = mfma4f(Am[(48 + li) * 65 + 4 * ks + lk], bb, x1); }
#pragma unroll
        for (int r = 0; r < 4; ++r) { X[(4 * lk + r) * 16 + li] = x0[r]; X[(16 + 4 * lk + r) * 16 + li] = x1[r]; }
        asm volatile("s_waitcnt lgkmcnt(0)" ::: "memory");
        f32x4 y0 = {0.f, 0.f, 0.f, 0.f}, y1 = y0;
#pragma unroll
        for (int ks = 0; ks < 8; ++ks) { const float bb = X[(4 * ks + lk) * 16 + li];
            y0 = mfma4f(Tm[(32 + li) * 65 + 32 + 4 * ks + lk], bb, y0); y1 = mfma4f(Tm[(48 + li) * 65 + 32 + 4 * ks + lk], bb, y1); }
#pragma unroll
        for (int r = 0; r < 4; ++r) { Tb[(32 + 4 * lk + r) * 72 + 16 * w + li] = (bf16_t)f2bf(-y0[r]); Tb[(48 + 4 * lk + r) * 72 + 16 * w + li] = (bf16_t)f2bf(-y1[r]); } }
    lds_barrier();
}

__device__ __forceinline__ void gdn_prep_unit(const Ctx& c, int l, int u) {
    int w = c.wave; asm volatile("" : "+s"(w)); const int lane = hw_lane(), tid = w * 64 + lane;
    const int cch = u % NCH, bh = u / NCH, h = bh % HB, b = bh / HB;
    int t0, Lv; chunk_range(cch, t0, Lv);
    const size_t row0 = (size_t)b * TP + t0;
    const bf16_t* PROJ = (const bf16_t*)(c.ws + WS_PROJ); const float* SG = (const float*)(c.ws + WS_SG);
    LAS bf16_t* Qs = (LAS bf16_t*)c.lds; LAS bf16_t* Ks = Qs + 64 * 136; LAS bf16_t* RAW = Ks + 64 * 136; LAS bf16_t* RT = RAW; LAS bf16_t* Tb = RT + 256 * 72;
    LAS float* Am = (LAS float*)(c.lds + 86272); LAS float* Tm = Am + 64 * 65; LAS float* Xt = Tm + 64 * 65; LAS float* psq = Xt + 32 * 33; LAS float* sg = psq + 1024; LAS float* sbe = sg + 64;
    bf16_t* gW = (bf16_t*)(c.ws + WS_GD_W) + (size_t)u * 64 * 128; bf16_t* gUT = (bf16_t*)(c.ws + WS_GD_UT) + (size_t)u * 128 * 64; bf16_t* gAT = (bf16_t*)(c.ws + WS_GD_AT) + (size_t)u * 64 * 64;
    bf16_t* gQ = (bf16_t*)(c.ws + WS_GD_Q) + (size_t)u * 64 * 128; bf16_t* gKD = (bf16_t*)(c.ws + WS_GD_KD) + (size_t)u * 128 * 64; float* gSC = (float*)(c.ws + WS_GD_SC) + (size_t)u * 128;
    if (w == 0) { float ga = 0.f, be = 0.f;
        if (lane < Lv) { const float a = SG[(row0 + lane) * SGLD + 8 + h], bb = SG[(row0 + lane) * SGLD + 16 + h];
            ga = -__expf(inp(c, I_ALOG)[l * HB + h]) * softplusf_(a + inp(c, I_DTB)[l * HB + h]); be = sigmoidf_(bb); }
        const float g = wave_incl_sum(ga, lane); sg[lane] = g; sbe[lane] = be; gSC[lane] = __expf(g); if (lane == 63) gSC[64] = __expf(g); }
    { u32x4 rv[7]; float cwv[3];
#pragma unroll
      for (int k = 0; k < 3; ++k) { const int i = tid + k * NTHR; const int j = i / 384, ch = i % 384; cwv[k] = inp(c, I_CONVW)[(size_t)l * 4 * 3072 + j * 3072 + (ch >> 7) * 1024 + h * 128 + (ch & 127)]; }
#pragma unroll
      for (int k = 0; k < 7; ++k) { const int i = tid + k * NTHR; rv[k] = (u32x4){0u, 0u, 0u, 0u};
          if (i < 67 * 48) { const int rr = i / 48, c8 = i % 48, part = c8 >> 4, d8 = c8 & 15; const int tt = t0 - 3 + rr;
              if (tt >= 0 && rr - 3 < Lv) rv[k] = *(const u32x4*)(PROJ + ((size_t)b * TP + tt) * NPROJ + PB_QKV + part * 1024 + h * 128 + d8 * 8); } }
#pragma unroll
      for (int k = 0; k < 7; ++k) { const int i = tid + k * NTHR; if (i < 67 * 48) { const int rr = i / 48, c8 = i % 48; *(LAS u32x4*)(RAW + rr * 384 + c8 * 8) = rv[k]; } }
#pragma unroll
      for (int k = 0; k < 3; ++k) ((LAS float*)(c.lds + 102912))[tid + k * NTHR] = cwv[k]; }
    lds_barrier();
    const int s = lane, p = w;
    float yq[16], yk[16], yv[16];
    { const LAS float* cw = (const LAS float*)(c.lds + 102912); float sq = 0.f, sk = 0.f;
#pragma unroll
      for (int part = 0; part < 3; ++part) {
#pragma unroll
          for (int e4 = 0; e4 < 4; ++e4) { f32x4 a = (f32x4){0.f, 0.f, 0.f, 0.f};
#pragma unroll
              for (int j = 0; j < 4; ++j) { const f32x4 wv = *(const LAS f32x4*)(cw + j * 384 + part * 128 + p * 16 + e4 * 4);
                  const u32x2 rv = *(const LAS u32x2*)(RAW + (s + j) * 384 + part * 128 + p * 16 + e4 * 4);
                  a[0] += wv[0] * __uint_as_float(rv.x << 16); a[1] += wv[1] * __uint_as_float(rv.x & 0xffff0000u); a[2] += wv[2] * __uint_as_float(rv.y << 16); a[3] += wv[3] * __uint_as_float(rv.y & 0xffff0000u); }
#pragma unroll
              for (int e = 0; e < 4; ++e) { const float y = s < Lv ? siluf_(a[e]) : 0.f;
                  if (part == 0) { yq[e4 * 4 + e] = y; sq += y * y; } else if (part == 1) { yk[e4 * 4 + e] = y; sk += y * y; } else yv[e4 * 4 + e] = y; } } }
      psq[p * 64 + s] = sq; psq[512 + p * 64 + s] = sk; }
    lds_barrier();
    { float sq = 0.f, sk = 0.f;
#pragma unroll
      for (int i = 0; i < 8; ++i) { sq += psq[i * 64 + s]; sk += psq[512 + i * 64 + s]; }
      const float qn = rsqrtf(sq + 1e-12f) * 0.08838834764831845f, kn = rsqrtf(sk + 1e-12f);
      const float g = sg[s], be = sbe[s], gL = sg[63]; const float kb = kn * be * __expf(g), kd = kn * __expf(gL - g);
      u32x4 o0, o1;
      o0.x = pk2(yq[0] * qn, yq[1] * qn); o0.y = pk2(yq[2] * qn, yq[3] * qn); o0.z = pk2(yq[4] * qn, yq[5] * qn); o0.w = pk2(yq[6] * qn, yq[7] * qn);
      o1.x = pk2(yq[8] * qn, yq[9] * qn); o1.y = pk2(yq[10] * qn, yq[11] * qn); o1.z = pk2(yq[12] * qn, yq[13] * qn); o1.w = pk2(yq[14] * qn, yq[15] * qn);
      *(LAS u32x4*)(Qs + s * 136 + p * 16) = o0; *(LAS u32x4*)(Qs + s * 136 + p * 16 + 8) = o1; *(u32x4*)(gQ + s * 128 + p * 16) = o0; *(u32x4*)(gQ + s * 128 + p * 16 + 8) = o1;
      o0.x = pk2(yk[0] * kn, yk[1] * kn); o0.y = pk2(yk[2] * kn, yk[3] * kn); o0.z = pk2(yk[4] * kn, yk[5] * kn); o0.w = pk2(yk[6] * kn, yk[7] * kn);
      o1.x = pk2(yk[8] * kn, yk[9] * kn); o1.y = pk2(yk[10] * kn, yk[11] * kn); o1.z = pk2(yk[12] * kn, yk[13] * kn); o1.w = pk2(yk[14] * kn, yk[15] * kn);
      *(LAS u32x4*)(Ks + s * 136 + p * 16) = o0; *(LAS u32x4*)(Ks + s * 136 + p * 16 + 8) = o1;
#pragma unroll
      for (int e = 0; e < 16; ++e) { RT[(p * 16 + e) * 72 + s] = (bf16_t)f2bf(yv[e] * be); RT[(128 + p * 16 + e) * 72 + s] = (bf16_t)f2bf(yk[e] * kb); gKD[(p * 16 + e) * 64 + s] = (bf16_t)f2bf(yk[e] * kd); } }
    lds_barrier();
    { const int mt = w & 3, nh = w >> 2;
      f32x4 aK[2][1], aQ[2][1]; aK[0][0] = (f32x4){0.f, 0.f, 0.f, 0.f}; aK[1][0] = aK[0][0]; aQ[0][0] = aK[0][0]; aQ[1][0] = aK[0][0];
      mma_lds<2, 1, 4>(aK, Ks, 136, 32 * nh, Ks, 136, 16 * mt, lane);
      mma_lds<2, 1, 4>(aQ, Ks, 136, 32 * nh, Qs, 136, 16 * mt, lane);
      const int lidx = 16 * mt + (lane & 15); const float gl = sg[lidx], bel = sbe[lidx];
#pragma unroll
      for (int i = 0; i < 2; ++i) { const int s0 = 32 * nh + 16 * i + 4 * (lane >> 4); const f32x4 gs = *(const LAS f32x4*)(sg + s0); float q[4];
#pragma unroll
          for (int r = 0; r < 4; ++r) { const int sidx = s0 + r; const float dcy = sidx <= lidx ? __expf(gl - gs[r]) : 0.f;
              Am[lidx * 65 + sidx] = sidx < lidx ? bel * aK[i][0][r] * dcy : 0.f; q[r] = aQ[i][0][r] * dcy; }
          u32x2 o; o.x = pk2(q[0], q[1]); o.y = pk2(q[2], q[3]); *(u32x2*)(gAT + lidx * 64 + s0) = o; } }
    lds_barrier();
    tri_inv64(Am, Tm, Xt, tid, w, Tb);
    { f32x4 aU[1][4], aW[1][4];
#pragma unroll
      for (int j = 0; j < 4; ++j) { aU[0][j] = (f32x4){0.f, 0.f, 0.f, 0.f}; aW[0][j] = aU[0][j]; }
      const int mt = w & 3, vq = w >> 2;
      mma_lds<1, 4, 2>(aU, Tb, 72, 16 * mt, RT, 72, 64 * vq, lane);
      mma_lds<1, 4, 2>(aW, RT, 72, 128 + 16 * w, Tb, 72, 0, lane);
#pragma unroll
      for (int j = 0; j < 4; ++j) { u32x2 o; o.x = pk2(aU[0][j][0], aU[0][j][1]); o.y = pk2(aU[0][j][2], aU[0][j][3]);
          *(u32x2*)(gUT + (64 * vq + 16 * j + (lane & 15)) * 64 + 16 * mt + 4 * (lane >> 4)) = o;
          o.x = pk2(aW[0][j][0], aW[0][j][1]); o.y = pk2(aW[0][j][2], aW[0][j][3]);
          *(u32x2*)(gW + (16 * j + (lane & 15)) * 128 + 16 * w + 4 * (lane >> 4)) = o; } }
    lds_barrier();
}

__device__ __forceinline__ void gdn_seq_unit(const Ctx& c, int l, int b, int h) {
    int w = c.wave; asm volatile("" : "+s"(w)); const int lane = hw_lane(), tid = w * 64 + lane;
    const bf16_t* PROJ = (const bf16_t*)(c.ws + WS_PROJ); bf16_t* YBR = (bf16_t*)(c.ws + WS_YBR);
    LAS bf16_t* Qs = (LAS bf16_t*)c.lds; LAS bf16_t* Wm = Qs + 64 * 136; LAS bf16_t* UT = Wm + 64 * 136; LAS bf16_t* ATs = UT + 128 * 72; LAS bf16_t* KD = ATs + 64 * 72; LAS bf16_t* ST = KD + 128 * 72;
    LAS float* seg = (LAS float*)(ST + 128 * 136); LAS float* ssq = seg + 128; LAS float* gnws = ssq + 128;
    for (int i = tid; i < 128 * 136; i += NTHR) ST[i] = 0;
    if (tid < 128) gnws[tid] = inp(c, I_GNW)[l * DHB + tid];
    f32x4 Sst[1][8];
#pragma unroll
    for (int j = 0; j < 8; ++j) Sst[0][j] = (f32x4){0.f, 0.f, 0.f, 0.f};
    const int lt = w & 3, vq = w >> 2;
    const LAS float* gnwp = gnws + 64 * vq + 4 * (lane >> 4);
    u32x4 pQ[1][2], pW[1][2], pU[1][2], pK[1][2], pA[1]; float psc[1] = {0.f}; u32x2 pz[4];
#define GD_ISSUE(cc, S_) do { const int u_ = (b * HB + h) * NCH + (cc); \
        const bf16_t* gW_ = (const bf16_t*)(c.ws + WS_GD_W) + (size_t)u_ * 64 * 128; const bf16_t* gUT_ = (const bf16_t*)(c.ws + WS_GD_UT) + (size_t)u_ * 128 * 64; const bf16_t* gAT_ = (const bf16_t*)(c.ws + WS_GD_AT) + (size_t)u_ * 64 * 64; \
        const bf16_t* gQ_ = (const bf16_t*)(c.ws + WS_GD_Q) + (size_t)u_ * 64 * 128; const bf16_t* gKD_ = (const bf16_t*)(c.ws + WS_GD_KD) + (size_t)u_ * 128 * 64; const float* gSC_ = (const float*)(c.ws + WS_GD_SC) + (size_t)u_ * 128; \
        _Pragma("unroll") for (int k_ = 0; k_ < 2; ++k_) { const int i_ = tid + k_ * NTHR; pQ[S_][k_] = *(const u32x4*)(gQ_ + (i_ >> 4) * 128 + (i_ & 15) * 8); pW[S_][k_] = *(const u32x4*)(gW_ + (i_ >> 4) * 128 + (i_ & 15) * 8); \
            pU[S_][k_] = *(const u32x4*)(gUT_ + (i_ >> 3) * 64 + (i_ & 7) * 8); pK[S_][k_] = *(const u32x4*)(gKD_ + (i_ >> 3) * 64 + (i_ & 7) * 8); } \
        pA[S_] = *(const u32x4*)(gAT_ + (tid >> 3) * 64 + (tid & 7) * 8); psc[S_] = tid < 65 ? gSC_[tid] : 0.f; } while (0)
#define GD_ZISSUE(cc) do { int t0_, Lv_; chunk_range((cc), t0_, Lv_); const size_t row0_ = (size_t)b * TP + t0_; \
        _Pragma("unroll") for (int i_ = 0; i_ < 4; ++i_) { const int zr_ = 16 * lt + (lane & 15) < Lv_ ? 16 * lt + (lane & 15) : Lv_ - 1; pz[i_] = *(const u32x2*)(PROJ + (row0_ + zr_) * NPROJ + PB_Z + h * 128 + 64 * vq + 16 * i_ + 4 * (lane >> 4)); } } while (0)
#define GD_CHUNK(cch, S) do { \
        int t0, Lv; chunk_range((cch), t0, Lv); \
        const size_t row0 = (size_t)b * TP + t0; \
        _Pragma("unroll") \
        for (int k = 0; k < 2; ++k) { const int i = tid + k * NTHR; *(LAS u32x4*)(Qs + (i >> 4) * 136 + (i & 15) * 8) = pQ[S][k]; *(LAS u32x4*)(Wm + (i >> 4) * 136 + (i & 15) * 8) = pW[S][k]; \
            *(LAS u32x4*)(UT + (i >> 3) * 72 + (i & 7) * 8) = pU[S][k]; *(LAS u32x4*)(KD + (i >> 3) * 72 + (i & 7) * 8) = pK[S][k]; } \
        *(LAS u32x4*)(ATs + (tid >> 3) * 72 + (tid & 7) * 8) = pA[S]; \
        if (tid < 65) seg[tid] = psc[S]; \
        if ((cch) + 1 < NCH) GD_ISSUE((cch) + 1, S); \
        GD_ZISSUE(cch); \
        lds_barrier(); \
        f32x4 aq[4][1]; \
        _Pragma("unroll") for (int j = 0; j < 4; ++j) aq[j][0] = (f32x4){0.f, 0.f, 0.f, 0.f}; \
        _Pragma("unroll") for (int jh = 0; jh < 2; ++jh) { f32x4 ws_[1][2]; ws_[0][0] = (f32x4){0.f, 0.f, 0.f, 0.f}; ws_[0][1] = ws_[0][0]; \
          mma_lds<1, 2, 4>(ws_, Wm, 136, 16 * lt, ST, 136, 64 * vq + 32 * jh, lane); \
          { f32x4 (&aqh)[2][1] = *(f32x4 (*)[2][1])&aq[2 * jh]; mma_lds<2, 1, 4>(aqh, ST, 136, 64 * vq + 32 * jh, Qs, 136, 16 * lt, lane); } \
          _Pragma("unroll") for (int j2 = 0; j2 < 2; ++j2) { const int j = 2 * jh + j2; LAS u32x2* pu = (LAS u32x2*)(UT + (64 * vq + 16 * j + (lane & 15)) * 72 + 16 * lt + 4 * (lane >> 4)); const u32x2 uu = *pu; \
              u32x2 o; o.x = pk2(__uint_as_float(uu.x << 16) - ws_[0][j2][0], __uint_as_float(uu.x & 0xffff0000u) - ws_[0][j2][1]); \
              o.y = pk2(__uint_as_float(uu.y << 16) - ws_[0][j2][2], __uint_as_float(uu.y & 0xffff0000u) - ws_[0][j2][3]); *pu = o; } } \
        lds_barrier(); \
        { const int lidx = 16 * lt + (lane & 15); const float egl = seg[lidx], egL = seg[64]; \
        _Pragma("unroll") \
          for (int i = 0; i < 4; ++i) aq[i][0] = aq[i][0] * egl; \
          mma_lds<4, 1, 2>(aq, UT, 72, 64 * vq, ATs, 72, 16 * lt, lane); \
        _Pragma("unroll") \
          for (int j = 0; j < 8; ++j) Sst[0][j] = Sst[0][j] * egL; \
          mma_lds<1, 8, 2>(Sst, KD, 72, 16 * w, UT, 72, 0, lane); \
        _Pragma("unroll") \
          for (int j = 0; j < 8; ++j) { u32x2 o; o.x = pk2(Sst[0][j][0], Sst[0][j][1]); o.y = pk2(Sst[0][j][2], Sst[0][j][3]); *(LAS u32x2*)(ST + (16 * j + (lane & 15)) * 136 + 16 * w + 4 * (lane >> 4)) = o; } \
          float ss = 0.f; \
        _Pragma("unroll") \
          for (int i = 0; i < 4; ++i) ss += (aq[i][0][0] * aq[i][0][0] + aq[i][0][1] * aq[i][0][1]) + (aq[i][0][2] * aq[i][0][2] + aq[i][0][3] * aq[i][0][3]); \
          ss += __shfl_xor(ss, 16); ss += __shfl_xor(ss, 32); \
          if (lane < 16) ssq[vq * 64 + lidx] = ss; \
          lds_barrier(); \
          const float rs = rsqrtf((ssq[lidx] + ssq[64 + lidx]) * (1.f / 128.f) + 1e-6f); \
          if (lidx < Lv) { \
        _Pragma("unroll") \
              for (int i = 0; i < 4; ++i) { const int v0 = 64 * vq + 16 * i + 4 * (lane >> 4); const f32x4 gw4 = *(const LAS f32x4*)(gnwp + 16 * i); \
                  const u32x2 zz = pz[i]; \
                  u32x2 o; o.x = pk2(aq[i][0][0] * rs * gw4[0] * siluf_(__uint_as_float(zz.x << 16)), aq[i][0][1] * rs * gw4[1] * siluf_(__uint_as_float(zz.x & 0xffff0000u))); \
                  o.y = pk2(aq[i][0][2] * rs * gw4[2] * siluf_(__uint_as_float(zz.y << 16)), aq[i][0][3] * rs * gw4[3] * siluf_(__uint_as_float(zz.y & 0xffff0000u))); \
                  *(u32x2*)(YBR + (row0 + lidx) * YLD + 1024 + h * 128 + v0) = o; } } } \
        lds_barrier(); \
    } while (0)
    GD_ISSUE(0, 0);
    lds_barrier();
#pragma unroll 1
    for (int cch = 0; cch < NCH; ++cch) GD_CHUNK(cch, 0);
#undef GD_CHUNK
#undef GD_ZISSUE
#undef GD_ISSUE
    float* os = c.out + O_PGS + (((size_t)l * BATCH + b) * HB + h) * DHB * DHB;
#pragma unroll
    for (int j = 0; j < 8; ++j)
#pragma unroll
        for (int r = 0; r < 4; ++r) os[(size_t)(16 * w + 4 * (lane >> 4) + r) * 128 + 16 * j + (lane & 15)] = Sst[0][j][r];
    if (tid < 384) { const int cg = (tid >> 7) * 1024 + h * 128 + (tid & 127); float* ocv = c.out + O_PGC + ((size_t)l * BATCH + b) * 3 * 3072;
#pragma unroll
        for (int j = 0; j < 3; ++j) ocv[j * 3072 + cg] = bf2f(PROJ[((size_t)b * TP + TP - 3 + j) * NPROJ + PB_QKV + cg]); }
    __syncthreads();
}

__device__ __forceinline__ void rwkv_prep_unit(const Ctx& c, int l, int u) {
    int w = c.wave; asm volatile("" : "+s"(w)); const int lane = hw_lane(), tid = w * 64 + lane;
    const int cch = u % NCH, bh = u / NCH, h = bh % HC, b = bh / HC;
    int t0, Lv; chunk_range(cch, t0, Lv);
    const bf16_t* PROJ = (const bf16_t*)(c.ws + WS_PROJ);
    LAS bf16_t* XW = (LAS bf16_t*)c.lds; LAS bf16_t* XA = XW + 64 * 72; LAS bf16_t* XG = XA + 64 * 72; LAS bf16_t* W2T = XG + 64 * 136; LAS bf16_t* A2T = W2T + 64 * 72; LAS bf16_t* G2T = A2T + 64 * 72;
    LAS bf16_t* STG = (LAS bf16_t*)(c.lds + 73728); LAS float* LO = (LAS float*)(c.lds + 73728); LAS float* red = (LAS float*)(c.lds + 123648);
    LAS bf16_t* AR = (LAS bf16_t*)c.lds; LAS bf16_t* KB = AR + 128 * 72; LAS bf16_t* VT = KB + 128 * 72; LAS bf16_t* KhT = VT + 64 * 72; LAS bf16_t* R2T = KhT + 64 * 72;
    LAS bf16_t* AkR = (LAS bf16_t*)(c.lds + 73728); LAS float* Am = (LAS float*)(c.lds + 92160); LAS float* Tm = Am + 64 * 65; LAS float* Xt = Tm + 64 * 65; LAS bf16_t* Tb = AR;
    bf16_t* gU = (bf16_t*)(c.ws + WS_RW) + (size_t)u * RW_N * 4096;
    bf16_t* gTA = gU + RW_TA * 4096; bf16_t* gPVT = gU + RW_PVT * 4096; bf16_t* gRH = gU + RW_RH * 4096; bf16_t* gYV = gU + RW_YV * 4096;
    bf16_t* gARB = gU + RW_ARB * 4096; bf16_t* gBHT = gU + RW_BHT * 4096; bf16_t* gKVT = gU + RW_KVT * 4096; bf16_t* gV = gU + RW_V * 4096; bf16_t* gG = gU + RW_G * 4096;
    float* gSC = (float*)(c.ws + WS_RW_SC) + (size_t)u * 128;
    LAS float* PRM = (LAS float*)(c.lds + 127744);
    u32x4 st1[4], st2[5];
    { const float* w2p = inp(c, I_W2) + (size_t)l * 64 * 1024 + h * 64 + (tid >> 6) * 1024 + (tid & 63); const float* a2p = inp(c, I_A2) + (size_t)l * 64 * 1024 + h * 64 + (tid >> 6) * 1024 + (tid & 63);
      const float* g2p = inp(c, I_G2) + (size_t)l * 128 * 1024 + h * 64 + (tid >> 6) * 1024 + (tid & 63);
      float lw2[8], la2[8], lg2[16], pv_[2];
#pragma unroll
      for (int k = 0; k < 8; ++k) { lw2[k] = w2p[k * 8192]; la2[k] = a2p[k * 8192]; }
#pragma unroll
      for (int k = 0; k < 16; ++k) lg2[k] = g2p[k * 8192];
#pragma unroll
      for (int q = 0; q < 2; ++q) { const int idx = tid + q * NTHR; pv_[q] = 0.f;
          if (idx < 768) { const float* src;
              if (idx < 192) src = inp(c, I_MU) + (size_t)l * NCC + (idx >> 6) * 1024 + h * 64 + (idx & 63);
              else if (idx < 448) src = inp(c, I_MU) + (size_t)l * NCC + 3072 + (idx - 192);
              else { const int t_ = (idx - 448) >> 6, o_ = l * 1024 + h * 64 + ((idx - 448) & 63);
                  src = (t_ == 0 ? inp(c, I_W0) : t_ == 1 ? inp(c, I_A0) : t_ == 2 ? inp(c, I_KK) : t_ == 3 ? inp(c, I_KA) : inp(c, I_RK)) + o_; }
              pv_[q] = *src; } }
#pragma unroll
      for (int k = 0; k < 4; ++k) { const int i = tid + k * NTHR; st1[k] = (u32x4){0u, 0u, 0u, 0u};
          if (i < 65 * 24) { const int rr = i / 24, c8 = i % 24, part = c8 >> 3, d8 = c8 & 7; const int tt = t0 - 1 + rr;
              if (tt >= 0 && rr - 1 < Lv) st1[k] = *(const u32x4*)(PROJ + ((size_t)b * TP + tt) * NPROJ + PC0 + part * 1024 + h * 64 + d8 * 8); } }
#pragma unroll
      for (int k = 0; k < 5; ++k) { const int i = tid + k * NTHR; st2[k] = (u32x4){0u, 0u, 0u, 0u};
          if (i < 65 * 32) { const int rr = i >> 5, c8 = i & 31; const int tt = t0 - 1 + rr;
              if (tt >= 0 && rr - 1 < Lv) st2[k] = *(const u32x4*)(PROJ + ((size_t)b * TP + tt) * NPROJ + PC0 + 3072 + c8 * 8); } }
      LAS bf16_t* dw = W2T + (tid & 63) * 72 + (tid >> 6); LAS bf16_t* da = A2T + (tid & 63) * 72 + (tid >> 6); LAS bf16_t* dg = G2T + (tid & 63) * 136 + (tid >> 6);
#pragma unroll
      for (int k = 0; k < 8; ++k) { dw[8 * k] = (bf16_t)f2bf(lw2[k]); da[8 * k] = (bf16_t)f2bf(la2[k]); }
#pragma unroll
      for (int k = 0; k < 16; ++k) dg[8 * k] = (bf16_t)f2bf(lg2[k]);
#pragma unroll
      for (int q = 0; q < 2; ++q) { const int idx = tid + q * NTHR; if (idx < 768) PRM[idx] = pv_[q]; } }
    const int s = lane, p = w;
    const bool valid = s < Lv;
    float r8[8], k8[8], v8[8];
    auto mix8 = [&](const LAS bf16_t* st, int pitch, int col, int ch, float (&o)[8]) {
        const u32x4 a = *(const LAS u32x4*)(st + (s + 1) * pitch + col), bq = *(const LAS u32x4*)(st + s * pitch + col);
        const f32x4 m0 = *(const LAS f32x4*)(PRM + ch), m1 = *(const LAS f32x4*)(PRM + ch + 4);
        const unsigned aw[4] = {a.x, a.y, a.z, a.w}, bw[4] = {bq.x, bq.y, bq.z, bq.w};
#pragma unroll
        for (int e = 0; e < 4; ++e) { const float c0 = __uint_as_float(aw[e] << 16), c1 = __uint_as_float(aw[e] & 0xffff0000u), p0 = __uint_as_float(bw[e] << 16), p1 = __uint_as_float(bw[e] & 0xffff0000u);
            const float mm0 = (2 * e < 4) ? m0[2 * e] : m1[2 * e - 4], mm1 = (2 * e + 1 < 4) ? m0[2 * e + 1] : m1[2 * e + 1 - 4];
            o[2 * e] = valid ? c0 + (p0 - c0) * mm0 : 0.f; o[2 * e + 1] = valid ? c1 + (p1 - c1) * mm1 : 0.f; } };
#pragma unroll
    for (int k = 0; k < 4; ++k) { const int i = tid + k * NTHR; if (i < 65 * 24) { const int rr = i / 24, c8 = i % 24; *(LAS u32x4*)(STG + rr * 200 + (c8 >> 3) * 64 + (c8 & 7) * 8) = st1[k]; } }
    lds_barrier();
    mix8(STG, 200, p * 8, p * 8, r8); mix8(STG, 200, 64 + p * 8, 64 + p * 8, k8); mix8(STG, 200, 128 + p * 8, 128 + p * 8, v8);
#pragma unroll
    for (int e = 0; e < 8; ++e) asm volatile("" : "+v"(r8[e]), "+v"(k8[e]), "+v"(v8[e]));
    lds_barrier();
#pragma unroll
    for (int k = 0; k < 5; ++k) { const int i = tid + k * NTHR; if (i < 65 * 32) *(LAS u32x4*)(STG + (i >> 5) * 264 + (i & 31) * 8) = st2[k]; }
    lds_barrier();
    { float t8[8]; u32x4 o;
      mix8(STG, 264, p * 8, 192 + p * 8, t8);
      o.x = pk2(ftanh(t8[0]), ftanh(t8[1])); o.y = pk2(ftanh(t8[2]), ftanh(t8[3])); o.z = pk2(ftanh(t8[4]), ftanh(t8[5])); o.w = pk2(ftanh(t8[6]), ftanh(t8[7])); *(LAS u32x4*)(XW + s * 72 + p * 8) = o;
      mix8(STG, 264, 64 + p * 8, 256 + p * 8, t8);
      o.x = pk2(t8[0], t8[1]); o.y = pk2(t8[2], t8[3]); o.z = pk2(t8[4], t8[5]); o.w = pk2(t8[6], t8[7]); *(LAS u32x4*)(XA + s * 72 + p * 8) = o;
#pragma unroll
      for (int q = 0; q < 2; ++q) { mix8(STG, 264, 128 + p * 16 + q * 8, 320 + p * 16 + q * 8, t8);
          o.x = pk2(fsigmoid(t8[0]), fsigmoid(t8[1])); o.y = pk2(fsigmoid(t8[2]), fsigmoid(t8[3])); o.z = pk2(fsigmoid(t8[4]), fsigmoid(t8[5])); o.w = pk2(fsigmoid(t8[6]), fsigmoid(t8[7]));
          *(LAS u32x4*)(XG + s * 136 + p * 16 + q * 8) = o; } }
    lds_barrier();
    { const int mt = w & 3, nh = w >> 2; f32x4 a0[1][2], a1[1][2], a2[1][2];
#pragma unroll
      for (int j = 0; j < 2; ++j) { a0[0][j] = (f32x4){0.f, 0.f, 0.f, 0.f}; a1[0][j] = a0[0][j]; a2[0][j] = a0[0][j]; }
      mma_lds<1, 2, 2>(a0, XW, 72, 16 * mt, W2T, 72, 32 * nh, lane);
      mma_lds<1, 2, 2>(a1, XA, 72, 16 * mt, A2T, 72, 32 * nh, lane);
      mma_lds<1, 2, 4>(a2, XG, 136, 16 * mt, G2T, 136, 32 * nh, lane);
#pragma unroll
      for (int j = 0; j < 2; ++j)
#pragma unroll
          for (int r = 0; r < 4; ++r) { const int tok = 16 * mt + 4 * (lane >> 4) + r, cc = 32 * nh + 16 * j + (lane & 15);
              LO[tok * 65 + cc] = a0[0][j][r]; LO[4160 + tok * 65 + cc] = a1[0][j][r]; LO[8320 + tok * 65 + cc] = a2[0][j][r]; } }
    lds_barrier();
    const LAS float* pW0 = PRM + 448 + p * 8; const LAS float* pA0 = PRM + 512 + p * 8; const LAS float* pKK = PRM + 576 + p * 8; const LAS float* pKA = PRM + 640 + p * 8; const LAS float* pRK = PRM + 704 + p * 8;
    { float sq = 0.f, bn = 0.f;
#pragma unroll
      for (int e = 0; e < 8; ++e) { const int cc = p * 8 + e;
          const float et = fsigmoid(pA0[e] + LO[4160 + s * 65 + cc]);
          const float kkv = k8[e] * pKK[e]; sq += kkv * kkv;
          const float k2 = k8[e] * (1.f + (et - 1.f) * pKA[e]); bn += r8[e] * k2 * pRK[e]; }
      red[p * 64 + s] = sq; red[512 + p * 64 + s] = bn; }
    lds_barrier();
    { float sq = 0.f, bn = 0.f;
#pragma unroll
      for (int i = 0; i < 8; ++i) { sq += red[i * 64 + s]; bn += red[512 + i * 64 + s]; }
      const float kn = rsqrtf(sq + 1e-12f);
      if (p == 0) gSC[64 + s] = valid ? bn : 0.f;
#pragma unroll
      for (int e2 = 0; e2 < 4; ++e2) { float fa[2], fr[2], fk[2], fb[2], frh[2], fv[2], fg[2];
#pragma unroll
          for (int q = 0; q < 2; ++q) { const int e = 2 * e2 + q, cc = p * 8 + e;
              const float wl = pW0[e] + LO[s * 65 + cc]; const float lw = valid ? -0.6065306597126334f * fsigmoid(wl) : 0.f;
              const float et = fsigmoid(pA0[e] + LO[4160 + s * 65 + cc]);
              const float Lc = wave_incl_sum(lw, lane); const float Lex = Lc - lw; const float mid = lane_bcast(Lc, 31), LL = lane_bcast(Lc, 63);
              const float kk = k8[e] * pKK[e] * kn; const float k2 = k8[e] * (1.f + (et - 1.f) * pKA[e]);
              const float av = valid ? -kk : 0.f, bv = valid ? kk * et : 0.f, rv = valid ? r8[e] : 0.f, kv = valid ? k2 : 0.f;
              fv[q] = valid ? v8[e] : 0.f; fg[q] = valid ? LO[8320 + s * 65 + cc] : 0.f;
              fa[q] = av * __expf(Lex - mid); fr[q] = rv * __expf(Lc - mid); const float ek = __expf(mid - Lc); fk[q] = kv * ek; fb[q] = bv * ek;
              frh[q] = rv * __expf(Lc); const float eh = __expf(LL - Lc);
              if (s == 0) gSC[p * 8 + e] = __expf(LL);
              VT[(p * 8 + e) * 72 + s] = (bf16_t)f2bf(fv[q]); KhT[(p * 8 + e) * 72 + s] = (bf16_t)f2bf(kv * eh); R2T[(p * 8 + e) * 72 + s] = (bf16_t)f2bf(av * __expf(Lex));
              gBHT[(p * 8 + e) * 64 + s] = (bf16_t)f2bf(bv * eh); }
          const int co = p * 8 + 2 * e2;
          *(LAS unsigned*)(AR + s * 72 + co) = pk2(fa[0], fa[1]); *(LAS unsigned*)(AR + (64 + s) * 72 + co) = pk2(fr[0], fr[1]);
          *(LAS unsigned*)(KB + s * 72 + co) = pk2(fk[0], fk[1]); *(LAS unsigned*)(KB + (64 + s) * 72 + co) = pk2(fb[0], fb[1]);
          *(unsigned*)(gRH + s * 64 + co) = pk2(frh[0], frh[1]); *(unsigned*)(gV + s * 64 + co) = pk2(fv[0], fv[1]); *(unsigned*)(gG + s * 64 + co) = pk2(fg[0], fg[1]);
          asm volatile("" ::: "memory"); } }
    lds_barrier();
    { f32x4 acc[8][1];
#pragma unroll
      for (int j = 0; j < 8; ++j) acc[j][0] = (f32x4){0.f, 0.f, 0.f, 0.f};
      mma_lds<8, 1, 2>(acc, KB, 72, 0, AR, 72, 16 * w, lane);
      const int t = 16 * (w & 3) + (lane & 15);
#pragma unroll
      for (int j = 0; j < 8; ++j) { const int s0 = 16 * (j & 3) + 4 * (lane >> 4); float x[4];
#pragma unroll
          for (int r = 0; r < 4; ++r) x[r] = (w < 4 ? s0 + r < t : s0 + r <= t) ? acc[j][0][r] : 0.f;
          if (j < 4) { u32x2 o; o.x = pk2(x[0], x[1]); o.y = pk2(x[2], x[3]); *(LAS u32x2*)(AkR + ((w < 4 ? 0 : 64) + t) * 72 + s0) = o; }
          else if (w < 4) {
#pragma unroll
              for (int r = 0; r < 4; ++r) Am[t * 65 + s0 + r] = -x[r]; }
          else { u32x2 o; o.x = pk2(x[0], x[1]); o.y = pk2(x[2], x[3]); *(u32x2*)(gARB + t * 64 + s0) = o; } } }
    lds_barrier();
    tri_inv64(Am, Tm, Xt, tid, w, Tb);
    { const int mt = w & 3, nh = w >> 2; f32x4 av[1][2], yv[1][2], kv[1][2];
#pragma unroll
      for (int j = 0; j < 2; ++j) { av[0][j] = (f32x4){0.f, 0.f, 0.f, 0.f}; yv[0][j] = av[0][j]; kv[0][j] = av[0][j]; }
      mma_lds<1, 2, 2>(av, AkR, 72, 16 * mt, VT, 72, 32 * nh, lane);
      mma_lds<1, 2, 2>(yv, VT, 72, 16 * mt, AkR, 72, 64 + 32 * nh, lane);
      mma_lds<1, 2, 2>(kv, KhT, 72, 16 * mt, VT, 72, 32 * nh, lane);
#pragma unroll
      for (int j = 0; j < 2; ++j) { u32x2 o; const int cj = 32 * nh + 16 * j + (lane & 15), r0 = 16 * mt + 4 * (lane >> 4);
          o.x = pk2(av[0][j][0], av[0][j][1]); o.y = pk2(av[0][j][2], av[0][j][3]); *(LAS u32x2*)(R2T + (64 + cj) * 72 + r0) = o;
          o.x = pk2(yv[0][j][0], yv[0][j][1]); o.y = pk2(yv[0][j][2], yv[0][j][3]); *(u32x2*)(gYV + cj * 64 + r0) = o;
          o.x = pk2(kv[0][j][0], kv[0][j][1]); o.y = pk2(kv[0][j][2], kv[0][j][3]); *(u32x2*)(gKVT + cj * 64 + r0) = o; } }
    lds_barrier();
    { const int mt = w & 3, nh = w >> 2; f32x4 ta[1][2], pv[1][2];
#pragma unroll
      for (int j = 0; j < 2; ++j) { ta[0][j] = (f32x4){0.f, 0.f, 0.f, 0.f}; pv[0][j] = ta[0][j]; }
      mma_lds<1, 2, 2>(ta, R2T, 72, 16 * mt, Tb, 72, 32 * nh, lane);
      mma_lds<1, 2, 2>(pv, Tb, 72, 16 * mt, R2T, 72, 64 + 32 * nh, lane);
#pragma unroll
      for (int j = 0; j < 2; ++j) { u32x2 o; const int cj = 32 * nh + 16 * j + (lane & 15), r0 = 16 * mt + 4 * (lane >> 4);
          o.x = pk2(ta[0][j][0], ta[0][j][1]); o.y = pk2(ta[0][j][2], ta[0][j][3]); *(u32x2*)(gTA + cj * 64 + r0) = o;
          o.x = pk2(pv[0][j][0], pv[0][j][1]); o.y = pk2(pv[0][j][2], pv[0][j][3]); *(u32x2*)(gPVT + cj * 64 + r0) = o; } }
    lds_barrier();
}

__device__ __forceinline__ void rwkv_seq_unit(const Ctx& c, int l, int b, int h) {
    int w = c.wave; asm volatile("" : "+s"(w)); const int lane = hw_lane(), tid = w * 64 + lane;
    bf16_t* YBR = (bf16_t*)(c.ws + WS_YBR); const bf16_t* PROJ = (const bf16_t*)(c.ws + WS_PROJ);
    LAS bf16_t* TA = (LAS bf16_t*)c.lds; LAS bf16_t* RH = TA + 64 * 72; LAS bf16_t* ARB = RH + 64 * 72; LAS bf16_t* BHT = ARB + 64 * 72; LAS bf16_t* HT = BHT + 64 * 72; LAS bf16_t* PT = HT + 64 * 72;
    LAS float* ssc = (LAS float*)(PT + 64 * 72); LAS float* rsum = ssc + 128; LAS float* rsq = rsum + 128;
    for (int i = tid; i < 64 * 72; i += NTHR) HT[i] = 0;
    const int kt = w & 3, vh = w >> 2;
    f32x4 Hst[1][2]; Hst[0][0] = (f32x4){0.f, 0.f, 0.f, 0.f}; Hst[0][1] = Hst[0][0];
    f32x4 lnw[2], lnb[2];
#pragma unroll
    for (int i = 0; i < 2; ++i) { lnw[i] = *(const f32x4*)(inp(c, I_LNW) + l * 1024 + h * 64 + 32 * vh + 16 * i + 4 * (lane >> 4)); lnb[i] = *(const f32x4*)(inp(c, I_LNB) + l * 1024 + h * 64 + 32 * vh + 16 * i + 4 * (lane >> 4)); }
    u32x4 pT[3], pR[3], pAB[3], pBH[3]; float psc[3] = {0.f, 0.f, 0.f}; u32x2 pPV[3][2], pYV[3][2], pKV[3][2], pVV[3][2], pGG[3][2];
#define RW_ISSUE(cc, S_) do { const int u_ = (b * HC + h) * NCH + (cc); const bf16_t* gU_ = (const bf16_t*)(c.ws + WS_RW) + (size_t)u_ * RW_N * 4096; const float* gSC_ = (const float*)(c.ws + WS_RW_SC) + (size_t)u_ * 128; \
        const int o_ = (tid >> 3) * 64 + (tid & 7) * 8; pT[S_] = *(const u32x4*)(gU_ + RW_TA * 4096 + o_); pR[S_] = *(const u32x4*)(gU_ + RW_RH * 4096 + o_); pAB[S_] = *(const u32x4*)(gU_ + RW_ARB * 4096 + o_); pBH[S_] = *(const u32x4*)(gU_ + RW_BHT * 4096 + o_); \
        psc[S_] = tid < 128 ? gSC_[tid] : 0.f; \
        _Pragma("unroll") for (int j_ = 0; j_ < 2; ++j_) { const int dv_ = 32 * vh + 16 * j_ + (lane & 15), q4_ = 16 * kt + 4 * (lane >> 4); const int tc_ = 16 * kt + (lane & 15), dv0_ = 32 * vh + 16 * j_ + 4 * (lane >> 4); \
            pPV[S_][j_] = *(const u32x2*)(gU_ + RW_PVT * 4096 + dv_ * 64 + q4_); pKV[S_][j_] = *(const u32x2*)(gU_ + RW_KVT * 4096 + dv_ * 64 + q4_); \
            pYV[S_][j_] = *(const u32x2*)(gU_ + RW_YV * 4096 + tc_ * 64 + dv0_); pVV[S_][j_] = *(const u32x2*)(gU_ + RW_V * 4096 + tc_ * 64 + dv0_); pGG[S_][j_] = *(const u32x2*)(gU_ + RW_G * 4096 + tc_ * 64 + dv0_); } } while (0)
#define RW_CHUNK(cch, S) do { \
        int t0, Lv; chunk_range((cch), t0, Lv); \
        const size_t row0 = (size_t)b * TP + t0; \
        { const int o = (tid >> 3) * 72 + (tid & 7) * 8; *(LAS u32x4*)(TA + o) = pT[S]; *(LAS u32x4*)(RH + o) = pR[S]; *(LAS u32x4*)(ARB + o) = pAB[S]; *(LAS u32x4*)(BHT + o) = pBH[S]; } \
        if (tid < 128) ssc[tid] = psc[S]; \
        const u32x2 cPV0 = pPV[S][0], cPV1 = pPV[S][1], cYV0 = pYV[S][0], cYV1 = pYV[S][1], cKV0 = pKV[S][0], cKV1 = pKV[S][1], cVV0 = pVV[S][0], cVV1 = pVV[S][1], cGG0 = pGG[S][0], cGG1 = pGG[S][1]; \
        if ((cch) + 3 < NCH) RW_ISSUE((cch) + 3, S); \
        lds_barrier(); \
        f32x4 ay[2][1]; \
        { f32x4 ap[1][2]; ap[0][0] = (f32x4){0.f, 0.f, 0.f, 0.f}; ap[0][1] = ap[0][0]; ay[0][0] = ap[0][0]; ay[1][0] = ap[0][0]; \
          mma_lds<1, 2, 2>(ap, TA, 72, 16 * kt, HT, 72, 32 * vh, lane); \
          mma_lds<2, 1, 2>(ay, HT, 72, 32 * vh, RH, 72, 16 * kt, lane); \
        _Pragma("unroll") \
          for (int j = 0; j < 2; ++j) { const int dv = 32 * vh + 16 * j + (lane & 15), tq = 16 * kt + 4 * (lane >> 4); const u32x2 pv = j == 0 ? cPV0 : cPV1; \
              u32x2 o; o.x = pk2(ap[0][j][0] + __uint_as_float(pv.x << 16), ap[0][j][1] + __uint_as_float(pv.x & 0xffff0000u)); o.y = pk2(ap[0][j][2] + __uint_as_float(pv.y << 16), ap[0][j][3] + __uint_as_float(pv.y & 0xffff0000u)); \
              *(LAS u32x2*)(PT + dv * 72 + tq) = o; } \
        _Pragma("unroll") \
          for (int i = 0; i < 2; ++i) { const int tcol = 16 * kt + (lane & 15), dv0 = 32 * vh + 16 * i + 4 * (lane >> 4); const u32x2 yv = i == 0 ? cYV0 : cYV1; \
              ay[i][0][0] += __uint_as_float(yv.x << 16); ay[i][0][1] += __uint_as_float(yv.x & 0xffff0000u); ay[i][0][2] += __uint_as_float(yv.y << 16); ay[i][0][3] += __uint_as_float(yv.y & 0xffff0000u); } } \
        lds_barrier(); \
        { mma_lds<2, 1, 2>(ay, PT, 72, 32 * vh, ARB, 72, 16 * kt, lane); \
        _Pragma("unroll") \
          for (int j = 0; j < 2; ++j) { const int dv = 32 * vh + 16 * j + (lane & 15), dk0 = 16 * kt + 4 * (lane >> 4); const u32x2 kv = j == 0 ? cKV0 : cKV1; \
              Hst[0][j][0] = Hst[0][j][0] * ssc[dk0] + __uint_as_float(kv.x << 16); Hst[0][j][1] = Hst[0][j][1] * ssc[dk0 + 1] + __uint_as_float(kv.x & 0xffff0000u); \
              Hst[0][j][2] = Hst[0][j][2] * ssc[dk0 + 2] + __uint_as_float(kv.y << 16); Hst[0][j][3] = Hst[0][j][3] * ssc[dk0 + 3] + __uint_as_float(kv.y & 0xffff0000u); } \
          mma_lds<1, 2, 2>(Hst, BHT, 72, 16 * kt, PT, 72, 32 * vh, lane); \
        _Pragma("unroll") \
          for (int j = 0; j < 2; ++j) { u32x2 o; o.x = pk2(Hst[0][j][0], Hst[0][j][1]); o.y = pk2(Hst[0][j][2], Hst[0][j][3]); *(LAS u32x2*)(HT + (32 * vh + 16 * j + (lane & 15)) * 72 + 16 * kt + 4 * (lane >> 4)) = o; } \
          const int tcol = 16 * kt + (lane & 15); \
          float sm = 0.f, sq = 0.f; \
        _Pragma("unroll") \
          for (int i = 0; i < 2; ++i) \
        _Pragma("unroll") \
              for (int r = 0; r < 4; ++r) { sm += ay[i][0][r]; sq += ay[i][0][r] * ay[i][0][r]; } \
          sm += __shfl_xor(sm, 16); sm += __shfl_xor(sm, 32); sq += __shfl_xor(sq, 16); sq += __shfl_xor(sq, 32); \
          if (lane < 16) { rsum[vh * 64 + tcol] = sm; rsq[vh * 64 + tcol] = sq; } \
          lds_barrier(); \
          const float mean = (rsum[tcol] + rsum[64 + tcol]) * (1.f / 64.f); const float var = fmaxf((rsq[tcol] + rsq[64 + tcol]) * (1.f / 64.f) - mean * mean, 0.f); const float rstd = rsqrtf(var + 64e-5f); \
          const float bon = ssc[64 + tcol]; \
          if (tcol < Lv) { \
        _Pragma("unroll") \
              for (int i = 0; i < 2; ++i) { const int dv0 = 32 * vh + 16 * i + 4 * (lane >> 4); const u32x2 vv = i == 0 ? cVV0 : cVV1, gg = i == 0 ? cGG0 : cGG1; \
                  const float o0 = ((ay[i][0][0] - mean) * rstd * lnw[i][0] + lnb[i][0] + bon * __uint_as_float(vv.x << 16)) * __uint_as_float(gg.x << 16); \
                  const float o1 = ((ay[i][0][1] - mean) * rstd * lnw[i][1] + lnb[i][1] + bon * __uint_as_float(vv.x & 0xffff0000u)) * __uint_as_float(gg.x & 0xffff0000u); \
                  const float o2 = ((ay[i][0][2] - mean) * rstd * lnw[i][2] + lnb[i][2] + bon * __uint_as_float(vv.y << 16)) * __uint_as_float(gg.y << 16); \
                  const float o3 = ((ay[i][0][3] - mean) * rstd * lnw[i][3] + lnb[i][3] + bon * __uint_as_float(vv.y & 0xffff0000u)) * __uint_as_float(gg.y & 0xffff0000u); \
                  u32x2 o; o.x = pk2(o0, o1); o.y = pk2(o2, o3); *(u32x2*)(YBR + (row0 + tcol) * YLD + 2048 + h * 64 + dv0) = o; } } } \
        lds_barrier(); \
    } while (0)
    RW_ISSUE(0, 0); RW_ISSUE(1, 1); RW_ISSUE(2, 2);
    lds_barrier();
    for (int cch = 0; cch < NCH; cch += 3) { RW_CHUNK(cch, 0); RW_CHUNK(cch + 1, 1); RW_CHUNK(cch + 2, 2); }
#undef RW_CHUNK
#undef RW_ISSUE
    const int lane_e = hw_lane(), tid_e = w * 64 + lane_e;
    float* os = c.out + O_PRS + (((size_t)l * BATCH + b) * HC + h) * DHC * DHC;
#pragma unroll
    for (int j = 0; j < 2; ++j) *(f32x4*)(os + (size_t)(32 * vh + 16 * j + (lane_e & 15)) * 64 + 16 * kt + 4 * (lane_e >> 4)) = Hst[0][j];
    { float* osh = c.out + O_PRSH + ((size_t)l * BATCH + b) * NCC; const bf16_t* last = PROJ + ((size_t)b * TP + TP - 1) * NPROJ + PC0;
      int cidx = -1;
      if (tid_e < 64) cidx = h * 64 + tid_e; else if (tid_e < 128) cidx = 1024 + h * 64 + (tid_e - 64); else if (tid_e < 192) cidx = 2048 + h * 64 + (tid_e - 128); else if (tid_e < 448 && h == 0) cidx = 3072 + (tid_e - 192);
      if (cidx >= 0) osh[cidx] = bf2f(last[cidx]); }
    lds_barrier();
}

__device__ __forceinline__ void mlstm_post_rows(const Ctx& c, int l, int bb, int h, int vs) {
    int w = c.wave; asm volatile("" : "+s"(w)); const int lane = hw_lane();
    const float* HAo = (const float*)(c.ws + WS_HA); const bf16_t* PROJ = (const bf16_t*)(c.ws + WS_PROJ); bf16_t* YBR = (bf16_t*)(c.ws + WS_YBR);
    const f32x4 wv = *(const f32x4*)(inp(c, I_MNW) + l * 1024 + h * 256 + 4 * lane);
    constexpr int RQ = TP / 4;
    const size_t row0 = (size_t)bb * TP + (size_t)vs * RQ;
#pragma unroll 1
    for (int i = w; i < RQ; i += 4 * NWAVES) {
        f32x4 v[4]; u32x2 og[4];
#pragma unroll
        for (int k = 0; k < 4; ++k) { const int ii = i + NWAVES * k < RQ ? i + NWAVES * k : i; const size_t row = row0 + ii;
            v[k] = *(const f32x4*)(HAo + row * 1024 + h * 256 + 4 * lane); og[k] = *(const u32x2*)(PROJ + row * NPROJ + PA_O + h * 256 + 4 * lane); }
#pragma unroll
        for (int k = 0; k < 4; ++k) { if (i + NWAVES * k >= RQ) continue; const size_t row = row0 + i + NWAVES * k;
            const float ss = wave_sum((v[k].x * v[k].x + v[k].y * v[k].y) + (v[k].z * v[k].z + v[k].w * v[k].w)); const float rs = rsqrtf(ss * (1.f / 256.f) + 1e-6f);
            const float o0 = sigmoidf_(__uint_as_float(og[k].x << 16)), o1 = sigmoidf_(__uint_as_float(og[k].x & 0xffff0000u)), o2 = sigmoidf_(__uint_as_float(og[k].y << 16)), o3 = sigmoidf_(__uint_as_float(og[k].y & 0xffff0000u));
            u32x2 o; o.x = pk2(o0 * v[k].x * rs * wv.x, o1 * v[k].y * rs * wv.y); o.y = pk2(o2 * v[k].z * rs * wv.z, o3 * v[k].w * rs * wv.w);
            *(u32x2*)(YBR + row * YLD + h * 256 + 4 * lane) = o; }
    }
}
__device__ __forceinline__ void phase_mix_prep(const Ctx& c, int l) {
    unsigned* qctr = (unsigned*)(c.ws + WS_CTL) + 8192 + (12 + 3 * l) * 64;
    volatile LAS unsigned* MISC = (volatile LAS unsigned*)(c.lds + LDS_MISC);
#define QBEGIN(k, n) int qn_ = 0; if (c.wave == 0 && hw_lane() == 0) qn_ = (int)__hip_atomic_fetch_add(qctr + 64 * (k), (unsigned)(n), __ATOMIC_RELAXED, __HIP_MEMORY_SCOPE_AGENT)
#define QNEXT(k, n) ({ lds_barrier(); if (c.wave == 0 && hw_lane() == 0) MISC[12] = (unsigned)qn_; lds_barrier(); const int u_ = (int)MISC[12]; \
        if (c.wave == 0 && hw_lane() == 0) qn_ = (int)__hip_atomic_fetch_add(qctr + 64 * (k), (unsigned)(n), __ATOMIC_RELAXED, __HIP_MEMORY_SCOPE_AGENT); u_; })
#ifndef NO_RWP
    { QBEGIN(0, 1); for (;;) { const int u = QNEXT(0, 1); if (u >= NU_RW) break; rwkv_prep_unit(c, l, u); } }
#endif
#ifndef ONLY_RWP
    { QBEGIN(1, 1); for (;;) { const int u = QNEXT(1, 1); if (u >= NU_ML) break; mlstm_prep_unit(c, l, u); } }
    { QBEGIN(2, 1); for (;;) { const int u = QNEXT(2, 1); if (u >= NU_GD) break; gdn_prep_unit(c, l, u); } }
#endif
#if TAILCONV
    { QBEGIN(6 - 2 * l, 8); for (;;) { const int u = QNEXT(6 - 2 * l, 8); if (u >= WBR_DYN) break; convert_one(c, l, CO_BR + WBR_G1 + u + c.wave); } }
#endif
}

__device__ __forceinline__ void phase_mix_seq(const Ctx& c, int l, int rep = 0) {
    constexpr int W_ML = BATCH * HA * 4, W_GD = BATCH * HB, W_RW = BATCH * HC, NPU = W_ML + W_GD + W_RW;
    const int b = c.bid;
    if (b < W_ML && (rep < 2 || rep == 2)) mlstm_seq_unit(c, l, b >> 4, (b >> 2) & 3, b & 3);
    if (b < W_ML && rep == 0) {
        mini_barrier((unsigned*)(c.ws + WS_CTL) + 8192 + (32 + 16 * l + (b >> 2)) * 64, 4u, c.wave);
        mlstm_post_rows(c, l, b >> 4, (b >> 2) & 3, b & 3); }
    if (b >= W_ML && b < W_ML + W_GD && (rep < 2 || rep == 3)) { const int r = b - W_ML; gdn_seq_unit(c, l, r / HB, r % HB); }
#ifndef NO_RWS
    if (b >= W_ML + W_GD && b < NPU && (rep < 2 || rep == 4)) { const int r = b - W_ML - W_GD; rwkv_seq_unit(c, l, r / HC, r % HC); }
#endif
    unsigned* qctr = (unsigned*)(c.ws + WS_CTL) + 8192 + (3 * l + 6 * (rep == 1 ? 1 : 0)) * 64;
    volatile LAS unsigned* MISC = (volatile LAS unsigned*)(c.lds + LDS_MISC);
    { QBEGIN(0, 1); for (;;) { const int u = QNEXT(0, 1); if (u >= NB * HA) break; mlstm_unit_s(c, l, u / HA, u % HA); } }
    { QBEGIN(1, 2); for (;;) { const int u0 = QNEXT(1, 2); if (u0 >= NB * HB) break;
        for (int u = u0; u < u0 + 2 && u < NB * HB; ++u) gdn_unit_s(c, l, u / HB, u % HB); } }
    int cached_h = -1;
    { QBEGIN(2, 4); for (;;) { const int u0 = QNEXT(2, 4); if (u0 >= NB * HC) break;
        rwkv_unit4(c, l, u0 % NB, u0 / NB, cached_h); } }
#if TAILCONV
    if (rep == 0) { unsigned* qctr = (unsigned*)(c.ws + WS_CTL) + 8192 + (20 + l) * 64; const int nq = CI_O + (l == 0 ? WIN1_SEQ : 0);
        QBEGIN(0, 8); for (;;) { const int u = QNEXT(0, 8); if (u >= nq) break; const int it = u + c.wave; if (it < CI_O) convert_one(c, l, CO_O + it); else convert_one(c, 1, it - CI_O); } }
#endif
#undef QBEGIN
#undef QNEXT
}

__device__ __forceinline__ void phase_combine(const Ctx& c0, const int nblk) {
    Ctx c = c0; c.lane = hw_lane(); c.tid = c.wave * 64 + c.lane; c.G = nblk;
    const u32x4* B = (const u32x4*)(c.ws + WS_MRGF); u32x4* M = (u32x4*)(c.ws + WS_MRG);
    constexpr size_t NV = (size_t)MP * D / 8, V0 = (size_t)8192 * D / 8;
    for (size_t i = V0 + (size_t)c.bid * NTHR + c.tid; i < NV; i += (size_t)c.G * NTHR * 2) {
        const size_t i2 = i + (size_t)c.G * NTHR; const bool two = i2 < NV;
        u32x4 a[2][3];
#pragma unroll
        for (int z = 0; z < 3; ++z) { a[0][z] = B[i + z * NV]; a[1][z] = two ? B[i2 + z * NV] : (u32x4){0u, 0u, 0u, 0u}; }
#pragma unroll
        for (int q = 0; q < 2; ++q) { u32x4 o; unsigned* po = (unsigned*)&o;
            const unsigned* p0 = (const unsigned*)&a[q][0]; const unsigned* p1 = (const unsigned*)&a[q][1]; const unsigned* p2 = (const unsigned*)&a[q][2];
#pragma unroll
            for (int e = 0; e < 4; ++e) po[e] = pk2(__uint_as_float(p0[e] << 16) + __uint_as_float(p1[e] << 16) + __uint_as_float(p2[e] << 16),
                                                   __uint_as_float(p0[e] & 0xffff0000u) + __uint_as_float(p1[e] & 0xffff0000u) + __uint_as_float(p2[e] & 0xffff0000u));
            if (q == 0) M[i] = o; else if (two) M[i2] = o; }
    }
}

#define IN(k) (lo <= (k) && (k) < hi)
#ifdef ONLY_G
#define GSEL(k) ((k) == ONLY_G)
#else
#define GSEL(k) true
#endif
#if MK_MULTI
#define SEAM(k) do { } while (0)
#else
#define SEAM(k) do { if (IN(k) && IN((k) + 1)) xcd_barrier(bar, c.wave); } while (0)
#endif
template <int L> __device__ __forceinline__ void layer_phases(const Ctx& c, const XcdBarrier& bar, const int lo, const int hi) {
    constexpr int pb = 1 + 10 * L;
#ifndef SKIP_NORM
    if (IN(pb + 0)) { phase_norm_gates<L == 0>(c, inp(c, I_NMIX) + (size_t)L * D, (const float*)(c.ws + WS_WSG) + (size_t)L * NSG * D); if (REP_MISC > 1) phase_norm_gates<L == 0>(c, inp(c, I_NMIX) + (size_t)L * D, (const float*)(c.ws + WS_WSG) + (size_t)L * NSG * D); }
#endif
    SEAM(pb + 0);
    if (IN(pb + 1) && GSEL(1)) {
        pg8::Gemm<D, D, D> g{(const bf16_t*)(c.ws + WS_HN), (const bf16_t*)(c.ws + WS_WIN) + (size_t)L * NPROJ * D};
        pg8::TileOrder<MP, NPROJ, 1> S; S.init(c.G, c.bid);
        pg8::EpiBf16<0> E{(bf16_t*)(c.ws + WS_PROJ), NPROJ};
        pg8::gemm_phase(c.lds, c.wave, g, S, E);
        if (REP_G1 > 1) pg8::gemm_phase(c.lds, c.wave, g, S, E);
#if TAILCONV
        convert_items(c, L, CO_BR, CO_BR + WBR_G1, (33 * 69) % c.G);
#endif
    }
    SEAM(pb + 1);
#ifndef SKIP_MIX
    if (IN(pb + 2)) { phase_mix_prep(c, L); if (REP_PREP > 1) phase_mix_prep(c, L); }
    SEAM(pb + 2);
#ifndef ONLY_RWP
    if (IN(pb + 3)) { phase_mix_seq(c, L); if (REP_SEQ > 1) { xcd_barrier(bar, c.wave); phase_mix_seq(c, L, REP_SEQ == 2 ? 1 : REP_SEQ == 3 ? 0 : REP_SEQ - 2); } }
#endif
    SEAM(pb + 3);
#endif
    if (IN(pb + 5) && GSEL(3)) {
        pg8::Gemm<YLD, 1024, 1024, 1024 * 2, (long)D * 1024 * 2> g{(const bf16_t*)(c.ws + WS_YBR), (const bf16_t*)(c.ws + WS_WBR) + (size_t)L * 3 * D * 1024};
        { pg8::TileOrder<8192, D, 3> S; S.init(c.G, c.bid);
          pg8::EpiGateAcc E{(const bf16_t*)(c.ws + WS_PROJ) + PG0, NPROJ, (bf16_t*)(c.ws + WS_MRG), D};
          pg8::gemm_phase(c.lds, c.wave, g, S, E); }
        { pg8::TailOrder<32, D, 3> S; S.init(c.G, c.bid);
          pg8::EpiGateBf16 E{(const bf16_t*)(c.ws + WS_PROJ) + PG0, NPROJ, (bf16_t*)(c.ws + WS_MRGF), D, (size_t)MP * D};
          pg8::gemm_phase(c.lds, c.wave, g, S, E); }
#if TAILCONV
        convert_items(c, L, CO_U, CO_U + CI_U / 2, (3 * 8) % c.G);
#endif
        if (c.G >= 24) {
            if (c.bid < 24) { unsigned* ctr = (unsigned*)(c.ws + WS_CTL) + 8192 + (96 + L) * 64; wg_signal(ctr, c.wave); wg_wait(ctr, 24u, c.wave); phase_combine(c, 24); }
        } else { xcd_barrier(bar, c.wave); phase_combine(c, c.G); }
    }
    SEAM(pb + 5);
    if (IN(pb + 6) && GSEL(4)) {
        pg8::Gemm<D, D, D> g{(const bf16_t*)(c.ws + WS_MRG), (const bf16_t*)(c.ws + WS_WOUT) + (size_t)L * D * D};
        pg8::TileOrder<MP, D, 1> S; S.init(c.G, c.bid);
        if (L == 0) { pg8::EpiResidSrc E{inp(c, I_META), inp(c, I_XP), inp(c, I_XS), (float*)(c.ws + WS_X), D}; pg8::gemm_phase(c.lds, c.wave, g, S, E); }
        else { pg8::EpiResid E{(const float*)(c.ws + WS_X), (float*)(c.ws + WS_X), D}; pg8::gemm_phase(c.lds, c.wave, g, S, E); }
#if TAILCONV
        convert_items(c, L, CO_U + CI_U / 2, CO_D + CI_D / 4, (33 * 8) % c.G);
#endif
    }
    SEAM(pb + 6);
#ifndef SKIP_NORM
    if (IN(pb + 7)) { phase_norm<false>(c, inp(c, I_NMLP) + (size_t)L * D, nullptr); if (REP_MISC > 1) phase_norm<false>(c, inp(c, I_NMLP) + (size_t)L * D, nullptr); }
#endif
    SEAM(pb + 7);
    if (IN(pb + 8) && GSEL(6)) {
        pg8::Gemm<D, D, D> g{(const bf16_t*)(c.ws + WS_HN), (const bf16_t*)(c.ws + WS_WUP) + (size_t)L * DFF * D};
        pg8::TileOrder<MP, DFF, 1> S; S.init(c.G, c.bid);
        pg8::EpiBf16<1> E{(bf16_t*)(c.ws + WS_PROJ), DFF};
        pg8::gemm_phase(c.lds, c.wave, g, S, E);
#if TAILCONV
        convert_items(c, L, CO_D + CI_D / 4, C_PER_L, (33 * 32) % c.G);
        if (L == 0) convert_items(c, 1, WIN1_SEQ, WIN1_G4, (33 * 32) % c.G);
#endif
    }
    SEAM(pb + 8);
    if (IN(pb + 9) && GSEL(7)) {
        pg8::Gemm<DFF, DFF, DFF> g{(const bf16_t*)(c.ws + WS_PROJ), (const bf16_t*)(c.ws + WS_WDN) + (size_t)L * D * DFF};
        pg8::TileOrder<8192, D, 1> S; S.init(c.G, c.bid);
        pg8::EpiResid E{(const float*)(c.ws + WS_X), (float*)(c.ws + WS_X), D};
        pg8::gemm_phase(c.lds, c.wave, g, S, E);
        unsigned* pdone = (unsigned*)(c.ws + WS_CTL) + 8192 + 64 * 64;
        const bool fin_tail = FIN_IN_TAIL && L == 1 && c.G == 256;
        if (fin_tail) { pg8::Unit u0; if (S.next(0, u0)) wg_signal(pdone + 64 * u0.pm, c.wave); }
        const pg8::StreamX sx{(float*)(c.ws + WS_SLOTS), (unsigned*)(c.ws + WS_CTL) + FLAG_W0 + (3 * L + 2) * 256 * 64, (unsigned*)(c.ws + WS_CTL) + 4096 + XB_TMO};
        pg8::SplitOrder<32, D, 4, 32> S2; S2.init(c.G, c.bid);
        pg8::gemm_phase(c.lds, c.wave, g, S2, E, sx);
        if (c.bid >= 32 && c.bid < 40) pg8::split_reduce<0>(c.wave, (float*)(c.ws + WS_X), nullptr, D, sx, 32, c.bid - 32, 8, 4);
#if TAILCONV
        if (L == 0) convert_items(c, 1, WIN1_G4, CI_IN, 40);
#endif
        if (fin_tail && c.bid >= 40) {
            const int r = c.bid - 40, p = r & 31, k = r >> 5, cnt = (216 - p + 31) >> 5;
            wg_wait(pdone + 64 * p, 8u, c.wave);
            final_rows(c, 256 * p, 256 * p + 256, k * NWAVES + c.wave, cnt * NWAVES);
        }
    }
    SEAM(pb + 9);
}

__global__ void __launch_bounds__(NTHR, 2) mega(Params p) {
    extern __shared__ __attribute__((aligned(16))) unsigned char lds_raw[];
    Ctx c{p.out, p.ws, (LAS unsigned char*)lds_raw, (int)threadIdx.x, (int)(threadIdx.x & 63), __builtin_amdgcn_readfirstlane((int)(threadIdx.x >> 6)), (int)gridDim.x, (int)blockIdx.x};
    volatile LAS unsigned* MISC = (volatile LAS unsigned*)(c.lds + LDS_MISC);
    if (c.tid < 16) MISC[c.tid] = 0u;
    if (c.tid < 38) ((LAS unsigned long long*)(c.lds + LDS_MISC + 64))[c.tid] = (unsigned long long)p.in[c.tid];
    __syncthreads();
    unsigned* barw = (unsigned*)(c.ws + WS_CTL) + 4096;
    XcdBarrier bar; bar.bar = barw; bar.x = 0; bar.st = MISC + 8;
#if !MK_MULTI
    bar = xcd_barrier_post(barw, MISC + 8);
#endif
    const int lo = p.ph_lo, hi = p.ph_hi;
#ifndef SKIP_PREP
    if (IN(0)) { phase_prep(c); if (REP_MISC > 1) phase_prep(c); }
#endif
    SEAM(0);
    layer_phases<0>(c, bar, lo, hi);
    layer_phases<1>(c, bar, lo, hi);
#ifndef SKIP_NORM
    if (IN(21)) { phase_final(c); if (REP_MISC > 1) phase_final(c); }
#endif
}
#undef IN
#undef SEAM

extern "C" void kernel_launch(void* const* d_in, const int* in_sizes, int n_in, void* d_out, int out_size, void* d_ws, size_t ws_size, hipStream_t stream) {
    static int grid = 0;
    if (grid == 0) {
        if (n_in != 38 || (size_t)out_size != O_END || ws_size < WS_END) { fprintf(stderr, "kernel_launch: unexpected shapes (n_in %d out %d ws %zu need %zu)\n", n_in, out_size, ws_size, (size_t)WS_END); grid = -1; return; }
        int dev = 0, cus = 0, per_cu = 0;
        if (hipGetDevice(&dev) != hipSuccess || hipDeviceGetAttribute(&cus, hipDeviceAttributeMultiprocessorCount, dev) != hipSuccess) { grid = -1; return; }
        if (hipFuncSetAttribute((const void*)mega, hipFuncAttributeMaxDynamicSharedMemorySize, LDS_BYTES) != hipSuccess) { fprintf(stderr, "kernel_launch: hipFuncSetAttribute failed\n"); grid = -1; return; }
        if (hipOccupancyMaxActiveBlocksPerMultiprocessor(&per_cu, (const void*)mega, NTHR, LDS_BYTES) != hipSuccess || per_cu < 1) { fprintf(stderr, "kernel_launch: occupancy query says %d\n", per_cu); (void)hipGetLastError(); grid = -1; return; }
        grid = cus;
    }
    if (grid < 0) return;
    (void)hipMemsetAsync((char*)d_ws + WS_CTL, 0, CTL_BYTES, stream);
    Params p{};
    for (int i = 0; i < 38; ++i) p.in[i] = (const float*)d_in[i];
    p.out = (float*)d_out; p.ws = (unsigned char*)d_ws;
#if MK_MULTI
    for (int k = 0; k < NPHASE; ++k) { p.ph_lo = k; p.ph_hi = k + 1; hipLaunchKernelGGL(mega, dim3(grid), dim3(NTHR), LDS_BYTES, stream, p); }
#else
    p.ph_lo = 0; p.ph_hi = NPHASE;
    hipLaunchKernelGGL(mega, dim3(grid), dim3(NTHR), LDS_BYTES, stream, p);
#endif
}
```

```cpp
#include <hip/hip_runtime.h>
#include <cstdio>
#include <cstdint>

#ifndef MK_MULTI
#define MK_MULTI 0
#endif

#ifndef REP_PREP
#define REP_PREP 1
#endif
#ifndef REP_MISC
#define REP_MISC 1
#endif
#ifndef REP_SEQ
#define REP_SEQ 1
#endif
#ifndef REP_G1
#define REP_G1 1
#endif
#ifndef REP_G4
#define REP_G4 1
#endif
#define LAS __attribute__((address_space(3)))
#define GAS __attribute__((address_space(1)))
typedef unsigned short bf16_t;
typedef short bf16x8 __attribute__((ext_vector_type(8)));
typedef float f32x4 __attribute__((ext_vector_type(4)));
typedef float f32x2 __attribute__((ext_vector_type(2)));
typedef unsigned u32x4 __attribute__((ext_vector_type(4)));
typedef unsigned u32x2 __attribute__((ext_vector_type(2)));

constexpr int D = 2048, BATCH = 4, SEQ = 2048, NMETA = 16, TP = SEQ + NMETA, NB = 128;
constexpr int MPROMPT = BATCH * TP;
constexpr int MREAL = MPROMPT + NB;
constexpr int MP = 8448;
constexpr int NSEQ = BATCH + NB;
constexpr int HA = 4, DHA = 256, HB = 8, DHB = 128, HC = 16, DHC = 64;
constexpr int NCC = 3328, NIN = 17688, NPROJ = 17664, DFF = 8192;
constexpr int PA_Q = 0, PA_K = 1024, PA_V = 2048, PA_O = 3072, PB_QKV = 4096, PB_Z = 7168, PC0 = 8192, PG0 = 11520;
constexpr int NSG = 24, SGLD = 32;
constexpr int YLD = 3072;

constexpr size_t O_YP = 0;
constexpr size_t O_YS = O_YP + (size_t)BATCH * SEQ * D;
constexpr size_t O_PC = O_YS + (size_t)NB * D;
constexpr size_t O_PN = O_PC + (size_t)2 * BATCH * HA * DHA * DHA;
constexpr size_t O_PM = O_PN + (size_t)2 * BATCH * HA * DHA;
constexpr size_t O_PGS = O_PM + (size_t)2 * BATCH * HA;
constexpr size_t O_PGC = O_PGS + (size_t)2 * BATCH * HB * DHB * DHB;
constexpr size_t O_PRS = O_PGC + (size_t)2 * BATCH * 3 * 3072;
constexpr size_t O_PRSH = O_PRS + (size_t)2 * BATCH * HC * DHC * DHC;
constexpr size_t O_SC = O_PRSH + (size_t)2 * BATCH * NCC;
constexpr size_t O_SN = O_SC + (size_t)2 * NB * HA * DHA * DHA;
constexpr size_t O_SM = O_SN + (size_t)2 * NB * HA * DHA;
constexpr size_t O_SGS = O_SM + (size_t)2 * NB * HA;
constexpr size_t O_SGC = O_SGS + (size_t)2 * NB * HB * DHB * DHB;
constexpr size_t O_SRS = O_SGC + (size_t)2 * NB * 3 * 3072;
constexpr size_t O_SRSH = O_SRS + (size_t)2 * NB * HC * DHC * DHC;
constexpr size_t O_END = O_SRSH + (size_t)2 * NB * NCC;
static_assert(O_END == 141732896ull, "output size");

constexpr size_t AL(size_t x) { return (x + 255) & ~(size_t)255; }
constexpr size_t WS_CTL = 0, CTL_BYTES = 1u << 20;
constexpr size_t WS_WIN = CTL_BYTES;
constexpr size_t WS_WSG = AL(WS_WIN + (size_t)2 * NPROJ * D * 2);
constexpr size_t WS_WBR = AL(WS_WSG + (size_t)2 * NSG * D * 4);
constexpr size_t WS_WOUT = AL(WS_WBR + (size_t)2 * 3 * D * 1024 * 2);
constexpr size_t WS_WUP = AL(WS_WOUT + (size_t)2 * D * D * 2);
constexpr size_t WS_WDN = AL(WS_WUP + (size_t)2 * DFF * D * 2);
constexpr size_t WS_X = AL(WS_WDN + (size_t)2 * D * DFF * 2);
constexpr size_t WS_HN = AL(WS_X + (size_t)MP * D * 4);
constexpr size_t WS_SG = AL(WS_HN + (size_t)MP * D * 2);
constexpr size_t WS_YBR = AL(WS_SG + (size_t)MP * SGLD * 4);
constexpr size_t WS_MRG = AL(WS_YBR + (size_t)MP * YLD * 2);
constexpr size_t WS_PROJ = AL(WS_MRG + (size_t)MP * D * 2);
constexpr size_t WS_MRGF = AL(WS_PROJ + (size_t)MP * NPROJ * 2);
constexpr int NCH = 33;
constexpr int NU_ML = BATCH * HA * NCH, NU_GD = BATCH * HB * NCH, NU_RW = BATCH * HC * NCH;
constexpr size_t WS_ML_KTW = WS_MRGF;
constexpr size_t WS_ML_VT = AL(WS_ML_KTW + (size_t)NU_ML * 256 * 64 * 2);
constexpr size_t WS_ML_NP = AL(WS_ML_VT + (size_t)NU_ML * 256 * 64 * 2);
constexpr size_t WS_ML_SC = AL(WS_ML_NP + (size_t)NU_ML * 64 * 256 * 4);
constexpr size_t WS_HA = AL(WS_ML_SC + (size_t)NU_ML * 256 * 4);
constexpr size_t WS_GD_W = AL(WS_HA + (size_t)MPROMPT * 1024 * 4);
constexpr size_t WS_GD_UT = AL(WS_GD_W + (size_t)NU_GD * 64 * 128 * 2);
constexpr size_t WS_GD_AT = AL(WS_GD_UT + (size_t)NU_GD * 128 * 64 * 2);
constexpr size_t WS_GD_Q = AL(WS_GD_AT + (size_t)NU_GD * 64 * 64 * 2);
constexpr size_t WS_GD_KD = AL(WS_GD_Q + (size_t)NU_GD * 64 * 128 * 2);
constexpr size_t WS_GD_SC = AL(WS_GD_KD + (size_t)NU_GD * 128 * 64 * 2);
constexpr size_t WS_RW = AL(WS_GD_SC + (size_t)NU_GD * 128 * 4);
enum { RW_TA = 0  , RW_PVT  , RW_RH  , RW_YV  , RW_ARB  , RW_BHT  , RW_KVT  , RW_V  , RW_G  , RW_N };
constexpr size_t WS_RW_SC = AL(WS_RW + (size_t)NU_RW * RW_N * 4096 * 2);
constexpr size_t WS_MIX_END = AL(WS_RW_SC + (size_t)NU_RW * 128 * 4);
constexpr size_t WS_SLOTS = WS_MRGF;
constexpr int FLAG_W0 = 16384;
static_assert((size_t)(FLAG_W0 + 6 * 256 * 64) * 4 <= CTL_BYTES && WS_SLOTS + (size_t)256 * 65536 * 4 <= WS_MIX_END, "stream-K scratch");
constexpr size_t WS_END = WS_MIX_END > AL(WS_MRGF + (size_t)MP * D * 4) ? WS_MIX_END : AL(WS_MRGF + (size_t)MP * D * 4);
static_assert((size_t)MP * DFF * 2 <= (size_t)MP * NPROJ * 2, "U overlays PROJ");

__device__ __forceinline__ float bf2f(bf16_t b) { return __uint_as_float(((unsigned)b) << 16); }
typedef __bf16 bf16x2_t __attribute__((ext_vector_type(2)));
__device__ __forceinline__ unsigned pk2(float lo, float hi) { const f32x2 v = {lo, hi}; return __builtin_bit_cast(unsigned, __builtin_convertvector(v, bf16x2_t)); }
__device__ __forceinline__ unsigned f2bf(float f) { return pk2(f, 0.f) & 0xffffu; }
__device__ __forceinline__ float sigmoidf_(float x) { return __builtin_amdgcn_rcpf(1.f + __expf(-x)); }
__device__ __forceinline__ float softplusf_(float x) { const float e = __expf(x); return x > 15.f ? x : (e < 1e-3f ? e * (1.f - 0.5f * e) : __logf(1.f + e)); }
__device__ __forceinline__ float siluf_(float x) { return x * __builtin_amdgcn_rcpf(1.f + __expf(-x)); }
__device__ __forceinline__ float fsigmoid(float x) { return __builtin_amdgcn_rcpf(1.f + __expf(-x)); }
__device__ __forceinline__ float fsoftplus(float x) { return x > 15.f ? x : __logf(1.f + __expf(x)); }
__device__ __forceinline__ float ftanh(float x) { return 1.f - 2.f * __builtin_amdgcn_rcpf(1.f + __expf(2.f * x)); }
__device__ __forceinline__ int hw_lane() { int l; asm volatile("v_mbcnt_lo_u32_b32 %0, -1, 0\n\tv_mbcnt_hi_u32_b32 %0, -1, %0" : "=v"(l)); return l; }
template <int CTRL, int ROWMASK>
__device__ __forceinline__ float dpp_mov(float old, float src) {
    return __builtin_bit_cast(float, __builtin_amdgcn_update_dpp(__builtin_bit_cast(int, old), __builtin_bit_cast(int, src), CTRL, ROWMASK, 0xf, false));
}
__device__ __forceinline__ float lane_bcast(float v, int l) { return __builtin_bit_cast(float, __builtin_amdgcn_readlane(__builtin_bit_cast(int, v), l)); }
__device__ __forceinline__ float wave_scan_sum(float v) {
    v += dpp_mov<0x111, 0xf>(0.f, v); v += dpp_mov<0x112, 0xf>(0.f, v); v += dpp_mov<0x114, 0xf>(0.f, v); v += dpp_mov<0x118, 0xf>(0.f, v);
    v += dpp_mov<0x142, 0xa>(0.f, v); v += dpp_mov<0x143, 0xc>(0.f, v);
    return v;
}
__device__ __forceinline__ float wave_sum(float v) { return lane_bcast(wave_scan_sum(v), 63); }
__device__ __forceinline__ float row16_sum(float v) {
    v += dpp_mov<0x121, 0xf>(0.f, v); v += dpp_mov<0x122, 0xf>(0.f, v); v += dpp_mov<0x124, 0xf>(0.f, v); v += dpp_mov<0x128, 0xf>(0.f, v);
    return v;
}
__device__ __forceinline__ void lds_barrier() { asm volatile("s_waitcnt lgkmcnt(0)" ::: "memory"); __builtin_amdgcn_s_barrier(); asm volatile("" ::: "memory"); }
__device__ __forceinline__ float block_sum(float v, LAS float* sc, const int wave) {
    v = wave_sum(v);
    if (hw_lane() == 0) sc[wave] = v;
    lds_barrier();
    float r = 0.f;
#pragma unroll
    for (int i = 0; i < 8; ++i) r += sc[i];
    lds_barrier();
    return r;
}

#define XB_TMO      128
#define XB_XCNT(j)  (256  + 64 * (j))
#define XB_XSUB(j)  (1280 + 64 * (j))
#define XB_XGEN(j)  (2304 + 64 * (j))
#define XB_TOP      3328
#define XB_TOPGEN   3392
#define XCD_BAR_WORDS 3456
#define XB_SPIN_CAP (1u << 22)

__device__ __forceinline__ unsigned xb_ld(unsigned* p)              { return __hip_atomic_load(p, __ATOMIC_RELAXED, __HIP_MEMORY_SCOPE_AGENT); }
__device__ __forceinline__ unsigned xb_add(unsigned* p, unsigned v) { return __hip_atomic_fetch_add(p, v, __ATOMIC_RELAXED, __HIP_MEMORY_SCOPE_AGENT); }
__device__ __forceinline__ unsigned xb_xcc_id() { return (unsigned)__builtin_amdgcn_s_getreg((3 << 11) | 20) & 0xFu; }
#define XB_SPIN(cond, bar) do { unsigned _sp = 0; while (cond) { __builtin_amdgcn_s_sleep(1); \
    if ((++_sp & 255u) == 0u) { if (xb_ld(&(bar)[XB_TMO])) break; if (_sp > XB_SPIN_CAP) { atomicAdd(&(bar)[XB_TMO], 1u); break; } } } } while (0)

struct XcdBarrier { unsigned* bar; unsigned x; volatile LAS unsigned* st; };

__device__ __forceinline__ XcdBarrier xcd_barrier_post(unsigned* bar, volatile LAS unsigned* st) {
    XcdBarrier b; b.bar = bar; b.x = xb_xcc_id(); b.st = st;
    if (threadIdx.x == 0) (void)xb_add(&bar[XB_XCNT(b.x)], 1u);
    return b;
}
__device__ __forceinline__ void xcd_barrier_complete(unsigned* bar, unsigned x, unsigned& nloc, unsigned& nx) {
    const unsigned G = gridDim.x * gridDim.y * gridDim.z;
    unsigned sum, cnt, mine, sp = 0u;
    for (;;) {
        sum = 0u; cnt = 0u; mine = 0u;
#pragma unroll
        for (unsigned j = 0; j < 16; ++j) { const unsigned c = xb_ld(&bar[XB_XCNT(j)]); sum += c; cnt += (c > 0u) ? 1u : 0u; mine = (j == x) ? c : mine; }
        if (sum == G) break;
        __builtin_amdgcn_s_sleep(1);
        if ((++sp & 255u) == 0u) { if (xb_ld(&bar[XB_TMO])) break; if (sp > XB_SPIN_CAP) { atomicAdd(&bar[XB_TMO], 1u); break; } }
    }
    nloc = mine > 0u ? mine : 1u; nx = cnt > 0u ? cnt : 1u;
}
__device__ __forceinline__ void xcd_barrier(const XcdBarrier& b, const int wave) {
    asm volatile("s_waitcnt vmcnt(0)" ::: "memory");
    __syncthreads();
    if (wave == 0 && hw_lane() == 0) {
        unsigned* bar = b.bar;
        __builtin_amdgcn_s_waitcnt(0);
        unsigned nloc = b.st[0], nx = b.st[1];
        if (nloc == 0u) { xcd_barrier_complete(bar, b.x, nloc, nx); b.st[0] = nloc; b.st[1] = nx; }
        const unsigned old = xb_add(&bar[XB_XSUB(b.x)], 1u);
        const unsigned gen = old / nloc;
        if (old + 1u == (gen + 1u) * nloc) {
            __builtin_amdgcn_fence(__ATOMIC_RELEASE, "agent");
            asm volatile("s_waitcnt vmcnt(0)" ::: "memory");
            const unsigned og = xb_add(&bar[XB_TOP], 1u);
            const unsigned tg = og / nx;
            if (og + 1u == (tg + 1u) * nx) xb_add(&bar[XB_TOPGEN], 1u);
            else XB_SPIN(xb_ld(&bar[XB_TOPGEN]) == tg, bar);
            __builtin_amdgcn_fence(__ATOMIC_ACQUIRE, "agent");
            xb_add(&bar[XB_XGEN(b.x)], 1u);
            asm volatile("s_waitcnt vmcnt(0)" ::: "memory");
        } else {
            XB_SPIN(xb_ld(&bar[XB_XGEN(b.x)]) == gen, bar);
            __builtin_amdgcn_fence(__ATOMIC_ACQUIRE, "agent");
            asm volatile("s_waitcnt vmcnt(0)" ::: "memory");
        }
    }
    __syncthreads();
}

__device__ __forceinline__ void mini_barrier(unsigned* ctr, unsigned n, const int wave) {
    asm volatile("s_waitcnt vmcnt(0)" ::: "memory");
    __syncthreads();
    if (wave == 0 && hw_lane() == 0) {
        __builtin_amdgcn_fence(__ATOMIC_RELEASE, "agent");
        asm volatile("s_waitcnt vmcnt(0)" ::: "memory");
        (void)xb_add(ctr, 1u);
        unsigned sp = 0u;
        while (xb_ld(ctr) < n) { __builtin_amdgcn_s_sleep(1); if (++sp > XB_SPIN_CAP) break; }
        __builtin_amdgcn_fence(__ATOMIC_ACQUIRE, "agent");
        asm volatile("s_waitcnt vmcnt(0)" ::: "memory");
    }
    __syncthreads();
}

__device__ __forceinline__ void wg_signal(unsigned* ctr, const int wave) {
    asm volatile("s_waitcnt vmcnt(0)" ::: "memory");
    __syncthreads();
    if (wave == 0 && hw_lane() == 0) { __builtin_amdgcn_fence(__ATOMIC_RELEASE, "agent"); asm volatile("s_waitcnt vmcnt(0)" ::: "memory"); (void)xb_add(ctr, 1u); }
}
__device__ __forceinline__ void wg_wait(unsigned* ctr, unsigned n, const int wave) {
    if (wave == 0 && hw_lane() == 0) { unsigned sp = 0u;
        while (xb_ld(ctr) < n) { __builtin_amdgcn_s_sleep(1); if (++sp > XB_SPIN_CAP) break; }
        __builtin_amdgcn_fence(__ATOMIC_ACQUIRE, "agent");
        asm volatile("s_waitcnt vmcnt(0)" ::: "memory"); }
    __syncthreads();
}

__device__ __forceinline__ const float* x0_row(const float* meta, const float* xp, const float* xs, int row) {
    const int b = row / TP, t = row - b * TP;
    const float* p = t < NMETA ? meta + (size_t)t * D : xp + ((size_t)b * SEQ + (t - NMETA)) * D;
    if (row >= MPROMPT) p = row < MREAL ? xs + (size_t)(row - MPROMPT) * D : meta;
    return p;
}
namespace pg8 {
constexpr int BM = 256, BK = 64, HALF = 128, HTB = HALF * BK * 2, STAGE_BYTES = 8 * HTB, NXCD = 8, WGM = 8;
__host__ __device__ __forceinline__ int lds_byte(int r, int c) { const int st = (r >> 4) * 2 + (c >> 5), rr = r & 15, cc = c & 31, ob = rr * 64 + cc * 2; return st * 1024 + (ob ^ (((ob >> 9) & 1) << 5)); }
__host__ __device__ __forceinline__ void stage_rc(int b, int& R, int& C) { const int st = b / 1024, sb = b % 1024, swz = sb ^ (((sb >> 9) & 1) << 5); R = (st >> 1) * 16 + swz / 64; C = (st & 1) * 32 + (swz % 64) / 2; }
__host__ __device__ __forceinline__ int perm32(int rho) { const int n = rho >> 4, i = rho & 15; return 8 * (i >> 2) + 4 * n + (i & 3); }

struct Unit { int pm, pn, z, kb, kn, role; };
template <int LDA_, int LDB_, int K_, long ZSA_ = 0, long ZSB_ = 0> struct Gemm { static constexpr int lda = LDA_, ldb = LDB_, K = K_; static constexpr size_t zsA = (size_t)ZSA_, zsB = (size_t)ZSB_; const bf16_t* A; const bf16_t* Bt; };

template <int M_, int N_, int NZ_> struct TileOrder {
    static constexpr bool STREAM = false;
    static constexpr int nM = M_ / BM, nN = N_ / BM, nz = NZ_, nwg = nM * nN;
    int G, c;
    __device__ void init(int G_, int c_) { G = G_; c = c_; }
    __device__ __forceinline__ bool next(int i, Unit& u) const {
        u.kb = 0; u.kn = 0; u.role = 0;
        const int ti = i / nz; u.z = i - ti * nz;
        const long L = (long)ti * G + c; if (L >= nwg) return false;
        int wgid = (int)L; { const int q = nwg / NXCD, r = nwg % NXCD, xcd = wgid % NXCD, off = wgid / NXCD; wgid = (xcd < r ? xcd * (q + 1) : r * (q + 1) + (xcd - r) * q) + off; }
        const int nig = WGM * nN, gid = wgid / nig, fm = gid * WGM, gsz = (nM - fm) < WGM ? (nM - fm) : WGM;
        u.pm = fm + ((wgid % nig) % gsz); u.pn = (wgid % nig) / gsz; return true;
    }
};

template <int M_, int N_, int NT_> struct StreamOrder {
    static constexpr bool STREAM = true;
    static constexpr int nN = N_ / BM, nU = (M_ / BM) * nN, UQ = NT_ / 4, Q = nU * UQ;
    int G, c, start, share;
    __device__ void init(int G_, int c_) { G = G_; c = c_; const int base = Q / G_, rem = Q % G_; share = base + (c_ < rem ? 1 : 0); start = c_ * base + (c_ < rem ? c_ : rem); }
    __device__ __forceinline__ bool next(int i, Unit& u) const {
        int p = start; const int e = start + share;
        for (int idx = 0; p < e; ++idx) { const int uu = p / UQ, off = p - uu * UQ; const int len = (UQ - off) < (e - p) ? (UQ - off) : (e - p);
            if (idx == i) { u.pm = uu / nN; u.pn = uu - u.pm * nN; u.z = 0; u.kb = 4 * off; u.kn = 4 * len; u.role = off > 0 ? 1 : (len < UQ ? 2 : 0); return true; }
            p += len; }
        return false;
    }
};
template <int M_, int N_, int NZ_> struct FlatOrder {
    static constexpr bool STREAM = false;
    static constexpr int nM = M_ / BM, nN = N_ / BM, nwg = nM * nN;
    int G, c;
    __device__ void init(int G_, int c_) { G = G_; c = c_; }
    __device__ __forceinline__ bool next(int i, Unit& u) const {
        u.kb = 0; u.kn = 0; u.role = 0;
        const int L = i * G + c; if (L >= nwg * NZ_) return false;
        u.z = L / nwg; int wgid = L - u.z * nwg;
        { const int q = nwg / NXCD, r = nwg % NXCD, xcd = wgid % NXCD, off = wgid / NXCD; wgid = (xcd < r ? xcd * (q + 1) : r * (q + 1) + (xcd - r) * q) + off; }
        const int nig = WGM * nN, gid = wgid / nig, fm = gid * WGM, gsz = (nM - fm) < WGM ? (nM - fm) : WGM;
        u.pm = fm + ((wgid % nig) % gsz); u.pn = (wgid % nig) / gsz; return true;
    }
};
template <int PM_, int N_, int NZ_> struct TailOrder {
    static constexpr bool STREAM = false;
    static constexpr int nN = N_ / BM;
    int G, c;
    __device__ void init(int G_, int c_) { G = G_; c = c_; }
    __device__ __forceinline__ bool next(int i, Unit& u) const { const int L = i * G + c; if (L >= nN * NZ_) return false; u.pm = PM_; u.pn = L % nN; u.z = L / nN; u.kb = 0; u.kn = 0; u.role = 0; return true; }
};
template <int PM_, int N_, int NP_, int KP_> struct SplitOrder {
    static constexpr bool STREAM = true;
    static constexpr int nN = N_ / BM, nprod = nN * NP_;
    int G, c;
    __device__ void init(int G_, int c_) { G = G_; c = c_; }
    __device__ __forceinline__ bool next(int i, Unit& u) const { if (i > 0 || c >= nprod) return false; u.pm = PM_; u.pn = c % nN; u.z = 0; u.kb = KP_ * (c / nN); u.kn = KP_; u.role = 1; return true; }
};
struct StreamX { float* slots; unsigned* flags; unsigned* tmo; };

__device__ __forceinline__ unsigned cvt_pk_bf16(float lo, float hi) { unsigned r; asm volatile("v_cvt_pk_bf16_f32 %0, %1, %2" : "=v"(r) : "v"(lo), "v"(hi)); return r; }

template <int ACT> struct EpiBf16 {
    static constexpr bool PERM = true;
    bf16_t* O; int ldc;
    __device__ __forceinline__ void operator()(const f32x4 (&acc)[2][2][4][2], const Unit& u, int wr, int wc, int fr, int fq) const {
        const int row0 = u.pm * BM + wr * 64 + fr; const int col0 = u.pn * BM + wc * 32 + 8 * fq;
#pragma unroll
        for (int ai = 0; ai < 2; ++ai)
#pragma unroll
            for (int m = 0; m < 4; ++m) { bf16_t* rowp = O + (size_t)(row0 + ai * HALF + m * 16) * ldc + col0;
#pragma unroll
                for (int bj = 0; bj < 2; ++bj) { f32x4 v0 = acc[ai][bj][m][0], v1 = acc[ai][bj][m][1];
                    if (ACT == 1) {
#pragma unroll
                        for (int j = 0; j < 4; ++j) { const float a = fmaxf(v0[j], 0.f), b = fmaxf(v1[j], 0.f); v0[j] = a * a; v1[j] = b * b; } }
                    u32x4 w; w.x = cvt_pk_bf16(v0[0], v0[1]); w.y = cvt_pk_bf16(v0[2], v0[3]); w.z = cvt_pk_bf16(v1[0], v1[1]); w.w = cvt_pk_bf16(v1[2], v1[3]);
                    *(u32x4*)(rowp + bj * HALF) = w; } }
    }
};
struct EpiGateBf16 {
    static constexpr bool PERM = true;
    const bf16_t* PG; int ldg; bf16_t* O; int ldc; size_t zstride;
    __device__ __forceinline__ void operator()(const f32x4 (&acc)[2][2][4][2], const Unit& u, int wr, int wc, int fr, int fq) const {
        const int row0 = u.pm * BM + wr * 64 + fr; const int col0 = u.pn * BM + wc * 32 + 8 * fq;
        bf16_t* Oz = O + (size_t)u.z * zstride;
#pragma unroll
        for (int ai = 0; ai < 2; ++ai)
#pragma unroll
            for (int m2 = 0; m2 < 2; ++m2) { u32x4 g[2][2];
#pragma unroll
                for (int mm = 0; mm < 2; ++mm)
#pragma unroll
                    for (int bj = 0; bj < 2; ++bj) g[mm][bj] = *(const u32x4*)(PG + (size_t)(row0 + ai * HALF + (2 * m2 + mm) * 16) * ldg + (size_t)u.z * 2048 + col0 + bj * HALF);
#pragma unroll
                for (int mm = 0; mm < 2; ++mm)
#pragma unroll
                    for (int bj = 0; bj < 2; ++bj) { const int m = 2 * m2 + mm; const u32x4 gg = g[mm][bj];
                        f32x4 v0 = acc[ai][bj][m][0], v1 = acc[ai][bj][m][1];
                        v0[0] *= fsigmoid(__uint_as_float(gg.x << 16)); v0[1] *= fsigmoid(__uint_as_float(gg.x & 0xffff0000u));
                        v0[2] *= fsigmoid(__uint_as_float(gg.y << 16)); v0[3] *= fsigmoid(__uint_as_float(gg.y & 0xffff0000u));
                        v1[0] *= fsigmoid(__uint_as_float(gg.z << 16)); v1[1] *= fsigmoid(__uint_as_float(gg.z & 0xffff0000u));
                        v1[2] *= fsigmoid(__uint_as_float(gg.w << 16)); v1[3] *= fsigmoid(__uint_as_float(gg.w & 0xffff0000u));
                        u32x4 w; w.x = cvt_pk_bf16(v0[0], v0[1]); w.y = cvt_pk_bf16(v0[2], v0[3]); w.z = cvt_pk_bf16(v1[0], v1[1]); w.w = cvt_pk_bf16(v1[2], v1[3]);
                        *(u32x4*)(Oz + (size_t)(row0 + ai * HALF + m * 16) * ldc + col0 + bj * HALF) = w; } }
    }
};
struct EpiGateAcc {
    static constexpr bool PERM = true;
    const bf16_t* PG; int ldg; bf16_t* O; int ldc;
    __device__ __forceinline__ void operator()(const f32x4 (&acc)[2][2][4][2], const Unit& u, int wr, int wc, int fr, int fq) const {
        const int row0 = u.pm * BM + wr * 64 + fr; const int col0 = u.pn * BM + wc * 32 + 8 * fq;
        const bool first = u.z == 0;
#pragma unroll
        for (int ai = 0; ai < 2; ++ai)
#pragma unroll
            for (int m2 = 0; m2 < 2; ++m2) { u32x4 g[2][2], p[2][2];
#pragma unroll
                for (int mm = 0; mm < 2; ++mm)
#pragma unroll
                    for (int bj = 0; bj < 2; ++bj) { const size_t row = (size_t)(row0 + ai * HALF + (2 * m2 + mm) * 16);
                        g[mm][bj] = *(const u32x4*)(PG + row * ldg + (size_t)u.z * 2048 + col0 + bj * HALF);
                        p[mm][bj] = (u32x4){0u, 0u, 0u, 0u};
                        if (!first) p[mm][bj] = *(const u32x4*)(O + row * ldc + col0 + bj * HALF); }
#pragma unroll
                for (int mm = 0; mm < 2; ++mm)
#pragma unroll
                    for (int bj = 0; bj < 2; ++bj) { const int m = 2 * m2 + mm; const u32x4 gg = g[mm][bj], pp = p[mm][bj];
                        f32x4 v0 = acc[ai][bj][m][0], v1 = acc[ai][bj][m][1];
                        v0[0] = v0[0] * fsigmoid(__uint_as_float(gg.x << 16)) + __uint_as_float(pp.x << 16); v0[1] = v0[1] * fsigmoid(__uint_as_float(gg.x & 0xffff0000u)) + __uint_as_float(pp.x & 0xffff0000u);
                        v0[2] = v0[2] * fsigmoid(__uint_as_float(gg.y << 16)) + __uint_as_float(pp.y << 16); v0[3] = v0[3] * fsigmoid(__uint_as_float(gg.y & 0xffff0000u)) + __uint_as_float(pp.y & 0xffff0000u);
                        v1[0] = v1[0] * fsigmoid(__uint_as_float(gg.z << 16)) + __uint_as_float(pp.z << 16); v1[1] = v1[1] * fsigmoid(__uint_as_float(gg.z & 0xffff0000u)) + __uint_as_float(pp.z & 0xffff0000u);
                        v1[2] = v1[2] * fsigmoid(__uint_as_float(gg.w << 16)) + __uint_as_float(pp.w << 16); v1[3] = v1[3] * fsigmoid(__uint_as_float(gg.w & 0xffff0000u)) + __uint_as_float(pp.w & 0xffff0000u);
                        u32x4 w; w.x = cvt_pk_bf16(v0[0], v0[1]); w.y = cvt_pk_bf16(v0[2], v0[3]); w.z = cvt_pk_bf16(v1[0], v1[1]); w.w = cvt_pk_bf16(v1[2], v1[3]);
                        *(u32x4*)(O + (size_t)(row0 + ai * HALF + m * 16) * ldc + col0 + bj * HALF) = w; }
                asm volatile("" ::: "memory"); }
    }
};
struct EpiGate {
    static constexpr bool PERM = true;
    const bf16_t* PG; int ldg;
    float* F; bf16_t* O; int ldc;
    __device__ __forceinline__ void operator()(const f32x4 (&acc)[2][2][4][2], const Unit& u, int wr, int wc, int fr, int fq) const {
        const int row0 = u.pm * BM + wr * 64 + fr; const int col0 = u.pn * BM + wc * 32 + 8 * fq;
#pragma unroll
        for (int ai = 0; ai < 2; ++ai)
#pragma unroll
            for (int m = 0; m < 4; ++m) { const size_t row = (size_t)(row0 + ai * HALF + m * 16);
                u32x4 g[2]; f32x4 f0[2], f1[2];
#pragma unroll
                for (int bj = 0; bj < 2; ++bj) { const int col = col0 + bj * HALF; g[bj] = *(const u32x4*)(PG + row * ldg + (size_t)u.z * 2048 + col);
                    f0[bj] = (f32x4){0.f, 0.f, 0.f, 0.f}; f1[bj] = f0[bj];
                    if (u.z > 0) { const float* fp = F + row * ldc + col; f0[bj] = *(const f32x4*)fp; f1[bj] = *(const f32x4*)(fp + 4); } }
#pragma unroll
                for (int bj = 0; bj < 2; ++bj) { const int col = col0 + bj * HALF;
                    f32x4 v0 = acc[ai][bj][m][0], v1 = acc[ai][bj][m][1];
                    v0[0] *= fsigmoid(__uint_as_float(g[bj].x << 16)); v0[1] *= fsigmoid(__uint_as_float(g[bj].x & 0xffff0000u));
                    v0[2] *= fsigmoid(__uint_as_float(g[bj].y << 16)); v0[3] *= fsigmoid(__uint_as_float(g[bj].y & 0xffff0000u));
                    v1[0] *= fsigmoid(__uint_as_float(g[bj].z << 16)); v1[1] *= fsigmoid(__uint_as_float(g[bj].z & 0xffff0000u));
                    v1[2] *= fsigmoid(__uint_as_float(g[bj].w << 16)); v1[3] *= fsigmoid(__uint_as_float(g[bj].w & 0xffff0000u));
                    v0 += f0[bj]; v1 += f1[bj];
                    float* fp = F + row * ldc + col;
                    if (u.z < 2) { *(f32x4*)fp = v0; *(f32x4*)(fp + 4) = v1; }
                    else { u32x4 w; w.x = cvt_pk_bf16(v0[0], v0[1]); w.y = cvt_pk_bf16(v0[2], v0[3]); w.z = cvt_pk_bf16(v1[0], v1[1]); w.w = cvt_pk_bf16(v1[2], v1[3]);
                           *(u32x4*)(O + row * ldc + col) = w; } } }
    }
};
struct EpiResid {
    static constexpr bool PERM = false;
    const float* Xin; float* Xout; int ldc;
    __device__ __forceinline__ void operator()(const f32x4 (&acc)[2][2][4][2], const Unit& u, int wr, int wc, int fr, int fq) const {
        const int row0 = u.pm * BM + wr * 64 + fr, col0 = u.pn * BM + wc * 32 + 4 * fq;
#pragma unroll
        for (int ai = 0; ai < 2; ++ai)
#pragma unroll
            for (int m = 0; m < 4; ++m) { f32x4 t[2][2]; const size_t ro = (size_t)(row0 + ai * HALF + m * 16) * ldc + col0;
#pragma unroll
                for (int bj = 0; bj < 2; ++bj)
#pragma unroll
                    for (int n = 0; n < 2; ++n) t[bj][n] = *(const f32x4*)(Xin + ro + bj * HALF + n * 16);
#pragma unroll
                for (int bj = 0; bj < 2; ++bj)
#pragma unroll
                    for (int n = 0; n < 2; ++n) *(f32x4*)(Xout + ro + bj * HALF + n * 16) = t[bj][n] + acc[ai][bj][m][n];
                asm volatile("" ::: "memory"); }
    }
};

struct EpiResidSrc {
    static constexpr bool PERM = false;
    const float* meta; const float* xp; const float* xs; float* Xout; int ldc;
    __device__ __forceinline__ void operator()(const f32x4 (&acc)[2][2][4][2], const Unit& u, int wr, int wc, int fr, int fq) const {
        const int row0 = u.pm * BM + wr * 64 + fr, col0 = u.pn * BM + wc * 32 + 4 * fq;
#pragma unroll
        for (int ai = 0; ai < 2; ++ai)
#pragma unroll
            for (int m = 0; m < 4; ++m) { f32x4 t[2][2]; const int row = row0 + ai * HALF + m * 16; const size_t ro = (size_t)row * ldc + col0;
                const float* src = x0_row(meta, xp, xs, row) + col0;
#pragma unroll
                for (int bj = 0; bj < 2; ++bj)
#pragma unroll
                    for (int n = 0; n < 2; ++n) t[bj][n] = *(const f32x4*)(src + bj * HALF + n * 16);
#pragma unroll
                for (int bj = 0; bj < 2; ++bj)
#pragma unroll
                    for (int n = 0; n < 2; ++n) *(f32x4*)(Xout + ro + bj * HALF + n * 16) = t[bj][n] + acc[ai][bj][m][n];
                asm volatile("" ::: "memory"); }
    }
};

template <int MODE>
__device__ __forceinline__ void split_reduce(const int wid, float* X, bf16_t* U, int ldc, const StreamX sx, int pm, int pn, int nN, int NP) {
    const int lane = hw_lane(), tid = wid * 64 + lane, wr = wid >> 2, wc = wid & 3, fr = lane & 15, fq = lane >> 4;
    if (wid == 0) {
#pragma unroll 1
        for (int j = 0; j < NP; ++j) { unsigned sp = 0;
            while ((unsigned)__builtin_amdgcn_readfirstlane(__hip_atomic_load(sx.flags + 64 * (pn + nN * j), __ATOMIC_RELAXED, __HIP_MEMORY_SCOPE_AGENT)) != 1u) {
                __builtin_amdgcn_s_sleep(1);
                if ((++sp & 255u) == 0u) { if (__builtin_amdgcn_readfirstlane(__hip_atomic_load(sx.tmo, __ATOMIC_RELAXED, __HIP_MEMORY_SCOPE_AGENT))) break; if (sp > (1u << 20)) { if (lane == 0) __hip_atomic_store(sx.tmo, 1u, __ATOMIC_RELAXED, __HIP_MEMORY_SCOPE_AGENT); break; } } } }
        __builtin_amdgcn_fence(__ATOMIC_ACQUIRE, "agent"); asm volatile("s_waitcnt vmcnt(0)" ::: "memory"); }
    __syncthreads();
    const float* s0 = sx.slots + (size_t)pn * 65536 + tid * 32; const size_t jstride = (size_t)nN * 65536;
#pragma unroll 2
    for (int am = 0; am < 16; ++am) {
        const int a = am >> 3, b = (am >> 2) & 1, m = am & 3;
        f32x4 v0 = (f32x4){0.f, 0.f, 0.f, 0.f}, v1 = v0;
        const float* p = s0 + (am >> 2) * 16384 + (am & 3) * 8;
#pragma unroll 4
        for (int j = 0; j < NP; ++j) { v0 += *(const f32x4*)(p + j * jstride); v1 += *(const f32x4*)(p + j * jstride + 4); }
        const size_t row = (size_t)(pm * BM + a * HALF + wr * 64 + m * 16 + fr);
        if (MODE == 0) { float* xp = X + row * ldc + pn * BM + b * HALF + wc * 32 + 4 * fq;
            *(f32x4*)xp = *(const f32x4*)xp + v0; *(f32x4*)(xp + 16) = *(const f32x4*)(xp + 16) + v1; }
        else {
#pragma unroll
            for (int e = 0; e < 4; ++e) { const float x0 = fmaxf(v0[e], 0.f), x1 = fmaxf(v1[e], 0.f); v0[e] = x0 * x0; v1[e] = x1 * x1; }
            u32x4 w; w.x = cvt_pk_bf16(v0[0], v0[1]); w.y = cvt_pk_bf16(v0[2], v0[3]); w.z = cvt_pk_bf16(v1[0], v1[1]); w.w = cvt_pk_bf16(v1[2], v1[3]);
            *(u32x4*)(U + row * ldc + pn * BM + b * HALF + wc * 32 + 8 * fq) = w; }
    }
    __syncthreads();
}

template <class Epi, class Sched, class GemmT>
__device__ __forceinline__ void gemm_phase(LAS unsigned char* lds, const int wid, const GemmT g, const Sched& S, const Epi& E, const StreamX sx = StreamX{nullptr, nullptr, nullptr}) {
    const int lane = hw_lane(), tid = wid * 64 + lane, wr = wid >> 2, wc = wid & 3, fr = lane & 15, fq = lane >> 4;
    constexpr int K = GemmT::K, nt = K / BK;
    unsigned voffA[2], voffB[2];
#pragma unroll
    for (int i = 0; i < 2; ++i) { int R, C; stage_rc(tid * 16 + i * 8192, R, C); const int Rb = Epi::PERM ? ((R & ~31) + perm32(R & 31)) : R;
        voffA[i] = (unsigned)(R * GemmT::lda + C) * 2u; voffB[i] = (unsigned)(Rb * GemmT::ldb + C) * 2u; }
    constexpr size_t kstep = (size_t)(BK * 2);
    constexpr size_t hstepA = (size_t)HALF * GemmT::lda * 2, hstepB = (size_t)HALF * GemmT::ldb * 2;
    constexpr size_t tstepA = 2 * hstepA, tstepB = 2 * hstepB;
    const unsigned ldsw = (unsigned)wid * 1024u;
    const int aoff = lds_byte(wr * 64 + fr, fq * 8), boff = lds_byte(wc * 32 + fr, fq * 8);
#define PG8_SA(b, h) (((b) * 2 + (h)) * HTB)
#define PG8_SB(b, h) ((4 + (b) * 2 + (h)) * HTB)
#define PG8_STAGE(bufoff, gbase, voff) do { _Pragma("unroll") for (int _i = 0; _i < 2; ++_i) \
        __builtin_amdgcn_global_load_lds((const unsigned*)((const char*)(gbase) + (voff)[_i]), (LAS unsigned*)(lds + (bufoff) + ldsw + _i * 8192), 16, 0, 0); } while (0)
#define PG8_LDA(dst, b, h) do { _Pragma("unroll") for (int m = 0; m < 4; ++m) _Pragma("unroll") for (int k = 0; k < 2; ++k) dst[m][k] = *(const LAS bf16x8*)(lds + PG8_SA(b, h) + aoff + m * 2048 + k * 1024); } while (0)
#define PG8_LDB(dst, b, h) do { _Pragma("unroll") for (int n = 0; n < 2; ++n) _Pragma("unroll") for (int k = 0; k < 2; ++k) dst[n][k] = *(const LAS bf16x8*)(lds + PG8_SB(b, h) + boff + n * 2048 + k * 1024); } while (0)
#define PG8_MMA(ai, bj, At, Bt) do { __builtin_amdgcn_s_setprio(1); _Pragma("unroll") for (int m = 0; m < 4; ++m) _Pragma("unroll") for (int n = 0; n < 2; ++n) _Pragma("unroll") for (int k = 0; k < 2; ++k) \
        acc[ai][bj][m][n] = __builtin_amdgcn_mfma_f32_16x16x32_bf16(Bt[n][k], At[m][k], acc[ai][bj][m][n], 0, 0, 0); __builtin_amdgcn_s_setprio(0); } while (0)
#define PG8_WAIT_V(n) asm volatile("s_waitcnt vmcnt(" #n ")" ::: "memory")
#define PG8_WAIT_L(n) asm volatile("s_waitcnt lgkmcnt(" #n ")" ::: "memory")
#define PG8_BAR __builtin_amdgcn_s_barrier()
#define PG8_SCHED __builtin_amdgcn_sched_barrier(0)
    Unit cur, nxt; int ui = 0;
    if (!S.next(0, cur)) return;
    f32x4 acc[2][2][4][2];
#pragma unroll
    for (int a = 0; a < 2; ++a)
#pragma unroll
        for (int b = 0; b < 2; ++b)
#pragma unroll
            for (int m = 0; m < 4; ++m)
#pragma unroll
                for (int n = 0; n < 2; ++n) acc[a][b][m][n] = (f32x4){0.f, 0.f, 0.f, 0.f};
    bf16x8 At[4][2], B0[2][2], B1[2][2];
    const char* cA = (const char*)g.A + (size_t)cur.pm * tstepA + (size_t)cur.z * GemmT::zsA + (size_t)cur.kb * kstep; const char* cB = (const char*)g.Bt + (size_t)cur.pn * tstepB + (size_t)cur.z * GemmT::zsB + (size_t)cur.kb * kstep;
    PG8_STAGE(PG8_SB(0, 0), cB, voffB); PG8_STAGE(PG8_SB(0, 1), cB + hstepB, voffB); PG8_STAGE(PG8_SA(0, 0), cA, voffA); PG8_STAGE(PG8_SA(0, 1), cA + hstepA, voffA);
    if (wr == 1) PG8_BAR;
    PG8_WAIT_V(2); PG8_BAR;
    PG8_STAGE(PG8_SB(1, 0), cB + kstep, voffB); PG8_STAGE(PG8_SA(1, 0), cA + kstep, voffA); PG8_STAGE(PG8_SB(1, 1), cB + hstepB + kstep, voffB);
    PG8_WAIT_V(6); PG8_BAR;
    for (;;) {
        const bool has_next = S.next(ui + 1, nxt);
        const char* nA = has_next ? (const char*)g.A + (size_t)nxt.pm * tstepA + (size_t)nxt.z * GemmT::zsA + (size_t)nxt.kb * kstep : cA;
        const char* nB = has_next ? (const char*)g.Bt + (size_t)nxt.pn * tstepB + (size_t)nxt.z * GemmT::zsB + (size_t)nxt.kb * kstep : cB;
        const int ntu = Sched::STREAM ? cur.kn : nt;
        for (int t = 0; t < ntu; t += 2) {
            const bool last = (t == ntu - 2);
            const char* a1 = cA + (size_t)(t + 1) * kstep;
            const char* a2 = last ? nA : cA + (size_t)(t + 2) * kstep; const char* b2 = last ? nB : cB + (size_t)(t + 2) * kstep;
            const char* a3 = a2 + kstep; const char* b3 = b2 + kstep;
            PG8_LDB(B0, 0, 0); PG8_LDB(B1, 0, 1); PG8_SCHED; PG8_LDA(At, 0, 0); PG8_STAGE(PG8_SA(1, 1), a1 + hstepA, voffA);
            PG8_WAIT_V(8); PG8_WAIT_L(0); PG8_BAR; PG8_MMA(0, 0, At, B0); PG8_MMA(0, 1, At, B1); PG8_BAR; PG8_SCHED;
            PG8_LDA(At, 0, 1); PG8_STAGE(PG8_SB(0, 0), b2, voffB); PG8_STAGE(PG8_SB(0, 1), b2 + hstepB, voffB); PG8_STAGE(PG8_SA(0, 0), a2, voffA);
            PG8_WAIT_V(8); PG8_WAIT_L(0); PG8_BAR; PG8_MMA(1, 0, At, B0); PG8_MMA(1, 1, At, B1); PG8_BAR; PG8_SCHED;
            PG8_LDB(B0, 1, 0); PG8_LDB(B1, 1, 1); PG8_SCHED; PG8_LDA(At, 1, 0); PG8_STAGE(PG8_SA(0, 1), a2 + hstepA, voffA);
            PG8_WAIT_V(8); PG8_WAIT_L(0); PG8_BAR; PG8_MMA(0, 0, At, B0); PG8_MMA(0, 1, At, B1); PG8_BAR; PG8_SCHED;
            PG8_LDA(At, 1, 1); PG8_STAGE(PG8_SB(1, 0), b3, voffB); PG8_STAGE(PG8_SB(1, 1), b3 + hstepB, voffB); PG8_STAGE(PG8_SA(1, 0), a3, voffA);
            PG8_WAIT_V(8); PG8_WAIT_L(0); PG8_BAR; PG8_MMA(1, 0, At, B0); PG8_MMA(1, 1, At, B1); PG8_BAR; PG8_SCHED;
        }
        if (wr == 0) PG8_BAR;
        const int lane_e = hw_lane(), tid_e = wid * 64 + lane_e, fr_e = lane_e & 15, fq_e = lane_e >> 4;
        if (Sched::STREAM && cur.role == 1) {
            const __amdgpu_buffer_rsrc_t rs = __builtin_amdgcn_make_buffer_rsrc(sx.slots, 0, 256 * 65536 * 4, 0x00020000);
            const unsigned sbase = (unsigned)S.c * 262144u + (unsigned)tid_e * 128u;
#pragma unroll
            for (int a = 0; a < 2; ++a)
#pragma unroll
                for (int b = 0; b < 2; ++b)
#pragma unroll
                    for (int m = 0; m < 4; ++m)
#pragma unroll
                        for (int n = 0; n < 2; ++n) { constexpr int dummy = 0; const int k = ((a * 2 + b) * 4 + m) * 2 + n;
                            __builtin_amdgcn_raw_buffer_store_b128(__builtin_bit_cast(u32x4, acc[a][b][m][n]), rs, sbase + (unsigned)((k >> 3) * 65536), (k & 7) * 16 + dummy, 16); }
            asm volatile("s_waitcnt vmcnt(0)" ::: "memory"); PG8_BAR; asm volatile("" ::: "memory");
            if (tid_e == 0) __hip_atomic_store(sx.flags + 64 * S.c, 1u, __ATOMIC_RELAXED, __HIP_MEMORY_SCOPE_AGENT);
        } else {
            E(acc, cur, wr, wc, fr_e, fq_e);
        }
        if (!has_next) break;
        if (Sched::STREAM && nxt.role == 2) {
            if (wid == 0) { unsigned sp = 0;
                while ((unsigned)__builtin_amdgcn_readfirstlane(__hip_atomic_load(sx.flags + 64 * (S.c + 1), __ATOMIC_RELAXED, __HIP_MEMORY_SCOPE_AGENT)) != 1u) {
                    __builtin_amdgcn_s_sleep(1);
                    if ((++sp & 255u) == 0u) { if (__builtin_amdgcn_readfirstlane(__hip_atomic_load(sx.tmo, __ATOMIC_RELAXED, __HIP_MEMORY_SCOPE_AGENT))) break; if (sp > (1u << 20)) { if (lane == 0) __hip_atomic_store(sx.tmo, 1u, __ATOMIC_RELAXED, __HIP_MEMORY_SCOPE_AGENT); break; } } }
                __builtin_amdgcn_fence(__ATOMIC_ACQUIRE, "agent"); asm volatile("s_waitcnt vmcnt(0)" ::: "memory"); }
            asm volatile("" ::: "memory"); PG8_BAR; asm volatile("" ::: "memory");
            const float* ps = sx.slots + (size_t)(S.c + 1) * 65536 + tid * 32;
#pragma unroll
            for (int a = 0; a < 2; ++a)
#pragma unroll
                for (int b = 0; b < 2; ++b)
#pragma unroll
                    for (int m = 0; m < 4; ++m)
#pragma unroll
                        for (int n = 0; n < 2; ++n) { const int k = ((a * 2 + b) * 4 + m) * 2 + n; acc[a][b][m][n] = *(const f32x4*)(ps + (k >> 3) * 16384 + (k & 7) * 4); }
        } else {
#pragma unroll
        for (int a = 0; a < 2; ++a)
#pragma unroll
            for (int b = 0; b < 2; ++b)
#pragma unroll
                for (int m = 0; m < 4; ++m)
#pragma unroll
                    for (int n = 0; n < 2; ++n) acc[a][b][m][n] = (f32x4){0.f, 0.f, 0.f, 0.f};
        }
        cur = nxt; cA = nA; cB = nB; ++ui;
        if (wr == 1) PG8_BAR;
    }
    PG8_WAIT_V(0);
    PG8_BAR;
#undef PG8_SA
#undef PG8_SB
#undef PG8_STAGE
#undef PG8_LDA
#undef PG8_LDB
#undef PG8_MMA
#undef PG8_WAIT_V
#undef PG8_WAIT_L
#undef PG8_BAR
#undef PG8_SCHED
}
}

constexpr int NWAVES = 8, NTHR = 512;
constexpr int LDS_BYTES = 147456;
constexpr int LDS_MISC = 131072;
constexpr int NPHASE = 22;

struct Params {
    const float* in[38];
    float* out;
    unsigned char* ws;
    int ph_lo, ph_hi;
};
struct Ctx {
    float* out; unsigned char* ws;
    LAS unsigned char* lds;
    int tid, lane, wave, G, bid;
};
__device__ __forceinline__ const float* inp(const Ctx& c, int i);
enum { I_XP = 0, I_XS, I_SC, I_SN, I_SM, I_SGS, I_SGC, I_SRS, I_SRSH, I_META, I_NMIX, I_WIN, I_BI, I_BF, I_MNW, I_CONVW, I_ALOG, I_DTB, I_GNW, I_MU, I_W0, I_W2, I_A0, I_A2, I_G2,
       I_KK, I_KA, I_RK, I_LNW, I_LNB, I_WBA, I_WBB, I_WBC, I_WOUT, I_NMLP, I_WUP, I_WDN, I_FNW };

__device__ __forceinline__ const float* inp(const Ctx& c, int i) {
    const LAS unsigned* t = (const LAS unsigned*)(c.lds + LDS_MISC + 64) + 2 * i;
    const unsigned lo = __builtin_amdgcn_readfirstlane(t[0]), hi = __builtin_amdgcn_readfirstlane(t[1]);
    typedef const float __attribute__((address_space(1)))* gptr_t;
    return (const float*)(gptr_t)(((unsigned long long)hi << 32) | lo);
}
__device__ __forceinline__ void transpose_item(const float* W, int K, int Nsrc, int src_col, bf16_t* WT, int dst_row, int k0, LAS float* scr, int lane) {
    float v[32];
    const float* src = W + (size_t)(k0 + (lane >> 5)) * Nsrc + src_col + (lane & 31);
#pragma unroll
    for (int i = 0; i < 32; ++i) v[i] = src[(size_t)(2 * i) * Nsrc];
#pragma unroll
    for (int i = 0; i < 32; ++i) scr[(2 * i + (lane >> 5)) * 33 + (lane & 31)] = v[i];
    asm volatile("s_waitcnt lgkmcnt(0)" ::: "memory");
    const int c = lane & 7;
#pragma unroll
    for (int j = 0; j < 4; ++j) { const int n = (lane >> 3) + 8 * j; const LAS float* s = scr + (8 * c) * 33 + n;
        u32x4 o; o.x = pk2(s[0 * 33], s[1 * 33]); o.y = pk2(s[2 * 33], s[3 * 33]); o.z = pk2(s[4 * 33], s[5 * 33]); o.w = pk2(s[6 * 33], s[7 * 33]);
        *(u32x4*)(WT + (size_t)(dst_row + n) * K + k0 + 8 * c) = o; }
    asm volatile("s_waitcnt lgkmcnt(0)" ::: "memory");
}
__device__ __forceinline__ int win_src_col(int n) {
    return n < 4096 ? n : (n < 8192 ? n + 8 : (n < 11520 ? n + 24 : n + 24));
}
constexpr int CI_IN = 32 * (NPROJ / 32), CI_BR = 16 * 64, CI_O = 32 * 64, CI_U = 32 * 256, CI_D = 128 * 64;
constexpr int CO_BR = CI_IN, CO_O = CO_BR + 3 * CI_BR, CO_U = CO_O + CI_O, CO_D = CO_U + CI_U, C_PER_L = CO_D + CI_D;
#ifndef TAILCONV
#define TAILCONV 1
#endif
#if TAILCONV
constexpr int PREP_L0_END = CO_BR, PREP_L1_BEG = 0, PREP_L1_END = 0;
constexpr int WIN1_SEQ = 6144, WIN1_G4 = 8192;
constexpr int WBR_G1 = 1728, WBR_DYN = 3 * CI_BR - WBR_G1;
#else
constexpr int PREP_L0_END = C_PER_L, PREP_L1_BEG = 0, PREP_L1_END = C_PER_L, WBR_G1 = 0, WBR_DYN = 0;
#endif
__device__ __forceinline__ void convert_one(const Ctx& c0, const int l, const int it) {
    Ctx c = c0; c.lane = hw_lane();
    LAS float* scr = (LAS float*)(c.lds + c.wave * 16384);
    {
        int r = it;
        const float* W; bf16_t* WT; int K, Nsrc, scol, drow, k0;
        if (r < CI_IN) { const int nblk = NPROJ / 32, kb = r / nblk, nb = r % nblk;
            W = inp(c, I_WIN) + (size_t)l * D * NIN; K = D; Nsrc = NIN; scol = win_src_col(32 * nb); WT = (bf16_t*)(c.ws + WS_WIN) + (size_t)l * NPROJ * D; drow = 32 * nb; k0 = 64 * kb; }
        else if ((r -= CI_IN) < 3 * CI_BR) { const int br = r / CI_BR, rr = r % CI_BR, kb = rr / 64, nb = rr % 64;
            W = (br == 0 ? inp(c, I_WBA) : br == 1 ? inp(c, I_WBB) : inp(c, I_WBC)) + (size_t)l * 1024 * D; K = 1024; Nsrc = D; scol = 32 * nb; WT = (bf16_t*)(c.ws + WS_WBR) + ((size_t)l * 3 + br) * D * 1024; drow = 32 * nb; k0 = 64 * kb; }
        else if ((r -= 3 * CI_BR) < CI_O) { const int kb = r / 64, nb = r % 64;
            W = inp(c, I_WOUT) + (size_t)l * D * D; K = D; Nsrc = D; scol = 32 * nb; WT = (bf16_t*)(c.ws + WS_WOUT) + (size_t)l * D * D; drow = 32 * nb; k0 = 64 * kb; }
        else if ((r -= CI_O) < CI_U) { const int kb = r / 256, nb = r % 256;
            W = inp(c, I_WUP) + (size_t)l * D * DFF; K = D; Nsrc = DFF; scol = 32 * nb; WT = (bf16_t*)(c.ws + WS_WUP) + (size_t)l * DFF * D; drow = 32 * nb; k0 = 64 * kb; }
        else { r -= CI_U; const int kb = r / 64, nb = r % 64;
            W = inp(c, I_WDN) + (size_t)l * DFF * D; K = DFF; Nsrc = D; scol = 32 * nb; WT = (bf16_t*)(c.ws + WS_WDN) + (size_t)l * D * DFF; drow = 32 * nb; k0 = 64 * kb; }
        int ln = c.lane; asm volatile("" : "+v"(ln));
        transpose_item(W, K, Nsrc, scol, WT, drow, k0, scr, ln);
    }
}
__device__ __forceinline__ void convert_items(const Ctx& c0, const int l, const int r0, const int r1, const int b0) {
    if (c0.bid < b0) return;
    const int gw = (c0.bid - b0) * NWAVES + c0.wave, NGW = (c0.G - b0) * NWAVES;
#pragma unroll 1
    for (int it = r0 + gw; it < r1; it += NGW) convert_one(c0, l, it);
}
__device__ __forceinline__ void phase_prep(const Ctx& c0) {
    Ctx c = c0; c.lane = hw_lane(); c.tid = c.wave * 64 + c.lane;
    const int gw = c.bid * NWAVES + c.wave, NGW = c.G * NWAVES;
    convert_items(c0, 0, 0, PREP_L0_END, 0);
    convert_items(c0, 1, PREP_L1_BEG, PREP_L1_END, 0);
    float* wsg = (float*)(c.ws + WS_WSG);
    for (int i = c.bid * NTHR + c.tid; i < 2 * NSG * D; i += c.G * NTHR) {
        const int l = i / (NSG * D), r = i % (NSG * D), j = r / D, k = r % D;
        const int col = j < 8 ? 4096 + j : 8200 + (j - 8);
        wsg[i] = inp(c, I_WIN)[((size_t)l * D + k) * NIN + col];
    }
}

template <bool GATES>
__device__ __forceinline__ void phase_norm(const Ctx& c0, const float* w, const float* wsg) {
    Ctx c = c0; c.lane = hw_lane(); c.tid = c.wave * 64 + c.lane;
    const int gw = c.bid * NWAVES + c.wave, NGW = c.G * NWAVES;
    const float* X = (const float*)(c.ws + WS_X); bf16_t* HN = (bf16_t*)(c.ws + WS_HN); float* SG = (float*)(c.ws + WS_SG);
    f32x4 wv[8];
#pragma unroll
    for (int j = 0; j < 8; ++j) wv[j] = ((const f32x4*)w)[c.lane + 64 * j];
    for (int row = gw; row < MP; row += 2 * NGW) {
        const int row1 = row + NGW; const bool two = row1 < MP;
        const f32x4* xr0 = (const f32x4*)(X + (size_t)row * D) + c.lane; const f32x4* xr1 = (const f32x4*)(X + (size_t)(two ? row1 : row) * D) + c.lane;
        f32x4 v0[8], v1[8]; float s0 = 0.f, s1 = 0.f;
#pragma unroll
        for (int j = 0; j < 8; ++j) { v0[j] = xr0[64 * j]; v1[j] = xr1[64 * j]; }
#pragma unroll
        for (int j = 0; j < 8; ++j) { s0 += (v0[j].x * v0[j].x + v0[j].y * v0[j].y) + (v0[j].z * v0[j].z + v0[j].w * v0[j].w); s1 += (v1[j].x * v1[j].x + v1[j].y * v1[j].y) + (v1[j].z * v1[j].z + v1[j].w * v1[j].w); }
        const float r0 = rsqrtf(wave_sum(s0) * (1.f / D) + 1e-6f), r1 = rsqrtf(wave_sum(s1) * (1.f / D) + 1e-6f);
        u32x2* o0 = (u32x2*)(HN + (size_t)row * D) + c.lane; u32x2* o1 = (u32x2*)(HN + (size_t)(two ? row1 : row) * D) + c.lane;
#pragma unroll
        for (int j = 0; j < 8; ++j) { v0[j] = v0[j] * r0 * wv[j]; v1[j] = v1[j] * r1 * wv[j];
            u32x2 o; o.x = pk2(v0[j].x, v0[j].y); o.y = pk2(v0[j].z, v0[j].w); o0[64 * j] = o;
            if (two) { o.x = pk2(v1[j].x, v1[j].y); o.y = pk2(v1[j].z, v1[j].w); o1[64 * j] = o; } }
        if (GATES) {
#pragma unroll 1
            for (int g0 = 0; g0 < NSG; g0 += 2) {
                f32x4 q[2][8];
#pragma unroll
                for (int gg = 0; gg < 2; ++gg)
#pragma unroll
                    for (int j = 0; j < 8; ++j) q[gg][j] = ((const f32x4*)(wsg + (size_t)(g0 + gg) * D))[c.lane + 64 * j];
#pragma unroll
                for (int gg = 0; gg < 2; ++gg) { float a0 = 0.f, a1 = 0.f;
#pragma unroll
                    for (int j = 0; j < 8; ++j) { a0 += (v0[j].x * q[gg][j].x + v0[j].y * q[gg][j].y) + (v0[j].z * q[gg][j].z + v0[j].w * q[gg][j].w);
                                                  a1 += (v1[j].x * q[gg][j].x + v1[j].y * q[gg][j].y) + (v1[j].z * q[gg][j].z + v1[j].w * q[gg][j].w); }
                    a0 = wave_sum(a0); a1 = wave_sum(a1);
                    if (c.lane == 0) { SG[(size_t)row * SGLD + g0 + gg] = a0; if (two) SG[(size_t)row1 * SGLD + g0 + gg] = a1; } }
            }
        }
    }
}
constexpr int NR1 = 5;
template <int NV>
__device__ __forceinline__ void norm_gate_group(const f32x4 (&v)[NR1][8], const LAS f32x4* gb, float* SG, const int (&rows)[NR1], int g0, int lane) {
#pragma unroll 1
    for (int g = 0; g < 4; ++g) {
        f32x2 a[NR1];
#pragma unroll
        for (int r = 0; r < NR1; ++r) a[r] = (f32x2){0.f, 0.f};
#pragma unroll
        for (int j = 0; j < 8; ++j) { const f32x4 q = gb[g * 512 + lane + 64 * j]; const f32x2 q01 = {q.x, q.y}, q23 = {q.z, q.w};
#pragma unroll
            for (int r = 0; r < NV; ++r) { const f32x2 v01 = {v[r][j].x, v[r][j].y}, v23 = {v[r][j].z, v[r][j].w};
                a[r] = __builtin_elementwise_fma(v01, q01, a[r]); a[r] = __builtin_elementwise_fma(v23, q23, a[r]); } }
#pragma unroll
        for (int r = 0; r < NV; ++r) { const float t = wave_sum(a[r].x + a[r].y); if (lane == 0) SG[(size_t)rows[r] * SGLD + g0 + g] = t; }
    }
}
template <bool FIRST>
__device__ __forceinline__ void phase_norm_gates(const Ctx& c0, const float* w, const float* wsg) {
    Ctx c = c0; c.lane = hw_lane(); c.tid = c.wave * 64 + c.lane;
    const int gw = c.bid * NWAVES + c.wave, NGW = c.G * NWAVES;
    const float* X = (const float*)(c.ws + WS_X); bf16_t* HN = (bf16_t*)(c.ws + WS_HN); float* SG = (float*)(c.ws + WS_SG);
    LAS f32x4* GB = (LAS f32x4*)c.lds;
    const f32x4* wsg4 = (const f32x4*)wsg;
    const float* xmeta = FIRST ? inp(c, I_META) : nullptr; const float* xprm = FIRST ? inp(c, I_XP) : nullptr; const float* xsmp = FIRST ? inp(c, I_XS) : nullptr;
#pragma unroll 1
    for (int base = 0; base < MP; base += NR1 * NGW) {
        int rows[NR1]; f32x4 v[NR1][8]; f32x4 st[4];
        int nv = 0;
#pragma unroll
        for (int r = 0; r < NR1; ++r) { const int row = base + r * NGW + gw; nv += row < MP ? 1 : 0; rows[r] = row < MP ? row : MP - 1; }
        nv = __builtin_amdgcn_readfirstlane(nv);
#pragma unroll
        for (int r = 0; r < NR1; ++r) { const f32x4* xr = (const f32x4*)(FIRST ? x0_row(xmeta, xprm, xsmp, rows[r]) : X + (size_t)rows[r] * D) + c.lane;
#pragma unroll
            for (int j = 0; j < 8; ++j) v[r][j] = xr[64 * j]; }
#pragma unroll
        for (int k = 0; k < 4; ++k) st[k] = wsg4[c.tid + 512 * k];
        float rs[NR1];
#pragma unroll
        for (int r = 0; r < NR1; ++r) { float s = 0.f;
#pragma unroll
            for (int j = 0; j < 8; ++j) s += (v[r][j].x * v[r][j].x + v[r][j].y * v[r][j].y) + (v[r][j].z * v[r][j].z + v[r][j].w * v[r][j].w);
            rs[r] = rsqrtf(wave_sum(s) * (1.f / D) + 1e-6f); }
#pragma unroll
        for (int j = 0; j < 8; ++j) { const f32x4 wj = ((const f32x4*)w)[c.lane + 64 * j];
#pragma unroll
            for (int r = 0; r < NR1; ++r) { v[r][j] = v[r][j] * rs[r] * wj;
                if (r < nv) { u32x2 p; p.x = pk2(v[r][j].x, v[r][j].y); p.y = pk2(v[r][j].z, v[r][j].w); ((u32x2*)(HN + (size_t)rows[r] * D) + c.lane)[64 * j] = p; } } }
#pragma unroll
        for (int k = 0; k < 4; ++k) GB[c.tid + 512 * k] = st[k];
        lds_barrier();
#pragma unroll 1
        for (int ch = 0; ch < NSG / 4; ++ch) {
            if (ch + 1 < NSG / 4) {
#pragma unroll
                for (int k = 0; k < 4; ++k) st[k] = wsg4[(ch + 1) * 2048 + c.tid + 512 * k]; }
            const LAS f32x4* gb = GB + (ch & 1) * 2048;
            if (NR1 >= 5 && nv == 5) norm_gate_group<(NR1 >= 5 ? 5 : 1)>(v, gb, SG, rows, 4 * ch, c.lane);
            else if (NR1 >= 4 && nv == 4) norm_gate_group<(NR1 >= 4 ? 4 : 1)>(v, gb, SG, rows, 4 * ch, c.lane);
            else if (nv == 3) norm_gate_group<3>(v, gb, SG, rows, 4 * ch, c.lane);
            else if (nv == 2) norm_gate_group<2>(v, gb, SG, rows, 4 * ch, c.lane);
            else if (nv == 1) norm_gate_group<1>(v, gb, SG, rows, 4 * ch, c.lane);
            if (ch + 1 < NSG / 4) {
#pragma unroll
                for (int k = 0; k < 4; ++k) GB[((ch + 1) & 1) * 2048 + c.tid + 512 * k] = st[k]; }
            lds_barrier();
        }
    }
}
__device__ __forceinline__ void final_rows(const Ctx& c0, const int r0, const int r1, const int gw, const int NGW) {
    Ctx c = c0; c.lane = hw_lane(); c.tid = c.wave * 64 + c.lane;
    const float* X = (const float*)(c.ws + WS_X); const float* w = inp(c, I_FNW);
    f32x4 wv[8];
#pragma unroll
    for (int j = 0; j < 8; ++j) wv[j] = ((const f32x4*)w)[c.lane + 64 * j];
    for (int row = r0 + gw; row < r1; row += NGW) {
        float* dst;
        if (row < MPROMPT) { const int b = row / TP, t = row % TP; if (t < NMETA) continue; dst = c.out + O_YP + ((size_t)b * SEQ + (t - NMETA)) * D; }
        else dst = c.out + O_YS + (size_t)(row - MPROMPT) * D;
        const f32x4* xr = (const f32x4*)(X + (size_t)row * D) + c.lane;
        f32x4 v[8]; float s = 0.f;
#pragma unroll
        for (int j = 0; j < 8; ++j) { v[j] = xr[64 * j]; s += (v[j].x * v[j].x + v[j].y * v[j].y) + (v[j].z * v[j].z + v[j].w * v[j].w); }
        const float rstd = rsqrtf(wave_sum(s) * (1.f / D) + 1e-6f);
#pragma unroll
        for (int j = 0; j < 8; ++j) ((f32x4*)dst)[c.lane + 64 * j] = v[j] * rstd * wv[j];
    }
}
#ifndef FIN_IN_TAIL
#define FIN_IN_TAIL 1
#endif
__device__ __forceinline__ void phase_final(const Ctx& c0) {
    const bool tail_did = FIN_IN_TAIL && c0.G == 256;
    final_rows(c0, tail_did ? 8192 : 0, MREAL, c0.bid * NWAVES + c0.wave, c0.G * NWAVES);
}

__device__ __forceinline__ void mlstm_unit(const Ctx& c0, int l, int seq, int h) {
    Ctx c = c0; c.lane = hw_lane(); c.tid = c.wave * 64 + c.lane;
    const int tid = c.tid, v = tid & 255, kh = c.wave >> 2;
    const bool prompt = seq < BATCH; const int T = prompt ? TP : 1; const int row0 = prompt ? seq * TP : MPROMPT + (seq - BATCH);
    const bf16_t* PROJ = (const bf16_t*)(c.ws + WS_PROJ); const float* SG = (const float*)(c.ws + WS_SG); bf16_t* YBR = (bf16_t*)(c.ws + WS_YBR);
    LAS float* sm = (LAS float*)c.lds; LAS float* qs = sm, *ks = sm + 256, *vs = sm + 512, *red = sm + 768, *misc = sm + 1280, *sc = sm + 1296;
    float C[128]; float nreg = 0.f, m = 0.f;
    float *oc, *on, *om;
    if (prompt) { oc = c.out + O_PC + (((size_t)l * BATCH + seq) * HA + h) * DHA * DHA; on = c.out + O_PN + (((size_t)l * BATCH + seq) * HA + h) * DHA; om = c.out + O_PM + ((size_t)l * BATCH + seq) * HA + h;
#pragma unroll
        for (int j = 0; j < 128; ++j) C[j] = 0.f;
    } else { const int s = seq - BATCH; const size_t u = ((size_t)l * NB + s) * HA + h;
        oc = c.out + O_SC + u * DHA * DHA; on = c.out + O_SN + u * DHA; om = c.out + O_SM + u;
        const float* ci = inp(c, I_SC) + u * DHA * DHA;
        { const float* cp = ci + ((size_t)(kh * 128) * 256 + v);
#pragma unroll
          for (int jj = 0; jj < 32; ++jj) { asm volatile("" : "+v"(cp)); C[4 * jj] = cp[0]; C[4 * jj + 1] = cp[256]; C[4 * jj + 2] = cp[512]; C[4 * jj + 3] = cp[768]; cp += 1024; } }
        if (tid < 256) nreg = inp(c, I_SN)[u * DHA + tid];
        m = inp(c, I_SM)[u];
    }
    const float bi = inp(c, I_BI)[l * HA + h], bfv = inp(c, I_BF)[l * HA + h];
    const float nw = tid < 256 ? inp(c, I_MNW)[l * 1024 + h * 256 + tid] : 0.f;
    for (int t = 0; t < T; ++t) {
        const size_t row = (size_t)(row0 + t); const bf16_t* prow = PROJ + row * NPROJ;
        if (tid < 256) { qs[tid] = bf2f(prow[PA_Q + h * 256 + tid]); ks[tid] = bf2f(prow[PA_K + h * 256 + tid]) * 0.0625f; vs[tid] = bf2f(prow[PA_V + h * 256 + tid]); }
        if (tid == 0) { misc[0] = SG[row * SGLD + h] + bi; misc[1] = -softplusf_(-(SG[row * SGLD + 4 + h] + bfv)); }
        lds_barrier();
        const float gi = misc[0], gf = misc[1];
        const float mn = fmaxf(gf + m, gi), fw = __expf(gf + m - mn), iw = __expf(gi - mn); m = mn;
        const float vv = vs[v] * iw; float acc = 0.f;
#pragma unroll
        for (int jj = 0; jj < 16; ++jj) {
            const f32x4 k0 = *(const LAS f32x4*)(ks + kh * 128 + jj * 8), k1 = *(const LAS f32x4*)(ks + kh * 128 + jj * 8 + 4);
            const f32x4 q0 = *(const LAS f32x4*)(qs + kh * 128 + jj * 8), q1 = *(const LAS f32x4*)(qs + kh * 128 + jj * 8 + 4);
#pragma unroll
            for (int e = 0; e < 4; ++e) { C[jj * 8 + e] = fw * C[jj * 8 + e] + k0[e] * vv; acc += q0[e] * C[jj * 8 + e];
                                          C[jj * 8 + 4 + e] = fw * C[jj * 8 + 4 + e] + k1[e] * vv; acc += q1[e] * C[jj * 8 + 4 + e]; }
            asm volatile("" ::: "memory");
        }
        red[tid] = acc;
        float dpart = 0.f;
        if (tid < 256) { nreg = fw * nreg + iw * ks[tid]; dpart = qs[tid] * nreg; }
        const float den = block_sum(dpart, sc, c.wave);
        float hh = 0.f;
        if (tid < 256) hh = (red[tid] + red[256 + tid]) / fmaxf(fabsf(den), __expf(-m));
        const float ss = block_sum(hh * hh, sc, c.wave);
        if (tid < 256) { const float y = hh * rsqrtf(ss * (1.f / 256.f) + 1e-6f) * nw; const float o = bf2f(prow[PA_O + h * 256 + tid]);
            YBR[row * YLD + h * 256 + tid] = (bf16_t)f2bf(sigmoidf_(o) * y); }
        lds_barrier();
    }
    { float* op = oc + ((size_t)(kh * 128) * 256 + v);
#pragma unroll
      for (int jj = 0; jj < 32; ++jj) { asm volatile("" : "+v"(op)); op[0] = C[4 * jj]; op[256] = C[4 * jj + 1]; op[512] = C[4 * jj + 2]; op[768] = C[4 * jj + 3]; op += 1024; } }
    if (tid < 256) on[tid] = nreg;
    if (tid == 0) *om = m;
    lds_barrier();
}

__device__ __forceinline__ void mlstm_unit_s(const Ctx& c0, int l, int s, int h) {
    Ctx c = c0; c.lane = hw_lane(); c.tid = c.wave * 64 + c.lane;
    const int tid = c.tid, vq = c.lane, kg = c.wave;
    const size_t row = (size_t)(MPROMPT + s);
    const bf16_t* PROJ = (const bf16_t*)(c.ws + WS_PROJ); const float* SG = (const float*)(c.ws + WS_SG); bf16_t* YBR = (bf16_t*)(c.ws + WS_YBR);
    LAS float* sm = (LAS float*)c.lds; LAS float* qs = sm, *ks = sm + 256, *vs = sm + 512, *red = sm + 768  , *misc = sm + 2816, *sc = sm + 2832;
    const size_t u = ((size_t)l * NB + s) * HA + h;
    const f32x4* ci = (const f32x4*)(inp(c, I_SC) + u * DHA * DHA) + (size_t)(kg * 32) * 64 + vq;
    f32x4* oc = (f32x4*)(c.out + O_SC + u * DHA * DHA) + (size_t)(kg * 32) * 64 + vq;
    f32x4 C[32];
#pragma unroll
    for (int j = 0; j < 32; ++j) C[j] = ci[j * 64];
    float nreg = 0.f;
    if (tid < 256) nreg = inp(c, I_SN)[u * DHA + tid];
    float m = inp(c, I_SM)[u];
    const float bi = inp(c, I_BI)[l * HA + h], bfv = inp(c, I_BF)[l * HA + h];
    const float nw = tid < 256 ? inp(c, I_MNW)[l * 1024 + h * 256 + tid] : 0.f;
    const bf16_t* prow = PROJ + row * NPROJ;
    if (tid < 256) { qs[tid] = bf2f(prow[PA_Q + h * 256 + tid]); ks[tid] = bf2f(prow[PA_K + h * 256 + tid]) * 0.0625f; vs[tid] = bf2f(prow[PA_V + h * 256 + tid]); }
    if (tid == 0) { misc[0] = SG[row * SGLD + h] + bi; misc[1] = -softplusf_(-(SG[row * SGLD + 4 + h] + bfv)); }
    lds_barrier();
    const float gi = misc[0], gf = misc[1];
    const float mn = fmaxf(gf + m, gi), fw = __expf(gf + m - mn), iw = __expf(gi - mn); m = mn;
    const f32x4 vv = *(const LAS f32x4*)(vs + 4 * vq) * iw;
    f32x4 acc = (f32x4){0.f, 0.f, 0.f, 0.f};
#pragma unroll
    for (int jj = 0; jj < 8; ++jj) {
        const f32x4 k4 = *(const LAS f32x4*)(ks + kg * 32 + jj * 4), q4 = *(const LAS f32x4*)(qs + kg * 32 + jj * 4);
#pragma unroll
        for (int e = 0; e < 4; ++e) { C[jj * 4 + e] = C[jj * 4 + e] * fw + vv * k4[e]; acc += C[jj * 4 + e] * q4[e]; }
    }
#pragma unroll
    for (int j = 0; j < 32; ++j) oc[j * 64] = C[j];
    *(LAS f32x4*)(red + kg * 256 + 4 * vq) = acc;
    float dpart = 0.f;
    if (tid < 256) { nreg = fw * nreg + iw * ks[tid]; dpart = qs[tid] * nreg; }
    const float den = block_sum(dpart, sc, c.wave);
    float hh = 0.f;
    if (tid < 256) { float num = 0.f;
#pragma unroll
        for (int g = 0; g < 8; ++g) num += red[g * 256 + tid];
        hh = num / fmaxf(fabsf(den), __expf(-m)); }
    const float ss = block_sum(hh * hh, sc, c.wave);
    if (tid < 256) { const float y = hh * rsqrtf(ss * (1.f / 256.f) + 1e-6f) * nw; const float o = bf2f(prow[PA_O + h * 256 + tid]);
        YBR[row * YLD + h * 256 + tid] = (bf16_t)f2bf(sigmoidf_(o) * y);
        (c.out + O_SN + u * DHA)[tid] = nreg; }
    if (tid == 0) (c.out + O_SM)[u] = m;
    lds_barrier();
}

__device__ __forceinline__ void gdn_unit(const Ctx& c0, int l, int seq, int h) {
    Ctx c = c0; c.lane = hw_lane(); c.tid = c.wave * 64 + c.lane;
    const int tid = c.tid, v = tid & 127, kq = tid >> 7;
    const bool prompt = seq < BATCH; const int T = prompt ? TP : 1; const int row0 = prompt ? seq * TP : MPROMPT + (seq - BATCH);
    const bf16_t* PROJ = (const bf16_t*)(c.ws + WS_PROJ); const float* SG = (const float*)(c.ws + WS_SG); bf16_t* YBR = (bf16_t*)(c.ws + WS_YBR);
    LAS float* sm = (LAS float*)c.lds; LAS float* ring = sm  , *qk = sm + 1536  , *red = sm + 1920  , *part = sm + 2432  , *sc = sm + 2448;
    float S[32];
    float *os, *ocv; const float* cin = nullptr;
    const int cg = tid < 384 ? (tid >> 7) * 1024 + h * 128 + (tid & 127) : 0;
    if (prompt) { os = c.out + O_PGS + (((size_t)l * BATCH + seq) * HB + h) * DHB * DHB; ocv = c.out + O_PGC + ((size_t)l * BATCH + seq) * 3 * 3072;
#pragma unroll
        for (int j = 0; j < 32; ++j) S[j] = 0.f;
    } else { const int s = seq - BATCH; const size_t u = ((size_t)l * NB + s) * HB + h;
        os = c.out + O_SGS + u * DHB * DHB; ocv = c.out + O_SGC + ((size_t)l * NB + s) * 3 * 3072;
        const float* si = inp(c, I_SGS) + u * DHB * DHB;
#pragma unroll
        for (int j = 0; j < 32; ++j) S[j] = si[(size_t)(kq * 32 + j) * 128 + v];
        cin = inp(c, I_SGC) + ((size_t)l * NB + s) * 3 * 3072;
    }
    float cw0 = 0.f, cw1 = 0.f, cw2 = 0.f, cw3 = 0.f;
    if (tid < 384) { const float* cw = inp(c, I_CONVW) + (size_t)l * 4 * 3072; cw0 = cw[cg]; cw1 = cw[3072 + cg]; cw2 = cw[2 * 3072 + cg]; cw3 = cw[3 * 3072 + cg];
        ring[3 * 384 + tid] = cin ? cin[2 * 3072 + cg] : 0.f; ring[2 * 384 + tid] = cin ? cin[3072 + cg] : 0.f; ring[1 * 384 + tid] = cin ? cin[cg] : 0.f; ring[tid] = 0.f; }
    const float alog = inp(c, I_ALOG)[l * HB + h], dtb = inp(c, I_DTB)[l * HB + h];
    const float gnw = tid < 128 ? inp(c, I_GNW)[l * DHB + tid] : 0.f;
    lds_barrier();
    for (int t = 0; t < T; ++t) {
        const size_t row = (size_t)(row0 + t); const bf16_t* prow = PROJ + row * NPROJ;
        float y = 0.f;
        if (tid < 384) { const float u = bf2f(prow[PB_QKV + cg]); ring[(t & 3) * 384 + tid] = u;
            y = cw3 * u + cw2 * ring[((t - 1) & 3) * 384 + tid] + cw1 * ring[((t - 2) & 3) * 384 + tid] + cw0 * ring[((t - 3) & 3) * 384 + tid];
            y = siluf_(y); qk[tid] = y; }
        { const float s2 = wave_sum(y * y); if (c.lane == 0) part[c.wave] = s2; }
        lds_barrier();
        const float qn = rsqrtf(part[0] + part[1] + 1e-12f) * 0.08838834764831845f, kn = rsqrtf(part[2] + part[3] + 1e-12f);
        const float ga = SG[row * SGLD + 8 + h], gb = SG[row * SGLD + 16 + h];
        const float alpha = __expf(-__expf(alog) * softplusf_(ga + dtb)), beta = sigmoidf_(gb);
        float p = 0.f;
#pragma unroll
        for (int j = 0; j < 32; ++j) p += qk[128 + kq * 32 + j] * S[j];
        red[tid] = p * kn;
        lds_barrier();
        const float kS = red[v] + red[128 + v] + red[256 + v] + red[384 + v];
        const float vn = beta * (qk[256 + v] - alpha * kS);
        float o = 0.f;
#pragma unroll
        for (int j = 0; j < 32; ++j) { S[j] = alpha * S[j] + (qk[128 + kq * 32 + j] * kn) * vn; o += qk[kq * 32 + j] * S[j]; }
        lds_barrier();
        red[tid] = o * qn;
        lds_barrier();
        float oo = 0.f;
        if (tid < 128) oo = red[tid] + red[128 + tid] + red[256 + tid] + red[384 + tid];
        const float ss = block_sum(oo * oo, sc, c.wave);
        if (tid < 128) { const float z = bf2f(prow[PB_Z + h * 128 + tid]);
            YBR[row * YLD + 1024 + h * 128 + tid] = (bf16_t)f2bf(oo * rsqrtf(ss * (1.f / 128.f) + 1e-6f) * gnw * siluf_(z)); }
        lds_barrier();
    }
#pragma unroll
    for (int j = 0; j < 32; ++j) os[(size_t)(kq * 32 + j) * 128 + v] = S[j];
    if (tid < 384) {
#pragma unroll
        for (int j = 0; j < 3; ++j) ocv[j * 3072 + cg] = ring[((T - 3 + j) & 3) * 384 + tid];
    }
    lds_barrier();
}

__device__ __forceinline__ void gdn_unit_s(const Ctx& c0, int l, int s, int h) {
    Ctx c = c0; c.lane = hw_lane(); c.tid = c.wave * 64 + c.lane;
    const int tid = c.tid, vq = tid & 31, kg = tid >> 5;
    const size_t row = (size_t)(MPROMPT + s);
    const bf16_t* PROJ = (const bf16_t*)(c.ws + WS_PROJ); const float* SG = (const float*)(c.ws + WS_SG); bf16_t* YBR = (bf16_t*)(c.ws + WS_YBR);
    LAS float* sm = (LAS float*)c.lds; LAS float* qk = sm  , *red = sm + 384  , *red2 = sm + 2432  , *part = sm + 4480  , *sc = sm + 4496;
    const size_t u = ((size_t)l * NB + s) * HB + h;
    const f32x4* si = (const f32x4*)(inp(c, I_SGS) + u * DHB * DHB) + (size_t)(kg * 8) * 32 + vq;
    f32x4* os = (f32x4*)(c.out + O_SGS + u * DHB * DHB) + (size_t)(kg * 8) * 32 + vq;
    f32x4 S[8];
#pragma unroll
    for (int j = 0; j < 8; ++j) S[j] = si[j * 32];
    const bf16_t* prow = PROJ + row * NPROJ;
    float y = 0.f;
    if (tid < 384) { const int cg = (tid >> 7) * 1024 + h * 128 + (tid & 127);
        const float* cw = inp(c, I_CONVW) + (size_t)l * 4 * 3072; const float* cin = inp(c, I_SGC) + ((size_t)l * NB + s) * 3 * 3072; float* ocv = c.out + O_SGC + ((size_t)l * NB + s) * 3 * 3072;
        const float cw0 = cw[cg], cw1 = cw[3072 + cg], cw2 = cw[2 * 3072 + cg], cw3 = cw[3 * 3072 + cg];
        const float p0 = cin[cg], p1 = cin[3072 + cg], p2 = cin[2 * 3072 + cg]; const float uu = bf2f(prow[PB_QKV + cg]);
        y = siluf_(cw3 * uu + cw2 * p2 + cw1 * p1 + cw0 * p0); qk[tid] = y;
        ocv[cg] = p1; ocv[3072 + cg] = p2; ocv[2 * 3072 + cg] = uu; }
    { const float s2 = wave_sum(y * y); if (c.lane == 0) part[c.wave] = s2; }
    const float alog = inp(c, I_ALOG)[l * HB + h], dtb = inp(c, I_DTB)[l * HB + h];
    const float ga = SG[row * SGLD + 8 + h], gb = SG[row * SGLD + 16 + h];
    const float gnw = tid < 128 ? inp(c, I_GNW)[l * DHB + tid] : 0.f;
    const float z = tid < 128 ? bf2f(prow[PB_Z + h * 128 + tid]) : 0.f;
    lds_barrier();
    const float qn = rsqrtf(part[0] + part[1] + 1e-12f) * 0.08838834764831845f, kn = rsqrtf(part[2] + part[3] + 1e-12f);
    const float alpha = __expf(-__expf(alog) * softplusf_(ga + dtb)), beta = sigmoidf_(gb);
    const f32x4 ka = *(const LAS f32x4*)(qk + 128 + kg * 8), kb = *(const LAS f32x4*)(qk + 128 + kg * 8 + 4);
    const f32x4 qa = *(const LAS f32x4*)(qk + kg * 8), qb = *(const LAS f32x4*)(qk + kg * 8 + 4);
    { f32x4 p = S[0] * ka[0];
#pragma unroll
      for (int j = 1; j < 8; ++j) p += S[j] * (j < 4 ? ka[j] : kb[j - 4]);
      *(LAS f32x4*)(red + kg * 128 + 4 * vq) = p; }
    lds_barrier();
    f32x4 kS = *(const LAS f32x4*)(red + 4 * vq);
#pragma unroll
    for (int g = 1; g < 16; ++g) kS += *(const LAS f32x4*)(red + g * 128 + 4 * vq);
    const f32x4 vn = (*(const LAS f32x4*)(qk + 256 + 4 * vq) - kS * (alpha * kn)) * beta;
    { f32x4 o = (f32x4){0.f, 0.f, 0.f, 0.f};
#pragma unroll
      for (int j = 0; j < 8; ++j) { const float kj = (j < 4 ? ka[j] : kb[j - 4]) * kn, qj = j < 4 ? qa[j] : qb[j - 4]; S[j] = S[j] * alpha + vn * kj; o += S[j] * qj; }
#pragma unroll
      for (int j = 0; j < 8; ++j) os[j * 32] = S[j];
      *(LAS f32x4*)(red2 + kg * 128 + 4 * vq) = o; }
    lds_barrier();
    float oo = 0.f;
    if (tid < 128) {
#pragma unroll
        for (int g = 0; g < 16; ++g) oo += red2[g * 128 + tid];
        oo *= qn; }
    const float ss = block_sum(oo * oo, sc, c.wave);
    if (tid < 128) YBR[row * YLD + 1024 + h * 128 + tid] = (bf16_t)f2bf(oo * rsqrtf(ss * (1.f / 128.f) + 1e-6f) * gnw * siluf_(z));
    lds_barrier();
}

__device__ __forceinline__ void rwkv_unit(const Ctx& c0, int l, int seq, int h, int& cached_h) {
    Ctx c = c0; c.lane = hw_lane(); c.tid = c.wave * 64 + c.lane;
    const int tid = c.tid, k = tid & 63, vq = tid >> 6;
    const bool prompt = seq < BATCH; const int T = prompt ? TP : 1; const int row0 = prompt ? seq * TP : MPROMPT + (seq - BATCH);
    const bf16_t* PROJ = (const bf16_t*)(c.ws + WS_PROJ); bf16_t* YBR = (bf16_t*)(c.ws + WS_YBR);
    LAS float* sm = (LAS float*)c.lds;
    LAS float* w2s = sm, *a2s = sm + 4096, *g2s = sm + 8192  , *xs = sm + 16384  , *partl = sm + 16896  ;
    LAS float* dec = sm + 17408, *k2s = dec + 64, *avs = dec + 128, *bvs = dec + 192, *rrs = dec + 256, *vvs = dec + 320, *ggs = dec + 384, *ys = dec + 448, *misc = dec + 512;
    float S[8];
    float *os, *osh; const float* shin = nullptr;
    if (prompt) { os = c.out + O_PRS + (((size_t)l * BATCH + seq) * HC + h) * DHC * DHC; osh = c.out + O_PRSH + ((size_t)l * BATCH + seq) * NCC;
#pragma unroll
        for (int j = 0; j < 8; ++j) S[j] = 0.f;
    } else { const int s = seq - BATCH; const size_t u = ((size_t)l * NB + s) * HC + h;
        os = c.out + O_SRS + u * DHC * DHC; osh = c.out + O_SRSH + ((size_t)l * NB + s) * NCC;
        const float* si = inp(c, I_SRS) + u * DHC * DHC;
#pragma unroll
        for (int j = 0; j < 8; ++j) S[j] = si[(size_t)(vq * 8 + j) * 64 + k];
        shin = inp(c, I_SRSH) + ((size_t)l * NB + s) * NCC;
    }
    if (cached_h != h) { cached_h = h; const float* w2p = inp(c, I_W2) + (size_t)l * 64 * 1024 + h * 64; const float* a2p = inp(c, I_A2) + (size_t)l * 64 * 1024 + h * 64; const float* g2p = inp(c, I_G2) + (size_t)l * 128 * 1024 + h * 64;
      float lw2[8], la2[8], lg2[16];
#pragma unroll
      for (int k = 0; k < 8; ++k) { const int i = tid + k * NTHR; lw2[k] = w2p[(i >> 6) * 1024 + (i & 63)]; la2[k] = a2p[(i >> 6) * 1024 + (i & 63)]; }
#pragma unroll
      for (int k = 0; k < 16; ++k) { const int i = tid + k * NTHR; lg2[k] = g2p[(i >> 6) * 1024 + (i & 63)]; }
#pragma unroll
      for (int k = 0; k < 8; ++k) { const int i = tid + k * NTHR; w2s[i] = lw2[k]; a2s[i] = la2[k]; }
#pragma unroll
      for (int k = 0; k < 16; ++k) { const int i = tid + k * NTHR; g2s[i] = lg2[k]; } }
    int cidx = 0;
    if (tid < 64) cidx = h * 64 + tid; else if (tid < 128) cidx = 1024 + h * 64 + (tid - 64); else if (tid < 192) cidx = 2048 + h * 64 + (tid - 128); else if (tid < 448) cidx = 3072 + (tid - 192);
    float prev = 0.f, mu = 0.f;
    if (tid < 448) { prev = shin ? shin[cidx] : 0.f; mu = inp(c, I_MU)[(size_t)l * NCC + cidx]; }
    const int C = h * 64 + (tid & 63);
    float w0 = 0.f, a0 = 0.f, kkw = 0.f, kaw = 0.f, rkw = 0.f, lnw = 0.f, lnb = 0.f;
    if (tid < 64) { w0 = inp(c, I_W0)[l * 1024 + C]; a0 = inp(c, I_A0)[l * 1024 + C]; kkw = inp(c, I_KK)[l * 1024 + C]; kaw = inp(c, I_KA)[l * 1024 + C]; rkw = inp(c, I_RK)[l * 1024 + C];
        lnw = inp(c, I_LNW)[l * 1024 + C]; lnb = inp(c, I_LNB)[l * 1024 + C]; }
    lds_barrier();
    for (int t = 0; t < T; ++t) {
        const size_t row = (size_t)(row0 + t); const bf16_t* prow = PROJ + row * NPROJ;
        if (tid < 448) { const float cur = bf2f(prow[PC0 + cidx]); float xm = cur + (prev - cur) * mu; prev = cur;
            if (tid >= 192 && tid < 256) xm = ftanh(xm); else if (tid >= 320) xm = sigmoidf_(xm);
            xs[tid] = xm; }
        lds_barrier();
        { const int cc = tid & 63, pt = tid >> 6; float a = 0.f;
            if (pt < 2) { for (int j = 0; j < 32; ++j) a += xs[192 + pt * 32 + j] * w2s[(pt * 32 + j) * 64 + cc]; }
            else if (pt < 4) { for (int j = 0; j < 32; ++j) a += xs[256 + (pt - 2) * 32 + j] * a2s[((pt - 2) * 32 + j) * 64 + cc]; }
            else { for (int j = 0; j < 32; ++j) a += xs[320 + (pt - 4) * 32 + j] * g2s[((pt - 4) * 32 + j) * 64 + cc]; }
            partl[pt * 64 + cc] = a; }
        lds_barrier();
        if (tid < 64) {
            const float wl = w0 + partl[tid] + partl[64 + tid]; const float wlog = -softplusf_(-wl) - 0.5f; const float dc = __expf(-__expf(wlog));
            const float aa = sigmoidf_(a0 + partl[128 + tid] + partl[192 + tid]);
            const float gg = (partl[256 + tid] + partl[320 + tid]) + (partl[384 + tid] + partl[448 + tid]);
            const float kraw = xs[64 + tid], kkv = kraw * kkw; const float nrm = wave_sum(kkv * kkv); const float kk = kkv * rsqrtf(nrm + 1e-12f);
            const float k2 = kraw * (1.f + (aa - 1.f) * kaw);
            dec[tid] = dc; k2s[tid] = k2; avs[tid] = -kk; bvs[tid] = kk * aa; rrs[tid] = xs[tid]; vvs[tid] = xs[128 + tid]; ggs[tid] = gg;
            const float bs = wave_sum(xs[tid] * k2 * rkw); if (tid == 0) misc[0] = bs;
        }
        lds_barrier();
        { const float av = avs[k], bv = bvs[k], dk = dec[k], kk2 = k2s[k], rr = rrs[k];
#pragma unroll
            for (int j = 0; j < 8; ++j) { const int vi = vq * 8 + j; const float sa = wave_sum(S[j] * av); S[j] = S[j] * dk + sa * bv + vvs[vi] * kk2; const float yy = wave_sum(S[j] * rr); if (k == 0) ys[vi] = yy; } }
        lds_barrier();
        if (tid < 64) { const float y = ys[tid]; const float mean = wave_sum(y) * (1.f / 64.f); const float d = y - mean; const float var = wave_sum(d * d) * (1.f / 64.f);
            const float yn = d * rsqrtf(var + 64e-5f) * lnw + lnb; const float o = (yn + misc[0] * vvs[tid]) * ggs[tid];
            YBR[row * YLD + 2048 + h * 64 + tid] = (bf16_t)f2bf(o); }
        lds_barrier();
    }
#pragma unroll
    for (int j = 0; j < 8; ++j) os[(size_t)(vq * 8 + j) * 64 + k] = S[j];
    if (tid < 192 || (h == 0 && tid < 448)) osh[cidx] = prev;
    lds_barrier();
}


__device__ __forceinline__ void rwkv_unit4(const Ctx& c0, int l, int s0, int h, int& cached_h) {
    Ctx c = c0; c.lane = hw_lane(); c.tid = c.wave * 64 + c.lane;
    const int tid = c.tid, k = tid & 63, vq = tid >> 6;
    const bf16_t* PROJ = (const bf16_t*)(c.ws + WS_PROJ); bf16_t* YBR = (bf16_t*)(c.ws + WS_YBR);
    LAS float* sm = (LAS float*)c.lds;
    LAS float* W = sm  , *xs = sm + 16384  , *partl = sm + 18176  , *vec = sm + 20224  , *misc = sm + 22272  ;
    const size_t u0 = ((size_t)l * NB + s0) * HC + h;
    float S[4][8];
    { const float* si = inp(c, I_SRS) + u0 * DHC * DHC;
#pragma unroll
      for (int q = 0; q < 4; ++q)
#pragma unroll
        for (int j = 0; j < 8; ++j) S[q][j] = si[(size_t)q * HC * DHC * DHC + (size_t)(vq * 8 + j) * 64 + k]; }
    if (cached_h != h) { cached_h = h; const float* w2p = inp(c, I_W2) + (size_t)l * 64 * 1024 + h * 64; const float* a2p = inp(c, I_A2) + (size_t)l * 64 * 1024 + h * 64; const float* g2p = inp(c, I_G2) + (size_t)l * 128 * 1024 + h * 64;
      float lw2[8], la2[8], lg2[16];
#pragma unroll
      for (int kk = 0; kk < 8; ++kk) { const int i = tid + kk * NTHR; lw2[kk] = w2p[(i >> 6) * 1024 + (i & 63)]; la2[kk] = a2p[(i >> 6) * 1024 + (i & 63)]; }
#pragma unroll
      for (int kk = 0; kk < 16; ++kk) { const int i = tid + kk * NTHR; lg2[kk] = g2p[(i >> 6) * 1024 + (i & 63)]; }
#pragma unroll
      for (int kk = 0; kk < 8; ++kk) { const int i = tid + kk * NTHR; W[i] = lw2[kk]; W[4096 + i] = la2[kk]; }
#pragma unroll
      for (int kk = 0; kk < 16; ++kk) { const int i = tid + kk * NTHR; W[8192 + i] = lg2[kk]; } }
    int cidx = 0;
    if (tid < 64) cidx = h * 64 + tid; else if (tid < 128) cidx = 1024 + h * 64 + (tid - 64); else if (tid < 192) cidx = 2048 + h * 64 + (tid - 128); else if (tid < 448) cidx = 3072 + (tid - 192);
    const int C = h * 64 + k;
    float w0 = 0.f, a0 = 0.f, kkw = 0.f, kaw = 0.f, rkw = 0.f, lnw = 0.f, lnb = 0.f;
    if (tid < 256) { w0 = inp(c, I_W0)[l * 1024 + C]; a0 = inp(c, I_A0)[l * 1024 + C]; kkw = inp(c, I_KK)[l * 1024 + C]; kaw = inp(c, I_KA)[l * 1024 + C]; rkw = inp(c, I_RK)[l * 1024 + C];
        lnw = inp(c, I_LNW)[l * 1024 + C]; lnb = inp(c, I_LNB)[l * 1024 + C]; }
    if (tid < 448) { const float mu = inp(c, I_MU)[(size_t)l * NCC + cidx]; const float* shin = inp(c, I_SRSH) + ((size_t)l * NB + s0) * NCC + cidx; float* osh = c.out + O_SRSH + ((size_t)l * NB + s0) * NCC + cidx;
        float prev[4], cur[4];
#pragma unroll
        for (int q = 0; q < 4; ++q) { prev[q] = shin[(size_t)q * NCC]; cur[q] = bf2f(PROJ[(size_t)(MPROMPT + s0 + q) * NPROJ + PC0 + cidx]); }
#pragma unroll
        for (int q = 0; q < 4; ++q) { float xm = cur[q] + (prev[q] - cur[q]) * mu;
            if (tid >= 192 && tid < 256) xm = ftanh(xm); else if (tid >= 320) xm = sigmoidf_(xm);
            xs[q * 448 + tid] = xm;
            if (tid < 192 || h == 0) osh[(size_t)q * NCC] = cur[q]; } }
    lds_barrier();
    { const int pt = vq; float a[4] = {0.f, 0.f, 0.f, 0.f};
        const LAS float* wp = W + (pt * 32) * 64 + k; const LAS float* xp = xs + 192 + pt * 32;
#pragma unroll 8
        for (int j = 0; j < 32; ++j) { const float wv = wp[j * 64];
#pragma unroll
            for (int q = 0; q < 4; ++q) a[q] += xp[q * 448 + j] * wv; }
#pragma unroll
        for (int q = 0; q < 4; ++q) partl[q * 512 + pt * 64 + k] = a[q]; }
    lds_barrier();
    if (tid < 256) { const int q = vq; const LAS float* pl = partl + q * 512; const LAS float* x = xs + q * 448; LAS float* vv = vec + q * 512;
        const float wl = w0 + pl[k] + pl[64 + k]; const float wlog = -softplusf_(-wl) - 0.5f; const float dc = __expf(-__expf(wlog));
        const float aa = sigmoidf_(a0 + pl[128 + k] + pl[192 + k]);
        const float gg = (pl[256 + k] + pl[320 + k]) + (pl[384 + k] + pl[448 + k]);
        const float kraw = x[64 + k], kkv = kraw * kkw; const float nrm = wave_sum(kkv * kkv); const float kk = kkv * rsqrtf(nrm + 1e-12f);
        const float k2 = kraw * (1.f + (aa - 1.f) * kaw);
        vv[k] = dc; vv[64 + k] = k2; vv[128 + k] = -kk; vv[192 + k] = kk * aa; vv[256 + k] = x[k]; vv[320 + k] = x[128 + k]; vv[384 + k] = gg;
        const float bs = wave_sum(x[k] * k2 * rkw); if (k == 0) misc[q] = bs; }
    lds_barrier();
#pragma unroll
    for (int q = 0; q < 4; ++q) { const LAS float* vv = vec + q * 512; const float dk = vv[k], kk2 = vv[64 + k], av = vv[128 + k], bv = vv[192 + k], rr = vv[256 + k];
#pragma unroll
        for (int j = 0; j < 8; ++j) { const int vi = vq * 8 + j; const float sa = wave_sum(S[q][j] * av); S[q][j] = S[q][j] * dk + sa * bv + vv[320 + vi] * kk2; const float yy = wave_sum(S[q][j] * rr); if (k == 0) vec[q * 512 + 448 + vi] = yy; } }
    lds_barrier();
    if (tid < 256) { const int q = vq; const LAS float* vv = vec + q * 512; const float y = vv[448 + k]; const float mean = wave_sum(y) * (1.f / 64.f); const float d = y - mean; const float var = wave_sum(d * d) * (1.f / 64.f);
        const float yn = d * rsqrtf(var + 64e-5f) * lnw + lnb; const float o = (yn + misc[q] * vv[320 + k]) * vv[384 + k];
        YBR[(size_t)(MPROMPT + s0 + q) * YLD + 2048 + h * 64 + k] = (bf16_t)f2bf(o); }
    { float* os = c.out + O_SRS + u0 * DHC * DHC;
#pragma unroll
      for (int q = 0; q < 4; ++q)
#pragma unroll
        for (int j = 0; j < 8; ++j) os[(size_t)q * HC * DHC * DHC + (size_t)(vq * 8 + j) * 64 + k] = S[q][j]; }
    lds_barrier();
}

__device__ __forceinline__ f32x4 mfma16(bf16x8 a, bf16x8 b, f32x4 c) { return __builtin_amdgcn_mfma_f32_16x16x32_bf16(a, b, c, 0, 0, 0); }
__device__ __forceinline__ bf16x8 ldfrag(const LAS bf16_t* X, int ld, int r0, int k0, int lane) { return *(const LAS bf16x8*)(X + (r0 + (lane & 15)) * ld + k0 + ((lane >> 4) << 3)); }
template <int MT, int NT, int KS>
__device__ __forceinline__ void mma_lds(f32x4 (&acc)[MT][NT], const LAS bf16_t* A, int lda, int m0, const LAS bf16_t* Bt, int ldb, int n0, int lane) {
#pragma unroll
    for (int ks = 0; ks < KS; ++ks) {
        bf16x8 a[MT], b[NT];
#pragma unroll
        for (int i = 0; i < MT; ++i) a[i] = ldfrag(A, lda, m0 + 16 * i, 32 * ks, lane);
#pragma unroll
        for (int j = 0; j < NT; ++j) b[j] = ldfrag(Bt, ldb, n0 + 16 * j, 32 * ks, lane);
#pragma unroll
        for (int i = 0; i < MT; ++i)
#pragma unroll
            for (int j = 0; j < NT; ++j) acc[i][j] = mfma16(a[i], b[j], acc[i][j]);
    }
}
__device__ __forceinline__ float wave_incl_sum(float x, int lane) { (void)lane; return wave_scan_sum(x); }
__device__ __forceinline__ float wave_incl_max(float x, int lane) { (void)lane; const float NI = -__builtin_huge_valf();
    x = fmaxf(x, dpp_mov<0x111, 0xf>(NI, x)); x = fmaxf(x, dpp_mov<0x112, 0xf>(NI, x)); x = fmaxf(x, dpp_mov<0x114, 0xf>(NI, x)); x = fmaxf(x, dpp_mov<0x118, 0xf>(NI, x));
    x = fmaxf(x, dpp_mov<0x142, 0xa>(NI, x)); x = fmaxf(x, dpp_mov<0x143, 0xc>(NI, x));
    return x;
}
__device__ __forceinline__ void chunk_range(int c, int& t0, int& Lv) { if (c == 0) { t0 = 0; Lv = NMETA; } else { t0 = NMETA + 64 * (c - 1); Lv = 64; } }

__device__ __forceinline__ void mlstm_prep_unit(const Ctx& c, int l, int u) {
    int w = c.wave; asm volatile("" : "+s"(w)); const int lane = hw_lane(), tid = w * 64 + lane;
    const int cch = u % NCH, bh = u / NCH, h = bh % HA, b = bh / HA;
    int t0, Lv; chunk_range(cch, t0, Lv);
    const size_t row0 = (size_t)b * TP + t0;
    const bf16_t* PROJ = (const bf16_t*)(c.ws + WS_PROJ); const float* SG = (const float*)(c.ws + WS_SG);
    LAS bf16_t* Qs = (LAS bf16_t*)c.lds; LAS bf16_t* Ks = Qs + 64 * 264; LAS bf16_t* VTs = Ks + 64 * 264; LAS bf16_t* Ss = VTs + 256 * 72;
    LAS float* ga = (LAS float*)(Ss + 64 * 72); LAS float* gcm = ga + 64, *gb = ga + 128, *gwk = ga + 192, *dpart = ga + 256  ;
    bf16_t* gKTw = (bf16_t*)(c.ws + WS_ML_KTW) + (size_t)u * 256 * 64; bf16_t* gVT = (bf16_t*)(c.ws + WS_ML_VT) + (size_t)u * 256 * 64;
    float* gNP = (float*)(c.ws + WS_ML_NP) + (size_t)u * 64 * 256; float* gSC = (float*)(c.ws + WS_ML_SC) + (size_t)u * 256;
    if (w == 0) {
        float li = -1e30f, lf = 0.f;
        if (lane < Lv) { li = SG[(row0 + lane) * SGLD + h] + inp(c, I_BI)[l * HA + h]; lf = -softplusf_(-(SG[(row0 + lane) * SGLD + 4 + h] + inp(c, I_BF)[l * HA + h])); }
        const float bb = wave_incl_sum(lf, lane); const float a = li - bb; const float cm = wave_incl_max(a, lane);
        const float cml = lane_bcast(cm, 63);
        ga[lane] = a; gcm[lane] = cm; gb[lane] = bb; gwk[lane] = __expf(a - cml);
        gSC[lane] = bb; gSC[64 + lane] = cm;
    }
    { u32x4 q4[4], k4[4], v4[4];
#pragma unroll
      for (int k = 0; k < 4; ++k) { const int i = tid + k * NTHR; const int r = i >> 5, c8 = i & 31, rv = i & 63, cv = i >> 6;
          q4[k] = (u32x4){0u, 0u, 0u, 0u}; k4[k] = q4[k]; v4[k] = q4[k];
          if (r < Lv) { const bf16_t* pr = PROJ + (row0 + r) * NPROJ + h * 256 + c8 * 8; q4[k] = *(const u32x4*)(pr + PA_Q); k4[k] = *(const u32x4*)(pr + PA_K); }
          if (rv < Lv) v4[k] = *(const u32x4*)(PROJ + (row0 + rv) * NPROJ + PA_V + h * 256 + cv * 8); }
#pragma unroll
      for (int k = 0; k < 4; ++k) { const int i = tid + k * NTHR; const int r = i >> 5, c8 = i & 31, rv = i & 63, cv = i >> 6;
          *(LAS u32x4*)(Qs + r * 264 + c8 * 8) = q4[k]; *(LAS u32x4*)(Ks + r * 264 + c8 * 8) = k4[k];
          LAS bf16_t* d = VTs + (cv * 8) * 72 + rv; const u32x4 v = v4[k];
          d[0] = (bf16_t)(v.x & 0xffffu); d[72] = (bf16_t)(v.x >> 16); d[144] = (bf16_t)(v.y & 0xffffu); d[216] = (bf16_t)(v.y >> 16);
          d[288] = (bf16_t)(v.z & 0xffffu); d[360] = (bf16_t)(v.z >> 16); d[432] = (bf16_t)(v.w & 0xffffu); d[504] = (bf16_t)(v.w >> 16); } }
    lds_barrier();
    { const int mt = w & 3, nh = w >> 2;
      f32x4 acc[1][2]; acc[0][0] = (f32x4){0.f, 0.f, 0.f, 0.f}; acc[0][1] = acc[0][0];
      mma_lds<1, 2, 8>(acc, Qs, 264, 16 * mt, Ks, 264, 32 * nh, lane);
      float rs[4] = {0.f, 0.f, 0.f, 0.f};
#pragma unroll
      for (int j = 0; j < 2; ++j) { const int sidx = 32 * nh + 16 * j + (lane & 15); const float as = ga[sidx];
#pragma unroll
          for (int r = 0; r < 4; ++r) { const int lidx = 16 * mt + 4 * (lane >> 4) + r;
              const float val = sidx <= lidx ? acc[0][j][r] * 0.0625f * __expf(as - gcm[lidx]) : 0.f;
              rs[r] += val; Ss[lidx * 72 + sidx] = (bf16_t)f2bf(val); } }
#pragma unroll
      for (int r = 0; r < 4; ++r) { const float x = row16_sum(rs[r]);
          if ((lane & 15) == 0) dpart[nh * 64 + 16 * mt + 4 * (lane >> 4) + r] = x; }
    }
    for (int i = tid; i < 256 * 8; i += NTHR) { const int r = i >> 3, c8 = i & 7; *(u32x4*)(gVT + r * 64 + c8 * 8) = *(const LAS u32x4*)(VTs + r * 72 + c8 * 8); }
    for (int i = tid; i < 256 * 8; i += NTHR) { const int k = i & 255, c8 = i >> 8; u32x4 o; float x[8];
#pragma unroll
        for (int e = 0; e < 8; ++e) x[e] = bf2f(Ks[(c8 * 8 + e) * 264 + k]) * 0.0625f * gwk[c8 * 8 + e];
        o.x = pk2(x[0], x[1]); o.y = pk2(x[2], x[3]); o.z = pk2(x[4], x[5]); o.w = pk2(x[6], x[7]);
        *(u32x4*)(gKTw + k * 64 + c8 * 8) = o; }
    lds_barrier();
    if (tid < 64) gSC[128 + tid] = dpart[tid] + dpart[64 + tid];
    { f32x4 acc[2][4];
#pragma unroll
      for (int i = 0; i < 2; ++i)
#pragma unroll
          for (int j = 0; j < 4; ++j) acc[i][j] = (f32x4){0.f, 0.f, 0.f, 0.f};
      mma_lds<2, 4, 2>(acc, VTs, 72, 32 * w, Ss, 72, 0, lane);
#pragma unroll
      for (int i = 0; i < 2; ++i)
#pragma unroll
          for (int j = 0; j < 4; ++j) { const int v0 = 32 * w + 16 * i + 4 * (lane >> 4), lidx = 16 * j + (lane & 15); *(f32x4*)(gNP + lidx * 256 + v0) = acc[i][j]; }
    }
    lds_barrier();
}

__device__ __forceinline__ void mlstm_seq_unit(const Ctx& c, int l, int b, int h, int vs) {
    int w = c.wave; asm volatile("" : "+s"(w)); const int lane = hw_lane(), tid = w * 64 + lane;
    const bf16_t* PROJ = (const bf16_t*)(c.ws + WS_PROJ);
    LAS bf16_t* Qs = (LAS bf16_t*)c.lds; LAS bf16_t* KTw = Qs + 64 * 264; LAS bf16_t* VTs = KTw + 256 * 72; LAS bf16_t* CTs = VTs + 80 * 72;
    LAS float* sb = (LAS float*)(CTs + 80 * 264); LAS float* scm = sb + 64, *sdp = sb + 128, *sqn = sb + 192;
    float* HAo = (float*)(c.ws + WS_HA);
    for (int i = tid; i < 80 * 264; i += NTHR) CTs[i] = 0;
    for (int i = tid; i < 16 * 72; i += NTHR) VTs[64 * 72 + i] = (i < 72) ? (bf16_t)0x3f80 : (bf16_t)0;
    f32x4 Cst[2][5];
#pragma unroll
    for (int i = 0; i < 2; ++i)
#pragma unroll
        for (int j = 0; j < 5; ++j) Cst[i][j] = (f32x4){0.f, 0.f, 0.f, 0.f};
    float m = 0.f;
    const int lt = w & 3, vh = w >> 2;
    u32x4 pq[2][4], pk[2][4], pv[2]; float psc[2] = {0.f, 0.f}; f32x4 pn[2][2];
#define ML_ISSUE(cc, S_) do { int t0_, Lv_; chunk_range((cc), t0_, Lv_); const size_t row0_ = (size_t)b * TP + t0_; const int u_ = (b * HA + h) * NCH + (cc); \
        const bf16_t* gK_ = (const bf16_t*)(c.ws + WS_ML_KTW) + (size_t)u_ * 256 * 64; const bf16_t* gV_ = (const bf16_t*)(c.ws + WS_ML_VT) + (size_t)u_ * 256 * 64 + (size_t)vs * 64 * 64; \
        const float* gN_ = (const float*)(c.ws + WS_ML_NP) + (size_t)u_ * 64 * 256; const float* gS_ = (const float*)(c.ws + WS_ML_SC) + (size_t)u_ * 256; \
        _Pragma("unroll") for (int k_ = 0; k_ < 4; ++k_) { const int i_ = tid + k_ * NTHR; const int r_ = i_ >> 5, c8_ = i_ & 31; pq[S_][k_] = (u32x4){0u, 0u, 0u, 0u}; \
            if (r_ < Lv_) pq[S_][k_] = *(const u32x4*)(PROJ + (row0_ + r_) * NPROJ + PA_Q + h * 256 + c8_ * 8); pk[S_][k_] = *(const u32x4*)(gK_ + (i_ >> 3) * 64 + (i_ & 7) * 8); } \
        pv[S_] = *(const u32x4*)(gV_ + (tid >> 3) * 64 + (tid & 7) * 8); psc[S_] = tid < 192 ? gS_[tid] : 0.f; \
        _Pragma("unroll") for (int j_ = 0; j_ < 2; ++j_) pn[S_][j_] = *(const f32x4*)(gN_ + (16 * lt + (lane & 15)) * 256 + vs * 64 + 16 * (vh + 2 * j_) + 4 * (lane >> 4)); } while (0)
#define ML_CHUNK(cch, S) do { \
        int t0, Lv; chunk_range((cch), t0, Lv); \
        const size_t row0 = (size_t)b * TP + t0; \
        _Pragma("unroll") \
        for (int k = 0; k < 4; ++k) { const int i = tid + k * NTHR; *(LAS u32x4*)(Qs + (i >> 5) * 264 + (i & 31) * 8) = pq[S][k]; *(LAS u32x4*)(KTw + (i >> 3) * 72 + (i & 7) * 8) = pk[S][k]; } \
        *(LAS u32x4*)(VTs + (tid >> 3) * 72 + (tid & 7) * 8) = pv[S]; \
        if (tid < 192) sb[tid] = psc[S]; \
        const f32x4 np0 = pn[S][0], np1 = pn[S][1]; \
        if ((cch) + 2 < NCH) ML_ISSUE((cch) + 2, S); \
        lds_barrier(); \
        f32x4 ia[3]; ia[0] = (f32x4){0.f, 0.f, 0.f, 0.f}; ia[1] = ia[0]; ia[2] = ia[0]; \
        _Pragma("unroll") \
        for (int ks = 0; ks < 8; ++ks) { const bf16x8 qf = ldfrag(Qs, 264, 16 * lt, 32 * ks, lane); \
            ia[0] = mfma16(ldfrag(CTs, 264, 16 * vh, 32 * ks, lane), qf, ia[0]); \
            ia[1] = mfma16(ldfrag(CTs, 264, 16 * (vh + 2), 32 * ks, lane), qf, ia[1]); \
            if (vh == 0) ia[2] = mfma16(ldfrag(CTs, 264, 64, 32 * ks, lane), qf, ia[2]); } \
        if (vh == 0 && lane < 16) sqn[16 * lt + lane] = ia[2][0]; \
        lds_barrier(); \
        { const int lidx = 16 * lt + (lane & 15); \
          const float cm = scm[lidx], bl = sb[lidx]; const float M = fmaxf(m, cm), rho = __expf(cm - M), sig = __expf(m - M); \
          float den = rho * sdp[lidx] + sig * sqn[lidx]; den = fmaxf(fabsf(den), __expf(-(bl + M))); const float dinv = __builtin_amdgcn_rcpf(den); \
          if (lidx < Lv) { \
        _Pragma("unroll") \
              for (int j = 0; j < 2; ++j) { const int v0 = 16 * (vh + 2 * j) + 4 * (lane >> 4); \
                  const f32x4 np = j == 0 ? np0 : np1; \
                  *(f32x4*)(HAo + (row0 + lidx) * 1024 + h * 256 + vs * 64 + v0) = (np * rho + ia[j] * sig) * dinv; } } } \
        { const float cml = scm[63], Ml = fmaxf(m, cml), dec = __expf(m - Ml), rl = __expf(cml - Ml); \
          _Pragma("unroll") for (int i = 0; i < 2; ++i) { f32x4 d2[1][5]; \
              _Pragma("unroll") for (int j = 0; j < 5; ++j) d2[0][j] = (f32x4){0.f, 0.f, 0.f, 0.f}; \
              mma_lds<1, 5, 2>(d2, KTw, 72, 32 * w + 16 * i, VTs, 72, 0, lane); \
              _Pragma("unroll") for (int j = 0; j < 5; ++j) { Cst[i][j] = Cst[i][j] * dec + d2[0][j] * rl; \
                  u32x2 o; o.x = pk2(Cst[i][j][0], Cst[i][j][1]); o.y = pk2(Cst[i][j][2], Cst[i][j][3]); \
                  *(LAS u32x2*)(CTs + (16 * j + (lane & 15)) * 264 + 32 * w + 16 * i + 4 * (lane >> 4)) = o; } } \
          m = sb[63] + Ml; } \
        lds_barrier(); \
    } while (0)
    ML_ISSUE(0, 0); ML_ISSUE(1, 1);
    lds_barrier();
    for (int cch = 0; cch + 1 < NCH; cch += 2) { ML_CHUNK(cch, 0); ML_CHUNK(cch + 1, 1); }
    ML_CHUNK(NCH - 1, 0);
#undef ML_CHUNK
#undef ML_ISSUE
    float* oc = c.out + O_PC + (((size_t)l * BATCH + b) * HA + h) * DHA * DHA; float* on = c.out + O_PN + (((size_t)l * BATCH + b) * HA + h) * DHA;
#pragma unroll
    for (int i = 0; i < 2; ++i) { const int k0 = 32 * w + 16 * i + 4 * (lane >> 4);
#pragma unroll
        for (int j = 0; j < 4; ++j)
#pragma unroll
            for (int r = 0; r < 4; ++r) oc[(size_t)(k0 + r) * 256 + vs * 64 + 16 * j + (lane & 15)] = Cst[i][j][r];
        if (vs == 0 && (lane & 15) == 0) {
#pragma unroll
            for (int r = 0; r < 4; ++r) on[k0 + r] = Cst[i][4][r]; } }
    if (vs == 0 && tid == 0) c.out[O_PM + ((size_t)l * BATCH + b) * HA + h] = m;
    lds_barrier();
}

__device__ __forceinline__ f32x4 mfma4f(float a, float b, f32x4 c) { return __builtin_amdgcn_mfma_f32_16x16x4f32(a, b, c, 0, 0, 0); }
__device__ __forceinline__ void tri_inv64(const LAS float* Am, LAS float* Tm, LAS float* Xt, int tid, int w, LAS bf16_t* Tb) {
    for (int i = tid; i < 64 * 65; i += NTHR) Tm[i] = 0.f;
    for (int i = tid; i < 64 * 36; i += NTHR) ((LAS unsigned*)Tb)[i] = 0u;
    lds_barrier();
    if (tid < 64) { const int base = (tid >> 3) * 8, cc = tid & 7; float x[8];
#pragma unroll
        for (int r = 0; r < 8; ++r) { float a = 0.f;
#pragma unroll
            for (int j = 0; j < r; ++j) a += Am[(base + r) * 65 + base + j] * x[j];
            x[r] = (r == cc) ? 1.f : (r < cc ? 0.f : -a); }
#pragma unroll
        for (int r = 0; r < 8; ++r) { Tm[(base + r) * 65 + base + cc] = x[r]; Tb[(base + r) * 72 + base + cc] = (bf16_t)f2bf(x[r]); } }
    lds_barrier();
    const int lane = tid & 63, li = lane & 15, lk = lane >> 4;
    if (w < 2) {
        const int bi = 32 * w + (li < 8 ? 0 : 16), l7 = li & 7; LAS float* X = Xt + w * 512;
        f32x4 x = {0.f, 0.f, 0.f, 0.f};
#pragma unroll
        for (int ks = 0; ks < 2; ++ks) x = mfma4f(Am[(bi + 8 + l7) * 65 + bi + 4 * ks + lk], Tm[(bi + 4 * ks + lk) * 65 + bi + l7], x);
#pragma unroll
        for (int r = 0; r < 4; ++r) X[(4 * lk + r) * 16 + li] = x[r];
        asm volatile("s_waitcnt lgkmcnt(0)" ::: "memory");
        f32x4 y = {0.f, 0.f, 0.f, 0.f};
#pragma unroll
        for (int ks = 0; ks < 2; ++ks) y = mfma4f(Tm[(bi + 8 + l7) * 65 + bi + 8 + 4 * ks + lk], X[(4 * ks + lk + (li < 8 ? 0 : 8)) * 16 + li], y);
        if ((lk < 2) == (li < 8)) {
#pragma unroll
            for (int r = 0; r < 4; ++r) { const int rr = bi + 8 + ((4 * lk + r) & 7); Tm[rr * 65 + bi + l7] = -y[r]; Tb[rr * 72 + bi + l7] = (bf16_t)f2bf(-y[r]); } } }
    lds_barrier();
    if (w < 2) { const int lb = 32 * w, hb = lb + 16; LAS float* X = Xt + w * 512;
        f32x4 x = {0.f, 0.f, 0.f, 0.f};
#pragma unroll
        for (int ks = 0; ks < 4; ++ks) x = mfma4f(Am[(hb + li) * 65 + lb + 4 * ks + lk], Tm[(lb + 4 * ks + lk) * 65 + lb + li], x);
#pragma unroll
        for (int r = 0; r < 4; ++r) X[(4 * lk + r) * 16 + li] = x[r];
        asm volatile("s_waitcnt lgkmcnt(0)" ::: "memory");
        f32x4 y = {0.f, 0.f, 0.f, 0.f};
#pragma unroll
        for (int ks = 0; ks < 4; ++ks) y = mfma4f(Tm[(hb + li) * 65 + hb + 4 * ks + lk], X[(4 * ks + lk) * 16 + li], y);
#pragma unroll
        for (int r = 0; r < 4; ++r) { Tm[(hb + 4 * lk + r) * 65 + lb + li] = -y[r]; Tb[(hb + 4 * lk + r) * 72 + lb + li] = (bf16_t)f2bf(-y[r]); } }
    lds_barrier();
    if (w < 2) { LAS float* X = Xt + w * 512;
        f32x4 x0 = {0.f, 0.f, 0.f, 0.f}, x1 = x0;
#pragma unroll
        for (int ks = 0; ks < 8; ++ks) { const float bb = Tm[(4 * ks + lk) * 65 + 16 * w + li];
            x0 = mfma4f(Am[(32 + li) * 65 + 4 * ks + lk], bb, x0); x1 = mfma4f(Am[(48 + li) * 65 + 4 * ks + lk], bb, x1); }
#pragma unroll
        for (int r = 0; r < 4; ++r) { X[(4 * lk + r) * 16 + li] = x0[r]; X[(16 + 4 * lk + r) * 16 + li] = x1[r]; }
        asm volatile("s_waitcnt lgkmcnt(0)" ::: "memory");
        f32x4 y0 = {0.f, 0.f, 0.f, 0.f}, y1 = y0;
#pragma unroll
        for (int ks = 0; ks < 8; ++ks) { const float bb = X[(4 * ks + lk) * 16 + li];
            y0 = mfma4f(Tm[(32 + li) * 65 + 32 + 4 * ks + lk], bb, y0); y1 = mfma4f(Tm[(48 + li) * 65 + 32 + 4 * ks + lk], bb, y1); }
#pragma unroll
        for (int r = 0; r < 4; ++r) { Tb[(32 + 4 * lk + r) * 72 + 16 * w + li] = (bf16_t)f2bf(-y0[r]); Tb[(48 + 4 * lk + r) * 72 + 16 * w + li] = (bf16_t)f2bf(-y1[r]); } }
    lds_barrier();
}

__device__ __forceinline__ void gdn_prep_unit(const Ctx& c, int l, int u) {
    int w = c.wave; asm volatile("" : "+s"(w)); const int lane = hw_lane(), tid = w * 64 + lane;
    const int cch = u % NCH, bh = u / NCH, h = bh % HB, b = bh / HB;
    int t0, Lv; chunk_range(cch, t0, Lv);
    const size_t row0 = (size_t)b * TP + t0;
    const bf16_t* PROJ = (const bf16_t*)(c.ws + WS_PROJ); const float* SG = (const float*)(c.ws + WS_SG);
    LAS bf16_t* Qs = (LAS bf16_t*)c.lds; LAS bf16_t* Ks = Qs + 64 * 136; LAS bf16_t* RAW = Ks + 64 * 136; LAS bf16_t* RT = RAW; LAS bf16_t* Tb = RT + 256 * 72;
    LAS float* Am = (LAS float*)(c.lds + 86272); LAS float* Tm = Am + 64 * 65; LAS float* Xt = Tm + 64 * 65; LAS float* psq = Xt + 32 * 33; LAS float* sg = psq + 1024; LAS float* sbe = sg + 64;
    bf16_t* gW = (bf16_t*)(c.ws + WS_GD_W) + (size_t)u * 64 * 128; bf16_t* gUT = (bf16_t*)(c.ws + WS_GD_UT) + (size_t)u * 128 * 64; bf16_t* gAT = (bf16_t*)(c.ws + WS_GD_AT) + (size_t)u * 64 * 64;
    bf16_t* gQ = (bf16_t*)(c.ws + WS_GD_Q) + (size_t)u * 64 * 128; bf16_t* gKD = (bf16_t*)(c.ws + WS_GD_KD) + (size_t)u * 128 * 64; float* gSC = (float*)(c.ws + WS_GD_SC) + (size_t)u * 128;
    if (w == 0) { float ga = 0.f, be = 0.f;
        if (lane < Lv) { const float a = SG[(row0 + lane) * SGLD + 8 + h], bb = SG[(row0 + lane) * SGLD + 16 + h];
            ga = -__expf(inp(c, I_ALOG)[l * HB + h]) * softplusf_(a + inp(c, I_DTB)[l * HB + h]); be = sigmoidf_(bb); }
        const float g = wave_incl_sum(ga, lane); sg[lane] = g; sbe[lane] = be; gSC[lane] = __expf(g); if (lane == 63) gSC[64] = __expf(g); }
    { u32x4 rv[7]; float cwv[3];
#pragma unroll
      for (int k = 0; k < 3; ++k) { const int i = tid + k * NTHR; const int j = i / 384, ch = i % 384; cwv[k] = inp(c, I_CONVW)[(size_t)l * 4 * 3072 + j * 3072 + (ch >> 7) * 1024 + h * 128 + (ch & 127)]; }
#pragma unroll
      for (int k = 0; k < 7; ++k) { const int i = tid + k * NTHR; rv[k] = (u32x4){0u, 0u, 0u, 0u};
          if (i < 67 * 48) { const int rr = i / 48, c8 = i % 48, part = c8 >> 4, d8 = c8 & 15; const int tt = t0 - 3 + rr;
              if (tt >= 0 && rr - 3 < Lv) rv[k] = *(const u32x4*)(PROJ + ((size_t)b * TP + tt) * NPROJ + PB_QKV + part * 1024 + h * 128 + d8 * 8); } }
#pragma unroll
      for (int k = 0; k < 7; ++k) { const int i = tid + k * NTHR; if (i < 67 * 48) { const int rr = i / 48, c8 = i % 48; *(LAS u32x4*)(RAW + rr * 384 + c8 * 8) = rv[k]; } }
#pragma unroll
      for (int k = 0; k < 3; ++k) ((LAS float*)(c.lds + 102912))[tid + k * NTHR] = cwv[k]; }
    lds_barrier();
    const int s = lane, p = w;
    float yq[16], yk[16], yv[16];
    { const LAS float* cw = (const LAS float*)(c.lds + 102912); float sq = 0.f, sk = 0.f;
#pragma unroll
      for (int part = 0; part < 3; ++part) {
#pragma unroll
          for (int e4 = 0; e4 < 4; ++e4) { f32x4 a = (f32x4){0.f, 0.f, 0.f, 0.f};
#pragma unroll
              for (int j = 0; j < 4; ++j) { const f32x4 wv = *(const LAS f32x4*)(cw + j * 384 + part * 128 + p * 16 + e4 * 4);
                  const u32x2 rv = *(const LAS u32x2*)(RAW + (s + j) * 384 + part * 128 + p * 16 + e4 * 4);
                  a[0] += wv[0] * __uint_as_float(rv.x << 16); a[1] += wv[1] * __uint_as_float(rv.x & 0xffff0000u); a[2] += wv[2] * __uint_as_float(rv.y << 16); a[3] += wv[3] * __uint_as_float(rv.y & 0xffff0000u); }
#pragma unroll
              for (int e = 0; e < 4; ++e) { const float y = s < Lv ? siluf_(a[e]) : 0.f;
                  if (part == 0) { yq[e4 * 4 + e] = y; sq += y * y; } else if (part == 1) { yk[e4 * 4 + e] = y; sk += y * y; } else yv[e4 * 4 + e] = y; } } }
      psq[p * 64 + s] = sq; psq[512 + p * 64 + s] = sk; }
    lds_barrier();
    { float sq = 0.f, sk = 0.f;
#pragma unroll
      for (int i = 0; i < 8; ++i) { sq += psq[i * 64 + s]; sk += psq[512 + i * 64 + s]; }
      const float qn = rsqrtf(sq + 1e-12f) * 0.08838834764831845f, kn = rsqrtf(sk + 1e-12f);
      const float g = sg[s], be = sbe[s], gL = sg[63]; const float kb = kn * be * __expf(g), kd = kn * __expf(gL - g);
      u32x4 o0, o1;
      o0.x = pk2(yq[0] * qn, yq[1] * qn); o0.y = pk2(yq[2] * qn, yq[3] * qn); o0.z = pk2(yq[4] * qn, yq[5] * qn); o0.w = pk2(yq[6] * qn, yq[7] * qn);
      o1.x = pk2(yq[8] * qn, yq[9] * qn); o1.y = pk2(yq[10] * qn, yq[11] * qn); o1.z = pk2(yq[12] * qn, yq[13] * qn); o1.w = pk2(yq[14] * qn, yq[15] * qn);
      *(LAS u32x4*)(Qs + s * 136 + p * 16) = o0; *(LAS u32x4*)(Qs + s * 136 + p * 16 + 8) = o1; *(u32x4*)(gQ + s * 128 + p * 16) = o0; *(u32x4*)(gQ + s * 128 + p * 16 + 8) = o1;
      o0.x = pk2(yk[0] * kn, yk[1] * kn); o0.y = pk2(yk[2] * kn, yk[3] * kn); o0.z = pk2(yk[4] * kn, yk[5] * kn); o0.w = pk2(yk[6] * kn, yk[7] * kn);
      o1.x = pk2(yk[8] * kn, yk[9] * kn); o1.y = pk2(yk[10] * kn, yk[11] * kn); o1.z = pk2(yk[12] * kn, yk[13] * kn); o1.w = pk2(yk[14] * kn, yk[15] * kn);
      *(LAS u32x4*)(Ks + s * 136 + p * 16) = o0; *(LAS u32x4*)(Ks + s * 136 + p * 16 + 8) = o1;
#pragma unroll
      for (int e = 0; e < 16; ++e) { RT[(p * 16 + e) * 72 + s] = (bf16_t)f2bf(yv[e] * be); RT[(128 + p * 16 + e) * 72 + s] = (bf16_t)f2bf(yk[e] * kb); gKD[(p * 16 + e) * 64 + s] = (bf16_t)f2bf(yk[e] * kd); } }
    lds_barrier();
    { const int mt = w & 3, nh = w >> 2;
      f32x4 aK[2][1], aQ[2][1]; aK[0][0] = (f32x4){0.f, 0.f, 0.f, 0.f}; aK[1][0] = aK[0][0]; aQ[0][0] = aK[0][0]; aQ[1][0] = aK[0][0];
      mma_lds<2, 1, 4>(aK, Ks, 136, 32 * nh, Ks, 136, 16 * mt, lane);
      mma_lds<2, 1, 4>(aQ, Ks, 136, 32 * nh, Qs, 136, 16 * mt, lane);
      const int lidx = 16 * mt + (lane & 15); const float gl = sg[lidx], bel = sbe[lidx];
#pragma unroll
      for (int i = 0; i < 2; ++i) { const int s0 = 32 * nh + 16 * i + 4 * (lane >> 4); const f32x4 gs = *(const LAS f32x4*)(sg + s0); float q[4];
#pragma unroll
          for (int r = 0; r < 4; ++r) { const int sidx = s0 + r; const float dcy = sidx <= lidx ? __expf(gl - gs[r]) : 0.f;
              Am[lidx * 65 + sidx] = sidx < lidx ? bel * aK[i][0][r] * dcy : 0.f; q[r] = aQ[i][0][r] * dcy; }
          u32x2 o; o.x = pk2(q[0], q[1]); o.y = pk2(q[2], q[3]); *(u32x2*)(gAT + lidx * 64 + s0) = o; } }
    lds_barrier();
    tri_inv64(Am, Tm, Xt, tid, w, Tb);
    { f32x4 aU[1][4], aW[1][4];
#pragma unroll
      for (int j = 0; j < 4; ++j) { aU[0][j] = (f32x4){0.f, 0.f, 0.f, 0.f}; aW[0][j] = aU[0][j]; }
      const int mt = w & 3, vq = w >> 2;
      mma_lds<1, 4, 2>(aU, Tb, 72, 16 * mt, RT, 72, 64 * vq, lane);
      mma_lds<1, 4, 2>(aW, RT, 72, 128 + 16 * w, Tb, 72, 0, lane);
#pragma unroll
      for (int j = 0; j < 4; ++j) { u32x2 o; o.x = pk2(aU[0][j][0], aU[0][j][1]); o.y = pk2(aU[0][j][2], aU[0][j][3]);
          *(u32x2*)(gUT + (64 * vq + 16 * j + (lane & 15)) * 64 + 16 * mt + 4 * (lane >> 4)) = o;
          o.x = pk2(aW[0][j][0], aW[0][j][1]); o.y = pk2(aW[0][j][2], aW[0][j][3]);
          *(u32x2*)(gW + (16 * j + (lane & 15)) * 128 + 16 * w + 4 * (lane >> 4)) = o; } }
    lds_barrier();
}

__device__ __forceinline__ void gdn_seq_unit(const Ctx& c, int l, int b, int h) {
    int w = c.wave; asm volatile("" : "+s"(w)); const int lane = hw_lane(), tid = w * 64 + lane;
    const bf16_t* PROJ = (const bf16_t*)(c.ws + WS_PROJ); bf16_t* YBR = (bf16_t*)(c.ws + WS_YBR);
    LAS bf16_t* Qs = (LAS bf16_t*)c.lds; LAS bf16_t* Wm = Qs + 64 * 136; LAS bf16_t* UT = Wm + 64 * 136; LAS bf16_t* ATs = UT + 128 * 72; LAS bf16_t* KD = ATs + 64 * 72; LAS bf16_t* ST = KD + 128 * 72;
    LAS float* seg = (LAS float*)(ST + 128 * 136); LAS float* ssq = seg + 128; LAS float* gnws = ssq + 128;
    for (int i = tid; i < 128 * 136; i += NTHR) ST[i] = 0;
    if (tid < 128) gnws[tid] = inp(c, I_GNW)[l * DHB + tid];
    f32x4 Sst[1][8];
#pragma unroll
    for (int j = 0; j < 8; ++j) Sst[0][j] = (f32x4){0.f, 0.f, 0.f, 0.f};
    const int lt = w & 3, vq = w >> 2;
    const LAS float* gnwp = gnws + 64 * vq + 4 * (lane >> 4);
    u32x4 pQ[1][2], pW[1][2], pU[1][2], pK[1][2], pA[1]; float psc[1] = {0.f}; u32x2 pz[4];
#define GD_ISSUE(cc, S_) do { const int u_ = (b * HB + h) * NCH + (cc); \
        const bf16_t* gW_ = (const bf16_t*)(c.ws + WS_GD_W) + (size_t)u_ * 64 * 128; const bf16_t* gUT_ = (const bf16_t*)(c.ws + WS_GD_UT) + (size_t)u_ * 128 * 64; const bf16_t* gAT_ = (const bf16_t*)(c.ws + WS_GD_AT) + (size_t)u_ * 64 * 64; \
        const bf16_t* gQ_ = (const bf16_t*)(c.ws + WS_GD_Q) + (size_t)u_ * 64 * 128; const bf16_t* gKD_ = (const bf16_t*)(c.ws + WS_GD_KD) + (size_t)u_ * 128 * 64; const float* gSC_ = (const float*)(c.ws + WS_GD_SC) + (size_t)u_ * 128; \
        _Pragma("unroll") for (int k_ = 0; k_ < 2; ++k_) { const int i_ = tid + k_ * NTHR; pQ[S_][k_] = *(const u32x4*)(gQ_ + (i_ >> 4) * 128 + (i_ & 15) * 8); pW[S_][k_] = *(const u32x4*)(gW_ + (i_ >> 4) * 128 + (i_ & 15) * 8); \
            pU[S_][k_] = *(const u32x4*)(gUT_ + (i_ >> 3) * 64 + (i_ & 7) * 8); pK[S_][k_] = *(const u32x4*)(gKD_ + (i_ >> 3) * 64 + (i_ & 7) * 8); } \
        pA[S_] = *(const u32x4*)(gAT_ + (tid >> 3) * 64 + (tid & 7) * 8); psc[S_] = tid < 65 ? gSC_[tid] : 0.f; } while (0)
#define GD_ZISSUE(cc) do { int t0_, Lv_; chunk_range((cc), t0_, Lv_); const size_t row0_ = (size_t)b * TP + t0_; \
        _Pragma("unroll") for (int i_ = 0; i_ < 4; ++i_) { const int zr_ = 16 * lt + (lane & 15) < Lv_ ? 16 * lt + (lane & 15) : Lv_ - 1; pz[i_] = *(const u32x2*)(PROJ + (row0_ + zr_) * NPROJ + PB_Z + h * 128 + 64 * vq + 16 * i_ + 4 * (lane >> 4)); } } while (0)
#define GD_CHUNK(cch, S) do { \
        int t0, Lv; chunk_range((cch), t0, Lv); \
        const size_t row0 = (size_t)b * TP + t0; \
        _Pragma("unroll") \
        for (int k = 0; k < 2; ++k) { const int i = tid + k * NTHR; *(LAS u32x4*)(Qs + (i >> 4) * 136 + (i & 15) * 8) = pQ[S][k]; *(LAS u32x4*)(Wm + (i >> 4) * 136 + (i & 15) * 8) = pW[S][k]; \
            *(LAS u32x4*)(UT + (i >> 3) * 72 + (i & 7) * 8) = pU[S][k]; *(LAS u32x4*)(KD + (i >> 3) * 72 + (i & 7) * 8) = pK[S][k]; } \
        *(LAS u32x4*)(ATs + (tid >> 3) * 72 + (tid & 7) * 8) = pA[S]; \
        if (tid < 65) seg[tid] = psc[S]; \
        if ((cch) + 1 < NCH) GD_ISSUE((cch) + 1, S); \
        GD_ZISSUE(cch); \
        lds_barrier(); \
        f32x4 aq[4][1]; \
        _Pragma("unroll") for (int j = 0; j < 4; ++j) aq[j][0] = (f32x4){0.f, 0.f, 0.f, 0.f}; \
        _Pragma("unroll") for (int jh = 0; jh < 2; ++jh) { f32x4 ws_[1][2]; ws_[0][0] = (f32x4){0.f, 0.f, 0.f, 0.f}; ws_[0][1] = ws_[0][0]; \
          mma_lds<1, 2, 4>(ws_, Wm, 136, 16 * lt, ST, 136, 64 * vq + 32 * jh, lane); \
          { f32x4 (&aqh)[2][1] = *(f32x4 (*)[2][1])&aq[2 * jh]; mma_lds<2, 1, 4>(aqh, ST, 136, 64 * vq + 32 * jh, Qs, 136, 16 * lt, lane); } \
          _Pragma("unroll") for (int j2 = 0; j2 < 2; ++j2) { const int j = 2 * jh + j2; LAS u32x2* pu = (LAS u32x2*)(UT + (64 * vq + 16 * j + (lane & 15)) * 72 + 16 * lt + 4 * (lane >> 4)); const u32x2 uu = *pu; \
              u32x2 o; o.x = pk2(__uint_as_float(uu.x << 16) - ws_[0][j2][0], __uint_as_float(uu.x & 0xffff0000u) - ws_[0][j2][1]); \
              o.y = pk2(__uint_as_float(uu.y << 16) - ws_[0][j2][2], __uint_as_float(uu.y & 0xffff0000u) - ws_[0][j2][3]); *pu = o; } } \
        lds_barrier(); \
        { const int lidx = 16 * lt + (lane & 15); const float egl = seg[lidx], egL = seg[64]; \
        _Pragma("unroll") \
          for (int i = 0; i < 4; ++i) aq[i][0] = aq[i][0] * egl; \
          mma_lds<4, 1, 2>(aq, UT, 72, 64 * vq, ATs, 72, 16 * lt, lane); \
        _Pragma("unroll") \
          for (int j = 0; j < 8; ++j) Sst[0][j] = Sst[0][j] * egL; \
          mma_lds<1, 8, 2>(Sst, KD, 72, 16 * w, UT, 72, 0, lane); \
        _Pragma("unroll") \
          for (int j = 0; j < 8; ++j) { u32x2 o; o.x = pk2(Sst[0][j][0], Sst[0][j][1]); o.y = pk2(Sst[0][j][2], Sst[0][j][3]); *(LAS u32x2*)(ST + (16 * j + (lane & 15)) * 136 + 16 * w + 4 * (lane >> 4)) = o; } \
          float ss = 0.f; \
        _Pragma("unroll") \
          for (int i = 0; i < 4; ++i) ss += (aq[i][0][0] * aq[i][0][0] + aq[i][0][1] * aq[i][0][1]) + (aq[i][0][2] * aq[i][0][2] + aq[i][0][3] * aq[i][0][3]); \
          ss += __shfl_xor(ss, 16); ss += __shfl_xor(ss, 32); \
          if (lane < 16) ssq[vq * 64 + lidx] = ss; \
          lds_barrier(); \
          const float rs = rsqrtf((ssq[lidx] + ssq[64 + lidx]) * (1.f / 128.f) + 1e-6f); \
          if (lidx < Lv) { \
        _Pragma("unroll") \
              for (int i = 0; i < 4; ++i) { const int v0 = 64 * vq + 16 * i + 4 * (lane >> 4); const f32x4 gw4 = *(const LAS f32x4*)(gnwp + 16 * i); \
                  const u32x2 zz = pz[i]; \
                  u32x2 o; o.x = pk2(aq[i][0][0] * rs * gw4[0] * siluf_(__uint_as_float(zz.x << 16)), aq[i][0][1] * rs * gw4[1] * siluf_(__uint_as_float(zz.x & 0xffff0000u))); \
                  o.y = pk2(aq[i][0][2] * rs * gw4[2] * siluf_(__uint_as_float(zz.y << 16)), aq[i][0][3] * rs * gw4[3] * siluf_(__uint_as_float(zz.y & 0xffff0000u))); \
                  *(u32x2*)(YBR + (row0 + lidx) * YLD + 1024 + h * 128 + v0) = o; } } } \
          \
    } while (0)
    GD_ISSUE(0, 0);
    lds_barrier();
#pragma unroll 1
    for (int cch = 0; cch < NCH; ++cch) GD_CHUNK(cch, 0);
#undef GD_CHUNK
#undef GD_ZISSUE
#undef GD_ISSUE
    float* os = c.out + O_PGS + (((size_t)l * BATCH + b) * HB + h) * DHB * DHB;
#pragma unroll
    for (int j = 0; j < 8; ++j)
#pragma unroll
        for (int r = 0; r < 4; ++r) os[(size_t)(16 * w + 4 * (lane >> 4) + r) * 128 + 16 * j + (lane & 15)] = Sst[0][j][r];
    if (tid < 384) { const int cg = (tid >> 7) * 1024 + h * 128 + (tid & 127); float* ocv = c.out + O_PGC + ((size_t)l * BATCH + b) * 3 * 3072;
#pragma unroll
        for (int j = 0; j < 3; ++j) ocv[j * 3072 + cg] = bf2f(PROJ[((size_t)b * TP + TP - 3 + j) * NPROJ + PB_QKV + cg]); }
    __syncthreads();
}

__device__ __forceinline__ void rwkv_prep_unit(const Ctx& c, int l, int u) {
    int w = c.wave; asm volatile("" : "+s"(w)); const int lane = hw_lane(), tid = w * 64 + lane;
    const int cch = u % NCH, bh = u / NCH, h = bh % HC, b = bh / HC;
    int t0, Lv; chunk_range(cch, t0, Lv);
    const bf16_t* PROJ = (const bf16_t*)(c.ws + WS_PROJ);
    LAS bf16_t* XW = (LAS bf16_t*)c.lds; LAS bf16_t* XA = XW + 64 * 72; LAS bf16_t* XG = XA + 64 * 72; LAS bf16_t* W2T = XG + 64 * 136; LAS bf16_t* A2T = W2T + 64 * 72; LAS bf16_t* G2T = A2T + 64 * 72;
    LAS bf16_t* STG = (LAS bf16_t*)(c.lds + 73728); LAS float* LO = (LAS float*)(c.lds + 73728); LAS float* red = (LAS float*)(c.lds + 123648);
    LAS bf16_t* AR = (LAS bf16_t*)c.lds; LAS bf16_t* KB = AR + 128 * 72; LAS bf16_t* VT = KB + 128 * 72; LAS bf16_t* KhT = VT + 64 * 72; LAS bf16_t* R2T = KhT + 64 * 72;
    LAS bf16_t* AkR = (LAS bf16_t*)(c.lds + 73728); LAS float* Am = (LAS float*)(c.lds + 92160); LAS float* Tm = Am + 64 * 65; LAS float* Xt = Tm + 64 * 65; LAS bf16_t* Tb = AR;
    bf16_t* gU = (bf16_t*)(c.ws + WS_RW) + (size_t)u * RW_N * 4096;
    bf16_t* gTA = gU + RW_TA * 4096; bf16_t* gPVT = gU + RW_PVT * 4096; bf16_t* gRH = gU + RW_RH * 4096; bf16_t* gYV = gU + RW_YV * 4096;
    bf16_t* gARB = gU + RW_ARB * 4096; bf16_t* gBHT = gU + RW_BHT * 4096; bf16_t* gKVT = gU + RW_KVT * 4096; bf16_t* gV = gU + RW_V * 4096; bf16_t* gG = gU + RW_G * 4096;
    float* gSC = (float*)(c.ws + WS_RW_SC) + (size_t)u * 128;
    LAS float* PRM = (LAS float*)(c.lds + 127744);
    u32x4 st1[4], st2[5];
    { const float* w2p = inp(c, I_W2) + (size_t)l * 64 * 1024 + h * 64 + (tid >> 6) * 1024 + (tid & 63); const float* a2p = inp(c, I_A2) + (size_t)l * 64 * 1024 + h * 64 + (tid >> 6) * 1024 + (tid & 63);
      const float* g2p = inp(c, I_G2) + (size_t)l * 128 * 1024 + h * 64 + (tid >> 6) * 1024 + (tid & 63);
      float lw2[8], la2[8], lg2[16], pv_[2];
#pragma unroll
      for (int k = 0; k < 8; ++k) { lw2[k] = w2p[k * 8192]; la2[k] = a2p[k * 8192]; }
#pragma unroll
      for (int k = 0; k < 16; ++k) lg2[k] = g2p[k * 8192];
#pragma unroll
      for (int q = 0; q < 2; ++q) { const int idx = tid + q * NTHR; pv_[q] = 0.f;
          if (idx < 768) { const float* src;
              if (idx < 192) src = inp(c, I_MU) + (size_t)l * NCC + (idx >> 6) * 1024 + h * 64 + (idx & 63);
              else if (idx < 448) src = inp(c, I_MU) + (size_t)l * NCC + 3072 + (idx - 192);
              else { const int t_ = (idx - 448) >> 6, o_ = l * 1024 + h * 64 + ((idx - 448) & 63);
                  src = (t_ == 0 ? inp(c, I_W0) : t_ == 1 ? inp(c, I_A0) : t_ == 2 ? inp(c, I_KK) : t_ == 3 ? inp(c, I_KA) : inp(c, I_RK)) + o_; }
              pv_[q] = *src; } }
#pragma unroll
      for (int k = 0; k < 4; ++k) { const int i = tid + k * NTHR; st1[k] = (u32x4){0u, 0u, 0u, 0u};
          if (i < 65 * 24) { const int rr = i / 24, c8 = i % 24, part = c8 >> 3, d8 = c8 & 7; const int tt = t0 - 1 + rr;
              if (tt >= 0 && rr - 1 < Lv) st1[k] = *(const u32x4*)(PROJ + ((size_t)b * TP + tt) * NPROJ + PC0 + part * 1024 + h * 64 + d8 * 8); } }
#pragma unroll
      for (int k = 0; k < 5; ++k) { const int i = tid + k * NTHR; st2[k] = (u32x4){0u, 0u, 0u, 0u};
          if (i < 65 * 32) { const int rr = i >> 5, c8 = i & 31; const int tt = t0 - 1 + rr;
              if (tt >= 0 && rr - 1 < Lv) st2[k] = *(const u32x4*)(PROJ + ((size_t)b * TP + tt) * NPROJ + PC0 + 3072 + c8 * 8); } }
      LAS bf16_t* dw = W2T + (tid & 63) * 72 + (tid >> 6); LAS bf16_t* da = A2T + (tid & 63) * 72 + (tid >> 6); LAS bf16_t* dg = G2T + (tid & 63) * 136 + (tid >> 6);
#pragma unroll
      for (int k = 0; k < 8; ++k) { dw[8 * k] = (bf16_t)f2bf(lw2[k]); da[8 * k] = (bf16_t)f2bf(la2[k]); }
#pragma unroll
      for (int k = 0; k < 16; ++k) dg[8 * k] = (bf16_t)f2bf(lg2[k]);
#pragma unroll
      for (int q = 0; q < 2; ++q) { const int idx = tid + q * NTHR; if (idx < 768) PRM[idx] = pv_[q]; } }
    const int s = lane, p = w;
    const bool valid = s < Lv;
    float r8[8], k8[8], v8[8];
    auto mix8 = [&](const LAS bf16_t* st, int pitch, int col, int ch, float (&o)[8]) {
        const u32x4 a = *(const LAS u32x4*)(st + (s + 1) * pitch + col), bq = *(const LAS u32x4*)(st + s * pitch + col);
        const f32x4 m0 = *(const LAS f32x4*)(PRM + ch), m1 = *(const LAS f32x4*)(PRM + ch + 4);
        const unsigned aw[4] = {a.x, a.y, a.z, a.w}, bw[4] = {bq.x, bq.y, bq.z, bq.w};
#pragma unroll
        for (int e = 0; e < 4; ++e) { const float c0 = __uint_as_float(aw[e] << 16), c1 = __uint_as_float(aw[e] & 0xffff0000u), p0 = __uint_as_float(bw[e] << 16), p1 = __uint_as_float(bw[e] & 0xffff0000u);
            const float mm0 = (2 * e < 4) ? m0[2 * e] : m1[2 * e - 4], mm1 = (2 * e + 1 < 4) ? m0[2 * e + 1] : m1[2 * e + 1 - 4];
            o[2 * e] = valid ? c0 + (p0 - c0) * mm0 : 0.f; o[2 * e + 1] = valid ? c1 + (p1 - c1) * mm1 : 0.f; } };
#pragma unroll
    for (int k = 0; k < 4; ++k) { const int i = tid + k * NTHR; if (i < 65 * 24) { const int rr = i / 24, c8 = i % 24; *(LAS u32x4*)(STG + rr * 200 + (c8 >> 3) * 64 + (c8 & 7) * 8) = st1[k]; } }
    lds_barrier();
    mix8(STG, 200, p * 8, p * 8, r8); mix8(STG, 200, 64 + p * 8, 64 + p * 8, k8); mix8(STG, 200, 128 + p * 8, 128 + p * 8, v8);
#pragma unroll
    for (int e = 0; e < 8; ++e) asm volatile("" : "+v"(r8[e]), "+v"(k8[e]), "+v"(v8[e]));
    lds_barrier();
#pragma unroll
    for (int k = 0; k < 5; ++k) { const int i = tid + k * NTHR; if (i < 65 * 32) *(LAS u32x4*)(STG + (i >> 5) * 264 + (i & 31) * 8) = st2[k]; }
    lds_barrier();
    { float t8[8]; u32x4 o;
      mix8(STG, 264, p * 8, 192 + p * 8, t8);
      o.x = pk2(ftanh(t8[0]), ftanh(t8[1])); o.y = pk2(ftanh(t8[2]), ftanh(t8[3])); o.z = pk2(ftanh(t8[4]), ftanh(t8[5])); o.w = pk2(ftanh(t8[6]), ftanh(t8[7])); *(LAS u32x4*)(XW + s * 72 + p * 8) = o;
      mix8(STG, 264, 64 + p * 8, 256 + p * 8, t8);
      o.x = pk2(t8[0], t8[1]); o.y = pk2(t8[2], t8[3]); o.z = pk2(t8[4], t8[5]); o.w = pk2(t8[6], t8[7]); *(LAS u32x4*)(XA + s * 72 + p * 8) = o;
#pragma unroll
      for (int q = 0; q < 2; ++q) { mix8(STG, 264, 128 + p * 16 + q * 8, 320 + p * 16 + q * 8, t8);
          o.x = pk2(fsigmoid(t8[0]), fsigmoid(t8[1])); o.y = pk2(fsigmoid(t8[2]), fsigmoid(t8[3])); o.z = pk2(fsigmoid(t8[4]), fsigmoid(t8[5])); o.w = pk2(fsigmoid(t8[6]), fsigmoid(t8[7]));
          *(LAS u32x4*)(XG + s * 136 + p * 16 + q * 8) = o; } }
    lds_barrier();
    { const int mt = w & 3, nh = w >> 2; f32x4 a0[1][2], a1[1][2], a2[1][2];
#pragma unroll
      for (int j = 0; j < 2; ++j) { a0[0][j] = (f32x4){0.f, 0.f, 0.f, 0.f}; a1[0][j] = a0[0][j]; a2[0][j] = a0[0][j]; }
      mma_lds<1, 2, 2>(a0, XW, 72, 16 * mt, W2T, 72, 32 * nh, lane);
      mma_lds<1, 2, 2>(a1, XA, 72, 16 * mt, A2T, 72, 32 * nh, lane);
      mma_lds<1, 2, 4>(a2, XG, 136, 16 * mt, G2T, 136, 32 * nh, lane);
#pragma unroll
      for (int j = 0; j < 2; ++j)
#pragma unroll
          for (int r = 0; r < 4; ++r) { const int tok = 16 * mt + 4 * (lane >> 4) + r, cc = 32 * nh + 16 * j + (lane & 15);
              LO[tok * 65 + cc] = a0[0][j][r]; LO[4160 + tok * 65 + cc] = a1[0][j][r]; LO[8320 + tok * 65 + cc] = a2[0][j][r]; } }
    lds_barrier();
    const LAS float* pW0 = PRM + 448 + p * 8; const LAS float* pA0 = PRM + 512 + p * 8; const LAS float* pKK = PRM + 576 + p * 8; const LAS float* pKA = PRM + 640 + p * 8; const LAS float* pRK = PRM + 704 + p * 8;
    { float sq = 0.f, bn = 0.f;
#pragma unroll
      for (int e = 0; e < 8; ++e) { const int cc = p * 8 + e;
          const float et = fsigmoid(pA0[e] + LO[4160 + s * 65 + cc]);
          const float kkv = k8[e] * pKK[e]; sq += kkv * kkv;
          const float k2 = k8[e] * (1.f + (et - 1.f) * pKA[e]); bn += r8[e] * k2 * pRK[e]; }
      red[p * 64 + s] = sq; red[512 + p * 64 + s] = bn; }
    lds_barrier();
    { float sq = 0.f, bn = 0.f;
#pragma unroll
      for (int i = 0; i < 8; ++i) { sq += red[i * 64 + s]; bn += red[512 + i * 64 + s]; }
      const float kn = rsqrtf(sq + 1e-12f);
      if (p == 0) gSC[64 + s] = valid ? bn : 0.f;
#pragma unroll
      for (int e2 = 0; e2 < 4; ++e2) { float fa[2], fr[2], fk[2], fb[2], frh[2], fv[2], fg[2];
#pragma unroll
          for (int q = 0; q < 2; ++q) { const int e = 2 * e2 + q, cc = p * 8 + e;
              const float wl = pW0[e] + LO[s * 65 + cc]; const float lw = valid ? -0.6065306597126334f * fsigmoid(wl) : 0.f;
              const float et = fsigmoid(pA0[e] + LO[4160 + s * 65 + cc]);
              const float Lc = wave_incl_sum(lw, lane); const float Lex = Lc - lw; const float mid = lane_bcast(Lc, 31), LL = lane_bcast(Lc, 63);
              const float kk = k8[e] * pKK[e] * kn; const float k2 = k8[e] * (1.f + (et - 1.f) * pKA[e]);
              const float av = valid ? -kk : 0.f, bv = valid ? kk * et : 0.f, rv = valid ? r8[e] : 0.f, kv = valid ? k2 : 0.f;
              fv[q] = valid ? v8[e] : 0.f; fg[q] = valid ? LO[8320 + s * 65 + cc] : 0.f;
              fa[q] = av * __expf(Lex - mid); fr[q] = rv * __expf(Lc - mid); const float ek = __expf(mid - Lc); fk[q] = kv * ek; fb[q] = bv * ek;
              frh[q] = rv * __expf(Lc); const float eh = __expf(LL - Lc);
              if (s == 0) gSC[p * 8 + e] = __expf(LL);
              VT[(p * 8 + e) * 72 + s] = (bf16_t)f2bf(fv[q]); KhT[(p * 8 + e) * 72 + s] = (bf16_t)f2bf(kv * eh); R2T[(p * 8 + e) * 72 + s] = (bf16_t)f2bf(av * __expf(Lex));
              gBHT[(p * 8 + e) * 64 + s] = (bf16_t)f2bf(bv * eh); }
          const int co = p * 8 + 2 * e2;
          *(LAS unsigned*)(AR + s * 72 + co) = pk2(fa[0], fa[1]); *(LAS unsigned*)(AR + (64 + s) * 72 + co) = pk2(fr[0], fr[1]);
          *(LAS unsigned*)(KB + s * 72 + co) = pk2(fk[0], fk[1]); *(LAS unsigned*)(KB + (64 + s) * 72 + co) = pk2(fb[0], fb[1]);
          *(unsigned*)(gRH + s * 64 + co) = pk2(frh[0], frh[1]); *(unsigned*)(gV + s * 64 + co) = pk2(fv[0], fv[1]); *(unsigned*)(gG + s * 64 + co) = pk2(fg[0], fg[1]);
          asm volatile("" ::: "memory"); } }
    lds_barrier();
    { f32x4 acc[8][1];
#pragma unroll
      for (int j = 0; j < 8; ++j) acc[j][0] = (f32x4){0.f, 0.f, 0.f, 0.f};
      mma_lds<8, 1, 2>(acc, KB, 72, 0, AR, 72, 16 * w, lane);
      const int t = 16 * (w & 3) + (lane & 15);
#pragma unroll
      for (int j = 0; j < 8; ++j) { const int s0 = 16 * (j & 3) + 4 * (lane >> 4); float x[4];
#pragma unroll
          for (int r = 0; r < 4; ++r) x[r] = (w < 4 ? s0 + r < t : s0 + r <= t) ? acc[j][0][r] : 0.f;
          if (j < 4) { u32x2 o; o.x = pk2(x[0], x[1]); o.y = pk2(x[2], x[3]); *(LAS u32x2*)(AkR + ((w < 4 ? 0 : 64) + t) * 72 + s0) = o; }
          else if (w < 4) {
#pragma unroll
              for (int r = 0; r < 4; ++r) Am[t * 65 + s0 + r] = -x[r]; }
          else { u32x2 o; o.x = pk2(x[0], x[1]); o.y = pk2(x[2], x[3]); *(u32x2*)(gARB + t * 64 + s0) = o; } } }
    lds_barrier();
    tri_inv64(Am, Tm, Xt, tid, w, Tb);
    { const int mt = w & 3, nh = w >> 2; f32x4 av[1][2], yv[1][2], kv[1][2];
#pragma unroll
      for (int j = 0; j < 2; ++j) { av[0][j] = (f32x4){0.f, 0.f, 0.f, 0.f}; yv[0][j] = av[0][j]; kv[0][j] = av[0][j]; }
      mma_lds<1, 2, 2>(av, AkR, 72, 16 * mt, VT, 72, 32 * nh, lane);
      mma_lds<1, 2, 2>(yv, VT, 72, 16 * mt, AkR, 72, 64 + 32 * nh, lane);
      mma_lds<1, 2, 2>(kv, KhT, 72, 16 * mt, VT, 72, 32 * nh, lane);
#pragma unroll
      for (int j = 0; j < 2; ++j) { u32x2 o; const int cj = 32 * nh + 16 * j + (lane & 15), r0 = 16 * mt + 4 * (lane >> 4);
          o.x = pk2(av[0][j][0], av[0][j][1]); o.y = pk2(av[0][j][2], av[0][j][3]); *(LAS u32x2*)(R2T + (64 + cj) * 72 + r0) = o;
          o.x = pk2(yv[0][j][0], yv[0][j][1]); o.y = pk2(yv[0][j][2], yv[0][j][3]); *(u32x2*)(gYV + cj * 64 + r0) = o;
          o.x = pk2(kv[0][j][0], kv[0][j][1]); o.y = pk2(kv[0][j][2], kv[0][j][3]); *(u32x2*)(gKVT + cj * 64 + r0) = o; } }
    lds_barrier();
    { const int mt = w & 3, nh = w >> 2; f32x4 ta[1][2], pv[1][2];
#pragma unroll
      for (int j = 0; j < 2; ++j) { ta[0][j] = (f32x4){0.f, 0.f, 0.f, 0.f}; pv[0][j] = ta[0][j]; }
      mma_lds<1, 2, 2>(ta, R2T, 72, 16 * mt, Tb, 72, 32 * nh, lane);
      mma_lds<1, 2, 2>(pv, Tb, 72, 16 * mt, R2T, 72, 64 + 32 * nh, lane);
#pragma unroll
      for (int j = 0; j < 2; ++j) { u32x2 o; const int cj = 32 * nh + 16 * j + (lane & 15), r0 = 16 * mt + 4 * (lane >> 4);
          o.x = pk2(ta[0][j][0], ta[0][j][1]); o.y = pk2(ta[0][j][2], ta[0][j][3]); *(u32x2*)(gTA + cj * 64 + r0) = o;
          o.x = pk2(pv[0][j][0], pv[0][j][1]); o.y = pk2(pv[0][j][2], pv[0][j][3]); *(u32x2*)(gPVT + cj * 64 + r0) = o; } }
    lds_barrier();
}

__device__ __forceinline__ void rwkv_seq_unit(const Ctx& c, int l, int b, int h) {
    int w = c.wave; asm volatile("" : "+s"(w)); const int lane = hw_lane(), tid = w * 64 + lane;
    bf16_t* YBR = (bf16_t*)(c.ws + WS_YBR); const bf16_t* PROJ = (const bf16_t*)(c.ws + WS_PROJ);
    LAS bf16_t* TA = (LAS bf16_t*)c.lds; LAS bf16_t* RH = TA + 64 * 72; LAS bf16_t* ARB = RH + 64 * 72; LAS bf16_t* BHT = ARB + 64 * 72; LAS bf16_t* HT = BHT + 64 * 72; LAS bf16_t* PT = HT + 64 * 72;
    LAS float* ssc = (LAS float*)(PT + 64 * 72); LAS float* rsum = ssc + 128; LAS float* rsq = rsum + 128;
    for (int i = tid; i < 64 * 72; i += NTHR) HT[i] = 0;
    const int kt = w & 3, vh = w >> 2;
    f32x4 Hst[1][2]; Hst[0][0] = (f32x4){0.f, 0.f, 0.f, 0.f}; Hst[0][1] = Hst[0][0];
    f32x4 lnw[2], lnb[2];
#pragma unroll
    for (int i = 0; i < 2; ++i) { lnw[i] = *(const f32x4*)(inp(c, I_LNW) + l * 1024 + h * 64 + 32 * vh + 16 * i + 4 * (lane >> 4)); lnb[i] = *(const f32x4*)(inp(c, I_LNB) + l * 1024 + h * 64 + 32 * vh + 16 * i + 4 * (lane >> 4)); }
    u32x4 pT[3], pR[3], pAB[3], pBH[3]; float psc[3] = {0.f, 0.f, 0.f}; u32x2 pPV[3][2], pYV[3][2], pKV[3][2], pVV[3][2], pGG[3][2];
#define RW_ISSUE(cc, S_) do { const int u_ = (b * HC + h) * NCH + (cc); const bf16_t* gU_ = (const bf16_t*)(c.ws + WS_RW) + (size_t)u_ * RW_N * 4096; const float* gSC_ = (const float*)(c.ws + WS_RW_SC) + (size_t)u_ * 128; \
        const int o_ = (tid >> 3) * 64 + (tid & 7) * 8; pT[S_] = *(const u32x4*)(gU_ + RW_TA * 4096 + o_); pR[S_] = *(const u32x4*)(gU_ + RW_RH * 4096 + o_); pAB[S_] = *(const u32x4*)(gU_ + RW_ARB * 4096 + o_); pBH[S_] = *(const u32x4*)(gU_ + RW_BHT * 4096 + o_); \
        psc[S_] = tid < 128 ? gSC_[tid] : 0.f; \
        _Pragma("unroll") for (int j_ = 0; j_ < 2; ++j_) { const int dv_ = 32 * vh + 16 * j_ + (lane & 15), q4_ = 16 * kt + 4 * (lane >> 4); const int tc_ = 16 * kt + (lane & 15), dv0_ = 32 * vh + 16 * j_ + 4 * (lane >> 4); \
            pPV[S_][j_] = *(const u32x2*)(gU_ + RW_PVT * 4096 + dv_ * 64 + q4_); pKV[S_][j_] = *(const u32x2*)(gU_ + RW_KVT * 4096 + dv_ * 64 + q4_); \
            pYV[S_][j_] = *(const u32x2*)(gU_ + RW_YV * 4096 + tc_ * 64 + dv0_); pVV[S_][j_] = *(const u32x2*)(gU_ + RW_V * 4096 + tc_ * 64 + dv0_); pGG[S_][j_] = *(const u32x2*)(gU_ + RW_G * 4096 + tc_ * 64 + dv0_); } } while (0)
#define RW_CHUNK(cch, S) do { \
        int t0, Lv; chunk_range((cch), t0, Lv); \
        const size_t row0 = (size_t)b * TP + t0; \
        { const int o = (tid >> 3) * 72 + (tid & 7) * 8; *(LAS u32x4*)(TA + o) = pT[S]; *(LAS u32x4*)(RH + o) = pR[S]; *(LAS u32x4*)(ARB + o) = pAB[S]; *(LAS u32x4*)(BHT + o) = pBH[S]; } \
        if (tid < 128) ssc[tid] = psc[S]; \
        const u32x2 cPV0 = pPV[S][0], cPV1 = pPV[S][1], cYV0 = pYV[S][0], cYV1 = pYV[S][1], cKV0 = pKV[S][0], cKV1 = pKV[S][1], cVV0 = pVV[S][0], cVV1 = pVV[S][1], cGG0 = pGG[S][0], cGG1 = pGG[S][1]; \
        if ((cch) + 3 < NCH) RW_ISSUE((cch) + 3, S); \
        lds_barrier(); \
        f32x4 ay[2][1]; \
        { f32x4 ap[1][2]; ap[0][0] = (f32x4){0.f, 0.f, 0.f, 0.f}; ap[0][1] = ap[0][0]; ay[0][0] = ap[0][0]; ay[1][0] = ap[0][0]; \
          mma_lds<1, 2, 2>(ap, TA, 72, 16 * kt, HT, 72, 32 * vh, lane); \
          mma_lds<2, 1, 2>(ay, HT, 72, 32 * vh, RH, 72, 16 * kt, lane); \
        _Pragma("unroll") \
          for (int j = 0; j < 2; ++j) { const int dv = 32 * vh + 16 * j + (lane & 15), tq = 16 * kt + 4 * (lane >> 4); const u32x2 pv = j == 0 ? cPV0 : cPV1; \
              u32x2 o; o.x = pk2(ap[0][j][0] + __uint_as_float(pv.x << 16), ap[0][j][1] + __uint_as_float(pv.x & 0xffff0000u)); o.y = pk2(ap[0][j][2] + __uint_as_float(pv.y << 16), ap[0][j][3] + __uint_as_float(pv.y & 0xffff0000u)); \
              *(LAS u32x2*)(PT + dv * 72 + tq) = o; } \
        _Pragma("unroll") \
          for (int i = 0; i < 2; ++i) { const int tcol = 16 * kt + (lane & 15), dv0 = 32 * vh + 16 * i + 4 * (lane >> 4); const u32x2 yv = i == 0 ? cYV0 : cYV1; \
              ay[i][0][0] += __uint_as_float(yv.x << 16); ay[i][0][1] += __uint_as_float(yv.x & 0xffff0000u); ay[i][0][2] += __uint_as_float(yv.y << 16); ay[i][0][3] += __uint_as_float(yv.y & 0xffff0000u); } } \
        lds_barrier(); \
        { mma_lds<2, 1, 2>(ay, PT, 72, 32 * vh, ARB, 72, 16 * kt, lane); \
        _Pragma("unroll") \
          for (int j = 0; j < 2; ++j) { const int dv = 32 * vh + 16 * j + (lane & 15), dk0 = 16 * kt + 4 * (lane >> 4); const u32x2 kv = j == 0 ? cKV0 : cKV1; \
              Hst[0][j][0] = Hst[0][j][0] * ssc[dk0] + __uint_as_float(kv.x << 16); Hst[0][j][1] = Hst[0][j][1] * ssc[dk0 + 1] + __uint_as_float(kv.x & 0xffff0000u); \
              Hst[0][j][2] = Hst[0][j][2] * ssc[dk0 + 2] + __uint_as_float(kv.y << 16); Hst[0][j][3] = Hst[0][j][3] * ssc[dk0 + 3] + __uint_as_float(kv.y & 0xffff0000u); } \
          mma_lds<1, 2, 2>(Hst, BHT, 72, 16 * kt, PT, 72, 32 * vh, lane); \
        _Pragma("unroll") \
          for (int j = 0; j < 2; ++j) { u32x2 o; o.x = pk2(Hst[0][j][0], Hst[0][j][1]); o.y = pk2(Hst[0][j][2], Hst[0][j][3]); *(LAS u32x2*)(HT + (32 * vh + 16 * j + (lane & 15)) * 72 + 16 * kt + 4 * (lane >> 4)) = o; } \
          const int tcol = 16 * kt + (lane & 15); \
          float sm = 0.f, sq = 0.f; \
        _Pragma("unroll") \
          for (int i = 0; i < 2; ++i) \
        _Pragma("unroll") \
              for (int r = 0; r < 4; ++r) { sm += ay[i][0][r]; sq += ay[i][0][r] * ay[i][0][r]; } \
          sm += __shfl_xor(sm, 16); sm += __shfl_xor(sm, 32); sq += __shfl_xor(sq, 16); sq += __shfl_xor(sq, 32); \
          if (lane < 16) { rsum[vh * 64 + tcol] = sm; rsq[vh * 64 + tcol] = sq; } \
          lds_barrier(); \
          const float mean = (rsum[tcol] + rsum[64 + tcol]) * (1.f / 64.f); const float var = fmaxf((rsq[tcol] + rsq[64 + tcol]) * (1.f / 64.f) - mean * mean, 0.f); const float rstd = rsqrtf(var + 64e-5f); \
          const float bon = ssc[64 + tcol]; \
          if (tcol < Lv) { \
        _Pragma("unroll") \
              for (int i = 0; i < 2; ++i) { const int dv0 = 32 * vh + 16 * i + 4 * (lane >> 4); const u32x2 vv = i == 0 ? cVV0 : cVV1, gg = i == 0 ? cGG0 : cGG1; \
                  const float o0 = ((ay[i][0][0] - mean) * rstd * lnw[i][0] + lnb[i][0] + bon * __uint_as_float(vv.x << 16)) * __uint_as_float(gg.x << 16); \
                  const float o1 = ((ay[i][0][1] - mean) * rstd * lnw[i][1] + lnb[i][1] + bon * __uint_as_float(vv.x & 0xffff0000u)) * __uint_as_float(gg.x & 0xffff0000u); \
                  const float o2 = ((ay[i][0][2] - mean) * rstd * lnw[i][2] + lnb[i][2] + bon * __uint_as_float(vv.y << 16)) * __uint_as_float(gg.y << 16); \
                  const float o3 = ((ay[i][0][3] - mean) * rstd * lnw[i][3] + lnb[i][3] + bon * __uint_as_float(vv.y & 0xffff0000u)) * __uint_as_float(gg.y & 0xffff0000u); \
                  u32x2 o; o.x = pk2(o0, o1); o.y = pk2(o2, o3); *(u32x2*)(YBR + (row0 + tcol) * YLD + 2048 + h * 64 + dv0) = o; } } } \
        lds_barrier(); \
    } while (0)
    RW_ISSUE(0, 0); RW_ISSUE(1, 1); RW_ISSUE(2, 2);
    lds_barrier();
    for (int cch = 0; cch < NCH; cch += 3) { RW_CHUNK(cch, 0); RW_CHUNK(cch + 1, 1); RW_CHUNK(cch + 2, 2); }
#undef RW_CHUNK
#undef RW_ISSUE
    const int lane_e = hw_lane(), tid_e = w * 64 + lane_e;
    float* os = c.out + O_PRS + (((size_t)l * BATCH + b) * HC + h) * DHC * DHC;
#pragma unroll
    for (int j = 0; j < 2; ++j) *(f32x4*)(os + (size_t)(32 * vh + 16 * j + (lane_e & 15)) * 64 + 16 * kt + 4 * (lane_e >> 4)) = Hst[0][j];
    { float* osh = c.out + O_PRSH + ((size_t)l * BATCH + b) * NCC; const bf16_t* last = PROJ + ((size_t)b * TP + TP - 1) * NPROJ + PC0;
      int cidx = -1;
      if (tid_e < 64) cidx = h * 64 + tid_e; else if (tid_e < 128) cidx = 1024 + h * 64 + (tid_e - 64); else if (tid_e < 192) cidx = 2048 + h * 64 + (tid_e - 128); else if (tid_e < 448 && h == 0) cidx = 3072 + (tid_e - 192);
      if (cidx >= 0) osh[cidx] = bf2f(last[cidx]); }
    lds_barrier();
}

__device__ __forceinline__ void mlstm_post_rows(const Ctx& c, int l, int bb, int h, int vs) {
    int w = c.wave; asm volatile("" : "+s"(w)); const int lane = hw_lane();
    const float* HAo = (const float*)(c.ws + WS_HA); const bf16_t* PROJ = (const bf16_t*)(c.ws + WS_PROJ); bf16_t* YBR = (bf16_t*)(c.ws + WS_YBR);
    const f32x4 wv = *(const f32x4*)(inp(c, I_MNW) + l * 1024 + h * 256 + 4 * lane);
    constexpr int RQ = TP / 4;
    const size_t row0 = (size_t)bb * TP + (size_t)vs * RQ;
#pragma unroll 1
    for (int i = w; i < RQ; i += 4 * NWAVES) {
        f32x4 v[4]; u32x2 og[4];
#pragma unroll
        for (int k = 0; k < 4; ++k) { const int ii = i + NWAVES * k < RQ ? i + NWAVES * k : i; const size_t row = row0 + ii;
            v[k] = *(const f32x4*)(HAo + row * 1024 + h * 256 + 4 * lane); og[k] = *(const u32x2*)(PROJ + row * NPROJ + PA_O + h * 256 + 4 * lane); }
#pragma unroll
        for (int k = 0; k < 4; ++k) { if (i + NWAVES * k >= RQ) continue; const size_t row = row0 + i + NWAVES * k;
            const float ss = wave_sum((v[k].x * v[k].x + v[k].y * v[k].y) + (v[k].z * v[k].z + v[k].w * v[k].w)); const float rs = rsqrtf(ss * (1.f / 256.f) + 1e-6f);
            const float o0 = sigmoidf_(__uint_as_float(og[k].x << 16)), o1 = sigmoidf_(__uint_as_float(og[k].x & 0xffff0000u)), o2 = sigmoidf_(__uint_as_float(og[k].y << 16)), o3 = sigmoidf_(__uint_as_float(og[k].y & 0xffff0000u));
            u32x2 o; o.x = pk2(o0 * v[k].x * rs * wv.x, o1 * v[k].y * rs * wv.y); o.y = pk2(o2 * v[k].z * rs * wv.z, o3 * v[k].w * rs * wv.w);
            *(u32x2*)(YBR + row * YLD + h * 256 + 4 * lane) = o; }
    }
}
__device__ __forceinline__ void phase_mix_prep(const Ctx& c, int l) {
    unsigned* qctr = (unsigned*)(c.ws + WS_CTL) + 8192 + (12 + 3 * l) * 64;
    volatile LAS unsigned* MISC = (volatile LAS unsigned*)(c.lds + LDS_MISC);
#define QBEGIN(k, n) int qn_ = 0; if (c.wave == 0 && hw_lane() == 0) qn_ = (int)__hip_atomic_fetch_add(qctr + 64 * (k), (unsigned)(n), __ATOMIC_RELAXED, __HIP_MEMORY_SCOPE_AGENT)
#define QNEXT(k, n) ({ lds_barrier(); if (c.wave == 0 && hw_lane() == 0) MISC[12] = (unsigned)qn_; lds_barrier(); const int u_ = (int)MISC[12]; \
        if (c.wave == 0 && hw_lane() == 0) qn_ = (int)__hip_atomic_fetch_add(qctr + 64 * (k), (unsigned)(n), __ATOMIC_RELAXED, __HIP_MEMORY_SCOPE_AGENT); u_; })
#ifndef NO_RWP
    { QBEGIN(0, 1); for (;;) { const int u = QNEXT(0, 1); if (u >= NU_RW) break; rwkv_prep_unit(c, l, u); } }
#endif
#ifndef ONLY_RWP
    { QBEGIN(1, 1); for (;;) { const int u = QNEXT(1, 1); if (u >= NU_ML) break; mlstm_prep_unit(c, l, u); } }
    { QBEGIN(2, 1); for (;;) { const int u = QNEXT(2, 1); if (u >= NU_GD) break; gdn_prep_unit(c, l, u); } }
#endif
#if TAILCONV
    { QBEGIN(6 - 2 * l, 8); for (;;) { const int u = QNEXT(6 - 2 * l, 8); if (u >= WBR_DYN) break; convert_one(c, l, CO_BR + WBR_G1 + u + c.wave); } }
#endif
}

__device__ __forceinline__ void phase_mix_seq(const Ctx& c, int l, int rep = 0) {
    constexpr int W_ML = BATCH * HA * 4, W_GD = BATCH * HB, W_RW = BATCH * HC, NPU = W_ML + W_GD + W_RW;
    const int b = c.bid;
    if (b < W_ML && (rep < 2 || rep == 2)) mlstm_seq_unit(c, l, b >> 4, (b >> 2) & 3, b & 3);
    if (b < W_ML && rep == 0) {
        mini_barrier((unsigned*)(c.ws + WS_CTL) + 8192 + (32 + 16 * l + (b >> 2)) * 64, 4u, c.wave);
        mlstm_post_rows(c, l, b >> 4, (b >> 2) & 3, b & 3); }
    if (b >= W_ML && b < W_ML + W_GD && (rep < 2 || rep == 3)) { const int r = b - W_ML; gdn_seq_unit(c, l, r / HB, r % HB); }
#ifndef NO_RWS
    if (b >= W_ML + W_GD && b < NPU && (rep < 2 || rep == 4)) { const int r = b - W_ML - W_GD; rwkv_seq_unit(c, l, r / HC, r % HC); }
#endif
    unsigned* qctr = (unsigned*)(c.ws + WS_CTL) + 8192 + (3 * l + 6 * (rep == 1 ? 1 : 0)) * 64;
    volatile LAS unsigned* MISC = (volatile LAS unsigned*)(c.lds + LDS_MISC);
    { QBEGIN(0, 1); for (;;) { const int u = QNEXT(0, 1); if (u >= NB * HA) break; mlstm_unit_s(c, l, u / HA, u % HA); } }
    { QBEGIN(1, 2); for (;;) { const int u0 = QNEXT(1, 2); if (u0 >= NB * HB) break;
        for (int u = u0; u < u0 + 2 && u < NB * HB; ++u) gdn_unit_s(c, l, u / HB, u % HB); } }
    int cached_h = -1;
    { QBEGIN(2, 4); for (;;) { const int u0 = QNEXT(2, 4); if (u0 >= NB * HC) break;
        rwkv_unit4(c, l, u0 % NB, u0 / NB, cached_h); } }
#if TAILCONV
    if (rep == 0) { unsigned* qctr = (unsigned*)(c.ws + WS_CTL) + 8192 + (20 + l) * 64; const int nq = CI_O + (l == 0 ? WIN1_SEQ : 0);
        QBEGIN(0, 8); for (;;) { const int u = QNEXT(0, 8); if (u >= nq) break; const int it = u + c.wave; if (it < CI_O) convert_one(c, l, CO_O + it); else convert_one(c, 1, it - CI_O); } }
#endif
#undef QBEGIN
#undef QNEXT
}

__device__ __forceinline__ void phase_combine(const Ctx& c0, const int nblk) {
    Ctx c = c0; c.lane = hw_lane(); c.tid = c.wave * 64 + c.lane; c.G = nblk;
    const u32x4* B = (const u32x4*)(c.ws + WS_MRGF); u32x4* M = (u32x4*)(c.ws + WS_MRG);
    constexpr size_t NV = (size_t)MP * D / 8, V0 = (size_t)8192 * D / 8;
    for (size_t i = V0 + (size_t)c.bid * NTHR + c.tid; i < NV; i += (size_t)c.G * NTHR * 2) {
        const size_t i2 = i + (size_t)c.G * NTHR; const bool two = i2 < NV;
        u32x4 a[2][3];
#pragma unroll
        for (int z = 0; z < 3; ++z) { a[0][z] = B[i + z * NV]; a[1][z] = two ? B[i2 + z * NV] : (u32x4){0u, 0u, 0u, 0u}; }
#pragma unroll
        for (int q = 0; q < 2; ++q) { u32x4 o; unsigned* po = (unsigned*)&o;
            const unsigned* p0 = (const unsigned*)&a[q][0]; const unsigned* p1 = (const unsigned*)&a[q][1]; const unsigned* p2 = (const unsigned*)&a[q][2];
#pragma unroll
            for (int e = 0; e < 4; ++e) po[e] = pk2(__uint_as_float(p0[e] << 16) + __uint_as_float(p1[e] << 16) + __uint_as_float(p2[e] << 16),
                                                   __uint_as_float(p0[e] & 0xffff0000u) + __uint_as_float(p1[e] & 0xffff0000u) + __uint_as_float(p2[e] & 0xffff0000u));
            if (q == 0) M[i] = o; else if (two) M[i2] = o; }
    }
}

#define IN(k) (lo <= (k) && (k) < hi)
#ifdef ONLY_G
#define GSEL(k) ((k) == ONLY_G)
#else
#define GSEL(k) true
#endif
#if MK_MULTI
#define SEAM(k) do { } while (0)
#else
#define SEAM(k) do { if (IN(k) && IN((k) + 1)) xcd_barrier(bar, c.wave); } while (0)
#endif
template <int L> __device__ __forceinline__ void layer_phases(const Ctx& c, const XcdBarrier& bar, const int lo, const int hi) {
    constexpr int pb = 1 + 10 * L;
#ifndef SKIP_NORM
    if (IN(pb + 0)) { phase_norm_gates<L == 0>(c, inp(c, I_NMIX) + (size_t)L * D, (const float*)(c.ws + WS_WSG) + (size_t)L * NSG * D); if (REP_MISC > 1) phase_norm_gates<L == 0>(c, inp(c, I_NMIX) + (size_t)L * D, (const float*)(c.ws + WS_WSG) + (size_t)L * NSG * D); }
#endif
    SEAM(pb + 0);
    if (IN(pb + 1) && GSEL(1)) {
        pg8::Gemm<D, D, D> g{(const bf16_t*)(c.ws + WS_HN), (const bf16_t*)(c.ws + WS_WIN) + (size_t)L * NPROJ * D};
        pg8::TileOrder<MP, NPROJ, 1> S; S.init(c.G, c.bid);
        pg8::EpiBf16<0> E{(bf16_t*)(c.ws + WS_PROJ), NPROJ};
        pg8::gemm_phase(c.lds, c.wave, g, S, E);
        if (REP_G1 > 1) pg8::gemm_phase(c.lds, c.wave, g, S, E);
#if TAILCONV
        convert_items(c, L, CO_BR, CO_BR + WBR_G1, (33 * 69) % c.G);
#endif
    }
    SEAM(pb + 1);
#ifndef SKIP_MIX
    if (IN(pb + 2)) { phase_mix_prep(c, L); if (REP_PREP > 1) phase_mix_prep(c, L); }
    SEAM(pb + 2);
#ifndef ONLY_RWP
    if (IN(pb + 3)) { phase_mix_seq(c, L); if (REP_SEQ > 1) { xcd_barrier(bar, c.wave); phase_mix_seq(c, L, REP_SEQ == 2 ? 1 : REP_SEQ == 3 ? 0 : REP_SEQ - 2); } }
#endif
    SEAM(pb + 3);
#endif
    if (IN(pb + 5) && GSEL(3)) {
        pg8::Gemm<YLD, 1024, 1024, 1024 * 2, (long)D * 1024 * 2> g{(const bf16_t*)(c.ws + WS_YBR), (const bf16_t*)(c.ws + WS_WBR) + (size_t)L * 3 * D * 1024};
        { pg8::TileOrder<8192, D, 3> S; S.init(c.G, c.bid);
          pg8::EpiGateAcc E{(const bf16_t*)(c.ws + WS_PROJ) + PG0, NPROJ, (bf16_t*)(c.ws + WS_MRG), D};
          pg8::gemm_phase(c.lds, c.wave, g, S, E); }
        { pg8::TailOrder<32, D, 3> S; S.init(c.G, c.bid);
          pg8::EpiGateBf16 E{(const bf16_t*)(c.ws + WS_PROJ) + PG0, NPROJ, (bf16_t*)(c.ws + WS_MRGF), D, (size_t)MP * D};
          pg8::gemm_phase(c.lds, c.wave, g, S, E); }
#if TAILCONV
        convert_items(c, L, CO_U, CO_U + CI_U / 2, (3 * 8) % c.G);
#endif
        if (c.G >= 24) {
            if (c.bid < 24) { unsigned* ctr = (unsigned*)(c.ws + WS_CTL) + 8192 + (96 + L) * 64; wg_signal(ctr, c.wave); wg_wait(ctr, 24u, c.wave); phase_combine(c, 24); }
        } else { xcd_barrier(bar, c.wave); phase_combine(c, c.G); }
    }
    SEAM(pb + 5);
    if (IN(pb + 6) && GSEL(4)) {
        pg8::Gemm<D, D, D> g{(const bf16_t*)(c.ws + WS_MRG), (const bf16_t*)(c.ws + WS_WOUT) + (size_t)L * D * D};
        pg8::TileOrder<MP, D, 1> S; S.init(c.G, c.bid);
        if (L == 0) { pg8::EpiResidSrc E{inp(c, I_META), inp(c, I_XP), inp(c, I_XS), (float*)(c.ws + WS_X), D}; pg8::gemm_phase(c.lds, c.wave, g, S, E); }
        else { pg8::EpiResid E{(const float*)(c.ws + WS_X), (float*)(c.ws + WS_X), D}; pg8::gemm_phase(c.lds, c.wave, g, S, E); }
#if TAILCONV
        convert_items(c, L, CO_U + CI_U / 2, CO_D + CI_D / 4, (33 * 8) % c.G);
#endif
    }
    SEAM(pb + 6);
#ifndef SKIP_NORM
    if (IN(pb + 7)) { phase_norm<false>(c, inp(c, I_NMLP) + (size_t)L * D, nullptr); if (REP_MISC > 1) phase_norm<false>(c, inp(c, I_NMLP) + (size_t)L * D, nullptr); }
#endif
    SEAM(pb + 7);
    if (IN(pb + 8) && GSEL(6)) {
        pg8::Gemm<D, D, D> g{(const bf16_t*)(c.ws + WS_HN), (const bf16_t*)(c.ws + WS_WUP) + (size_t)L * DFF * D};
        pg8::TileOrder<MP, DFF, 1> S; S.init(c.G, c.bid);
        pg8::EpiBf16<1> E{(bf16_t*)(c.ws + WS_PROJ), DFF};
        pg8::gemm_phase(c.lds, c.wave, g, S, E);
#if TAILCONV
        convert_items(c, L, CO_D + CI_D / 4, C_PER_L, (33 * 32) % c.G);
        if (L == 0) convert_items(c, 1, WIN1_SEQ, WIN1_G4, (33 * 32) % c.G);
#endif
    }
    SEAM(pb + 8);
    if (IN(pb + 9) && GSEL(7)) {
        pg8::Gemm<DFF, DFF, DFF> g{(const bf16_t*)(c.ws + WS_PROJ), (const bf16_t*)(c.ws + WS_WDN) + (size_t)L * D * DFF};
        pg8::TileOrder<8192, D, 1> S; S.init(c.G, c.bid);
        pg8::EpiResid E{(const float*)(c.ws + WS_X), (float*)(c.ws + WS_X), D};
        pg8::gemm_phase(c.lds, c.wave, g, S, E);
        unsigned* pdone = (unsigned*)(c.ws + WS_CTL) + 8192 + 64 * 64;
        const bool fin_tail = FIN_IN_TAIL && L == 1 && c.G == 256;
        if (fin_tail) { pg8::Unit u0; if (S.next(0, u0)) wg_signal(pdone + 64 * u0.pm, c.wave); }
        const pg8::StreamX sx{(float*)(c.ws + WS_SLOTS), (unsigned*)(c.ws + WS_CTL) + FLAG_W0 + (3 * L + 2) * 256 * 64, (unsigned*)(c.ws + WS_CTL) + 4096 + XB_TMO};
        pg8::SplitOrder<32, D, 4, 32> S2; S2.init(c.G, c.bid);
        pg8::gemm_phase(c.lds, c.wave, g, S2, E, sx);
        if (c.bid >= 32 && c.bid < 40) pg8::split_reduce<0>(c.wave, (float*)(c.ws + WS_X), nullptr, D, sx, 32, c.bid - 32, 8, 4);
#if TAILCONV
        if (L == 0) convert_items(c, 1, WIN1_G4, CI_IN, 40);
#endif
        if (fin_tail && c.bid >= 40) {
            const int r = c.bid - 40, p = r & 31, k = r >> 5, cnt = (216 - p + 31) >> 5;
            wg_wait(pdone + 64 * p, 8u, c.wave);
            final_rows(c, 256 * p, 256 * p + 256, k * NWAVES + c.wave, cnt * NWAVES);
        }
    }
    SEAM(pb + 9);
}

__global__ void __launch_bounds__(NTHR, 2) mega(Params p) {
    extern __shared__ __attribute__((aligned(16))) unsigned char lds_raw[];
    Ctx c{p.out, p.ws, (LAS unsigned char*)lds_raw, (int)threadIdx.x, (int)(threadIdx.x & 63), __builtin_amdgcn_readfirstlane((int)(threadIdx.x >> 6)), (int)gridDim.x, (int)blockIdx.x};
    volatile LAS unsigned* MISC = (volatile LAS unsigned*)(c.lds + LDS_MISC);
    if (c.tid < 16) MISC[c.tid] = 0u;
    if (c.tid < 38) ((LAS unsigned long long*)(c.lds + LDS_MISC + 64))[c.tid] = (unsigned long long)p.in[c.tid];
    __syncthreads();
    unsigned* barw = (unsigned*)(c.ws + WS_CTL) + 4096;
    XcdBarrier bar; bar.bar = barw; bar.x = 0; bar.st = MISC + 8;
#if !MK_MULTI
    bar = xcd_barrier_post(barw, MISC + 8);
#endif
    const int lo = p.ph_lo, hi = p.ph_hi;
#ifndef SKIP_PREP
    if (IN(0)) { phase_prep(c); if (REP_MISC > 1) phase_prep(c); }
#endif
    SEAM(0);
    layer_phases<0>(c, bar, lo, hi);
    layer_phases<1>(c, bar, lo, hi);
#ifndef SKIP_NORM
    if (IN(21)) { phase_final(c); if (REP_MISC > 1) phase_final(c); }
#endif
}
#undef IN
#undef SEAM

extern "C" void kernel_launch(void* const* d_in, const int* in_sizes, int n_in, void* d_out, int out_size, void* d_ws, size_t ws_size, hipStream_t stream) {
    static int grid = 0;
    if (grid == 0) {
        if (n_in != 38 || (size_t)out_size != O_END || ws_size < WS_END) { fprintf(stderr, "kernel_launch: unexpected shapes (n_in %d out %d ws %zu need %zu)\n", n_in, out_size, ws_size, (size_t)WS_END); grid = -1; return; }
        int dev = 0, cus = 0, per_cu = 0;
        if (hipGetDevice(&dev) != hipSuccess || hipDeviceGetAttribute(&cus, hipDeviceAttributeMultiprocessorCount, dev) != hipSuccess) { grid = -1; return; }
        if (hipFuncSetAttribute((const void*)mega, hipFuncAttributeMaxDynamicSharedMemorySize, LDS_BYTES) != hipSuccess) { fprintf(stderr, "kernel_launch: hipFuncSetAttribute failed\n"); grid = -1; return; }
        if (hipOccupancyMaxActiveBlocksPerMultiprocessor(&per_cu, (const void*)mega, NTHR, LDS_BYTES) != hipSuccess || per_cu < 1) { fprintf(stderr, "kernel_launch: occupancy query says %d\n", per_cu); (void)hipGetLastError(); grid = -1; return; }
        grid = cus;
    }
    if (grid < 0) return;
    (void)hipMemsetAsync((char*)d_ws + WS_CTL, 0, CTL_BYTES, stream);
    Params p{};
    for (int i = 0; i < 38; ++i) p.in[i] = (const float*)d_in[i];
    p.out = (float*)d_out; p.ws = (unsigned char*)d_ws;
#if MK_MULTI
    for (int k = 0; k < NPHASE; ++k) { p.ph_lo = k; p.ph_hi = k + 1; hipLaunchKernelGGL(mega, dim3(grid), dim3(NTHR), LDS_BYTES, stream, p); }
#else
    p.ph_lo = 0; p.ph_hi = NPHASE;
    hipLaunchKernelGGL(mega, dim3(grid), dim3(NTHR), LDS_BYTES, stream, p);
#endif
}
```
